# Optimizing an MI355X kernel written in HIP

```python
import jax, jax.numpy as jnp
from jax import lax
import numpy as np

D_MODEL = 1024
BATCH = 8
SEQ = 4096
DEPTH = 2

FOURIER_GROUPS = 4
FOURIER_GROUP_DIM = 128
FOURIER_WIDTH = FOURIER_GROUPS * FOURIER_GROUP_DIM

DILATION_PATTERNS = ((128, 1), (512, 4), (2048, 16))
N_DIL_GROUPS = len(DILATION_PATTERNS)
HEADS_PER_GROUP = 4
HEAD_DIM = 64
N_ATTN_HEADS = N_DIL_GROUPS * HEADS_PER_GROUP
ATTN_WIDTH = N_ATTN_HEADS * HEAD_DIM
ATTN_OUT_WIDTH = HEADS_PER_GROUP * HEAD_DIM
Q_BLOCK = 128
ROPE_THETA = 10000.0

IN_COLS = FOURIER_WIDTH + 3 * ATTN_WIDTH + 2 * D_MODEL

FFN_DIM = 3584
N_EXPERTS = 8
TOP_K = 2
N_DENSE_LAYERS = (DEPTH + 1) // 2
N_MOE_LAYERS = DEPTH // 2

RMS_EPS = 1e-6
NEG_INF = -1e30

kernel_name = "hybrid_fourier_dilated_attn_moe_encoder"


def rms_norm(x, gain):
    xf = x.astype(jnp.float32)
    y = xf * lax.rsqrt(jnp.mean(xf * xf, axis=-1, keepdims=True) + RMS_EPS)
    return (y * gain.astype(jnp.float32)).astype(x.dtype)


def rope_tables(seq_len):
    half = HEAD_DIM // 2
    inv_freq = ROPE_THETA ** (-jnp.arange(half, dtype=jnp.float32) * 2.0 / HEAD_DIM)
    pos = jnp.arange(seq_len, dtype=jnp.float32)
    ang = pos[:, None] * inv_freq[None, :]
    return jnp.cos(ang), jnp.sin(ang)


def apply_rope(t, cos, sin):
    half = HEAD_DIM // 2
    tf = t.astype(jnp.float32)
    t1, t2 = tf[..., :half], tf[..., half:]
    c = cos[None, :, None, :]
    s = sin[None, :, None, :]
    return jnp.concatenate([t1 * c - t2 * s, t2 * c + t1 * s], axis=-1).astype(t.dtype)


def fourier_mix(u):
    b, s, _ = u.shape
    ug = u.reshape(b, s, FOURIER_GROUPS, FOURIER_GROUP_DIM).astype(jnp.float32)
    yf = jnp.fft.fft2(ug, axes=(1, 3), norm="ortho").real
    return yf.reshape(b, s, FOURIER_WIDTH).astype(u.dtype)


def dilated_window_attention(q, k, v, window, dilation):
    b, s, h, hd = q.shape
    half_span = window // (2 * dilation)
    offsets = dilation * jnp.arange(-half_span, half_span + 1)
    n_blk = s // Q_BLOCK
    q_blocks = q.reshape(b, n_blk, Q_BLOCK, h, hd).transpose(1, 0, 2, 3, 4)
    starts = jnp.arange(n_blk) * Q_BLOCK

    def one_block(args):
        q_blk, start = args
        pos = start + jnp.arange(Q_BLOCK)
        idx = pos[:, None] + offsets[None, :]
        valid = (idx >= 0) & (idx < s)
        idx_c = jnp.clip(idx, 0, s - 1)
        k_g = k[:, idx_c]
        v_g = v[:, idx_c]
        scores = jnp.einsum("bqhd,bqkhd->bhqk", q_blk, k_g).astype(jnp.float32)
        scores = jnp.where(valid[None, None], scores, NEG_INF)
        lse = jax.nn.logsumexp(scores, axis=-1)
        p = jnp.exp(scores - lse[..., None])
        out = jnp.einsum("bhqk,bqkhd->bqhd", p.astype(v.dtype), v_g)
        return out, lse.transpose(0, 2, 1)

    out, lse = lax.map(one_block, (q_blocks, starts))
    out = out.transpose(1, 0, 2, 3, 4).reshape(b, s, h, hd)
    lse = lse.transpose(1, 0, 2, 3).reshape(b, s, h)
    return out, lse


def swiglu(h, w1, w3, w2):
    return (jax.nn.silu(h @ w1) * (h @ w3)) @ w2


def moe_swiglu(h, w_router, b_router, w1, w3, w2):
    logits = (h @ w_router).astype(jnp.float32) + b_router.astype(jnp.float32)
    top_vals, top_idx = lax.top_k(logits, TOP_K)
    top_w = jax.nn.softmax(top_vals, axis=-1)
    combine = jnp.sum(jax.nn.one_hot(top_idx, N_EXPERTS, dtype=jnp.float32) * top_w[..., None], axis=-2)
    combine = combine.astype(h.dtype)
    out = jnp.zeros_like(h)
    for e in range(N_EXPERTS):
        out = out + combine[..., e:e + 1] * swiglu(h, w1[e], w3[e], w2[e])
    return out


def setup_inputs(seed: int = 0) -> dict:
    key = jax.random.key(seed)
    ks = jax.random.split(key, 20)
    f32 = jnp.float32

    def nrm(k, shape, fan_in):
        return jax.random.normal(k, shape, f32) * (fan_in ** -0.5)

    def gain(k, shape):
        return 1.0 + 0.05 * jax.random.normal(k, shape, f32)

    return {
        "x": jax.random.normal(ks[0], (BATCH, SEQ, D_MODEL), f32),
        "ln_mix": gain(ks[1], (DEPTH, D_MODEL)),
        "w_in": nrm(ks[2], (DEPTH, D_MODEL, IN_COLS), D_MODEL),
        "w_fourier": nrm(ks[3], (DEPTH, FOURIER_WIDTH, D_MODEL), FOURIER_WIDTH),
        "w_attn": nrm(ks[4], (DEPTH, ATTN_OUT_WIDTH, D_MODEL), ATTN_OUT_WIDTH),
        "w_out": nrm(ks[5], (DEPTH, D_MODEL, D_MODEL), D_MODEL),
        "ln_ffn": gain(ks[6], (DEPTH, D_MODEL)),
        "dense_w1": nrm(ks[7], (N_DENSE_LAYERS, D_MODEL, FFN_DIM), D_MODEL),
        "dense_w3": nrm(ks[8], (N_DENSE_LAYERS, D_MODEL, FFN_DIM), D_MODEL),
        "dense_w2": nrm(ks[9], (N_DENSE_LAYERS, FFN_DIM, D_MODEL), FFN_DIM),
        "router_w": nrm(ks[10], (N_MOE_LAYERS, D_MODEL, N_EXPERTS), D_MODEL),
        "router_b": 0.01 * jax.random.normal(ks[11], (N_MOE_LAYERS, N_EXPERTS), f32),
        "moe_w1": nrm(ks[12], (N_MOE_LAYERS, N_EXPERTS, D_MODEL, FFN_DIM), D_MODEL),
        "moe_w3": nrm(ks[13], (N_MOE_LAYERS, N_EXPERTS, D_MODEL, FFN_DIM), D_MODEL),
        "moe_w2": nrm(ks[14], (N_MOE_LAYERS, N_EXPERTS, FFN_DIM, D_MODEL), FFN_DIM),
        "ln_final": gain(ks[15], (D_MODEL,)),
    }


def reference(x, ln_mix, w_in, w_fourier, w_attn, w_out, ln_ffn, dense_w1, dense_w3, dense_w2,
              router_w, router_b, moe_w1, moe_w3, moe_w2, ln_final):
    b, s, _ = x.shape
    cos, sin = rope_tables(s)
    q_scale = HEAD_DIM ** -0.5
    split_points = np.cumsum([FOURIER_WIDTH, ATTN_WIDTH, ATTN_WIDTH, ATTN_WIDTH, D_MODEL]).tolist()

    for layer in range(DEPTH):
        h = rms_norm(x, ln_mix[layer])
        proj = h @ w_in[layer]
        u_f, q, k, v, gate_f, gate_a = jnp.split(proj, split_points, axis=-1)

        y_f = fourier_mix(u_f) @ w_fourier[layer]

        q = apply_rope(q.reshape(b, s, N_ATTN_HEADS, HEAD_DIM), cos, sin) * q_scale
        k = apply_rope(k.reshape(b, s, N_ATTN_HEADS, HEAD_DIM), cos, sin)
        v = v.reshape(b, s, N_ATTN_HEADS, HEAD_DIM)
        outs, lses = [], []
        for g, (window, dilation) in enumerate(DILATION_PATTERNS):
            hs = slice(g * HEADS_PER_GROUP, (g + 1) * HEADS_PER_GROUP)
            o_g, lse_g = dilated_window_attention(q[:, :, hs], k[:, :, hs], v[:, :, hs], window, dilation)
            outs.append(o_g)
            lses.append(lse_g)
        o_all = jnp.stack(outs, axis=0).astype(jnp.float32)
        alpha = jax.nn.softmax(jnp.stack(lses, axis=0), axis=0)
        o_att = jnp.einsum("gbsh,gbshd->bshd", alpha, o_all).astype(x.dtype)
        y_a = o_att.reshape(b, s, ATTN_OUT_WIDTH) @ w_attn[layer]

        g_f = jax.nn.sigmoid(gate_f.astype(jnp.float32)).astype(x.dtype)
        g_a = jax.nn.sigmoid(gate_a.astype(jnp.float32)).astype(x.dtype)
        x = x + (g_f * y_f + g_a * y_a) @ w_out[layer]

        h2 = rms_norm(x, ln_ffn[layer])
        if layer % 2 == 0:
            i = layer // 2
            x = x + swiglu(h2, dense_w1[i], dense_w3[i], dense_w2[i])
        else:
            i = layer // 2
            x = x + moe_swiglu(h2, router_w[i], router_b[i], moe_w1[i], moe_w3[i], moe_w2[i])

    return rms_norm(x, ln_final)
```

```cpp
#include <hip/hip_runtime.h>
#include <cstdio>
#include <cstdint>

namespace pg8 {
#define PG8_LAS __attribute__((address_space(3)))
typedef unsigned short bf16_t;
typedef short bf16x8 __attribute__((ext_vector_type(8)));
typedef float f32x4 __attribute__((ext_vector_type(4)));
typedef unsigned u32x4 __attribute__((ext_vector_type(4)));
typedef unsigned u32x2 __attribute__((ext_vector_type(2)));
constexpr int BM = 256, BK = 64, HALF = 128, HTB = HALF * BK * 2  , STAGE_BYTES = 8 * HTB, NXCD = 8, WGM = 8;

__host__ __device__ __forceinline__ int lds_byte(int r, int c) { const int st = (r >> 4) * 2 + (c >> 5), rr = r & 15, cc = c & 31, ob = rr * 64 + cc * 2; return st * 1024 + (ob ^ (((ob >> 9) & 1) << 5)); }
__host__ __device__ __forceinline__ void stage_rc(int b, int& R, int& C) { const int st = b / 1024, sb = b % 1024, swz = sb ^ (((sb >> 9) & 1) << 5); R = (st >> 1) * 16 + swz / 64; C = (st & 1) * 32 + (swz % 64) / 2; }
__host__ __device__ __forceinline__ int perm32(int rho) { const int n = rho >> 4, i = rho & 15; return 8 * (i >> 2) + 4 * n + (i & 3); }

struct Unit { int pm, pn, z; size_t aoff, boff; };
struct Gemm { const char* A; const char* B; unsigned lda, ldb; int K; };

struct PlainOrder {
    int nM, nN, nwg, G, c; unsigned lda, ldb;
    __device__ void init(int M, int N, int G_, int c_, unsigned lda_, unsigned ldb_) { nM = M / BM; nN = N / BM; nwg = nM * nN; G = G_; c = c_; lda = lda_; ldb = ldb_; }
    __device__ bool next(int i, Unit& u) const {
        const long L = (long)i * G + c; if (L >= nwg) return false;
        int wgid = (int)L; { const int q = nwg / NXCD, r = nwg % NXCD, xcd = wgid % NXCD, off = wgid / NXCD; wgid = (xcd < r ? xcd * (q + 1) : r * (q + 1) + (xcd - r) * q) + off; }
        const int nig = WGM * nN, gid = wgid / nig, fm = gid * WGM, gsz = (nM - fm) < WGM ? (nM - fm) : WGM;
        u.pm = fm + ((wgid % nig) % gsz); u.pn = (wgid % nig) / gsz; u.z = 0;
        u.aoff = (size_t)u.pm * BM * lda; u.boff = (size_t)u.pn * BM * ldb; return true;
    }
};

__device__ __forceinline__ unsigned cvt_pk_bf16(float lo, float hi) { unsigned r; asm volatile("v_cvt_pk_bf16_f32 %0, %1, %2" : "=v"(r) : "v"(lo), "v"(hi)); return r; }
__device__ __forceinline__ float bf_lo(unsigned w) { return __uint_as_float(w << 16); }
__device__ __forceinline__ float bf_hi(unsigned w) { return __uint_as_float(w & 0xffff0000u); }
__device__ __forceinline__ float fast_sigmoid(float x) { return __builtin_amdgcn_rcpf(1.0f + __builtin_amdgcn_exp2f(-1.4426950408889634f * x)); }
__device__ __forceinline__ u32x4 pack8(const f32x4& v0, const f32x4& v1) { u32x4 w; w.x = cvt_pk_bf16(v0[0], v0[1]); w.y = cvt_pk_bf16(v0[2], v0[3]); w.z = cvt_pk_bf16(v1[0], v1[1]); w.w = cvt_pk_bf16(v1[2], v1[3]); return w; }


struct EpiBf16 {
    static constexpr bool PERM = true;
    bf16_t* O; int ldc;
    __device__ __forceinline__ void operator()(const f32x4 (&acc)[2][2][4][2], const Unit& u, int wr, int wc, int fr, int fq) const {
        const int row0 = u.pm * BM + wr * 64 + fr, col0 = u.pn * BM + wc * 32 + 8 * fq;
#pragma unroll
        for (int ai = 0; ai < 2; ++ai)
#pragma unroll
            for (int m = 0; m < 4; ++m) { bf16_t* rowp = O + (size_t)(row0 + ai * HALF + m * 16) * ldc + col0;
#pragma unroll
                for (int bj = 0; bj < 2; ++bj) *(u32x4*)(rowp + bj * HALF) = pack8(acc[ai][bj][m][0], acc[ai][bj][m][1]); }
    }
};
struct EpiInproj {
    static constexpr bool PERM = true;
    unsigned char* ws; size_t oV, oQ, oK, oGF, oGA, oRope; float qscale;
    __device__ __forceinline__ void operator()(const f32x4 (&acc)[2][2][4][2], const Unit& u, int wr, int wc, int fr, int fq) const {
        const int row0 = u.pm * BM + wr * 64 + fr, pn = u.pn;
        if (pn < 3 || pn >= 9) {
            bf16_t* base; int ldc, colt; bool sig;
            if (pn < 3) { base = (bf16_t*)(ws + oV); ldc = 768; colt = pn * 256; sig = false; }
            else if (pn < 13) { base = (bf16_t*)(ws + oGF); ldc = 1024; colt = (pn - 9) * 256; sig = true; }
            else { base = (bf16_t*)(ws + oGA); ldc = 1024; colt = (pn - 13) * 256; sig = true; }
            const int col0 = colt + wc * 32 + 8 * fq;
#pragma unroll
            for (int ai = 0; ai < 2; ++ai)
#pragma unroll
                for (int m = 0; m < 4; ++m) { bf16_t* rowp = base + (size_t)(row0 + ai * HALF + m * 16) * ldc + col0;
#pragma unroll
                    for (int bj = 0; bj < 2; ++bj) { f32x4 v0 = acc[ai][bj][m][0], v1 = acc[ai][bj][m][1];
                        if (sig) {
#pragma unroll
                            for (int j = 0; j < 4; ++j) { v0[j] = fast_sigmoid(v0[j]); v1[j] = fast_sigmoid(v1[j]); } }
                        *(u32x4*)(rowp + bj * HALF) = pack8(v0, v1); } }
        } else {
            const bool isq = pn < 6; bf16_t* base = (bf16_t*)(ws + (isq ? oQ : oK)); const float* rope = (const float*)(ws + oRope); const int colt = (isq ? pn - 3 : pn - 6) * 256; const float sc = isq ? qscale : 1.0f;
            const int col0 = colt + wc * 32 + 8 * fq, i0 = 16 * (wc & 1) + 4 * fq;
#pragma unroll
            for (int ai = 0; ai < 2; ++ai)
#pragma unroll
                for (int m = 0; m < 4; ++m) { const int row = row0 + ai * HALF + m * 16, pos = row & 4095;
                    const f32x4 cs0 = *(const f32x4*)(rope + (size_t)(pos * 32 + i0) * 2), cs1 = *(const f32x4*)(rope + (size_t)(pos * 32 + i0) * 2 + 4);
                    bf16_t* rowp = base + (size_t)row * 768 + col0;
#pragma unroll
                    for (int bj = 0; bj < 2; ++bj) { const f32x4 v0 = acc[ai][bj][m][0], v1 = acc[ai][bj][m][1]; f32x4 o0, o1;
                        o0[0] = (v0[0] * cs0[0] - v0[1] * cs0[1]) * sc; o0[1] = (v0[1] * cs0[0] + v0[0] * cs0[1]) * sc;
                        o0[2] = (v0[2] * cs0[2] - v0[3] * cs0[3]) * sc; o0[3] = (v0[3] * cs0[2] + v0[2] * cs0[3]) * sc;
                        o1[0] = (v1[0] * cs1[0] - v1[1] * cs1[1]) * sc; o1[1] = (v1[1] * cs1[0] + v1[0] * cs1[1]) * sc;
                        o1[2] = (v1[2] * cs1[2] - v1[3] * cs1[3]) * sc; o1[3] = (v1[3] * cs1[2] + v1[2] * cs1[3]) * sc;
                        *(u32x4*)(rowp + bj * HALF) = pack8(o0, o1); }
                    asm volatile("" ::: "memory"); }
        }
    }
};
struct EpiDft {
    static constexpr bool PERM = true;
    bf16_t* Z;
    __device__ __forceinline__ void operator()(const f32x4 (&acc)[2][2][4][2], const Unit& u, int wr, int wc, int fr, int fq) const {
        const int row0 = u.z * 4096 + (u.pm & 15) * BM + wr * 64 + fr, col0 = (u.pm >> 4) * 512 + u.pn * BM + wc * 32 + 8 * fq;
#pragma unroll
        for (int ai = 0; ai < 2; ++ai)
#pragma unroll
            for (int m = 0; m < 4; ++m) { bf16_t* rowp = Z + (size_t)(row0 + ai * HALF + m * 16) * 1024 + col0;
#pragma unroll
                for (int bj = 0; bj < 2; ++bj) *(u32x4*)(rowp + bj * HALF) = pack8(acc[ai][bj][m][0], acc[ai][bj][m][1]); }
    }
};
template <bool ADD_T> struct EpiGate {
    static constexpr bool PERM = true;
    const bf16_t* G; const bf16_t* T; bf16_t* O;
    __device__ __forceinline__ void operator()(const f32x4 (&acc)[2][2][4][2], const Unit& u, int wr, int wc, int fr, int fq) const {
        const int row0 = u.pm * BM + wr * 64 + fr, col0 = u.pn * BM + wc * 32 + 8 * fq;
#pragma unroll
        for (int ai = 0; ai < 2; ++ai)
#pragma unroll
            for (int m = 0; m < 4; ++m) { const size_t off = (size_t)(row0 + ai * HALF + m * 16) * 1024 + col0;
#pragma unroll
                for (int bj = 0; bj < 2; ++bj) { const u32x4 g = *(const u32x4*)(G + off + bj * HALF); f32x4 v0 = acc[ai][bj][m][0], v1 = acc[ai][bj][m][1];
                    v0[0] *= bf_lo(g.x); v0[1] *= bf_hi(g.x); v0[2] *= bf_lo(g.y); v0[3] *= bf_hi(g.y); v1[0] *= bf_lo(g.z); v1[1] *= bf_hi(g.z); v1[2] *= bf_lo(g.w); v1[3] *= bf_hi(g.w);
                    if (ADD_T) { const u32x4 t = *(const u32x4*)(T + off + bj * HALF);
                        v0[0] += bf_lo(t.x); v0[1] += bf_hi(t.x); v0[2] += bf_lo(t.y); v0[3] += bf_hi(t.y); v1[0] += bf_lo(t.z); v1[1] += bf_hi(t.z); v1[2] += bf_lo(t.w); v1[3] += bf_hi(t.w); }
                    *(u32x4*)(O + off + bj * HALF) = pack8(v0, v1); }
                asm volatile("" ::: "memory"); }
    }
};
struct EpiResid {
    static constexpr bool PERM = false;
    const float* res; float* out; const float* rowscale;
    __device__ __forceinline__ void operator()(const f32x4 (&acc)[2][2][4][2], const Unit& u, int wr, int wc, int fr, int fq) const {
        const int row0 = u.pm * BM + wr * 64 + fr, col0 = u.pn * BM + wc * 32 + 4 * fq;
#pragma unroll
        for (int ai = 0; ai < 2; ++ai)
#pragma unroll
            for (int m = 0; m < 4; ++m) { const int row = row0 + ai * HALF + m * 16; const size_t off = (size_t)row * 1024 + col0; const float rs = rowscale ? rowscale[row] : 1.0f;
#pragma unroll
                for (int bj = 0; bj < 2; ++bj)
#pragma unroll
                    for (int n = 0; n < 2; ++n) { const f32x4 r = *(const f32x4*)(res + off + bj * HALF + n * 16); *(f32x4*)(out + off + bj * HALF + n * 16) = r + acc[ai][bj][m][n] * rs; }
                asm volatile("" ::: "memory"); }
    }
};
struct EpiSwiglu {
    static constexpr bool PERM = true;
    bf16_t* T; int ldc;
    __device__ __forceinline__ void operator()(const f32x4 (&acc)[2][2][4][2], const Unit& u, int wr, int wc, int fr, int fq) const {
        const int row0 = u.pm * BM + wr * 64 + fr, col0 = u.pn * 128 + wc * 16 + 4 * fq;
#pragma unroll
        for (int ai = 0; ai < 2; ++ai)
#pragma unroll
            for (int m = 0; m < 4; ++m) { bf16_t* rowp = T + (size_t)(row0 + ai * HALF + m * 16) * ldc + col0;
#pragma unroll
                for (int bj = 0; bj < 2; ++bj) { const f32x4 a = acc[ai][bj][m][0], b = acc[ai][bj][m][1]; f32x4 o;
#pragma unroll
                    for (int j = 0; j < 4; ++j) o[j] = a[j] * fast_sigmoid(a[j]) * b[j];
                    u32x2 w; w.x = cvt_pk_bf16(o[0], o[1]); w.y = cvt_pk_bf16(o[2], o[3]); *(u32x2*)(rowp + bj * 64) = w; } }
    }
};
template <class Epi, class Sched, bool ALIGN_EPI = true, bool SP2 = true>
__device__ __forceinline__ void gemm_phase(PG8_LAS unsigned char* lds, const Gemm g, const Sched& S, const Epi& E) {
    int tid_ = threadIdx.x; asm volatile("" : "+v"(tid_));
    const int tid = tid_, wid = __builtin_amdgcn_readfirstlane(tid >> 6), lane = tid & 63, wr = wid >> 2, wc = wid & 3, fr = lane & 15, fq = lane >> 4;
    const int K = g.K, nt = K / BK;
    unsigned voffA[2], voffB[2];
#pragma unroll
    for (int i = 0; i < 2; ++i) { int R, C; stage_rc(tid * 16 + i * 8192, R, C); const int Rb = Epi::PERM ? ((R & ~31) + perm32(R & 31)) : R;
        voffA[i] = (unsigned)R * g.lda + (unsigned)C * 2u; voffB[i] = (unsigned)Rb * g.ldb + (unsigned)C * 2u; }
    const size_t kstep = (size_t)(BK * 2);
    const size_t hstepA = (size_t)HALF * g.lda, hstepB = (size_t)HALF * g.ldb;
    const unsigned ldsw = (unsigned)wid * 1024u;
    const int aoff = lds_byte(wr * 64 + fr, fq * 8), boff = lds_byte(wc * 32 + fr, fq * 8);
#define PG8_SA(b, h) (((b) * 2 + (h)) * HTB)
#define PG8_SB(b, h) ((4 + (b) * 2 + (h)) * HTB)
#define PG8_STAGE(bufoff, gbase, voff) do { _Pragma("unroll") for (int _i = 0; _i < 2; ++_i) \
        __builtin_amdgcn_global_load_lds((const unsigned*)((const char*)(gbase) + (voff)[_i]), (PG8_LAS unsigned*)(lds + (bufoff) + ldsw + _i * 8192), 16, 0, 0); } while (0)
#define PG8_LDA(dst, b, h) do { _Pragma("unroll") for (int m = 0; m < 4; ++m) _Pragma("unroll") for (int k = 0; k < 2; ++k) dst[m][k] = *(const PG8_LAS bf16x8*)(lds + PG8_SA(b, h) + aoff + m * 2048 + k * 1024); } while (0)
#define PG8_LDB(dst, b, h) do { _Pragma("unroll") for (int n = 0; n < 2; ++n) _Pragma("unroll") for (int k = 0; k < 2; ++k) dst[n][k] = *(const PG8_LAS bf16x8*)(lds + PG8_SB(b, h) + boff + n * 2048 + k * 1024); } while (0)
#define PG8_MMA(ai, bj, At, Bt) do { __builtin_amdgcn_s_setprio(1); _Pragma("unroll") for (int m = 0; m < 4; ++m) _Pragma("unroll") for (int n = 0; n < 2; ++n) _Pragma("unroll") for (int k = 0; k < 2; ++k) \
        acc[ai][bj][m][n] = __builtin_amdgcn_mfma_f32_16x16x32_bf16(Bt[n][k], At[m][k], acc[ai][bj][m][n], 0, 0, 0); __builtin_amdgcn_s_setprio(0); } while (0)
#define PG8_WAIT_V(n) asm volatile("s_waitcnt vmcnt(" #n ")" ::: "memory")
#define PG8_WAIT_L(n) asm volatile("s_waitcnt lgkmcnt(" #n ")" ::: "memory")
#define PG8_BAR __builtin_amdgcn_s_barrier()
#define PG8_SCHED __builtin_amdgcn_sched_barrier(0)
    Unit cur, nxt; int ui = 0;
    if (!S.next(0, cur)) return;
    f32x4 acc[2][2][4][2];
#pragma unroll
    for (int a = 0; a < 2; ++a)
#pragma unroll
        for (int b = 0; b < 2; ++b)
#pragma unroll
            for (int m = 0; m < 4; ++m)
#pragma unroll
                for (int n = 0; n < 2; ++n) acc[a][b][m][n] = (f32x4){0.f, 0.f, 0.f, 0.f};
    bf16x8 At[4][2], B0[2][2], B1[2][2];
    const char* cA = g.A + cur.aoff; const char* cB = g.B + cur.boff;
    if constexpr (SP2) {
        PG8_STAGE(PG8_SB(0, 0), cB, voffB); PG8_STAGE(PG8_SB(0, 1), cB + hstepB, voffB); PG8_STAGE(PG8_SA(0, 0), cA, voffA); PG8_STAGE(PG8_SA(0, 1), cA + hstepA, voffA);
        if (wr == 1) PG8_BAR;
        PG8_WAIT_V(2); PG8_BAR;
        PG8_STAGE(PG8_SB(1, 0), cB + kstep, voffB); PG8_STAGE(PG8_SA(1, 0), cA + kstep, voffA); PG8_STAGE(PG8_SB(1, 1), cB + hstepB + kstep, voffB);
        PG8_WAIT_V(6); PG8_BAR;
    } else {
        PG8_STAGE(PG8_SB(0, 0), cB, voffB); PG8_STAGE(PG8_SA(0, 0), cA, voffA); PG8_STAGE(PG8_SB(0, 1), cB + hstepB, voffB); PG8_STAGE(PG8_SA(0, 1), cA + hstepA, voffA);
        if (wr == 1) PG8_BAR;
        PG8_WAIT_V(4); PG8_BAR;
        PG8_STAGE(PG8_SB(1, 0), cB + kstep, voffB); PG8_STAGE(PG8_SA(1, 0), cA + kstep, voffA); PG8_STAGE(PG8_SB(1, 1), cB + hstepB + kstep, voffB);
        PG8_WAIT_V(6); PG8_BAR;
    }
    for (;;) {
        const bool has_next = S.next(ui + 1, nxt);
        const char* nA = has_next ? g.A + nxt.aoff : cA; const char* nB = has_next ? g.B + nxt.boff : cB;
        for (int t = 0; t < nt; t += 2) {
            const bool last = (t == nt - 2);
            const char* a1 = cA + (size_t)(t + 1) * kstep;
            const char* a2 = last ? nA : cA + (size_t)(t + 2) * kstep; const char* b2 = last ? nB : cB + (size_t)(t + 2) * kstep;
            const char* a3 = a2 + kstep; const char* b3 = b2 + kstep;
            if constexpr (SP2) {
            PG8_LDB(B0, 0, 0); PG8_LDB(B1, 0, 1); PG8_SCHED; PG8_LDA(At, 0, 0); PG8_STAGE(PG8_SA(1, 1), a1 + hstepA, voffA);
            PG8_WAIT_V(8); PG8_WAIT_L(0); PG8_BAR; PG8_MMA(0, 0, At, B0); PG8_MMA(0, 1, At, B1); PG8_BAR; PG8_SCHED;
            PG8_LDA(At, 0, 1); PG8_STAGE(PG8_SB(0, 0), b2, voffB); PG8_STAGE(PG8_SB(0, 1), b2 + hstepB, voffB); PG8_STAGE(PG8_SA(0, 0), a2, voffA);
            PG8_WAIT_V(8); PG8_WAIT_L(0); PG8_BAR; PG8_MMA(1, 0, At, B0); PG8_MMA(1, 1, At, B1); PG8_BAR; PG8_SCHED;
            PG8_LDB(B0, 1, 0); PG8_LDB(B1, 1, 1); PG8_SCHED; PG8_LDA(At, 1, 0); PG8_STAGE(PG8_SA(0, 1), a2 + hstepA, voffA);
            PG8_WAIT_V(8); PG8_WAIT_L(0); PG8_BAR; PG8_MMA(0, 0, At, B0); PG8_MMA(0, 1, At, B1); PG8_BAR; PG8_SCHED;
            PG8_LDA(At, 1, 1); PG8_STAGE(PG8_SB(1, 0), b3, voffB); PG8_STAGE(PG8_SB(1, 1), b3 + hstepB, voffB); PG8_STAGE(PG8_SA(1, 0), a3, voffA);
            PG8_WAIT_V(8); PG8_WAIT_L(0); PG8_BAR; PG8_MMA(1, 0, At, B0); PG8_MMA(1, 1, At, B1); PG8_BAR; PG8_SCHED;
            } else {
            PG8_LDB(B0, 0, 0); PG8_SCHED; PG8_LDA(At, 0, 0); PG8_STAGE(PG8_SA(1, 1), a1 + hstepA, voffA);
            PG8_WAIT_L(8); PG8_BAR; PG8_WAIT_L(0); PG8_MMA(0, 0, At, B0); PG8_BAR; PG8_SCHED;
            PG8_LDB(B1, 0, 1); PG8_STAGE(PG8_SB(0, 0), b2, voffB);
            PG8_BAR; PG8_WAIT_L(0); PG8_MMA(0, 1, At, B1); PG8_BAR;
            PG8_LDA(At, 0, 1); PG8_STAGE(PG8_SA(0, 0), a2, voffA);
            PG8_BAR; PG8_WAIT_L(0); PG8_MMA(1, 0, At, B0); PG8_BAR; PG8_SCHED;
            PG8_STAGE(PG8_SB(0, 1), b2 + hstepB, voffB);
            PG8_WAIT_V(6); PG8_BAR; PG8_MMA(1, 1, At, B1); PG8_BAR;
            PG8_LDB(B0, 1, 0); PG8_SCHED; PG8_LDA(At, 1, 0); PG8_STAGE(PG8_SA(0, 1), a2 + hstepA, voffA);
            PG8_WAIT_L(8); PG8_BAR; PG8_WAIT_L(0); PG8_MMA(0, 0, At, B0); PG8_BAR; PG8_SCHED;
            PG8_LDB(B1, 1, 1); PG8_STAGE(PG8_SB(1, 0), b3, voffB);
            PG8_BAR; PG8_WAIT_L(0); PG8_MMA(0, 1, At, B1); PG8_BAR;
            PG8_LDA(At, 1, 1); PG8_STAGE(PG8_SA(1, 0), a3, voffA);
            PG8_BAR; PG8_WAIT_L(0); PG8_MMA(1, 0, At, B0); PG8_BAR; PG8_SCHED;
            PG8_STAGE(PG8_SB(1, 1), b3 + hstepB, voffB);
            PG8_WAIT_V(6); PG8_BAR; PG8_MMA(1, 1, At, B1); PG8_BAR;
            }
        }
        if constexpr (ALIGN_EPI) { if (wr == 0) PG8_BAR; }
        E(acc, cur, wr, wc, fr, fq);
        if (!has_next) break;
#pragma unroll
        for (int a = 0; a < 2; ++a)
#pragma unroll
            for (int b = 0; b < 2; ++b)
#pragma unroll
                for (int m = 0; m < 4; ++m)
#pragma unroll
                    for (int n = 0; n < 2; ++n) acc[a][b][m][n] = (f32x4){0.f, 0.f, 0.f, 0.f};
        cur = nxt; cA = nA; cB = nB; ++ui;
        if constexpr (ALIGN_EPI) { if (wr == 1) PG8_BAR; }
    }
    PG8_WAIT_V(0);
    if constexpr (!ALIGN_EPI) { if (wr == 0) PG8_BAR; }
    PG8_BAR;
#undef PG8_SA
#undef PG8_SB
#undef PG8_STAGE
#undef PG8_LDA
#undef PG8_LDB
#undef PG8_MMA
#undef PG8_WAIT_V
#undef PG8_WAIT_L
#undef PG8_BAR
#undef PG8_SCHED
}
}
#define GAS __attribute__((address_space(1)))
#define LAS __attribute__((address_space(3)))
typedef unsigned short bf16;
typedef unsigned v4u __attribute__((ext_vector_type(4)));
typedef float f32x4 __attribute__((ext_vector_type(4)));
typedef short bf16x8 __attribute__((ext_vector_type(8)));
typedef GAS unsigned gu32;
typedef GAS unsigned long long gu64;
#define RLX_AGENT __ATOMIC_RELAXED, __HIP_MEMORY_SCOPE_AGENT
#define LDS_WAIT() asm volatile("s_waitcnt lgkmcnt(0)" ::: "memory")
#define VM_WAIT() asm volatile("s_waitcnt vmcnt(0)" ::: "memory")
__device__ __forceinline__ unsigned long long rt() { return __builtin_amdgcn_s_memrealtime(); }
__device__ __forceinline__ unsigned f2bf(float f) { unsigned u = __builtin_bit_cast(unsigned, f); return (u + 0x7fffu + ((u >> 16) & 1u)) >> 16; }
__device__ __forceinline__ unsigned pk2(float lo, float hi) { return f2bf(lo) | (f2bf(hi) << 16); }

#define XB_TMO      128
#define XB_XCNT(j)  (256  + 64 * (j))
#define XB_XSUB(j)  (1280 + 64 * (j))
#define XB_XGEN(j)  (2304 + 64 * (j))
#define XB_TOP      3328
#define XB_TOPGEN   3392
#define XCD_BAR_WORDS 3456
#define XB_SPIN_CAP (1u << 18)

__device__ __forceinline__ unsigned xb_ld(unsigned* p)              { return __hip_atomic_load(p, __ATOMIC_RELAXED, __HIP_MEMORY_SCOPE_AGENT); }
__device__ __forceinline__ unsigned xb_add(unsigned* p, unsigned v) { return __hip_atomic_fetch_add(p, v, __ATOMIC_RELAXED, __HIP_MEMORY_SCOPE_AGENT); }
__device__ __forceinline__ unsigned xb_xcc_id() { return (unsigned)__builtin_amdgcn_s_getreg((3 << 11) | 20) & 0xFu; }
#define XB_SPIN(cond, bar) do { unsigned _sp = 0; while (cond) { __builtin_amdgcn_s_sleep(1); \
    if ((++_sp & 255u) == 0u) { if (xb_ld(&(bar)[XB_TMO])) break; if (_sp > XB_SPIN_CAP) { atomicAdd(&(bar)[XB_TMO], 1u); break; } } } } while (0)

struct XcdBarrier {
    unsigned* bar; unsigned x;
    volatile LAS unsigned* st;
};

__device__ __forceinline__ XcdBarrier xcd_barrier_post(unsigned* bar, volatile LAS unsigned* st) {
    XcdBarrier b; b.bar = bar; b.x = xb_xcc_id(); b.st = st;
    if (threadIdx.x == 0) (void)xb_add(&bar[XB_XCNT(b.x)], 1u);
    return b;
}
__device__ __forceinline__ void xcd_barrier_complete(unsigned* bar, unsigned x, unsigned& nloc, unsigned& nx) {
    const unsigned G = gridDim.x * gridDim.y * gridDim.z;
    unsigned sum, cnt, mine, sp = 0u;
    for (;;) {
        sum = 0u; cnt = 0u; mine = 0u;
#pragma nounroll
        for (unsigned j = 0; j < 16; ++j) { const unsigned c = xb_ld(&bar[XB_XCNT(j)]); sum += c; cnt += (c > 0u) ? 1u : 0u; mine = (j == x) ? c : mine; }
        if (sum == G) break;
        __builtin_amdgcn_s_sleep(1);
        if ((++sp & 255u) == 0u) { if (xb_ld(&bar[XB_TMO])) break; if (sp > XB_SPIN_CAP) { atomicAdd(&bar[XB_TMO], 1u); break; } }
    }
    nloc = mine > 0u ? mine : 1u; nx = cnt > 0u ? cnt : 1u;
}

__device__ __forceinline__ void xcd_barrier(const XcdBarrier& b) {
    asm volatile("s_waitcnt vmcnt(0)" ::: "memory");
    __syncthreads();
    if (threadIdx.x == 0) {
        unsigned* bar = b.bar;
        __builtin_amdgcn_s_waitcnt(0);
        unsigned nloc = b.st[0], nx = b.st[1];
        if (nloc == 0u) { xcd_barrier_complete(bar, b.x, nloc, nx); b.st[0] = nloc; b.st[1] = nx; }
        const unsigned old = xb_add(&bar[XB_XSUB(b.x)], 1u);
        const unsigned gen = old / nloc;
        if (old + 1u == (gen + 1u) * nloc) {
            __builtin_amdgcn_fence(__ATOMIC_RELEASE, "agent");
            asm volatile("s_waitcnt vmcnt(0)" ::: "memory");
            const unsigned og = xb_add(&bar[XB_TOP], 1u);
            const unsigned tg = og / nx;
            if (og + 1u == (tg + 1u) * nx) xb_add(&bar[XB_TOPGEN], 1u);
            else XB_SPIN(xb_ld(&bar[XB_TOPGEN]) == tg, bar);
            __builtin_amdgcn_fence(__ATOMIC_ACQUIRE, "agent");
            xb_add(&bar[XB_XGEN(b.x)], 1u);
            asm volatile("s_waitcnt vmcnt(0)" ::: "memory");
        } else {
            XB_SPIN(xb_ld(&bar[XB_XGEN(b.x)]) == gen, bar);
            __builtin_amdgcn_fence(__ATOMIC_ACQUIRE, "agent");
            asm volatile("s_waitcnt vmcnt(0)" ::: "memory");
        }
    }
    __syncthreads();
}

constexpr int NWAVES = 8;
constexpr int BATCH = 8, SEQ = 4096, DM = 1024, MTOK = BATCH * SEQ, INC = 4864, FF = 3584, NEXP = 8, AW = 768, AOW = 256;
constexpr float RMS_EPS = 1e-6f;
constexpr float QSCALE = 0.125f * 1.4426950408889634f;

constexpr size_t MiB = 1u << 20;
constexpr size_t WS_CTL = 0, CTL_ZERO_BYTES = 1 * MiB;
constexpr size_t WS_WIN = 1 * MiB;
constexpr size_t WIN_L = (size_t)INC * DM * 2;
constexpr size_t WS_WF = 20 * MiB;
constexpr size_t WS_WATT = 24 * MiB;
constexpr size_t WS_WOUT = 25 * MiB;
constexpr size_t WS_W13 = 29 * MiB;
constexpr size_t WS_W2 = 43 * MiB;
constexpr size_t WS_ROPE = 50 * MiB;
constexpr size_t WS_COMB = 51 * MiB;
constexpr size_t WS_LSE = 52 * MiB;
constexpr size_t WS_FCS = 54 * MiB;
constexpr size_t WS_H = 118 * MiB;
constexpr size_t WS_Z = WS_H;
constexpr size_t WS_UT = 182 * MiB;
constexpr size_t WS_OATT = WS_UT;
constexpr size_t WS_Q = 214 * MiB, WS_K = 262 * MiB, WS_V = 310 * MiB;
constexpr size_t WS_GF = 358 * MiB, WS_GA = 422 * MiB;
constexpr size_t WS_OG = 486 * MiB;
constexpr size_t WS_T = WS_Q, WS_MIX = 278 * MiB;
constexpr size_t WS_H2 = 118 * MiB, WS_TT = 182 * MiB;
constexpr size_t WS_M13 = 54 * MiB, WS_M2 = 166 * MiB;
constexpr size_t WS_H2B = 222 * MiB, WS_TTB = 286 * MiB;
constexpr size_t WS_END = 534 * MiB;
static_assert(WS_TTB + (size_t)MTOK * FF * 2 <= WS_END && WS_OG + (size_t)3 * MTOK * 256 * 2 <= WS_END && WS_M2 + (size_t)8 * 1024 * FF * 2 <= WS_H2B && WS_MIX + (size_t)MTOK * DM * 2 <= WS_GF, "d_ws map");

constexpr int CW_BAR = 4096;
constexpr int RING_BYTES = 131072, LDSCTL_OFF = RING_BYTES, MISC_OFF = LDSCTL_OFF + 320, LDS_BYTES = 147456;

struct Args { const float* in[16]; float* out; unsigned char* ws; };

struct Frame { LAS unsigned char* lds; volatile LAS unsigned* MISC; gu32* ctl; int tid, lane, wave, vcu, G; };

__device__ __forceinline__ float wave_sum(float v, int lane) {
#pragma unroll
    for (int o = 1; o < 64; o <<= 1) v += __int_as_float(__builtin_amdgcn_ds_bpermute((lane ^ o) << 2, __float_as_int(v)));
    return v;
}
__device__ __forceinline__ float bflo(unsigned w) { return __uint_as_float(w << 16); }
__device__ __forceinline__ float bfhi(unsigned w) { return __uint_as_float(w & 0xffff0000u); }

struct RowMap { int kind, base;
    __device__ __forceinline__ int operator()(int n) const {
        if (kind == 0) return n + base;
        if (kind == 2) return (n >> 2) * 8 + (n & 3) + base;
        if (n < 512) return n;
        if (n < 2048) { const int isk = n >= 1280, c = n - (isk ? 1280 : 512), hd = c >> 6, d = c & 63; return (isk ? 2048 : 1280) + hd * 64 + 2 * (d & 31) + (d >> 5); }
        if (n < 2816) return 512 + (n - 2048);
        return n;
    } };
__device__ __forceinline__ void tr_item(const float* W, int N, bf16* WT, int ldk, RowMap rm, LAS float* scr, int item, int lane) {
    const int nblk = N / 32, kb = item / nblk, nb = item % nblk, k0 = 64 * kb, n0 = 32 * nb;
#pragma unroll 8
    for (int i = 0; i < 32; ++i) { const int kk = 2 * i + (lane >> 5); scr[kk * 33 + (lane & 31)] = W[(size_t)(k0 + kk) * N + n0 + (lane & 31)]; }
    LDS_WAIT(); asm volatile("" ::: "memory");
    const int c = lane & 7;
#pragma unroll
    for (int j = 0; j < 4; ++j) { const int n = (lane >> 3) + 8 * j; const LAS float* s = scr + (8 * c) * 33 + n;
        v4u o; o.x = pk2(s[0 * 33], s[1 * 33]); o.y = pk2(s[2 * 33], s[3 * 33]); o.z = pk2(s[4 * 33], s[5 * 33]); o.w = pk2(s[6 * 33], s[7 * 33]);
        *(GAS v4u*)(WT + (size_t)rm(n0 + n) * ldk + k0 + 8 * c) = o; }
    LDS_WAIT(); asm volatile("" ::: "memory");
}
__device__ __forceinline__ void rms_row(const float* xrow, const f32x4 (&gn)[4], f32x4 (&v)[4], int lane) {
    const GAS f32x4* xr = (const GAS f32x4*)xrow + lane; float s = 0.f;
#pragma unroll
    for (int j = 0; j < 4; ++j) { v[j] = xr[64 * j]; s += (v[j].x * v[j].x + v[j].y * v[j].y) + (v[j].z * v[j].z + v[j].w * v[j].w); }
    const float rstd = 1.0f / sqrtf(wave_sum(s, lane) * (1.0f / DM) + RMS_EPS);
#pragma unroll
    for (int j = 0; j < 4; ++j) v[j] = v[j] * rstd * gn[j];
}
__device__ __forceinline__ void norm_phase(Frame& F, const float* x, const float* gain, bf16* out) {
    const int gw = F.vcu * NWAVES + F.wave, NGW = F.G * NWAVES;
    f32x4 gn[4];
#pragma unroll
    for (int j = 0; j < 4; ++j) gn[j] = ((const GAS f32x4*)gain)[F.lane + 64 * j];
    for (int m = gw; m < MTOK; m += NGW) { f32x4 v[4]; rms_row(x + (size_t)m * DM, gn, v, F.lane);
        GAS unsigned long long* o8 = (GAS unsigned long long*)(out + (size_t)m * DM) + F.lane;
#pragma unroll
        for (int j = 0; j < 4; ++j) o8[64 * j] = (unsigned long long)pk2(v[j].x, v[j].y) | ((unsigned long long)pk2(v[j].z, v[j].w) << 32); }
}

__device__ __forceinline__ void p0_weights(Frame& F, const Args& a) {
    LAS float* scr = (LAS float*)(F.lds + F.wave * 16384);
    const int gw = F.vcu * NWAVES + F.wave, NGW = F.G * NWAVES;
    unsigned char* ws = a.ws;
    constexpr int I_IN = 16 * (INC / 32), I_AT = 4 * 32, I_OUT = 16 * 32, I_W1 = 16 * (FF / 32), I_W2 = (FF / 64) * 32;
    constexpr int PER_L = I_IN + I_AT + I_OUT, NITEMS = 2 * PER_L + 2 * I_W1 + I_W2;
    for (int it = gw; it < NITEMS; it += NGW) {
        int r = it; const float* W; bf16* WT; int N, ldk, kind = 0, base = 0;
        if (r < 2 * PER_L) { const int l = r / PER_L; r -= l * PER_L;
            if (r < I_IN) { W = a.in[2] + (size_t)l * DM * INC; N = INC; WT = (bf16*)(ws + WS_WIN + l * WIN_L); ldk = DM; kind = 1; }
            else if (r < I_IN + I_AT) { r -= I_IN; W = a.in[4] + (size_t)l * AOW * DM; N = DM; WT = (bf16*)(ws + WS_WATT) + (size_t)l * DM * AOW; ldk = AOW; }
            else { r -= I_IN + I_AT; W = a.in[5] + (size_t)l * DM * DM; N = DM; WT = (bf16*)(ws + WS_WOUT) + (size_t)l * DM * DM; ldk = DM; } }
        else { r -= 2 * PER_L;
            if (r < I_W1) { W = a.in[7]; N = FF; WT = (bf16*)(ws + WS_W13); ldk = DM; kind = 2; }
            else if (r < 2 * I_W1) { r -= I_W1; W = a.in[8]; N = FF; WT = (bf16*)(ws + WS_W13); ldk = DM; kind = 2; base = 4; }
            else { r -= 2 * I_W1; W = a.in[9]; N = DM; WT = (bf16*)(ws + WS_W2); ldk = FF; } }
        tr_item(W, N, WT, ldk, RowMap{kind, base}, scr, r, F.lane);
    }
}
__device__ __forceinline__ void p0_moe_weights(Frame& F, const Args& a) {
    LAS float* scr = (LAS float*)(F.lds + F.wave * 16384);
    const int gw = F.vcu * NWAVES + F.wave, NGW = F.G * NWAVES;
    unsigned char* ws = a.ws;
    constexpr int I_W1 = 16 * (FF / 32), I_W2 = (FF / 64) * 32, PER_E = 2 * I_W1 + I_W2;
    for (int it = gw; it < NEXP * PER_E; it += NGW) {
        const int e = it / PER_E; int r = it - e * PER_E; const float* W; bf16* WT; int N, ldk, kind = 0, base = 0;
        if (r < I_W1) { W = a.in[12] + (size_t)e * DM * FF; N = FF; WT = (bf16*)(ws + WS_M13) + (size_t)e * 2 * FF * DM; ldk = DM; kind = 2; }
        else if (r < 2 * I_W1) { r -= I_W1; W = a.in[13] + (size_t)e * DM * FF; N = FF; WT = (bf16*)(ws + WS_M13) + (size_t)e * 2 * FF * DM; ldk = DM; kind = 2; base = 4; }
        else { r -= 2 * I_W1; W = a.in[14] + (size_t)e * FF * DM; N = DM; WT = (bf16*)(ws + WS_M2) + (size_t)e * DM * FF; ldk = FF; }
        tr_item(W, N, WT, ldk, RowMap{kind, base}, scr, r, F.lane);
    }
}
__device__ __forceinline__ void p0_tables(Frame& F, const Args& a) {
    unsigned char* ws = a.ws;
    const int gt = F.vcu * (NWAVES * 64) + F.tid, NGT = F.G * NWAVES * 64;
    float* rope = (float*)(ws + WS_ROPE);
    for (int i = gt; i < SEQ * 32; i += NGT) { const int pos = i >> 5, f = i & 31; const float inv = powf(10000.0f, -(float)f * 2.0f / 64.0f); const float ang = (float)pos * inv;
        rope[2 * i] = cosf(ang); rope[2 * i + 1] = sinf(ang); }
    bf16* fcs = (bf16*)(ws + WS_FCS);
    for (int i = gt; i < 8192 * 512; i += NGT) { const int row = i >> 9, n0 = (i & 511) * 8, k = row & 4095, part = row >> 12; unsigned w[4];
#pragma unroll
        for (int j = 0; j < 4; ++j) { float v[2];
#pragma unroll
            for (int e = 0; e < 2; ++e) { const int t = (k * (n0 + 2 * j + e)) & 4095; const float x = (float)t * (1.0f / 2048.0f); v[e] = (part ? -sinpif(x) : cospif(x)) * (1.0f / 64.0f); }
            w[j] = pk2(v[0], v[1]); }
        v4u o; o.x = w[0]; o.y = w[1]; o.z = w[2]; o.w = w[3]; *(GAS v4u*)(fcs + (size_t)row * 4096 + n0) = o; }
    LAS float* tab = (LAS float*)F.lds;
    if (F.tid < 128) tab[F.tid] = cospif((float)F.tid * (1.0f / 64.0f));
    __syncthreads();
    const int gw = F.vcu * NWAVES + F.wave, NGW = F.G * NWAVES;
    for (int it = gw; it < 2 * DM * 16; it += NGW) { const int l = it >> 14, j = (it >> 4) & 1023, kk = (it & 15) * 64 + F.lane, part = kk >> 9, g = (kk >> 7) & 3, c = kk & 127;
        const float* wf = a.in[3] + (size_t)l * 512 * DM + (size_t)(g * 128) * DM + j; float acc = 0.f; const int sh = part ? 96 : 0;
        for (int kc = 0; kc < 128; ++kc) acc += tab[(c * kc + sh) & 127] * wf[(size_t)kc * DM];
        ((bf16*)(ws + WS_WF))[(size_t)l * DM * DM + (size_t)j * DM + kk] = (bf16)f2bf(acc * 0.08838834764831845f); }
}

__device__ __forceinline__ void attn_naive_phase(Frame& F, const Args& a) {
    const bf16* Q = (const bf16*)(a.ws + WS_Q); const bf16* K = (const bf16*)(a.ws + WS_K); const bf16* V = (const bf16*)(a.ws + WS_V);
    bf16* OG = (bf16*)(a.ws + WS_OG); float* LSE = (float*)(a.ws + WS_LSE);
    const int gw = F.vcu * NWAVES + F.wave, NGW = F.G * NWAVES;
    for (int t = gw; t < BATCH * 12 * 64; t += NGW) {
        const int b = t / 768, h = (t >> 6) % 12, ql = t & 63, g = h >> 2, dl = (g == 0) ? 1 : (g == 1 ? 4 : 16), L = SEQ / dl, nqb = L >> 6, r = ql / nqb, qb = ql % nqb;
        const int iq = qb * 64 + F.lane, posq = dl * iq + r;
        float q[64], o[64];
        { const GAS v4u* qp = (const GAS v4u*)(Q + (size_t)(b * SEQ + posq) * AW + h * 64);
#pragma unroll
          for (int j = 0; j < 8; ++j) { const v4u w = qp[j]; q[8 * j] = bflo(w.x); q[8 * j + 1] = bfhi(w.x); q[8 * j + 2] = bflo(w.y); q[8 * j + 3] = bfhi(w.y); q[8 * j + 4] = bflo(w.z); q[8 * j + 5] = bfhi(w.z); q[8 * j + 6] = bflo(w.w); q[8 * j + 7] = bfhi(w.w); } }
#pragma unroll
        for (int c = 0; c < 64; ++c) o[c] = 0.f;
        float m = -1e30f, l = 0.f;
        int ik_lo = qb * 64 - 64, ik_hi = qb * 64 + 128; ik_lo = ik_lo < 0 ? 0 : ik_lo; ik_hi = ik_hi > L ? L : ik_hi;
#pragma unroll 1
        for (int ik = ik_lo; ik < ik_hi; ++ik) {
            const size_t rowoff = (size_t)(b * SEQ + dl * ik + r) * AW + h * 64;
            const v4u* kp = (const v4u*)(K + rowoff); float d = 0.f;
#pragma unroll
            for (int j = 0; j < 8; ++j) { const v4u w = kp[j];
                d += q[8 * j] * bflo(w.x) + q[8 * j + 1] * bfhi(w.x) + q[8 * j + 2] * bflo(w.y) + q[8 * j + 3] * bfhi(w.y) + q[8 * j + 4] * bflo(w.z) + q[8 * j + 5] * bfhi(w.z) + q[8 * j + 6] * bflo(w.w) + q[8 * j + 7] * bfhi(w.w); }
            const int dd = ik - iq; const float sc = (dd <= 64 && dd >= -64) ? d : -__builtin_inff();
            const float mn = fmaxf(m, sc);
            if (__any(mn != m)) { const float al = __builtin_amdgcn_exp2f(m - mn); l *= al;
#pragma unroll
                for (int c = 0; c < 64; ++c) o[c] *= al; }
            m = mn;
            const float p = __builtin_amdgcn_exp2f(sc - mn); l += p;
            const v4u* vp = (const v4u*)(V + rowoff);
#pragma unroll
            for (int j = 0; j < 8; ++j) { const v4u w = vp[j];
                o[8 * j] += p * bflo(w.x); o[8 * j + 1] += p * bfhi(w.x); o[8 * j + 2] += p * bflo(w.y); o[8 * j + 3] += p * bfhi(w.y); o[8 * j + 4] += p * bflo(w.z); o[8 * j + 5] += p * bfhi(w.z); o[8 * j + 6] += p * bflo(w.w); o[8 * j + 7] += p * bfhi(w.w); }
        }
        const float il = 1.0f / l; const size_t tok = (size_t)(b * SEQ + posq);
        GAS v4u* op = (GAS v4u*)(OG + ((size_t)g * MTOK + tok) * AOW + (h & 3) * 64);
#pragma unroll
        for (int j = 0; j < 8; ++j) { v4u w; w.x = pk2(o[8 * j] * il, o[8 * j + 1] * il); w.y = pk2(o[8 * j + 2] * il, o[8 * j + 3] * il); w.z = pk2(o[8 * j + 4] * il, o[8 * j + 5] * il); w.w = pk2(o[8 * j + 6] * il, o[8 * j + 7] * il); op[j] = w; }
        LSE[((size_t)g * MTOK + tok) * 4 + (h & 3)] = m + __builtin_amdgcn_logf(l);
    }
}
__device__ __forceinline__ void merge_phase(Frame& F, const Args& a) {
    const bf16* OG = (const bf16*)(a.ws + WS_OG); const float* LSE = (const float*)(a.ws + WS_LSE); bf16* OA = (bf16*)(a.ws + WS_OATT);
    const int gt = F.vcu * (NWAVES * 64) + F.tid, NGT = F.G * NWAVES * 64;
    for (int i = gt; i < MTOK * 4; i += NGT) {
        const float l0 = LSE[i], l1 = LSE[(size_t)MTOK * 4 + i], l2 = LSE[(size_t)2 * MTOK * 4 + i], mx = fmaxf(l0, fmaxf(l1, l2));
        float w0 = __builtin_amdgcn_exp2f(l0 - mx), w1 = __builtin_amdgcn_exp2f(l1 - mx), w2 = __builtin_amdgcn_exp2f(l2 - mx); const float inv = 1.0f / (w0 + w1 + w2); w0 *= inv; w1 *= inv; w2 *= inv;
        const GAS v4u* p0 = (const GAS v4u*)(OG + (size_t)i * 64); const GAS v4u* p1 = (const GAS v4u*)(OG + ((size_t)MTOK * 4 + i) * 64); const GAS v4u* p2 = (const GAS v4u*)(OG + ((size_t)2 * MTOK * 4 + i) * 64);
        GAS v4u* po = (GAS v4u*)(OA + (size_t)i * 64);
#pragma unroll
        for (int j = 0; j < 8; ++j) { const v4u x = p0[j], y = p1[j], z = p2[j]; v4u w;
            w.x = pk2(w0 * bflo(x.x) + w1 * bflo(y.x) + w2 * bflo(z.x), w0 * bfhi(x.x) + w1 * bfhi(y.x) + w2 * bfhi(z.x));
            w.y = pk2(w0 * bflo(x.y) + w1 * bflo(y.y) + w2 * bflo(z.y), w0 * bfhi(x.y) + w1 * bfhi(y.y) + w2 * bfhi(z.y));
            w.z = pk2(w0 * bflo(x.z) + w1 * bflo(y.z) + w2 * bflo(z.z), w0 * bfhi(x.z) + w1 * bfhi(y.z) + w2 * bfhi(z.z));
            w.w = pk2(w0 * bflo(x.w) + w1 * bflo(y.w) + w2 * bflo(z.w), w0 * bfhi(x.w) + w1 * bfhi(y.w) + w2 * bfhi(z.w));
            po[j] = w; }
    }
}
__device__ __forceinline__ void norm_router_phase(Frame& F, const float* x, const float* gain, bf16* out, const float* rw, const float* rb, float* comb) {
    LAS float* wr = (LAS float*)F.lds;
    for (int i = F.tid; i < DM * NEXP; i += NWAVES * 64) wr[i] = rw[i];
    __syncthreads();
    const int gw = F.vcu * NWAVES + F.wave, NGW = F.G * NWAVES;
    f32x4 gn[4];
#pragma unroll
    for (int j = 0; j < 4; ++j) gn[j] = ((const GAS f32x4*)gain)[F.lane + 64 * j];
    for (int m = gw; m < MTOK; m += NGW) { f32x4 v[4]; rms_row(x + (size_t)m * DM, gn, v, F.lane);
        GAS unsigned long long* o8 = (GAS unsigned long long*)(out + (size_t)m * DM) + F.lane;
#pragma unroll
        for (int j = 0; j < 4; ++j) o8[64 * j] = (unsigned long long)pk2(v[j].x, v[j].y) | ((unsigned long long)pk2(v[j].z, v[j].w) << 32);
        float lg[8];
#pragma unroll
        for (int e = 0; e < 8; ++e) lg[e] = 0.f;
#pragma unroll
        for (int j = 0; j < 4; ++j)
#pragma unroll
            for (int c = 0; c < 4; ++c) { const int k = 4 * F.lane + 256 * j + c; const f32x4 wa = *(const LAS f32x4*)(wr + k * 8), wb = *(const LAS f32x4*)(wr + k * 8 + 4); const float xv = v[j][c];
                lg[0] += xv * wa[0]; lg[1] += xv * wa[1]; lg[2] += xv * wa[2]; lg[3] += xv * wa[3]; lg[4] += xv * wb[0]; lg[5] += xv * wb[1]; lg[6] += xv * wb[2]; lg[7] += xv * wb[3]; }
#pragma unroll
        for (int e = 0; e < 8; ++e) lg[e] = wave_sum(lg[e], F.lane) + rb[e];
        int e0 = 0; float v0 = lg[0];
#pragma unroll
        for (int e = 1; e < 8; ++e) if (lg[e] > v0) { v0 = lg[e]; e0 = e; }
        int e1 = -1; float v1 = -__builtin_inff();
#pragma unroll
        for (int e = 0; e < 8; ++e) if (e != e0 && lg[e] > v1) { v1 = lg[e]; e1 = e; }
        const float w0 = 1.0f / (1.0f + expf(v1 - v0)), w1 = 1.0f - w0;
        if (F.lane < 8) comb[(size_t)F.lane * MTOK + m] = (F.lane == e0) ? w0 : ((F.lane == e1) ? w1 : 0.0f);
    }
    __syncthreads();
}
__device__ __forceinline__ void final_norm_phase(Frame& F, float* xio, const float* gain) {
    const int gw = F.vcu * NWAVES + F.wave, NGW = F.G * NWAVES;
    f32x4 gn[4];
#pragma unroll
    for (int j = 0; j < 4; ++j) gn[j] = ((const GAS f32x4*)gain)[F.lane + 64 * j];
    for (int m = gw; m < MTOK; m += NGW) { f32x4 v[4]; rms_row(xio + (size_t)m * DM, gn, v, F.lane);
        GAS f32x4* o = (GAS f32x4*)(xio + (size_t)m * DM) + F.lane;
#pragma unroll
        for (int j = 0; j < 4; ++j) o[64 * j] = v[j]; }
}

struct DftOrder { int G, c; unsigned lda, ldb;
    __device__ bool next(int i, pg8::Unit& u) const { const int L = i * G + c; if (L >= 512) return false; u.pn = L & 1; u.pm = (L >> 1) & 31; u.z = L >> 6;
        u.aoff = (size_t)u.pm * 256 * lda; u.boff = (size_t)u.pn * 256 * ldb + (size_t)u.z * SEQ * 2; return true; } };

template <class Epi> __device__ __forceinline__ void run_gemm(Frame& F, const void* A, unsigned lda, const void* B, unsigned ldb, int Mrows, int Ncols, int K, const Epi& E) {
    int G_ = F.G, c_ = (int)blockIdx.x; asm volatile("" : "+s"(G_), "+s"(c_));
    pg8::Gemm g{(const char*)A, (const char*)B, lda, ldb, K}; pg8::PlainOrder S; S.init(Mrows, Ncols, G_, c_, lda, ldb);
    pg8::gemm_phase<Epi, pg8::PlainOrder>(F.lds, g, S, E);
}

__device__ __forceinline__ Args load_args() {
    Args r{};
#if defined(__HIP_DEVICE_COMPILE__)
    typedef const __attribute__((address_space(4))) Args CArgs;
    auto p = __builtin_amdgcn_kernarg_segment_ptr(); asm volatile("" : "+s"(p)); CArgs* q = (CArgs*)p;
#pragma unroll
    for (int i = 0; i < 16; ++i) r.in[i] = q->in[i];
    r.out = q->out; r.ws = q->ws;
#endif
    return r;
}
__device__ __forceinline__ Frame make_frame(LAS unsigned char* lds, unsigned char* ws) {
    Frame F; int t = threadIdx.x, g = gridDim.x, bx = blockIdx.x; asm volatile("" : "+v"(t), "+s"(g), "+s"(bx));
    F.lds = lds; F.MISC = (volatile LAS unsigned*)(lds + MISC_OFF); F.ctl = (gu32*)(ws + WS_CTL);
    F.tid = t; F.lane = t & 63; F.wave = __builtin_amdgcn_readfirstlane(t >> 6); F.G = g; F.vcu = (g % 8 == 0) ? (bx % 8) * (g / 8) + bx / 8 : bx; return F; }
#define PH_BEGIN const Args a = load_args(); unsigned char* const ws = a.ws; float* const xout = a.out; Frame F = make_frame((LAS unsigned char*)lds, ws); (void)xout
__global__ void __launch_bounds__(NWAVES * 64, 2) fwd_kernel(Args args) {
    extern __shared__ __attribute__((aligned(16))) unsigned char lds[];
    for (int u = threadIdx.x; u < (LDS_BYTES - LDSCTL_OFF) / 4; u += NWAVES * 64) ((LAS unsigned*)((LAS unsigned char*)lds + LDSCTL_OFF))[u] = 0u;
    __syncthreads();
    XcdBarrier bar = xcd_barrier_post((unsigned*)(args.ws + WS_CTL) + CW_BAR, (volatile LAS unsigned*)((LAS unsigned char*)lds + MISC_OFF) + 8);
#define GRID_BAR() do { XcdBarrier b2_ = bar; asm volatile("" : "+s"(b2_.bar), "+s"(b2_.x)); xcd_barrier(b2_); } while (0)

    { PH_BEGIN; p0_weights(F, a); __syncthreads(); p0_tables(F, a); norm_phase(F, a.in[0], a.in[1], (bf16*)(ws + WS_H)); }
    GRID_BAR();

    for (int layer = 0; layer < 2; ++layer) {
        if (layer > 0) { { PH_BEGIN; norm_phase(F, xout, a.in[1] + DM, (bf16*)(ws + WS_H)); } GRID_BAR(); }
        { PH_BEGIN; const bf16* WinT = (const bf16*)(ws + WS_WIN + layer * WIN_L);
          pg8::EpiInproj E{ws, WS_V, WS_Q, WS_K, WS_GF, WS_GA, WS_ROPE, QSCALE};
          run_gemm(F, ws + WS_H, DM * 2, WinT + (size_t)512 * DM, DM * 2, MTOK, INC - 512, DM, E); }
        { PH_BEGIN; const bf16* WinT = (const bf16*)(ws + WS_WIN + layer * WIN_L);
          pg8::EpiBf16 E{(bf16*)(ws + WS_UT), MTOK}; run_gemm(F, WinT, DM * 2, ws + WS_H, DM * 2, 512, MTOK, DM, E); }
        GRID_BAR();
        { PH_BEGIN; pg8::Gemm g{(const char*)(ws + WS_FCS), (const char*)(ws + WS_UT), 4096 * 2, MTOK * 2, 4096}; int G_ = F.G, c_ = (int)blockIdx.x; asm volatile("" : "+s"(G_), "+s"(c_)); DftOrder S{G_, c_, 4096 * 2, MTOK * 2}; pg8::EpiDft E{(bf16*)(ws + WS_Z)};
          pg8::gemm_phase<pg8::EpiDft, DftOrder>(F.lds, g, S, E); }
        { PH_BEGIN; attn_naive_phase(F, a); }
        GRID_BAR();
        { PH_BEGIN; merge_phase(F, a); }
        GRID_BAR();
        { PH_BEGIN; pg8::EpiGate<false> E{(const bf16*)(ws + WS_GA), nullptr, (bf16*)(ws + WS_T)};
          run_gemm(F, ws + WS_OATT, AOW * 2, (const bf16*)(ws + WS_WATT) + (size_t)layer * DM * AOW, AOW * 2, MTOK, DM, AOW, E); }
        GRID_BAR();
        { PH_BEGIN; pg8::EpiGate<true> E{(const bf16*)(ws + WS_GF), (const bf16*)(ws + WS_T), (bf16*)(ws + WS_MIX)};
          run_gemm(F, ws + WS_Z, DM * 2, (const bf16*)(ws + WS_WF) + (size_t)layer * DM * DM, DM * 2, MTOK, DM, DM, E); }
        GRID_BAR();
        { PH_BEGIN; pg8::EpiResid E{layer == 0 ? a.in[0] : xout, xout, nullptr};
          run_gemm(F, ws + WS_MIX, DM * 2, (const bf16*)(ws + WS_WOUT) + (size_t)layer * DM * DM, DM * 2, MTOK, DM, DM, E); }
        GRID_BAR();
        if (layer == 0) {
            { PH_BEGIN; norm_phase(F, xout, a.in[6], (bf16*)(ws + WS_H2)); }
            GRID_BAR();
            { PH_BEGIN; pg8::EpiSwiglu E{(bf16*)(ws + WS_TT), FF}; run_gemm(F, ws + WS_H2, DM * 2, ws + WS_W13, DM * 2, MTOK, 2 * FF, DM, E); }
            GRID_BAR();
            { PH_BEGIN; pg8::EpiResid E{xout, xout, nullptr}; run_gemm(F, ws + WS_TT, FF * 2, ws + WS_W2, FF * 2, MTOK, DM, FF, E); }
            GRID_BAR();
        } else {
            { PH_BEGIN; p0_moe_weights(F, a); __syncthreads();
              norm_router_phase(F, xout, a.in[6] + DM, (bf16*)(ws + WS_H2B), a.in[10], a.in[11], (float*)(ws + WS_COMB)); }
            GRID_BAR();
            for (int e = 0; e < NEXP; ++e) {
                { PH_BEGIN; pg8::EpiSwiglu E{(bf16*)(ws + WS_TTB), FF}; run_gemm(F, ws + WS_H2B, DM * 2, ws + WS_M13 + (size_t)e * 2 * FF * DM * 2, DM * 2, MTOK, 2 * FF, DM, E); }
                GRID_BAR();
                { PH_BEGIN; pg8::EpiResid E{xout, xout, (const float*)(ws + WS_COMB) + (size_t)e * MTOK}; run_gemm(F, ws + WS_TTB, FF * 2, ws + WS_M2 + (size_t)e * DM * FF * 2, FF * 2, MTOK, DM, FF, E); }
                GRID_BAR();
            }
        }
    }
    { PH_BEGIN; final_norm_phase(F, xout, a.in[15]); }
#undef GRID_BAR
}

extern "C" void kernel_launch(void* const* d_in, const int* in_sizes, int n_in, void* d_out, int out_size, void* d_ws, size_t ws_size, hipStream_t stream) {
    static int grid = 0;
    if (grid == 0) {
        if (n_in != 16 || out_size != MTOK * DM || ws_size < WS_END) { fprintf(stderr, "kernel_launch: unexpected problem (n_in %d, out %d, ws %zu); nothing launched\n", n_in, out_size, ws_size); grid = -1; return; }
        int dev = 0, cus = 0;
        if (hipGetDevice(&dev) != hipSuccess || hipDeviceGetAttribute(&cus, hipDeviceAttributeMultiprocessorCount, dev) != hipSuccess) { grid = -1; return; }
        if (hipFuncSetAttribute((const void*)fwd_kernel, hipFuncAttributeMaxDynamicSharedMemorySize, LDS_BYTES) != hipSuccess) { fprintf(stderr, "kernel_launch: hipFuncSetAttribute failed\n"); grid = -1; return; }
        int per_cu = 0;
        if (hipOccupancyMaxActiveBlocksPerMultiprocessor(&per_cu, (const void*)fwd_kernel, NWAVES * 64, LDS_BYTES) != hipSuccess || per_cu < 1) fprintf(stderr, "kernel_launch: occupancy query reports %d\n", per_cu);
        (void)hipGetLastError();
        grid = cus;
    }
    if (grid < 0) return;
    (void)hipMemsetAsync((char*)d_ws + WS_CTL, 0, CTL_ZERO_BYTES, stream);
    Args a{};
    for (int i = 0; i < 16; ++i) a.in[i] = (const float*)d_in[i];
    a.out = (float*)d_out; a.ws = (unsigned char*)d_ws;
    hipLaunchKernelGGL(fwd_kernel, dim3(grid), dim3(NWAVES * 64), LDS_BYTES, stream, a);
}
```

```cpp
#include <hip/hip_runtime.h>
#include <cstdio>
#include <cstdint>

namespace pg8 {
#define PG8_LAS __attribute__((address_space(3)))
typedef unsigned short bf16_t;
typedef short bf16x8 __attribute__((ext_vector_type(8)));
typedef float f32x4 __attribute__((ext_vector_type(4)));
typedef unsigned u32x4 __attribute__((ext_vector_type(4)));
typedef unsigned u32x2 __attribute__((ext_vector_type(2)));
typedef int v4i_t __attribute__((ext_vector_type(4)));
typedef int v8i_t __attribute__((ext_vector_type(8)));
constexpr int BM = 256, BK = 64, HALF = 128, HTB = HALF * BK * 2  , STAGE_BYTES = 8 * HTB, NXCD = 8, WGM = 4;

__host__ __device__ __forceinline__ int lds_byte(int r, int c) { const int st = (r >> 4) * 2 + (c >> 5), rr = r & 15, cc = c & 31, ob = rr * 64 + cc * 2; return st * 1024 + (ob ^ (((ob >> 9) & 1) << 5)); }
__host__ __device__ __forceinline__ void stage_rc(int b, int& R, int& C) { const int st = b / 1024, sb = b % 1024, swz = sb ^ (((sb >> 9) & 1) << 5); R = (st >> 1) * 16 + swz / 64; C = (st & 1) * 32 + (swz % 64) / 2; }
__host__ __device__ __forceinline__ int perm32(int rho) { const int n = rho >> 4, i = rho & 15; return 8 * (i >> 2) + 4 * n + (i & 3); }

struct Unit { int pm, pn, z; size_t aoff, boff; };
struct Gemm { const char* A; const char* B; unsigned lda, ldb; int K; const int* rows; };

struct PlainOrder {
    int nM, nN, nwg, G, c; unsigned lda, ldb; int bmap, alay;
    __device__ void init(int M, int N, int G_, int c_, unsigned lda_, unsigned ldb_, int bmap_ = 0, int alay_ = 0) { nM = M / BM; nN = N / BM; nwg = nM * nN; G = G_; c = c_; lda = lda_; ldb = ldb_; bmap = bmap_; alay = alay_; }
    __device__ bool next(int i, Unit& u) const {
        const long L = (long)i * G + c; if (L >= nwg) return false;
        int wgid = (int)L; { const int q = nwg / NXCD, r = nwg % NXCD, xcd = wgid % NXCD, off = wgid / NXCD; wgid = (xcd < r ? xcd * (q + 1) : r * (q + 1) + (xcd - r) * q) + off; }
        const int nig = WGM * nN, gid = wgid / nig, fm = gid * WGM, gsz = (nM - fm) < WGM ? (nM - fm) : WGM;
        u.pm = fm + ((wgid % nig) % gsz); u.pn = (wgid % nig) / gsz; u.z = 0;
        u.aoff = alay ? (size_t)u.pm * BM * 16 : (size_t)u.pm * BM * lda;
        if (bmap == 0) u.boff = (size_t)u.pn * BM * ldb;
        else { const int kind = bmap == 1 ? 1 : (u.pm < 2 ? 1 : (u.pm == 2 ? 0 : u.pm - 1)), bb = u.pn >> 4, t = u.pn & 15; u.z = kind;
            const int base = kind == 0 ? 256 * t : (kind == 1 ? 4 * t : (kind == 2 ? 1024 * (t & 3) + (t >> 2) : t));
            u.boff = (size_t)(bb * 4096 + base) * ldb; }
        return true;
    }
};

typedef float f32x2v_t __attribute__((ext_vector_type(2))); typedef __bf16 bf16x2v_t __attribute__((ext_vector_type(2)));
__device__ __forceinline__ unsigned cvt_pk_bf16(float lo, float hi) { const f32x2v_t v = {lo, hi}; return __builtin_bit_cast(unsigned, __builtin_convertvector(v, bf16x2v_t)); }
__device__ __forceinline__ float bf_lo(unsigned w) { return __uint_as_float(w << 16); }
__device__ __forceinline__ float bf_hi(unsigned w) { return __uint_as_float(w & 0xffff0000u); }
__device__ __forceinline__ f32x4 bf4_lo(const u32x4& w) { return (f32x4){bf_lo(w.x), bf_hi(w.x), bf_lo(w.y), bf_hi(w.y)}; }
__device__ __forceinline__ f32x4 bf4_hi(const u32x4& w) { return (f32x4){bf_lo(w.z), bf_hi(w.z), bf_lo(w.w), bf_hi(w.w)}; }
__device__ __forceinline__ float fast_sigmoid(float x) { return __builtin_amdgcn_rcpf(1.0f + __builtin_amdgcn_exp2f(-1.4426950408889634f * x)); }
__device__ __forceinline__ u32x4 pack8(const f32x4& v0, const f32x4& v1) { u32x4 w; w.x = cvt_pk_bf16(v0[0], v0[1]); w.y = cvt_pk_bf16(v0[2], v0[3]); w.z = cvt_pk_bf16(v1[0], v1[1]); w.w = cvt_pk_bf16(v1[2], v1[3]); return w; }

__device__ __forceinline__ float rstd_of(const float* ss, int row) { const f32x4 p = *(const f32x4*)(ss + (size_t)row * 4); return __builtin_amdgcn_rsqf(((p[0] + p[1]) + (p[2] + p[3])) * (1.0f / 1024.0f) + 1e-6f); }
__device__ __forceinline__ unsigned pk_fp8(float a, float b, unsigned old, bool hi) { a = __builtin_fminf(__builtin_fmaxf(a, -448.f), 448.f); b = __builtin_fminf(__builtin_fmaxf(b, -448.f), 448.f);
    return hi ? (unsigned)__builtin_amdgcn_cvt_pk_fp8_f32(a, b, (int)old, true) : (unsigned)__builtin_amdgcn_cvt_pk_fp8_f32(a, b, (int)old, false); }

struct EpiBf16 {
    static constexpr bool PERM = true;
    bf16_t* O; int ldc; bf16_t* O2; int split; const float* ss;
    __device__ __forceinline__ void operator()(const f32x4 (&acc)[2][2][4][2], const Unit& u, int wr, int wc, int fr, int fq) const {
        bf16_t* const O = u.pm >= split ? O2 : this->O;
        const int row0 = (u.pm >= split ? u.pm - split : u.pm) * BM + wr * 64 + fr, col0 = u.pn * BM + wc * 32 + 8 * fq;
        f32x4 cs[2][2]; const int kind = u.z, bb = u.pn >> 4;
#pragma unroll
        for (int bj = 0; bj < 2; ++bj)
#pragma unroll
            for (int e = 0; e < 8; ++e) { const int v = (col0 & 4095) + bj * HALF + e;
                const int pos = kind == 0 ? v : (kind == 1 ? 64 * (v & 63) + (v >> 6) : (kind == 2 ? 4 * (v & 1023) + (v >> 10) : 16 * (v & 255) + (v >> 8)));
                cs[bj][e >> 2][e & 3] = rstd_of(ss, bb * 4096 + pos); }
#pragma unroll
        for (int ai = 0; ai < 2; ++ai)
#pragma unroll
            for (int m = 0; m < 4; ++m) { const size_t eo = (size_t)(row0 + ai * HALF + m * 16) * ldc + col0;
#pragma unroll
                for (int bj = 0; bj < 2; ++bj) { const f32x4 v0 = acc[ai][bj][m][0] * cs[bj][0], v1 = acc[ai][bj][m][1] * cs[bj][1];
                    if (u.pm >= split) { u32x2 w8; w8.x = pk_fp8(v0[0], v0[1], 0u, false); w8.x = pk_fp8(v0[2], v0[3], w8.x, true); w8.y = pk_fp8(v1[0], v1[1], 0u, false); w8.y = pk_fp8(v1[2], v1[3], w8.y, true);
                        *(u32x2*)((unsigned char*)O + eo + bj * HALF) = w8; }
                    else *(u32x4*)(O + eo + bj * HALF) = pack8(v0, v1); } }
    }
};
struct EpiInproj {
    static constexpr bool PERM = true;
    unsigned char* ws; size_t oV, oQ, oK, oGF, oGA, oRope; float qscale; const float* ss; float ascale;
    __device__ __forceinline__ void operator()(const f32x4 (&acc)[2][2][4][2], const Unit& u, int wr, int wc, int fr, int fq) const {
        const int row0 = u.pm * BM + wr * 64 + fr, pn = u.pn;
        {
            const bool isq = pn < 3; bf16_t* base = (bf16_t*)(ws + (isq ? oQ : oK)); const float* rope = (const float*)(ws + oRope); const int colt = (isq ? pn : pn - 3) * 256; const float sc = isq ? qscale : 1.0f;
            const int col0 = colt + wc * 32 + 8 * fq, i0 = 16 * (wc & 1) + 4 * fq;
#pragma unroll
            for (int ai = 0; ai < 2; ++ai)
#pragma unroll
                for (int m = 0; m < 4; ++m) { const int row = row0 + ai * HALF + m * 16, pos = row & 4095;
                    const f32x4 cs0 = *(const f32x4*)(rope + (size_t)(pos * 32 + i0) * 2), cs1 = *(const f32x4*)(rope + (size_t)(pos * 32 + i0) * 2 + 4);
                    bf16_t* rowp = base + (size_t)row * 768 + col0; const float rs = rstd_of(ss, row) * ascale;
#pragma unroll
                    for (int bj = 0; bj < 2; ++bj) { const f32x4 v0 = acc[ai][bj][m][0] * rs, v1 = acc[ai][bj][m][1] * rs; f32x4 o0, o1;
                        o0[0] = (v0[0] * cs0[0] - v0[1] * cs0[1]) * sc; o0[1] = (v0[1] * cs0[0] + v0[0] * cs0[1]) * sc;
                        o0[2] = (v0[2] * cs0[2] - v0[3] * cs0[3]) * sc; o0[3] = (v0[3] * cs0[2] + v0[2] * cs0[3]) * sc;
                        o1[0] = (v1[0] * cs1[0] - v1[1] * cs1[1]) * sc; o1[1] = (v1[1] * cs1[0] + v1[0] * cs1[1]) * sc;
                        o1[2] = (v1[2] * cs1[2] - v1[3] * cs1[3]) * sc; o1[3] = (v1[3] * cs1[2] + v1[2] * cs1[3]) * sc;
                        { u32x2 w8; w8.x = pk_fp8(o0[0], o0[1], 0u, false); w8.x = pk_fp8(o0[2], o0[3], w8.x, true); w8.y = pk_fp8(o1[0], o1[1], 0u, false); w8.y = pk_fp8(o1[2], o1[3], w8.y, true);
                               *(u32x2*)((unsigned char*)base + (size_t)row * 768 + col0 + bj * HALF) = w8; } }
                    if (m == 3) asm volatile("" ::: "memory"); }
        }
    }
};
constexpr float WG8_SCALE = 32.0f;
struct EpiGates8 {
    static constexpr bool PERM = true;
    unsigned char* ws; size_t oGF, oGA; const float* ss;
    __device__ __forceinline__ void operator()(const f32x4 (&acc)[2][2][4][2], const Unit& u, int wr, int wc, int fr, int fq) const {
        const int row0 = u.pm * BM + wr * 64 + fr;
        {
            bf16_t* const gfp = (bf16_t*)(ws + oGF); bf16_t* const grp = (bf16_t*)(ws + oGA); const int col0 = u.pn * 128 + wc * 32 + 8 * fq;
#pragma unroll
            for (int ai = 0; ai < 2; ++ai)
#pragma unroll
                for (int m = 0; m < 4; ++m) { const size_t off = (size_t)(row0 + ai * HALF + m * 16) * 1024 + col0; const float rs = (-1.4426950408889634f / WG8_SCALE) * rstd_of(ss, row0 + ai * HALF + m * 16);
                    f32x4 g[2], r[2];
#pragma unroll
                    for (int n = 0; n < 2; ++n) { const f32x4 xf = acc[ai][0][m][n] * rs, xa = acc[ai][1][m][n] * rs; f32x4 ef, ea, ia;
#pragma unroll
                        for (int j = 0; j < 4; ++j) { ef[j] = __builtin_fminf(__builtin_amdgcn_exp2f(xf[j]), 1.0e18f); ea[j] = __builtin_amdgcn_exp2f(xa[j]); }
                        ef = ef + 1.0f; ea = ea + 1.0f;
#pragma unroll
                        for (int j = 0; j < 4; ++j) { g[n][j] = __builtin_amdgcn_rcpf(ef[j]); ia[j] = __builtin_amdgcn_rcpf(ea[j]); }
                        r[n] = ef * ia; }
                    *(u32x4*)(gfp + off) = pack8(g[0], g[1]); *(u32x4*)(grp + off) = pack8(r[0], r[1]); }
        }
    }
};
struct EpiMix {
    static constexpr bool PERM = true; static constexpr int RESCALE_T = 4;
    const bf16_t* G; const bf16_t* R; bf16_t* O;
    __device__ __forceinline__ void rescale(f32x4 (&acc)[2][2][4][2], const Unit& u, int wr, int wc, int fr, int fq) const {
        asm volatile("" : "+v"(fr), "+v"(fq));
        const int row0 = u.pm * BM + wr * 64 + fr, col0 = u.pn * BM + wc * 32 + 8 * fq;
#pragma unroll
        for (int ai = 0; ai < 2; ++ai)
#pragma unroll
            for (int m = 0; m < 4; ++m) { const unsigned off = (unsigned)(row0 + ai * HALF + m * 16) * 1024u + (unsigned)col0;
#pragma unroll
                for (int bj = 0; bj < 2; ++bj) { const u32x4 g = *(const u32x4*)(R + off + bj * HALF);
                    acc[ai][bj][m][0] = acc[ai][bj][m][0] * bf4_lo(g); acc[ai][bj][m][1] = acc[ai][bj][m][1] * bf4_hi(g); }
                if (m == 3) asm volatile("" ::: "memory"); }
    }
    __device__ __forceinline__ void operator()(const f32x4 (&acc)[2][2][4][2], const Unit& u, int wr, int wc, int fr, int fq) const {
        const int row0 = u.pm * BM + wr * 64 + fr, col0 = u.pn * BM + wc * 32 + 8 * fq;
#pragma unroll
        for (int ai = 0; ai < 2; ++ai) { u32x4 gq[4][2];
#pragma unroll
            for (int m = 0; m < 4; ++m)
#pragma unroll
                for (int bj = 0; bj < 2; ++bj) gq[m][bj] = *(const u32x4*)(G + (unsigned)(row0 + ai * HALF + m * 16) * 1024u + (unsigned)col0 + bj * HALF);
#pragma unroll
            for (int m = 0; m < 4; ++m) { const unsigned off = (unsigned)(row0 + ai * HALF + m * 16) * 1024u + (unsigned)col0;
#pragma unroll
                for (int bj = 0; bj < 2; ++bj) { const u32x4 g = gq[m][bj]; const f32x4 v0 = acc[ai][bj][m][0] * bf4_lo(g), v1 = acc[ai][bj][m][1] * bf4_hi(g);
                    *(u32x4*)(O + off + bj * HALF) = pack8(v0, v1); } }
            asm volatile("" ::: "memory"); }
    }
};
template <class E, class = void> struct rescale_at { static constexpr int t = -1; };
template <class E> struct rescale_at<E, decltype((void)E::RESCALE_T)> { static constexpr int t = E::RESCALE_T; };
template <bool SS> struct EpiResid {
    static constexpr bool PERM = true;
    const bf16_t* res; bf16_t* out; int ld; float* ssout; unsigned char* x8;
    __device__ __forceinline__ void operator()(const f32x4 (&acc)[2][2][4][2], const Unit& u, int wr, int wc, int fr, int fq) const {
        const int row0 = u.pm * BM + wr * 64 + fr, col0 = u.pn * BM + wc * 32 + 8 * fq, lane = fq * 16 + fr;
        PG8_LAS float* const part = (PG8_LAS float*)(unsigned)131072;
#pragma unroll
        for (int ai = 0; ai < 2; ++ai) { u32x4 rq[4][2];
#pragma unroll
            for (int m = 0; m < 4; ++m)
#pragma unroll
                for (int bj = 0; bj < 2; ++bj) rq[m][bj] = *(const u32x4*)(res + (size_t)(row0 + ai * HALF + m * 16) * ld + col0 + bj * HALF);
#pragma unroll
            for (int m = 0; m < 4; ++m) { const int row = row0 + ai * HALF + m * 16; const size_t off = (size_t)row * ld + col0; float sq = 0.f;
#pragma unroll
                for (int bj = 0; bj < 2; ++bj) { const u32x4 r = rq[m][bj]; const f32x4 v0 = acc[ai][bj][m][0] + bf4_lo(r), v1 = acc[ai][bj][m][1] + bf4_hi(r);
                    if (SS) { const f32x4 q = v0 * v0 + v1 * v1; sq += (q[0] + q[1]) + (q[2] + q[3]); }
                    *(u32x4*)(out + off + bj * HALF) = pack8(v0, v1);
                    if (x8) { u32x2 w8; w8.x = pk_fp8(v0[0], v0[1], 0u, false); w8.x = pk_fp8(v0[2], v0[3], w8.x, true); w8.y = pk_fp8(v1[0], v1[1], 0u, false); w8.y = pk_fp8(v1[2], v1[3], w8.y, true);
                        *(u32x2*)(x8 + (size_t)row * 1024 + col0 + bj * HALF) = w8; } }
                if (SS) { sq += __int_as_float(__builtin_amdgcn_ds_bpermute((lane ^ 16) << 2, __float_as_int(sq))); sq += __int_as_float(__builtin_amdgcn_ds_bpermute((lane ^ 32) << 2, __float_as_int(sq)));
                    if (fq == 0) part[wc * 256 + wr * 64 + fr + ai * HALF + m * 16] = sq; } }
            asm volatile("" ::: "memory"); }
        if (SS) {
            asm volatile("s_waitcnt lgkmcnt(0)" ::: "memory"); __builtin_amdgcn_s_barrier(); asm volatile("" ::: "memory");
            const int t = (wr * 4 + wc) * 64 + lane;
            if (t < 256) ssout[(size_t)(u.pm * BM + t) * 4 + u.pn] = (part[t] + part[256 + t]) + (part[512 + t] + part[768 + t]);
            asm volatile("s_waitcnt lgkmcnt(0)" ::: "memory"); __builtin_amdgcn_s_barrier(); asm volatile("" ::: "memory");
        }
    }
};
struct EpiSwiglu {
    static constexpr bool PERM = true;
    bf16_t* T; int ldc; const float* ss;
    __device__ __forceinline__ void operator()(const f32x4 (&acc)[2][2][4][2], const Unit& u, int wr, int wc, int fr, int fq) const {
        const int row0 = u.pm * BM + wr * 64 + fr, col0 = u.pn * 128 + wc * 32 + 8 * fq;
#pragma unroll
        for (int ai = 0; ai < 2; ++ai)
#pragma unroll
            for (int m = 0; m < 4; ++m) { const int r = row0 + ai * HALF + m * 16; const float rs = rstd_of(ss, r), rs2 = rs * rs, rse = -1.4426950408889634f * rs; f32x4 o[2];
#pragma unroll
                for (int n = 0; n < 2; ++n) { const f32x4 x = acc[ai][0][m][n] * rse; f32x4 e, q;
#pragma unroll
                    for (int j = 0; j < 4; ++j) e[j] = __builtin_amdgcn_exp2f(x[j]);
                    e = e + 1.0f;
#pragma unroll
                    for (int j = 0; j < 4; ++j) q[j] = __builtin_amdgcn_rcpf(e[j]);
                    o[n] = (acc[ai][0][m][n] * acc[ai][1][m][n]) * (q * rs2); }
                *(u32x4*)(T + (size_t)r * ldc + col0) = pack8(o[0], o[1]); }
    }
};
struct EpiSwigluF8 {
    static constexpr bool PERM = true;
    unsigned char* T; int ldc; float ascale;
    __device__ __forceinline__ void operator()(const f32x4 (&acc)[2][2][4][2], const Unit& u, int wr, int wc, int fr, int fq) const {
        const int row0 = u.pm * BM + wr * 64 + fr, col0 = u.pn * 128 + wc * 32 + 8 * fq;
#pragma unroll
        for (int ai = 0; ai < 2; ++ai)
#pragma unroll
            for (int m = 0; m < 4; ++m) { unsigned char* rowp = T + (size_t)(row0 + ai * HALF + m * 16) * ldc + col0; f32x4 o4[2];
#pragma unroll
                for (int n = 0; n < 2; ++n) { const f32x4 x = acc[ai][0][m][n] * (-1.4426950408889634f * ascale); f32x4 e;
#pragma unroll
                    for (int j = 0; j < 4; ++j) e[j] = __builtin_amdgcn_exp2f(x[j]);
                    e = e + 1.0f; f32x4 r;
#pragma unroll
                    for (int j = 0; j < 4; ++j) r[j] = __builtin_amdgcn_rcpf(e[j]);
                    o4[n] = (acc[ai][0][m][n] * acc[ai][1][m][n]) * (r * (ascale * ascale)); }
                const float* o = (const float*)o4;
                u32x2 w; w.x = pk_fp8(o4[0][0], o4[0][1], 0u, false); w.x = pk_fp8(o4[0][2], o4[0][3], w.x, true); w.y = pk_fp8(o4[1][0], o4[1][1], 0u, false); w.y = pk_fp8(o4[1][2], o4[1][3], w.y, true); (void)o;
                *(u32x2*)rowp = w; }
    }
};
struct EpiScatterY {
    static constexpr bool PERM = true;
    bf16_t* y; const int* rows; const float* w; float ascale; int slot_rows; size_t slot_stride;
    __device__ __forceinline__ void operator()(const f32x4 (&acc)[2][2][4][2], const Unit& u, int wr, int wc, int fr, int fq) const {
        const int row0 = u.pm * BM + wr * 64 + fr, col0 = u.pn * BM + wc * 32 + 8 * fq; bf16_t* const yb = y + (row0 >= slot_rows ? slot_stride : (size_t)0);
#pragma unroll
        for (int ai = 0; ai < 2; ++ai)
#pragma unroll
            for (int m = 0; m < 4; ++m) { const int r = row0 + ai * HALF + m * 16, tok = rows[r]; const float rs = w[r] * ascale;
                if (tok >= 0) { bf16_t* yp = yb + (size_t)tok * 1024 + col0;
#pragma unroll
                    for (int bj = 0; bj < 2; ++bj) *(u32x4*)(yp + bj * HALF) = pack8(acc[ai][bj][m][0] * rs, acc[ai][bj][m][1] * rs); } }
    }
};
template <class Epi, class Sched, bool GATHER = false, int BMAP = 0, int ALAY = 0, bool FP8 = false, bool ALIGN_EPI = true, bool SP2 = true>
__device__ __forceinline__ void gemm_phase(PG8_LAS unsigned char* lds, const Gemm g, const Sched& S, const Epi& E) {
    int tid_ = threadIdx.x; asm volatile("" : "+v"(tid_));
    const int tid = tid_, wid = __builtin_amdgcn_readfirstlane(tid >> 6), lane = tid & 63, wr = wid >> 2, wc = wid & 3, fr = lane & 15, fq = lane >> 4;
    const int K = g.K, nt = K / BK;
    unsigned voffA[2], voffA1[2], nvA0[2], nvA1[2], voffB[2], nvB[2]; int Rg[2], Cg[2], RbS[2];
#pragma unroll
    for (int i = 0; i < 2; ++i) { int R, C; stage_rc(tid * 16 + i * 8192, R, C); const int Rb = Epi::PERM ? ((R & ~31) + perm32(R & 31)) : R; Rg[i] = R; Cg[i] = C * 2;
        voffA[i] = ALAY == 1 ? (unsigned)(C >> 3) * g.lda + (unsigned)R * 16u : (unsigned)R * g.lda + (unsigned)C * 2u; voffA1[i] = voffA[i]; nvA0[i] = voffA[i]; nvA1[i] = voffA[i];
        voffB[i] = (BMAP == 1 ? (unsigned)(64 * (Rb & 63) + (Rb >> 6)) : (unsigned)Rb) * g.ldb + (unsigned)C * 2u; RbS[i] = Rb; }
#define PG8_BKIND(kind_, dv, dh) do { const int _k = (kind_); _Pragma("unroll") for (int _i = 0; _i < 2; ++_i) { const int _r = RbS[_i]; \
        dv[_i] = (unsigned)(_k == 0 ? _r : (_k == 1 ? 64 * (_r & 63) + (_r >> 6) : (_k == 2 ? 4 * _r : 16 * _r))) * g.ldb + (unsigned)Cg[_i]; } \
        dh = (size_t)(_k == 0 ? 128 : (_k == 1 ? 2 : (_k == 2 ? 512 : 2048))) * g.ldb; } while (0)
#define PG8_GROWS(pm_, d0, d1) do { _Pragma("unroll") for (int _i = 0; _i < 2; ++_i) { int _t0 = g.rows[(pm_) * BM + Rg[_i]], _t1 = g.rows[(pm_) * BM + HALF + Rg[_i]]; _t0 = _t0 < 0 ? 0 : _t0; _t1 = _t1 < 0 ? 0 : _t1; \
        d0[_i] = (unsigned)_t0 * g.lda + (unsigned)Cg[_i]; d1[_i] = (unsigned)_t1 * g.lda + (unsigned)Cg[_i]; } } while (0)
    const size_t kstepB = (size_t)(BK * 2), kstepA = ALAY == 1 ? (size_t)8 * g.lda : kstepB;
    const size_t hstepA = GATHER ? (size_t)0 : (ALAY == 1 ? (size_t)HALF * 16 : (size_t)HALF * g.lda); size_t hstepB = (BMAP == 1 ? (size_t)2 : (size_t)HALF) * g.ldb, nhB = hstepB;
    const unsigned ldsw = (unsigned)wid * 1024u;
    const int aoff = lds_byte(wr * 64 + fr, fq * 8), boff = lds_byte(wc * 32 + fr, fq * 8);
#define PG8_SA(b, h) (((b) * 2 + (h)) * HTB)
#define PG8_SB(b, h) ((4 + (b) * 2 + (h)) * HTB)
#define PG8_STAGE(bufoff, gbase, voff) do { _Pragma("unroll") for (int _i = 0; _i < 2; ++_i) \
        __builtin_amdgcn_global_load_lds((const unsigned*)((const char*)(gbase) + (voff)[_i]), (PG8_LAS unsigned*)(lds + (bufoff) + ldsw + _i * 8192), 16, 0, 0); } while (0)
#define PG8_LDA(dst, b, h) do { if constexpr (FP8) { _Pragma("unroll") for (int m = 0; m < 4; ++m) dst##8[m] = PG8_CAT8(*(const PG8_LAS bf16x8*)(lds + PG8_SA(b, h) + aoff + m * 2048), *(const PG8_LAS bf16x8*)(lds + PG8_SA(b, h) + aoff + m * 2048 + 1024)); } \
    else { _Pragma("unroll") for (int m = 0; m < 4; ++m) _Pragma("unroll") for (int k = 0; k < 2; ++k) dst[m][k] = *(const PG8_LAS bf16x8*)(lds + PG8_SA(b, h) + aoff + m * 2048 + k * 1024); } } while (0)
#define PG8_LDB(dst, b, h) do { if constexpr (FP8) { _Pragma("unroll") for (int n = 0; n < 2; ++n) dst##8[n] = PG8_CAT8(*(const PG8_LAS bf16x8*)(lds + PG8_SB(b, h) + boff + n * 2048), *(const PG8_LAS bf16x8*)(lds + PG8_SB(b, h) + boff + n * 2048 + 1024)); } \
    else { _Pragma("unroll") for (int n = 0; n < 2; ++n) _Pragma("unroll") for (int k = 0; k < 2; ++k) dst[n][k] = *(const PG8_LAS bf16x8*)(lds + PG8_SB(b, h) + boff + n * 2048 + k * 1024); } } while (0)
#define PG8_CAT8(lo, hi) __builtin_shufflevector(__builtin_bit_cast(v4i_t, lo), __builtin_bit_cast(v4i_t, hi), 0, 1, 2, 3, 4, 5, 6, 7)
#define PG8_MMA(ai, bj, At, Bt) do { __builtin_amdgcn_s_setprio(1); if constexpr (FP8) { _Pragma("unroll") for (int m = 0; m < 4; ++m) _Pragma("unroll") for (int n = 0; n < 2; ++n) \
        asm volatile("v_mfma_f32_16x16x128_f8f6f4 %0, %1, %2, %0" : "+v"(acc[ai][bj][m][n]) : "v"(Bt##8[n]), "v"(At##8[m])); } else { \
        _Pragma("unroll") for (int m = 0; m < 4; ++m) _Pragma("unroll") for (int n = 0; n < 2; ++n) _Pragma("unroll") for (int k = 0; k < 2; ++k) \
        acc[ai][bj][m][n] = __builtin_amdgcn_mfma_f32_16x16x32_bf16(Bt[n][k], At[m][k], acc[ai][bj][m][n], 0, 0, 0); } __builtin_amdgcn_s_setprio(0); } while (0)
#define PG8_WAIT_V(n) asm volatile("s_waitcnt vmcnt(" #n ")" ::: "memory")
#define PG8_WAIT_L(n) asm volatile("s_waitcnt lgkmcnt(" #n ")" ::: "memory")
#define PG8_BAR __builtin_amdgcn_s_barrier()
#define PG8_SCHED __builtin_amdgcn_sched_barrier(0)
    Unit cur, nxt; int ui = 0;
    if (!S.next(0, cur)) return;
    f32x4 acc[2][2][4][2];
#pragma unroll
    for (int a = 0; a < 2; ++a)
#pragma unroll
        for (int b = 0; b < 2; ++b)
#pragma unroll
            for (int m = 0; m < 4; ++m)
#pragma unroll
                for (int n = 0; n < 2; ++n) acc[a][b][m][n] = (f32x4){0.f, 0.f, 0.f, 0.f};
    bf16x8 At[4][2], B0[2][2], B1[2][2]; v8i_t At8[4], B08[2], B18[2];
    const char* cA = g.A + cur.aoff; const char* cB = g.B + cur.boff;
    if constexpr (GATHER) PG8_GROWS(cur.pm, voffA, voffA1);
    if constexpr (BMAP == 2) { PG8_BKIND(cur.z, voffB, hstepB); nvB[0] = voffB[0]; nvB[1] = voffB[1]; nhB = hstepB; }
    if constexpr (SP2) {
        PG8_STAGE(PG8_SB(0, 0), cB, voffB); PG8_STAGE(PG8_SB(0, 1), cB + hstepB, voffB); PG8_STAGE(PG8_SA(0, 0), cA, voffA); PG8_STAGE(PG8_SA(0, 1), cA + hstepA, voffA1);
        if (wr == 1) PG8_BAR;
        PG8_WAIT_V(2); PG8_BAR;
        PG8_STAGE(PG8_SB(1, 0), cB + kstepB, voffB); PG8_STAGE(PG8_SA(1, 0), cA + kstepA, voffA); PG8_STAGE(PG8_SB(1, 1), cB + hstepB + kstepB, voffB);
        PG8_WAIT_V(6); PG8_BAR;
    } else {
        PG8_STAGE(PG8_SB(0, 0), cB, voffB); PG8_STAGE(PG8_SA(0, 0), cA, voffA); PG8_STAGE(PG8_SB(0, 1), cB + hstepB, voffB); PG8_STAGE(PG8_SA(0, 1), cA + hstepA, voffA);
        if (wr == 1) PG8_BAR;
        PG8_WAIT_V(4); PG8_BAR;
        PG8_STAGE(PG8_SB(1, 0), cB + kstepB, voffB); PG8_STAGE(PG8_SA(1, 0), cA + kstepA, voffA); PG8_STAGE(PG8_SB(1, 1), cB + hstepB + kstepB, voffB);
        PG8_WAIT_V(6); PG8_BAR;
    }
    for (;;) {
        const bool has_next = S.next(ui + 1, nxt);
        const char* nA = has_next ? g.A + nxt.aoff : cA; const char* nB = has_next ? g.B + nxt.boff : cB;
        if constexpr (BMAP == 2) { if (has_next) PG8_BKIND(nxt.z, nvB, nhB); else { nvB[0] = voffB[0]; nvB[1] = voffB[1]; nhB = hstepB; } }
        if constexpr (GATHER) { if (has_next) PG8_GROWS(nxt.pm, nvA0, nvA1); else {
#pragma unroll
            for (int i = 0; i < 2; ++i) { nvA0[i] = voffA[i]; nvA1[i] = voffA1[i]; } } }
#pragma unroll 1
        for (int t = 0; t < nt; t += 2) {
            if constexpr (rescale_at<Epi>::t >= 0) { if (t == rescale_at<Epi>::t) E.rescale(acc, cur, wr, wc, fr, fq); }
            const bool last = (t == nt - 2);
            const char* a1 = cA + (size_t)(t + 1) * kstepA;
            const char* a2 = last ? nA : cA + (size_t)(t + 2) * kstepA; const char* b2 = last ? nB : cB + (size_t)(t + 2) * kstepB;
            const char* a3 = a2 + kstepA; const char* b3 = b2 + kstepB;
            unsigned w0[2], w1[2];
#pragma unroll
            for (int i = 0; i < 2; ++i) { w0[i] = voffA[i]; w1[i] = voffA1[i]; }
            unsigned wB[2] = {voffB[0], voffB[1]}; size_t hB = hstepB;
            if (BMAP == 2 && last) { asm volatile("; next unit's B row map" ::: ); wB[0] = nvB[0]; wB[1] = nvB[1]; hB = nhB; }
            if (GATHER && last) { asm volatile("; next unit's gathered rows" ::: );
#pragma unroll
                for (int i = 0; i < 2; ++i) { w0[i] = nvA0[i]; w1[i] = nvA1[i]; } }
            if constexpr (SP2) {
            PG8_LDB(B0, 0, 0); PG8_LDB(B1, 0, 1); PG8_SCHED; PG8_LDA(At, 0, 0); PG8_STAGE(PG8_SA(1, 1), a1 + hstepA, voffA1);
            PG8_WAIT_V(8); PG8_WAIT_L(0); PG8_BAR; PG8_MMA(0, 0, At, B0); PG8_MMA(0, 1, At, B1); PG8_BAR; PG8_SCHED;
            PG8_LDA(At, 0, 1); PG8_STAGE(PG8_SB(0, 0), b2, wB); PG8_STAGE(PG8_SB(0, 1), b2 + hB, wB); PG8_STAGE(PG8_SA(0, 0), a2, w0);
            PG8_WAIT_V(8); PG8_WAIT_L(0); PG8_BAR; PG8_MMA(1, 0, At, B0); PG8_MMA(1, 1, At, B1); PG8_BAR; PG8_SCHED;
            PG8_LDB(B0, 1, 0); PG8_LDB(B1, 1, 1); PG8_SCHED; PG8_LDA(At, 1, 0); PG8_STAGE(PG8_SA(0, 1), a2 + hstepA, w1);
            PG8_WAIT_V(8); PG8_WAIT_L(0); PG8_BAR; PG8_MMA(0, 0, At, B0); PG8_MMA(0, 1, At, B1); PG8_BAR; PG8_SCHED;
            PG8_LDA(At, 1, 1); PG8_STAGE(PG8_SB(1, 0), b3, wB); PG8_STAGE(PG8_SB(1, 1), b3 + hB, wB); PG8_STAGE(PG8_SA(1, 0), a3, w0);
            PG8_WAIT_V(8); PG8_WAIT_L(0); PG8_BAR; PG8_MMA(1, 0, At, B0); PG8_MMA(1, 1, At, B1); PG8_BAR; PG8_SCHED;
            } else { static_assert(SP2 || (!GATHER && BMAP != 2), "GATHER / BMAP 2 need the SP2 loop");
            PG8_LDB(B0, 0, 0); PG8_SCHED; PG8_LDA(At, 0, 0); PG8_STAGE(PG8_SA(1, 1), a1 + hstepA, voffA);
            PG8_WAIT_L(8); PG8_BAR; PG8_WAIT_L(0); PG8_MMA(0, 0, At, B0); PG8_BAR; PG8_SCHED;
            PG8_LDB(B1, 0, 1); PG8_STAGE(PG8_SB(0, 0), b2, voffB);
            PG8_BAR; PG8_WAIT_L(0); PG8_MMA(0, 1, At, B1); PG8_BAR;
            PG8_LDA(At, 0, 1); PG8_STAGE(PG8_SA(0, 0), a2, voffA);
            PG8_BAR; PG8_WAIT_L(0); PG8_MMA(1, 0, At, B0); PG8_BAR; PG8_SCHED;
            PG8_STAGE(PG8_SB(0, 1), b2 + hstepB, voffB);
            PG8_WAIT_V(6); PG8_BAR; PG8_MMA(1, 1, At, B1); PG8_BAR;
            PG8_LDB(B0, 1, 0); PG8_SCHED; PG8_LDA(At, 1, 0); PG8_STAGE(PG8_SA(0, 1), a2 + hstepA, voffA);
            PG8_WAIT_L(8); PG8_BAR; PG8_WAIT_L(0); PG8_MMA(0, 0, At, B0); PG8_BAR; PG8_SCHED;
            PG8_LDB(B1, 1, 1); PG8_STAGE(PG8_SB(1, 0), b3, voffB);
            PG8_BAR; PG8_WAIT_L(0); PG8_MMA(0, 1, At, B1); PG8_BAR;
            PG8_LDA(At, 1, 1); PG8_STAGE(PG8_SA(1, 0), a3, voffA);
            PG8_BAR; PG8_WAIT_L(0); PG8_MMA(1, 0, At, B0); PG8_BAR; PG8_SCHED;
            PG8_STAGE(PG8_SB(1, 1), b3 + hstepB, voffB);
            PG8_WAIT_V(6); PG8_BAR; PG8_MMA(1, 1, At, B1); PG8_BAR;
            }
        }
        if constexpr (ALIGN_EPI) { if (wr == 0) PG8_BAR; }
        if constexpr (FP8) {
            asm volatile("s_nop 15\n\ts_nop 15\n\ts_nop 15\n\ts_nop 15\n\ts_nop 15\n\ts_nop 15\n\ts_nop 15\n\ts_nop 15" ::: "memory");
#pragma unroll
            for (int a = 0; a < 2; ++a)
#pragma unroll
                for (int b = 0; b < 2; ++b)
#pragma unroll
                    for (int m = 0; m < 4; ++m) asm volatile("" : "+v"(acc[a][b][m][0]), "+v"(acc[a][b][m][1])); }
        E(acc, cur, wr, wc, fr, fq);
        if (!has_next) break;
#pragma unroll
        for (int a = 0; a < 2; ++a)
#pragma unroll
            for (int b = 0; b < 2; ++b)
#pragma unroll
                for (int m = 0; m < 4; ++m)
#pragma unroll
                    for (int n = 0; n < 2; ++n) acc[a][b][m][n] = (f32x4){0.f, 0.f, 0.f, 0.f};
        cur = nxt; cA = nA; cB = nB; ++ui;
        if constexpr (BMAP == 2) { voffB[0] = nvB[0]; voffB[1] = nvB[1]; hstepB = nhB; }
        if constexpr (GATHER) {
#pragma unroll
            for (int i = 0; i < 2; ++i) { voffA[i] = nvA0[i]; voffA1[i] = nvA1[i]; } }
        if constexpr (ALIGN_EPI) { if (wr == 1) PG8_BAR; }
    }
    PG8_WAIT_V(0);
    if constexpr (!ALIGN_EPI) { if (wr == 0) PG8_BAR; }
    PG8_BAR;
#undef PG8_GROWS
#undef PG8_BKIND
#undef PG8_SA
#undef PG8_SB
#undef PG8_STAGE
#undef PG8_LDA
#undef PG8_LDB
#undef PG8_MMA
#undef PG8_CAT8
#undef PG8_WAIT_V
#undef PG8_WAIT_L
#undef PG8_BAR
#undef PG8_SCHED
}
}
#define GAS __attribute__((address_space(1)))
#define LAS __attribute__((address_space(3)))
typedef unsigned short bf16;
typedef unsigned v4u __attribute__((ext_vector_type(4)));
typedef float f32x4 __attribute__((ext_vector_type(4)));
typedef short bf16x8 __attribute__((ext_vector_type(8)));
typedef GAS unsigned gu32;
typedef GAS unsigned long long gu64;
#define RLX_AGENT __ATOMIC_RELAXED, __HIP_MEMORY_SCOPE_AGENT
#define LDS_WAIT() asm volatile("s_waitcnt lgkmcnt(0)" ::: "memory")
#define VM_WAIT() asm volatile("s_waitcnt vmcnt(0)" ::: "memory")
__device__ __forceinline__ unsigned long long rt() { return __builtin_amdgcn_s_memrealtime(); }
__device__ __forceinline__ unsigned f2bf(float f) { unsigned u = __builtin_bit_cast(unsigned, f); return (u + 0x7fffu + ((u >> 16) & 1u)) >> 16; }
__device__ __forceinline__ unsigned pk2(float lo, float hi) { return f2bf(lo) | (f2bf(hi) << 16); }

#define XB_TMO      128
#define XB_XCNT(j)  (256  + 64 * (j))
#define XB_XSUB(j)  (1280 + 64 * (j))
#define XB_XGEN(j)  (2304 + 64 * (j))
#define XB_TOP      3328
#define XB_TOPGEN   3392
#define XCD_BAR_WORDS 3456
#define XB_SPIN_CAP (1u << 18)

__device__ __forceinline__ unsigned xb_ld(unsigned* p)              { return __hip_atomic_load(p, __ATOMIC_RELAXED, __HIP_MEMORY_SCOPE_AGENT); }
__device__ __forceinline__ unsigned xb_add(unsigned* p, unsigned v) { return __hip_atomic_fetch_add(p, v, __ATOMIC_RELAXED, __HIP_MEMORY_SCOPE_AGENT); }
__device__ __forceinline__ unsigned xb_xcc_id() { return (unsigned)__builtin_amdgcn_s_getreg((3 << 11) | 20) & 0xFu; }
#define XB_SPIN(cond, bar) do { unsigned _sp = 0; while (cond) { __builtin_amdgcn_s_sleep(1); \
    if ((++_sp & 255u) == 0u) { if (xb_ld(&(bar)[XB_TMO])) break; if (_sp > XB_SPIN_CAP) { atomicAdd(&(bar)[XB_TMO], 1u); break; } } } } while (0)

struct XcdBarrier {
    unsigned* bar; unsigned x; unsigned G;
    volatile LAS unsigned* st;
};

__device__ __forceinline__ XcdBarrier xcd_barrier_post(unsigned* bar, volatile LAS unsigned* st) {
    XcdBarrier b; b.bar = bar; b.x = xb_xcc_id(); b.st = st; b.G = 0u;
    if (threadIdx.x == 0) (void)xb_add(&bar[XB_XCNT(b.x)], 1u);
    return b;
}
__device__ __forceinline__ void xcd_barrier_complete(unsigned* bar, unsigned x, const unsigned G, unsigned& nloc, unsigned& nx) {
    unsigned sum, cnt, mine, sp = 0u;
    for (;;) {
        sum = 0u; cnt = 0u; mine = 0u;
#pragma nounroll
        for (unsigned j = 0; j < 16; ++j) { const unsigned c = xb_ld(&bar[XB_XCNT(j)]); sum += c; cnt += (c > 0u) ? 1u : 0u; mine = (j == x) ? c : mine; }
        if (sum == G) break;
        __builtin_amdgcn_s_sleep(1);
        if ((++sp & 255u) == 0u) { if (xb_ld(&bar[XB_TMO])) break; if (sp > XB_SPIN_CAP) { atomicAdd(&bar[XB_TMO], 1u); break; } }
    }
    nloc = mine > 0u ? mine : 1u; nx = cnt > 0u ? cnt : 1u;
}

__device__ __forceinline__ void xcd_barrier(const XcdBarrier& b) {
    asm volatile("s_waitcnt vmcnt(0)" ::: "memory");
    __syncthreads();
    if (threadIdx.x == 0) {
        unsigned* bar = b.bar;
        __builtin_amdgcn_s_waitcnt(0);
        unsigned nloc = b.st[0], nx = b.st[1];
        if (nloc == 0u) { xcd_barrier_complete(bar, b.x, b.G, nloc, nx); b.st[0] = nloc; b.st[1] = nx; }
        const unsigned old = xb_add(&bar[XB_XSUB(b.x)], 1u);
        const unsigned gen = old / nloc;
        if (old + 1u == (gen + 1u) * nloc) {
            __builtin_amdgcn_fence(__ATOMIC_RELEASE, "agent");
            asm volatile("s_waitcnt vmcnt(0)" ::: "memory");
            const unsigned og = xb_add(&bar[XB_TOP], 1u);
            const unsigned tg = og / nx;
            if (og + 1u == (tg + 1u) * nx) xb_add(&bar[XB_TOPGEN], 1u);
            else XB_SPIN(xb_ld(&bar[XB_TOPGEN]) == tg, bar);
            __builtin_amdgcn_fence(__ATOMIC_ACQUIRE, "agent");
            xb_add(&bar[XB_XGEN(b.x)], 1u);
            asm volatile("s_waitcnt vmcnt(0)" ::: "memory");
        } else {
            XB_SPIN(xb_ld(&bar[XB_XGEN(b.x)]) == gen, bar);
            __builtin_amdgcn_fence(__ATOMIC_ACQUIRE, "agent");
            asm volatile("s_waitcnt vmcnt(0)" ::: "memory");
        }
    }
    __syncthreads();
}

constexpr int NWAVES = 8;
constexpr int BATCH = 8, SEQ = 4096, DM = 1024, MTOK = BATCH * SEQ, INC = 4864, FF = 3584, NEXP = 8, AW = 768, AOW = 256;
constexpr float RMS_EPS = 1e-6f;
constexpr float QSCALE = 0.125f * 1.4426950408889634f;

constexpr size_t MiB = 1u << 20;
constexpr size_t WS_CTL = 0, CTL_ZERO_BYTES = 1 * MiB;
constexpr size_t WS_WIN = 1 * MiB;
constexpr size_t WIN_L = (size_t)INC * DM * 2;
constexpr size_t WS_WM = 20 * MiB; constexpr int KMIX = AOW + DM;
constexpr size_t WS_WOUT = 25 * MiB;
constexpr size_t WS_W13 = 29 * MiB;
constexpr size_t WS_W2 = 43 * MiB;
constexpr size_t WS_ROPE = 50 * MiB;
constexpr size_t WS_SS = 502 * MiB, SS_STRIDE = (size_t)MTOK * 4;
constexpr size_t WS_H = 118 * MiB;
constexpr size_t WS_Z = WS_H;
constexpr size_t WS_UT = 182 * MiB;
constexpr size_t WS_OATT = WS_Z - (size_t)(AOW / 8) * MTOK * 16;
constexpr size_t WS_Q = 214 * MiB, WS_K = 262 * MiB, WS_V = 310 * MiB;
constexpr size_t WS_GF = 358 * MiB, WS_GA = 422 * MiB;
constexpr size_t WS_MIX = 278 * MiB;
constexpr size_t WS_H2 = 118 * MiB, WS_TT = 182 * MiB;
constexpr size_t WS_M13 = 54 * MiB, WS_M2 = 110 * MiB;
constexpr size_t WS_H2B = 138 * MiB, WS_TTB = 170 * MiB;
constexpr float W13_SCALE = 32.0f, W2_SCALE = 64.0f;
constexpr int MOE_ROWS = MTOK + 2048;
constexpr int MOE_TILES = MOE_ROWS / 256;
constexpr size_t WS_ROWTOK = 52 * MiB, WS_ROWW = WS_ROWTOK + 512 * 1024;
constexpr size_t WS_SEL = 53 * MiB, WS_WTS = WS_SEL + 128 * 1024;
constexpr size_t WS_CNT = WS_WTS + 256 * 1024, WS_PLAN = WS_CNT + 64 * 1024;
constexpr size_t WS_WG8 = 96 * MiB;
constexpr size_t WS_WQK8 = 486 * MiB;
constexpr size_t WS_X8 = 504 * MiB;
constexpr float WG_SCALE = pg8::WG8_SCALE;
constexpr size_t WS_Y = 408 * MiB;
constexpr size_t WS_END = 536 * MiB;
static_assert(WS_TTB + (size_t)2 * MOE_ROWS * FF <= WS_Y && WS_Y + (size_t)2 * MTOK * DM * 2 <= WS_END && 2 * MOE_ROWS * 4 <= 512 * 1024 && WS_PLAN + 4096 <= 54 * MiB, "moe map");
static_assert(WS_M13 + (size_t)8 * 2 * FF * DM <= WS_M2 && WS_M2 + (size_t)8 * DM * FF <= WS_H2B && WS_H2B + (size_t)MTOK * DM <= WS_TTB && WS_MIX + (size_t)MTOK * DM * 2 <= WS_GF, "d_ws map");

constexpr int XP = 2 * DM;
constexpr int CW_BAR = 4096;
constexpr int RING_BYTES = 131072, LDS_BYTES = 147456, LDSCTL_OFF = LDS_BYTES - 1024, MISC_OFF = LDSCTL_OFF + 320;
static_assert(512 * 68 * 4 <= LDSCTL_OFF, "attention state fits under the control words");

struct Args { const float* in[16]; float* out; unsigned char* ws; int G, pad; };

struct Frame { LAS unsigned char* lds; volatile LAS unsigned* MISC; gu32* ctl; int tid, lane, wave, vcu, G; };

__device__ __forceinline__ float wave_sum(float v, int lane) {
#pragma unroll
    for (int o = 1; o < 64; o <<= 1) v += __int_as_float(__builtin_amdgcn_ds_bpermute((lane ^ o) << 2, __float_as_int(v)));
    return v;
}
__device__ __forceinline__ float bflo(unsigned w) { return __uint_as_float(w << 16); }
__device__ __forceinline__ float bfhi(unsigned w) { return __uint_as_float(w & 0xffff0000u); }

struct RowMap { int kind, base;
    __device__ __forceinline__ int operator()(int n) const {
        if (kind == 0) return n + base;
        if (kind == 2) return (n >> 2) * 8 + (n & 3) + base;
        if (kind == 5) { const int isk = n >= 768, c = n - (isk ? 768 : 0), hd = c >> 6, d = c & 63; return (isk ? 768 : 0) + hd * 64 + 2 * (d & 31) + (d >> 5); }
        if (kind == 4) { const int gch = n & 1023; return (gch >> 7) * 256 + (gch & 127) + (n >= 1024 ? 128 : 0); }
        if (kind == 3) return (n >> 7) * 256 + (n & 127) + base;
        if (n < 512) return n;
        if (n < 2048) { const int isk = n >= 1280, c = n - (isk ? 1280 : 512), hd = c >> 6, d = c & 63; return (isk ? 2048 : 1280) + hd * 64 + 2 * (d & 31) + (d >> 5); }
        if (n < 2816) return 512 + (n - 2048);
        { const int gch = (n - 2816) & 1023; return 2816 + (gch >> 7) * 256 + (gch & 127) + (n >= 3840 ? 128 : 0); }
    } };
struct TrJob { const float* W; int N; void* WT; int ldk; RowMap rm; const float* gain; float scale; int item; int ldw; int f8; };
__device__ __forceinline__ void tr_load(const TrJob& j, int lane, float (&r)[32]) {
    const int nblk = j.N / 32, kb = j.item / nblk, nb = j.item % nblk, k0 = 64 * kb, n0 = 32 * nb;
#pragma unroll
    for (int i = 0; i < 32; ++i) { const int kk = 2 * i + (lane >> 5); r[i] = j.W[(size_t)(k0 + kk) * (j.ldw ? j.ldw : j.N) + n0 + (lane & 31)]; }
}
template <bool F8> __device__ __forceinline__ void tr_store(const TrJob& j, int lane, const float (&r)[32], LAS float* scr) {
    const int nblk = j.N / 32, kb = j.item / nblk, nb = j.item % nblk, k0 = 64 * kb, n0 = 32 * nb;
#pragma unroll
    for (int i = 0; i < 32; ++i) { const int kk = 2 * i + (lane >> 5); scr[kk * 33 + (lane & 31)] = r[i] * (j.gain ? j.scale * j.gain[k0 + kk] : j.scale); }
    LDS_WAIT(); asm volatile("" ::: "memory");
    const int c = lane & 7;
#pragma unroll
    for (int q = 0; q < 4; ++q) { const int n = (lane >> 3) + 8 * q; const LAS float* sp = scr + (8 * c) * 33 + n; const size_t drow = (size_t)j.rm(n0 + n) * j.ldk + k0 + 8 * c;
        if (F8) { unsigned lo = pg8::pk_fp8(sp[0 * 33], sp[1 * 33], 0u, false); lo = pg8::pk_fp8(sp[2 * 33], sp[3 * 33], lo, true);
                  unsigned hi = pg8::pk_fp8(sp[4 * 33], sp[5 * 33], 0u, false); hi = pg8::pk_fp8(sp[6 * 33], sp[7 * 33], hi, true);
                  *(GAS unsigned long long*)((unsigned char*)j.WT + drow) = (unsigned long long)lo | ((unsigned long long)hi << 32); }
        else { v4u o; o.x = pk2(sp[0 * 33], sp[1 * 33]); o.y = pk2(sp[2 * 33], sp[3 * 33]); o.z = pk2(sp[4 * 33], sp[5 * 33]); o.w = pk2(sp[6 * 33], sp[7 * 33]);
               *(GAS v4u*)((bf16*)j.WT + drow) = o; } }
    LDS_WAIT(); asm volatile("" ::: "memory");
}
__device__ __forceinline__ void rms_row(const bf16* xrow, const f32x4 (&gn)[4], f32x4 (&v)[4], int lane) {
    const GAS unsigned long long* xr = (const GAS unsigned long long*)xrow + lane; float s = 0.f;
#pragma unroll
    for (int j = 0; j < 4; ++j) { const unsigned long long w = xr[64 * j]; v[j].x = bflo((unsigned)w); v[j].y = bfhi((unsigned)w); v[j].z = bflo((unsigned)(w >> 32)); v[j].w = bfhi((unsigned)(w >> 32)); s += (v[j].x * v[j].x + v[j].y * v[j].y) + (v[j].z * v[j].z + v[j].w * v[j].w); }
    const float rstd = 1.0f / sqrtf(wave_sum(s, lane) * (1.0f / DM) + RMS_EPS);
#pragma unroll
    for (int j = 0; j < 4; ++j) v[j] = v[j] * rstd * gn[j];
}
__device__ __forceinline__ void prep_x_phase(Frame& F, const float* x, bf16* xb, float* ss, unsigned char* x8) {
    const int gw = F.vcu * NWAVES + F.wave, NGW = F.G * NWAVES;
    for (int m = gw; m < MTOK; m += NGW) { const GAS f32x4* xr = (const GAS f32x4*)(x + (size_t)m * DM) + F.lane; f32x4 v[4]; float sq = 0.f;
#pragma unroll
        for (int j = 0; j < 4; ++j) { v[j] = xr[64 * j]; sq += (v[j].x * v[j].x + v[j].y * v[j].y) + (v[j].z * v[j].z + v[j].w * v[j].w); }
        sq = wave_sum(sq, F.lane); if (F.lane < 4) ss[(size_t)m * 4 + F.lane] = F.lane == 0 ? sq : 0.f;
        GAS unsigned long long* o8 = (GAS unsigned long long*)(xb + (size_t)m * XP) + F.lane;
#pragma unroll
        for (int j = 0; j < 4; ++j) o8[64 * j] = (unsigned long long)pk2(v[j].x, v[j].y) | ((unsigned long long)pk2(v[j].z, v[j].w) << 32);
        GAS unsigned* q8 = (GAS unsigned*)(x8 + (size_t)m * DM) + F.lane;
#pragma unroll
        for (int j = 0; j < 4; ++j) { unsigned w8 = pg8::pk_fp8(v[j].x, v[j].y, 0u, false); w8 = pg8::pk_fp8(v[j].z, v[j].w, w8, true); q8[64 * j] = w8; } }
}

__device__ __forceinline__ TrJob dense_job(const Args& a, int it) {
    unsigned char* ws = a.ws;
    constexpr int I_U = 16 * (512 / 32), I_V = 16 * (768 / 32), I_AT = 4 * 32, I_OUT = 16 * 32, I_W1 = 16 * (FF / 32), I_G = 16 * (2048 / 32), I_QK = 16 * (1536 / 32);
    constexpr int PER_L = I_U + I_V + I_AT + I_OUT;
    int r = it; TrJob j; j.gain = nullptr; j.scale = 1.0f; j.rm = RowMap{0, 0}; j.ldw = 0; j.f8 = 0;
    if (r < 2 * PER_L) { const int l = r / PER_L; r -= l * PER_L;
        if (r < I_U) { j.W = a.in[2] + (size_t)l * DM * INC; j.N = 512; j.ldw = INC; j.WT = ws + WS_WIN + l * WIN_L; j.ldk = DM; j.gain = a.in[1] + l * DM; }
        else if (r < I_U + I_V) { r -= I_U; j.W = a.in[2] + (size_t)l * DM * INC + 2048; j.N = 768; j.ldw = INC; j.WT = ws + WS_WIN + l * WIN_L; j.ldk = DM; j.rm = RowMap{0, 512}; j.gain = a.in[1] + l * DM; }
        else if (r < I_U + I_V + I_AT) { r -= I_U + I_V; j.W = a.in[4] + (size_t)l * AOW * DM; j.N = DM; j.WT = (bf16*)(ws + WS_WM) + (size_t)l * DM * KMIX; j.ldk = KMIX; }
        else { r -= I_U + I_V + I_AT; j.W = a.in[5] + (size_t)l * DM * DM; j.N = DM; j.WT = (bf16*)(ws + WS_WOUT) + (size_t)l * DM * DM; j.ldk = DM; } }
    else { r -= 2 * PER_L;
        if (r < I_W1) { j.W = a.in[7]; j.N = FF; j.WT = ws + WS_W13; j.ldk = DM; j.rm = RowMap{3, 0}; j.gain = a.in[6]; }
        else if (r < 2 * I_W1) { r -= I_W1; j.W = a.in[8]; j.N = FF; j.WT = ws + WS_W13; j.ldk = DM; j.rm = RowMap{3, 128}; j.gain = a.in[6]; }
        else if (r < 3 * I_W1) { r -= 2 * I_W1; j.W = a.in[9]; j.N = DM; j.WT = ws + WS_W2; j.ldk = FF; }
        else if (r < 3 * I_W1 + 2 * I_G) { r -= 3 * I_W1; const int l = r / I_G; r -= l * I_G; j.W = a.in[2] + (size_t)l * DM * INC + 2816; j.N = 2048; j.ldw = INC; j.WT = ws + WS_WG8 + (size_t)l * 2048 * DM; j.ldk = DM; j.rm = RowMap{4, 0};
               j.gain = a.in[1] + l * DM; j.scale = WG_SCALE; j.f8 = 1; }
        else { r -= 3 * I_W1 + 2 * I_G; const int l = r / I_QK; r -= l * I_QK; j.W = a.in[2] + (size_t)l * DM * INC + 512; j.N = 1536; j.ldw = INC; j.WT = ws + WS_WQK8 + (size_t)l * 1536 * DM; j.ldk = DM; j.rm = RowMap{5, 0};
               j.gain = a.in[1] + l * DM; j.scale = WG_SCALE; j.f8 = 1; } }
    j.item = r; return j;
}
constexpr int MOE_I_W1 = 16 * (FF / 32), MOE_I_W2 = (FF / 64) * 32, MOE_NITEMS = NEXP * (2 * MOE_I_W1 + MOE_I_W2), MOE_EARLY_E = 6, MOE_EARLY = MOE_EARLY_E * 2 * MOE_I_W1;
constexpr int CONV_WGS = 40, GEMM_WGS = 256 - CONV_WGS, CONV_PER_WAVE = 22, CONV_PHASE_ITEMS = CONV_WGS * NWAVES * CONV_PER_WAVE;
static_assert(2 * CONV_PHASE_ITEMS <= MOE_EARLY && GEMM_WGS % 8 == 0 && (640 + GEMM_WGS - 1) / GEMM_WGS == 3, "early conversion");
__device__ __forceinline__ TrJob moe_job(const Args& a, int v) {
    unsigned char* ws = a.ws;
    constexpr int I_W1 = MOE_I_W1;
    int e, r;
    if (v < MOE_EARLY) { e = v / (2 * I_W1); r = v - e * (2 * I_W1); }
    else { v -= MOE_EARLY; if (v < (NEXP - MOE_EARLY_E) * 2 * I_W1) { const int q = v / (2 * I_W1); e = MOE_EARLY_E + q; r = v - q * (2 * I_W1); } else { v -= (NEXP - MOE_EARLY_E) * 2 * I_W1; e = v / MOE_I_W2; r = 2 * I_W1 + (v - e * MOE_I_W2); } }
    TrJob j; j.gain = nullptr; j.scale = W13_SCALE; j.rm = RowMap{3, 0}; j.ldw = 0; j.f8 = 1;
    if (r < I_W1) { j.W = a.in[12] + (size_t)e * DM * FF; j.N = FF; j.WT = ws + WS_M13 + (size_t)e * 2 * FF * DM; j.ldk = DM; }
    else if (r < 2 * I_W1) { r -= I_W1; j.W = a.in[13] + (size_t)e * DM * FF; j.N = FF; j.WT = ws + WS_M13 + (size_t)e * 2 * FF * DM; j.ldk = DM; j.rm = RowMap{3, 128}; }
    else { r -= 2 * I_W1; j.W = a.in[14] + (size_t)e * FF * DM; j.N = DM; j.WT = ws + WS_M2 + (size_t)e * DM * FF; j.ldk = FF; j.scale = W2_SCALE; j.rm = RowMap{0, 0}; }
    j.item = r; return j;
}
__device__ __forceinline__ void p0_weights(Frame& F, const Args& a) {
    LAS float* scr = (LAS float*)(F.lds + F.wave * 16384);
    const int gw = F.vcu * NWAVES + F.wave, NGW = F.G * NWAVES;
    constexpr int I_IN = 16 * (512 / 32) + 16 * (768 / 32), I_AT = 4 * 32, I_OUT = 16 * 32, I_W1 = 16 * (FF / 32), I_W2 = (FF / 64) * 32, I_G = 16 * (2048 / 32), I_QK = 16 * (1536 / 32), NITEMS = 2 * (I_IN + I_AT + I_OUT) + 2 * I_W1 + I_W2 + 2 * I_G + 2 * I_QK;
    static_assert(I_W2 == I_W1, "dense_job counts w2's items as I_W1");
    if (gw >= NITEMS) return;
    TrJob cur = dense_job(a, gw); float rc[32]; tr_load(cur, F.lane, rc);
#pragma unroll 1
    for (int it = gw; it < NITEMS; it += NGW) { const int nx = it + NGW; const bool more = nx < NITEMS; TrJob nj = cur; float rn[32];
        if (more) { nj = dense_job(a, nx); tr_load(nj, F.lane, rn); }
        if (cur.f8) tr_store<true>(cur, F.lane, rc, scr); else tr_store<false>(cur, F.lane, rc, scr);
        if (more) { cur = nj;
#pragma unroll
            for (int i = 0; i < 32; ++i) rc[i] = rn[i]; } }
}
__device__ __forceinline__ void p0_moe_weights(Frame& F, const Args& a, int first, int NITEMS, int gw, int NGW) {
    LAS float* scr = (LAS float*)(F.lds + F.wave * 16384);
    gw += first;
    if (gw >= NITEMS) return;
    TrJob cur = moe_job(a, gw), nx1 = cur; float rc[32], r1[32];
    tr_load(cur, F.lane, rc);
    if (gw + NGW < NITEMS) { nx1 = moe_job(a, gw + NGW); tr_load(nx1, F.lane, r1); }
#pragma unroll 1
    for (int it = gw; it < NITEMS; it += NGW) { const int n2 = it + 2 * NGW; const bool more2 = n2 < NITEMS, more1 = it + NGW < NITEMS; TrJob nx2 = cur; float r2[32];
        if (more2) { nx2 = moe_job(a, n2); tr_load(nx2, F.lane, r2); }
        tr_store<true>(cur, F.lane, rc, scr);
        if (more1) { cur = nx1;
#pragma unroll
            for (int i = 0; i < 32; ++i) rc[i] = r1[i]; }
        if (more2) { nx1 = nx2;
#pragma unroll
            for (int i = 0; i < 32; ++i) r1[i] = r2[i]; } }
}
__device__ __forceinline__ void p0_tables(Frame& F, const Args& a) {
    unsigned char* ws = a.ws;
    const int gt = F.vcu * (NWAVES * 64) + F.tid, NGT = F.G * NWAVES * 64;
    float* rope = (float*)(ws + WS_ROPE);
    for (int i = gt; i < SEQ * 32; i += NGT) { const int pos = i >> 5, f = i & 31; const float inv = powf(10000.0f, -(float)f * 2.0f / 64.0f); const float ang = (float)pos * inv;
        rope[2 * i] = cosf(ang); rope[2 * i + 1] = sinf(ang); }
    LAS float* tab = (LAS float*)F.lds;
    LAS float* wl = (LAS float*)(F.lds + 1024 + F.wave * 2048);
    if (F.tid < 128) tab[F.tid] = cospif((float)F.tid * (1.0f / 64.0f));
    __syncthreads();
    const int gw = F.vcu * NWAVES + F.wave, NGW = F.G * NWAVES;
    for (int it = gw; it < 2 * DM; it += NGW) { const int l = it >> 10, j = it & 1023; const float* wf = a.in[3] + (size_t)l * 512 * DM + j;
#pragma unroll
        for (int q = 0; q < 8; ++q) wl[F.lane + 64 * q] = wf[(size_t)(F.lane + 64 * q) * DM];
        LDS_WAIT(); asm volatile("" ::: "memory");
#pragma unroll 1
        for (int o = 0; o < 16; ++o) { const int kk = o * 64 + F.lane, part = kk & 1, cf = 4 * (kk >> 3) + ((kk >> 1) & 3), g = cf >> 7, c = cf & 127, sh = part ? 96 : 0;
            const float c1 = tab[c], tw = 2.0f * c1; float u0 = part ? 0.f : 1.f, u1 = part ? tab[(c + sh) & 127] : c1;
            float acc = 0.f, acc2 = 0.f; const LAS float* wg = wl + g * 128;
#pragma unroll 4
            for (int kc = 0; kc < 128; kc += 4) { const f32x4 w4 = *(const LAS f32x4*)(wg + kc);
                const float u2 = tw * u1 - u0, u3 = tw * u2 - u1; acc += u0 * w4[0]; acc2 += u1 * w4[1]; acc += u2 * w4[2]; acc2 += u3 * w4[3]; u0 = tw * u3 - u2; u1 = tw * u0 - u3; }
            acc += acc2;
            ((bf16*)(ws + WS_WM))[(size_t)l * DM * KMIX + (size_t)j * KMIX + AOW + kk] = (bf16)f2bf(acc * 0.08838834764831845f); }
        LDS_WAIT(); asm volatile("" ::: "memory");
    }
}

__device__ __forceinline__ void fft_phase(Frame& F, const bf16* UT, bf16* Zb) {
    const int lane = F.lane, w = F.wave & 3, cg = F.wave >> 2, lr = lane & 15, lg = lane >> 4;
    LAS unsigned char* f2 = F.lds; LAS unsigned char* f1 = F.lds + 16384; LAS float* tw = (LAS float*)(F.lds + 32768);
#pragma unroll 1
    for (int idx = F.tid; idx < 4096; idx += NWAVES * 64) {
        { const int f = idx >> 8, l = (idx >> 2) & 63, e2 = idx & 3, q = f >> 2, KK = (f >> 1) & 1, cs = f & 1, llr = l & 15, llg = l >> 4; float v[2];
#pragma unroll
          for (int h = 0; h < 2; ++h) { const int e = 2 * e2 + h, n2 = 32 * KK + (e < 4 ? 4 * llg + e : 16 + 4 * llg + e - 4), k2 = 16 * q + llr; const float x = (float)((n2 * k2) & 63) * (1.0f / 32.0f); v[h] = (cs ? sinpif(x) : cospif(x)) * 0.125f; }
          *(LAS unsigned*)(f2 + f * 1024 + l * 16 + e2 * 4) = pk2(v[0], v[1]); }
        { const int f = idx >> 8, l = (idx >> 2) & 63, e2 = idx & 3, ww = f >> 2, kk = (f >> 1) & 1, cs = f & 1, llr = l & 15, llg = l >> 4; float v[2];
#pragma unroll
          for (int h = 0; h < 2; ++h) { const int n1 = 32 * kk + 8 * llg + 2 * e2 + h, k1 = 16 * ww + llr; const float x = (float)((n1 * k1) & 63) * (1.0f / 32.0f); v[h] = (cs ? -sinpif(x) : cospif(x)) * 0.125f; }
          *(LAS unsigned*)(f1 + f * 1024 + l * 16 + e2 * 4) = pk2(v[0], v[1]); }
        { const int ww = idx >> 10, l = (idx >> 4) & 63, ir = idx & 15, n2 = 16 * (ir >> 2) + 4 * (l >> 4) + (ir & 3), k1 = 16 * ww + (l & 15); const float x = (float)(n2 * k1) * (1.0f / 2048.0f);
          tw[(ww * 64 + l) * 32 + ir] = cospif(x); tw[(ww * 64 + l) * 32 + 16 + ir] = sinpif(x); }
    }
    __syncthreads();
    bf16x8 F1c[2], F1s[2];
#pragma unroll
    for (int kk = 0; kk < 2; ++kk) { F1c[kk] = *(const LAS bf16x8*)(f1 + ((w * 2 + kk) * 2) * 1024 + lane * 16); F1s[kk] = *(const LAS bf16x8*)(f1 + ((w * 2 + kk) * 2 + 1) * 1024 + lane * 16); }
    float twc[4][4], tws[4][4];
#pragma unroll
    for (int I = 0; I < 4; ++I) { const f32x4 tc = *(const LAS f32x4*)(tw + (w * 64 + lane) * 32 + 4 * I), ts = *(const LAS f32x4*)(tw + (w * 64 + lane) * 32 + 16 + 4 * I);
#pragma unroll
        for (int r = 0; r < 4; ++r) { twc[I][r] = tc[r]; tws[I][r] = ts[r]; } }
    for (int it = F.vcu * 2 + cg; it < BATCH * 128; it += F.G * 2) {
        const int b = it >> 7, quad = it & 127;
        unsigned outp[4][4][4];
#pragma unroll
        for (int cc = 0; cc < 4; ++cc) {
            const bf16* xp = UT + (size_t)(quad * 4 + cc) * MTOK + b * SEQ + 64 * lr + 8 * lg;
            bf16x8 xa[4][2];
#pragma unroll
            for (int I = 0; I < 4; ++I)
#pragma unroll
                for (int kk = 0; kk < 2; ++kk) xa[I][kk] = *(const GAS bf16x8*)(xp + 1024 * I + 32 * kk);
            f32x4 d1r[4], d1i[4];
#pragma unroll
            for (int I = 0; I < 4; ++I) { d1r[I] = (f32x4){0.f, 0.f, 0.f, 0.f}; d1i[I] = (f32x4){0.f, 0.f, 0.f, 0.f};
#pragma unroll
                for (int kk = 0; kk < 2; ++kk) { d1r[I] = __builtin_amdgcn_mfma_f32_16x16x32_bf16(xa[I][kk], F1c[kk], d1r[I], 0, 0, 0); d1i[I] = __builtin_amdgcn_mfma_f32_16x16x32_bf16(xa[I][kk], F1s[kk], d1i[I], 0, 0, 0); } }
            bf16x8 yr[2], yi[2], yn[2];
#pragma unroll
            for (int KK = 0; KK < 2; ++KK) { float vr[8], vi[8];
#pragma unroll
                for (int e = 0; e < 8; ++e) { const int I = 2 * KK + (e >> 2), r = e & 3; const float a = d1r[I][r], bb = d1i[I][r]; vr[e] = a * twc[I][r] + bb * tws[I][r]; vi[e] = bb * twc[I][r] - a * tws[I][r]; }
                v4u pr, pi, pn; pr.x = pg8::cvt_pk_bf16(vr[0], vr[1]); pr.y = pg8::cvt_pk_bf16(vr[2], vr[3]); pr.z = pg8::cvt_pk_bf16(vr[4], vr[5]); pr.w = pg8::cvt_pk_bf16(vr[6], vr[7]);
                pi.x = pg8::cvt_pk_bf16(vi[0], vi[1]); pi.y = pg8::cvt_pk_bf16(vi[2], vi[3]); pi.z = pg8::cvt_pk_bf16(vi[4], vi[5]); pi.w = pg8::cvt_pk_bf16(vi[6], vi[7]);
                pn.x = pr.x ^ 0x80008000u; pn.y = pr.y ^ 0x80008000u; pn.z = pr.z ^ 0x80008000u; pn.w = pr.w ^ 0x80008000u;
                yr[KK] = __builtin_bit_cast(bf16x8, pr); yi[KK] = __builtin_bit_cast(bf16x8, pi); yn[KK] = __builtin_bit_cast(bf16x8, pn); }
#pragma unroll
            for (int q = 0; q < 4; ++q) { f32x4 zr = (f32x4){0.f, 0.f, 0.f, 0.f}, zi = (f32x4){0.f, 0.f, 0.f, 0.f};
#pragma unroll
                for (int KK = 0; KK < 2; ++KK) { const bf16x8 fc = *(const LAS bf16x8*)(f2 + ((q * 2 + KK) * 2) * 1024 + lane * 16), fs = *(const LAS bf16x8*)(f2 + ((q * 2 + KK) * 2 + 1) * 1024 + lane * 16);
                    zr = __builtin_amdgcn_mfma_f32_16x16x32_bf16(yr[KK], fc, zr, 0, 0, 0); zr = __builtin_amdgcn_mfma_f32_16x16x32_bf16(yi[KK], fs, zr, 0, 0, 0);
                    zi = __builtin_amdgcn_mfma_f32_16x16x32_bf16(yi[KK], fc, zi, 0, 0, 0); zi = __builtin_amdgcn_mfma_f32_16x16x32_bf16(yn[KK], fs, zi, 0, 0, 0); }
#pragma unroll
                for (int r = 0; r < 4; ++r) outp[q][r][cc] = pg8::cvt_pk_bf16(zr[r], zi[r]); }
        }
#pragma unroll
        for (int q = 0; q < 4; ++q)
#pragma unroll
            for (int r = 0; r < 4; ++r) { const int k = 16 * w + 4 * lg + r + 64 * (16 * q + lr); v4u o; o.x = outp[q][r][0]; o.y = outp[q][r][1]; o.z = outp[q][r][2]; o.w = outp[q][r][3];
                *(GAS v4u*)(Zb + ((size_t)quad * MTOK + (size_t)b * SEQ + k) * 8) = o; }
    }
    __syncthreads();
}

__device__ __forceinline__ bf16x8 f8x8_bf16(unsigned long long w) {
    typedef float f32x2_t __attribute__((ext_vector_type(2)));
    const f32x2_t a = __builtin_amdgcn_cvt_pk_f32_fp8((int)(unsigned)w, false), b = __builtin_amdgcn_cvt_pk_f32_fp8((int)(unsigned)w, true),
                  c = __builtin_amdgcn_cvt_pk_f32_fp8((int)(unsigned)(w >> 32), false), d = __builtin_amdgcn_cvt_pk_f32_fp8((int)(unsigned)(w >> 32), true);
    v4u o; o.x = pg8::cvt_pk_bf16(a.x, a.y); o.y = pg8::cvt_pk_bf16(b.x, b.y); o.z = pg8::cvt_pk_bf16(c.x, c.y); o.w = pg8::cvt_pk_bf16(d.x, d.y); return __builtin_bit_cast(bf16x8, o); }
__device__ __forceinline__ void attn_mfma_phase(Frame& F, const unsigned char* Q, const unsigned char* K, const unsigned char* VT, bf16* OA) {
    LAS float* st = (LAS float*)F.lds;
    const int lane = F.lane, lr = lane & 15, lg = lane >> 4, bp16 = (lane ^ 16) << 2, bp32 = (lane ^ 32) << 2;
    for (int unit = F.vcu; unit < 256; unit += F.G) {
        const int b = unit >> 5, pb = (unit >> 2) & 7, j = unit & 3, P0 = pb * 512;
#pragma unroll 1
        for (int pass = 0; pass < 3; ++pass) {
            const int g = 2 - pass, dsh = 2 * g, dl = 1 << dsh, L = SEQ >> dsh, head = g * 4 + j, lns = 4 - dsh;
#pragma unroll 1
            for (int tt = 0; tt < 2; ++tt) {
                const int tau = F.wave * 2 + tt, r = tau >> lns, sblk = tau & ((1 << lns) - 1), iq0 = (P0 >> dsh) + 32 * sblk;
                const unsigned char* Kh = K + (size_t)b * SEQ * AW + head * 64 + 8 * lg;
                const unsigned char* Vh = VT + (size_t)(head * 64 + lr) * MTOK + (size_t)b * SEQ + r * L;
                long qf[2][2]; int prow[2]; f32x4 o[4][2]; float m[2], l[2];
#pragma unroll
                for (int qb = 0; qb < 2; ++qb) { const int pl = dl * (32 * sblk + 16 * qb + lr) + r; prow[qb] = pl;
                    const unsigned char* qp = Q + (size_t)(b * SEQ + P0 + pl) * AW + head * 64 + 8 * lg;
                    qf[qb][0] = *(const GAS long*)qp; qf[qb][1] = *(const GAS long*)(qp + 32); }
                if (pass == 0) {
#pragma unroll
                    for (int qb = 0; qb < 2; ++qb) { m[qb] = -1e30f; l[qb] = 0.f;
#pragma unroll
                        for (int t = 0; t < 4; ++t) o[t][qb] = (f32x4){0.f, 0.f, 0.f, 0.f}; }
                } else {
#pragma unroll
                    for (int qb = 0; qb < 2; ++qb) { const LAS float* sp = st + prow[qb] * 68; m[qb] = sp[64]; l[qb] = lg == 0 ? sp[65] : 0.f;
#pragma unroll
                        for (int t = 0; t < 4; ++t) o[t][qb] = *(const LAS f32x4*)(sp + 16 * t + 4 * lg); }
                }
                typedef unsigned long long u64t; u64t kf[2][2], vf[4], kfn[2][2], vfn[4];
#define ATT_LOAD(c_, kd, vd) do { const int kb_ = iq0 - 64 + 32 * (c_); int ia_ = kb_ + 8 * (lr >> 2) + (lr & 3), ib_ = ia_ + 4; ia_ = ia_ < 0 ? 0 : (ia_ >= L ? L - 1 : ia_); ib_ = ib_ < 0 ? 0 : (ib_ >= L ? L - 1 : ib_); \
        const unsigned char* ka_ = Kh + (size_t)(dl * ia_ + r) * AW; const unsigned char* kb2_ = Kh + (size_t)(dl * ib_ + r) * AW; \
        kd[0][0] = *(const GAS u64t*)ka_; kd[0][1] = *(const GAS u64t*)(ka_ + 32); kd[1][0] = *(const GAS u64t*)kb2_; kd[1][1] = *(const GAS u64t*)(kb2_ + 32); \
        int vk_ = kb_ + 8 * lg; vk_ = vk_ < 0 ? 0 : (vk_ > L - 8 ? L - 8 : vk_); \
        _Pragma("unroll") for (int t_ = 0; t_ < 4; ++t_) vd[t_] = *(const GAS u64t*)(Vh + (size_t)(16 * t_) * MTOK + vk_); } while (0)
                ATT_LOAD(0, kf, vf);
#pragma unroll 1
                for (int c = 0; c < 5; ++c) {
                    if (c < 4) ATT_LOAD(c + 1, kfn, vfn);
                    const int kb = iq0 - 64 + 32 * c;
                    f32x4 s[2][2];
#pragma unroll
                    for (int tl = 0; tl < 2; ++tl) {
#pragma unroll
                        for (int qb = 0; qb < 2; ++qb) { s[tl][qb] = __builtin_amdgcn_mfma_f32_16x16x32_fp8_fp8((long)kf[tl][0], qf[qb][0], (f32x4){0.f, 0.f, 0.f, 0.f}, 0, 0, 0);
                            s[tl][qb] = __builtin_amdgcn_mfma_f32_16x16x32_fp8_fp8((long)kf[tl][1], qf[qb][1], s[tl][qb], 0, 0, 0); } }
                    long pf[2];
                    if (c == 0 || c == 4 || kb < 0 || kb + 32 > L) {
#pragma unroll
                        for (int qb = 0; qb < 2; ++qb) { const int iq = iq0 + 16 * qb + lr, lo = iq - 64 < 0 ? 0 : iq - 64, hi = iq + 64 > L - 1 ? L - 1 : iq + 64; const unsigned span = (unsigned)(hi - lo); const int k0 = kb + 8 * lg - lo;
#pragma unroll
                            for (int e = 0; e < 8; ++e) s[e >> 2][qb][e & 3] = (unsigned)(k0 + e) <= span ? s[e >> 2][qb][e & 3] : -__builtin_inff(); } }
#pragma unroll
                    for (int qb = 0; qb < 2; ++qb) { float sv[8]; float mx = -__builtin_inff();
#pragma unroll
                        for (int e = 0; e < 8; ++e) { sv[e] = s[e >> 2][qb][e & 3]; mx = fmaxf(mx, sv[e]); }
                        mx = fmaxf(mx, __int_as_float(__builtin_amdgcn_ds_bpermute(bp16, __float_as_int(mx)))); mx = fmaxf(mx, __int_as_float(__builtin_amdgcn_ds_bpermute(bp32, __float_as_int(mx))));
                        const float mn = fmaxf(m[qb], mx), al = __builtin_amdgcn_exp2f(m[qb] - mn); m[qb] = mn; float ps = 0.f; float p[8];
#pragma unroll
                        for (int e = 0; e < 8; ++e) { p[e] = __builtin_amdgcn_exp2f(sv[e] - mn); ps += p[e]; }
                        l[qb] = l[qb] * al + ps;
#pragma unroll
                        for (int t = 0; t < 4; ++t) o[t][qb] = o[t][qb] * al;
                        unsigned plo = (unsigned)__builtin_amdgcn_cvt_pk_fp8_f32(p[0], p[1], 0, false); plo = (unsigned)__builtin_amdgcn_cvt_pk_fp8_f32(p[2], p[3], (int)plo, true);
                        unsigned phi = (unsigned)__builtin_amdgcn_cvt_pk_fp8_f32(p[4], p[5], 0, false); phi = (unsigned)__builtin_amdgcn_cvt_pk_fp8_f32(p[6], p[7], (int)phi, true);
                        pf[qb] = (long)((unsigned long long)plo | ((unsigned long long)phi << 32)); }
#pragma unroll
                    for (int t = 0; t < 4; ++t) {
#pragma unroll
                        for (int qb = 0; qb < 2; ++qb) o[t][qb] = __builtin_amdgcn_mfma_f32_16x16x32_fp8_fp8((long)vf[t], pf[qb], o[t][qb], 0, 0, 0); }
#pragma unroll
                    for (int tl = 0; tl < 2; ++tl) { kf[tl][0] = kfn[tl][0]; kf[tl][1] = kfn[tl][1]; }
#pragma unroll
                    for (int t = 0; t < 4; ++t) vf[t] = vfn[t];
                }
#undef ATT_LOAD
#pragma unroll
                for (int qb = 0; qb < 2; ++qb) { float lt = l[qb]; lt += __int_as_float(__builtin_amdgcn_ds_bpermute(bp16, __float_as_int(lt))); lt += __int_as_float(__builtin_amdgcn_ds_bpermute(bp32, __float_as_int(lt)));
                    if (pass < 2) { LAS float* sp = st + prow[qb] * 68;
#pragma unroll
                        for (int t = 0; t < 4; ++t) *(LAS f32x4*)(sp + 16 * t + 4 * lg) = o[t][qb];
                        if (lg == 0) { sp[64] = m[qb]; sp[65] = lt; } }
                    else { const float il = 1.0f / lt; bf16* op = OA + ((size_t)(8 * j + (lg >> 1)) * MTOK + (size_t)(b * SEQ + P0 + prow[qb])) * 8 + 4 * (lg & 1);
#pragma unroll
                        for (int t = 0; t < 4; ++t) { const f32x4 x = o[t][qb] * il; *(GAS unsigned long long*)(op + (size_t)(2 * t) * MTOK * 8) = (unsigned long long)pg8::cvt_pk_bf16(x[0], x[1]) | ((unsigned long long)pg8::cvt_pk_bf16(x[2], x[3]) << 32); } } }
            }
            __syncthreads();
        }
    }
}

__device__ __forceinline__ void norm_router_phase(Frame& F, const bf16* x, const float* gain, unsigned char* out8, const float* rw, const float* rb, int* SEL, float* WTS, int* CNT) {
    LAS float* wr = (LAS float*)F.lds;
    LAS int* sel_l = (LAS int*)(F.lds + 32768);
    for (int i = F.tid; i < DM * NEXP; i += NWAVES * 64) { const int k = i >> 3, e = i & 7; wr[(((e >> 2) * 1024) + (k & 3) * 256 + (k >> 2)) * 4 + (e & 3)] = rw[i]; }
    __syncthreads();
    f32x4 gn[4];
#pragma unroll
    for (int j = 0; j < 4; ++j) gn[j] = ((const GAS f32x4*)gain)[F.lane + 64 * j];
    typedef unsigned long long u64r;
    u64r rw_[4];
    { const GAS u64r* xr = (const GAS u64r*)(x + (size_t)(F.vcu * 128 + F.wave * 16) * XP) + F.lane;
#pragma unroll
      for (int j = 0; j < 4; ++j) rw_[j] = xr[64 * j]; }
    const bool b0 = F.lane & 1, b1 = F.lane & 2, b2 = F.lane & 4;
#pragma unroll 1
    for (int i = 0; i < 16; ++i) { const int tl = F.wave * 16 + i, m = F.vcu * 128 + tl; f32x4 v[4]; float ssq = 0.f;
#pragma unroll
        for (int j = 0; j < 4; ++j) { const u64r w = rw_[j]; v[j].x = bflo((unsigned)w); v[j].y = bfhi((unsigned)w); v[j].z = bflo((unsigned)(w >> 32)); v[j].w = bfhi((unsigned)(w >> 32));
            ssq += (v[j].x * v[j].x + v[j].y * v[j].y) + (v[j].z * v[j].z + v[j].w * v[j].w); }
        if (i < 15) { const GAS u64r* xr = (const GAS u64r*)(x + (size_t)(m + 1) * XP) + F.lane;
#pragma unroll
            for (int j = 0; j < 4; ++j) rw_[j] = xr[64 * j]; }
        const float rstd = 1.0f / sqrtf(wave_sum(ssq, F.lane) * (1.0f / DM) + RMS_EPS);
#pragma unroll
        for (int j = 0; j < 4; ++j) v[j] = v[j] * rstd * gn[j];
        GAS unsigned* o4 = (GAS unsigned*)(out8 + (size_t)m * DM) + F.lane;
#pragma unroll
        for (int j = 0; j < 4; ++j) { unsigned w8 = pg8::pk_fp8(v[j].x, v[j].y, 0u, false); w8 = pg8::pk_fp8(v[j].z, v[j].w, w8, true); o4[64 * j] = w8; }
        float lg[8];
#pragma unroll
        for (int e = 0; e < 8; ++e) lg[e] = 0.f;
#pragma unroll
        for (int j = 0; j < 4; ++j)
#pragma unroll
            for (int cc = 0; cc < 4; ++cc) { const int sl = cc * 256 + F.lane + 64 * j; const f32x4 wa = *(const LAS f32x4*)(wr + sl * 4), wb = *(const LAS f32x4*)(wr + 4096 + sl * 4); const float xv = v[j][cc];
                lg[0] += xv * wa[0]; lg[1] += xv * wa[1]; lg[2] += xv * wa[2]; lg[3] += xv * wa[3]; lg[4] += xv * wb[0]; lg[5] += xv * wb[1]; lg[6] += xv * wb[2]; lg[7] += xv * wb[3]; }
#define XCH(v_, o_) __int_as_float(__builtin_amdgcn_ds_bpermute((F.lane ^ (o_)) << 2, __float_as_int(v_)))
        float ra[4], rb2[2], rc;
#pragma unroll
        for (int t = 0; t < 4; ++t) { const float send = b0 ? lg[t] : lg[t + 4], keep = b0 ? lg[t + 4] : lg[t]; ra[t] = keep + XCH(send, 1); }
#pragma unroll
        for (int t = 0; t < 2; ++t) { const float send = b1 ? ra[t] : ra[t + 2], keep = b1 ? ra[t + 2] : ra[t]; rb2[t] = keep + XCH(send, 2); }
        { const float send = b2 ? rb2[0] : rb2[1], keep = b2 ? rb2[1] : rb2[0]; rc = keep + XCH(send, 4); }
        rc += XCH(rc, 8); rc += XCH(rc, 16); rc += XCH(rc, 32);
#undef XCH
        lg[0] = __int_as_float(__builtin_amdgcn_readlane(__float_as_int(rc), 0)) + rb[0]; lg[1] = __int_as_float(__builtin_amdgcn_readlane(__float_as_int(rc), 4)) + rb[1];
        lg[2] = __int_as_float(__builtin_amdgcn_readlane(__float_as_int(rc), 2)) + rb[2]; lg[3] = __int_as_float(__builtin_amdgcn_readlane(__float_as_int(rc), 6)) + rb[3];
        lg[4] = __int_as_float(__builtin_amdgcn_readlane(__float_as_int(rc), 1)) + rb[4]; lg[5] = __int_as_float(__builtin_amdgcn_readlane(__float_as_int(rc), 5)) + rb[5];
        lg[6] = __int_as_float(__builtin_amdgcn_readlane(__float_as_int(rc), 3)) + rb[6]; lg[7] = __int_as_float(__builtin_amdgcn_readlane(__float_as_int(rc), 7)) + rb[7];
        int e0 = 0; float v0 = lg[0];
#pragma unroll
        for (int e = 1; e < 8; ++e) if (lg[e] > v0) { v0 = lg[e]; e0 = e; }
        int e1 = 0; float v1 = -__builtin_inff();
#pragma unroll
        for (int e = 0; e < 8; ++e) if (e != e0 && lg[e] > v1) { v1 = lg[e]; e1 = e; }
        const float w0 = 1.0f / (1.0f + expf(v1 - v0)), w1 = 1.0f - w0;
        if (F.lane == 0) { sel_l[tl] = e0 | (e1 << 8); WTS[2 * (size_t)m] = w0; WTS[2 * (size_t)m + 1] = w1; }
    }
    __syncthreads();
    if (F.tid < 128) { const int me = sel_l[F.tid], e0 = me & 255, e1 = me >> 8; int r0 = 0, r1 = 0;
        for (int t = 0; t < F.tid; ++t) { const int o = sel_l[t]; r0 += ((o & 255) == e0); r1 += ((o >> 8) == e1); }
        SEL[F.vcu * 128 + F.tid] = me | (r0 << 16) | (r1 << 24); }
    else if (F.tid < 144) { const int q = F.tid - 128, s = q >> 3, e = q & 7; int n = 0;
        for (int t = 0; t < 128; ++t) { const int o = sel_l[t]; n += ((s ? (o >> 8) : (o & 255)) == e); }
        CNT[F.vcu * 16 + q] = n; }
    __syncthreads();
}
__device__ __forceinline__ void route2_phase(Frame& F, const int* SEL, const float* WTS, const int* CNT, int* ROWTOK, float* ROWW, int* PLAN) {
    LAS int* call = (LAS int*)F.lds;
    LAS int* tot = call + 4096; LAS int* basew = tot + 16; LAS int* segst = basew + 16; LAS int* ntile = segst + 16;
    for (int i = F.tid; i < 4096; i += NWAVES * 64) call[i] = CNT[i];
    __syncthreads();
    if (F.tid < 16) { int t = 0, bsum = 0; for (int w = 0; w < 256; ++w) { const int c = call[w * 16 + F.tid]; t += c; bsum += (w < F.vcu) ? c : 0; } tot[F.tid] = t; basew[F.tid] = bsum; }
    __syncthreads();
    if (F.tid < 2) { int run = 0; for (int e = 0; e < 8; ++e) { segst[F.tid * 8 + e] = run; run += (tot[F.tid * 8 + e] + 255) & ~255; } ntile[F.tid] = run >> 8; }
    __syncthreads();
    if (F.tid < 128) { const int m = F.vcu * 128 + F.tid, sl = SEL[m], e0 = sl & 255, e1 = (sl >> 8) & 255, r0 = (sl >> 16) & 255, r1 = (sl >> 24) & 255;
        const int p0 = segst[e0] + basew[e0] + r0, p1 = segst[8 + e1] + basew[8 + e1] + r1;
        ROWTOK[p0] = m; ROWW[p0] = WTS[2 * (size_t)m]; ROWTOK[MOE_ROWS + p1] = m; ROWW[MOE_ROWS + p1] = WTS[2 * (size_t)m + 1]; }
    if (F.vcu < 8) {
        for (int s = 0; s < 2; ++s) { const int q = s * 8 + F.vcu, n = tot[q], np = (n + 255) & ~255;
            for (int p = n + F.tid; p < np; p += NWAVES * 64) { ROWTOK[s * MOE_ROWS + segst[q] + p] = -1; ROWW[s * MOE_ROWS + segst[q] + p] = 0.f; } } }
    if (F.vcu == 8) {
        if (F.tid < 2) PLAN[F.tid] = ntile[F.tid];
        if (F.tid < 2 * MOE_TILES) { const int s = F.tid / MOE_TILES, t = F.tid % MOE_TILES; int e = 0;
            for (int k = 1; k < 8; ++k) if ((segst[s * 8 + k] >> 8) <= t) e = k;
            PLAN[16 + MOE_TILES * s + t] = e; } }
    __syncthreads();
}
__device__ __forceinline__ void final_norm_phase(Frame& F, float* xio, const bf16* xb, const float* gain, const bf16* y) {
    const int gw = F.vcu * NWAVES + F.wave, NGW = F.G * NWAVES;
    f32x4 gn[4];
#pragma unroll
    for (int j = 0; j < 4; ++j) gn[j] = ((const GAS f32x4*)gain)[F.lane + 64 * j];
    for (int m = gw; m < MTOK; m += NGW) { f32x4 v[4]; float s = 0.f;
        const GAS unsigned long long* xr = (const GAS unsigned long long*)(xb + (size_t)m * XP) + F.lane;
        const GAS unsigned long long* y0 = (const GAS unsigned long long*)(y + (size_t)m * DM) + F.lane; const GAS unsigned long long* y1 = (const GAS unsigned long long*)(y + ((size_t)MTOK + m) * DM) + F.lane;
#pragma unroll
        for (int j = 0; j < 4; ++j) { const unsigned long long xw = xr[64 * j]; v[j].x = bflo((unsigned)xw); v[j].y = bfhi((unsigned)xw); v[j].z = bflo((unsigned)(xw >> 32)); v[j].w = bfhi((unsigned)(xw >> 32));
            const unsigned long long a0 = y0[64 * j], a1 = y1[64 * j];
            v[j].x += bflo((unsigned)a0) + bflo((unsigned)a1); v[j].y += bfhi((unsigned)a0) + bfhi((unsigned)a1);
            v[j].z += bflo((unsigned)(a0 >> 32)) + bflo((unsigned)(a1 >> 32)); v[j].w += bfhi((unsigned)(a0 >> 32)) + bfhi((unsigned)(a1 >> 32));
            s += (v[j].x * v[j].x + v[j].y * v[j].y) + (v[j].z * v[j].z + v[j].w * v[j].w); }
        const float rstd = 1.0f / sqrtf(wave_sum(s, F.lane) * (1.0f / DM) + RMS_EPS);
        GAS f32x4* o = (GAS f32x4*)(xio + (size_t)m * DM) + F.lane;
#pragma unroll
        for (int j = 0; j < 4; ++j) o[64 * j] = v[j] * rstd * gn[j]; }
}

struct MoeOrder { int nT0, nM, nN, nwg, G, c; unsigned lda, ldb; const int* tile_e; size_t estride; bool gather;
    __device__ bool next(int i, pg8::Unit& u) const {
        const long L = (long)i * G + c; if (L >= nwg) return false;
        int wgid = (int)L; { const int q = nwg / pg8::NXCD, r = nwg % pg8::NXCD, xcd = wgid % pg8::NXCD, off = wgid / pg8::NXCD; wgid = (xcd < r ? xcd * (q + 1) : r * (q + 1) + (xcd - r) * q) + off; }
        const int nig = pg8::WGM * nN, gid = wgid / nig, fm = gid * pg8::WGM, gsz = (nM - fm) < pg8::WGM ? (nM - fm) : pg8::WGM;
        const int lin = fm + ((wgid % nig) % gsz); u.pm = lin < nT0 ? lin : MOE_TILES + (lin - nT0); u.pn = (wgid % nig) / gsz; u.z = __builtin_amdgcn_readfirstlane(tile_e[u.pm]);
        u.aoff = gather ? (size_t)0 : (size_t)u.pm * 256 * lda; u.boff = (size_t)u.z * estride + (size_t)u.pn * 256 * ldb; return true; } };

template <class Epi, int BMAP = 0, int ALAY = 0> __device__ __forceinline__ void run_gemm(Frame& F, const void* A, unsigned lda, const void* B, unsigned ldb, int Mrows, int Ncols, int K, const Epi& E, int geff = 0) {
    int G_ = geff ? geff : F.G, c_ = (int)blockIdx.x; asm volatile("" : "+s"(G_), "+s"(c_));
    pg8::Gemm g{(const char*)A, (const char*)B, lda, ldb, K, nullptr}; pg8::PlainOrder S; S.init(Mrows, Ncols, G_, c_, lda, ldb, BMAP, ALAY);
    pg8::gemm_phase<Epi, pg8::PlainOrder, false, BMAP, ALAY>(F.lds, g, S, E);
}

__device__ __forceinline__ Args load_args() {
    Args r{};
#if defined(__HIP_DEVICE_COMPILE__)
    typedef const __attribute__((address_space(4))) Args CArgs;
    auto p = __builtin_amdgcn_kernarg_segment_ptr(); asm volatile("" : "+s"(p)); CArgs* q = (CArgs*)p;
#pragma unroll
    for (int i = 0; i < 16; ++i) r.in[i] = q->in[i];
    r.out = q->out; r.ws = q->ws; r.G = q->G;
#endif
    return r;
}
__device__ __forceinline__ Frame make_frame(LAS unsigned char* lds, unsigned char* ws, int G) {
    Frame F; int t = threadIdx.x, g = G, bx = blockIdx.x; asm volatile("" : "+v"(t), "+s"(g), "+s"(bx));
    F.lds = lds; F.MISC = (volatile LAS unsigned*)(lds + MISC_OFF); F.ctl = (gu32*)(ws + WS_CTL);
    F.tid = t; F.lane = t & 63; F.wave = __builtin_amdgcn_readfirstlane(t >> 6); F.G = g; F.vcu = (g % 8 == 0) ? (bx % 8) * (g / 8) + bx / 8 : bx; return F; }
#define PH_BEGIN const Args a = load_args(); unsigned char* const ws = a.ws; float* const xout = a.out; bf16* const xsA = (bf16*)a.out; bf16* const xsB = xsA + DM; Frame F = make_frame((LAS unsigned char*)lds, ws, a.G); (void)xout; (void)xsA; (void)xsB
__global__ void __launch_bounds__(NWAVES * 64, 2) fwd_kernel(Args args) {
    extern __shared__ __attribute__((aligned(16))) unsigned char lds[];
    for (int u = threadIdx.x; u < (LDS_BYTES - LDSCTL_OFF) / 4; u += NWAVES * 64) ((LAS unsigned*)((LAS unsigned char*)lds + LDSCTL_OFF))[u] = 0u;
    __syncthreads();
    XcdBarrier bar = xcd_barrier_post((unsigned*)(args.ws + WS_CTL) + CW_BAR, (volatile LAS unsigned*)((LAS unsigned char*)lds + MISC_OFF) + 8);
    bar.G = (unsigned)args.G;
#define GRID_BAR() do { XcdBarrier b2_ = bar; asm volatile("" : "+s"(b2_.bar), "+s"(b2_.x), "+s"(b2_.G)); xcd_barrier(b2_); } while (0)

    { PH_BEGIN; p0_weights(F, a); __syncthreads(); p0_tables(F, a); prep_x_phase(F, a.in[0], xsA, (float*)(ws + WS_SS), ws + WS_X8); }
    GRID_BAR();

    for (int layer = 0; layer < 2; ++layer) {
        asm volatile("" : "+s"(layer));
        { PH_BEGIN; int lyr = layer; asm volatile("" : "+s"(lyr)); const bf16* WinT = (const bf16*)(ws + WS_WIN + lyr * WIN_L);
          pg8::EpiInproj E{ws, WS_V, WS_Q, WS_K, WS_GF, WS_GA, WS_ROPE, QSCALE, (const float*)(ws + WS_SS) + (size_t)(2 * lyr) * SS_STRIDE, 1.0f / WG_SCALE};
          int G_ = F.G, c_ = (int)blockIdx.x; asm volatile("" : "+s"(G_), "+s"(c_));
          pg8::Gemm g{(const char*)(ws + WS_X8), (const char*)(ws + WS_WQK8 + (size_t)lyr * 1536 * DM), DM, DM, DM / 2, nullptr}; pg8::PlainOrder S; S.init(MTOK, 1536, G_, c_, DM, DM, 0, 0);
          pg8::gemm_phase<pg8::EpiInproj, pg8::PlainOrder, false, 0, 0, true>(F.lds, g, S, E); }
        { PH_BEGIN; int lyr = layer; asm volatile("" : "+s"(lyr)); const bf16* WinT = (const bf16*)(ws + WS_WIN + lyr * WIN_L);
          pg8::EpiBf16 E{(bf16*)(ws + WS_UT), MTOK, (bf16*)(ws + WS_V), 2, (const float*)(ws + WS_SS) + (size_t)(2 * lyr) * SS_STRIDE}; int bx_ = (int)blockIdx.x; asm volatile("" : "+s"(bx_));
          if (bx_ < GEMM_WGS) run_gemm<pg8::EpiBf16, 2, 0>(F, WinT, DM * 2, xsA, XP * 2, 1280, MTOK, DM, E, GEMM_WGS);
          else p0_moe_weights(F, a, lyr * CONV_PHASE_ITEMS, (lyr + 1) * CONV_PHASE_ITEMS, (bx_ - GEMM_WGS) * NWAVES + F.wave, CONV_WGS * NWAVES); }
        GRID_BAR();
        { PH_BEGIN; fft_phase(F, (const bf16*)(ws + WS_UT), (bf16*)(ws + WS_Z)); }
        { PH_BEGIN; attn_mfma_phase(F, ws + WS_Q, ws + WS_K, ws + WS_V, (bf16*)(ws + WS_OATT)); }
        { PH_BEGIN; int lyr = layer; asm volatile("" : "+s"(lyr)); int G_ = F.G, c_ = (int)blockIdx.x; asm volatile("" : "+s"(G_), "+s"(c_));
          pg8::Gemm g{(const char*)(ws + WS_X8), (const char*)(ws + WS_WG8 + (size_t)lyr * 2048 * DM), DM, DM, DM / 2, nullptr}; pg8::PlainOrder S; S.init(MTOK, 2048, G_, c_, DM, DM, 0, 0);
          pg8::EpiGates8 E{ws, WS_GF, WS_GA, (const float*)(ws + WS_SS) + (size_t)(2 * lyr) * SS_STRIDE}; pg8::gemm_phase<pg8::EpiGates8, pg8::PlainOrder, false, 0, 0, true>(F.lds, g, S, E); }
        GRID_BAR();
        { PH_BEGIN; int lyr = layer; asm volatile("" : "+s"(lyr)); pg8::EpiMix E{(const bf16*)(ws + WS_GF), (const bf16*)(ws + WS_GA), (bf16*)(ws + WS_MIX)};
          run_gemm<pg8::EpiMix, 0, 1>(F, ws + WS_OATT, MTOK * 16, (const bf16*)(ws + WS_WM) + (size_t)lyr * DM * KMIX, KMIX * 2, MTOK, DM, KMIX, E); }
        GRID_BAR();
        if (layer == 0) { PH_BEGIN; pg8::EpiResid<true> E{xsA, xsB, XP, (float*)(ws + WS_SS) + SS_STRIDE, nullptr};
          run_gemm(F, ws + WS_MIX, DM * 2, ws + WS_WOUT, DM * 2, MTOK, DM, DM, E); }
        else { PH_BEGIN; pg8::EpiResid<false> E{xsA, xsB, XP, nullptr, nullptr};
          run_gemm(F, ws + WS_MIX, DM * 2, (const bf16*)(ws + WS_WOUT) + (size_t)DM * DM, DM * 2, MTOK, DM, DM, E); }
        GRID_BAR();
        if (layer == 0) {
            { PH_BEGIN; int lyr = layer; asm volatile("" : "+s"(lyr)); pg8::EpiSwiglu E{(bf16*)(ws + WS_TT), FF, (const float*)(ws + WS_SS) + SS_STRIDE}; run_gemm(F, xsB, XP * 2, ws + WS_W13, DM * 2, MTOK, 2 * FF, DM, E); }
            GRID_BAR();
            { PH_BEGIN; int lyr = layer; asm volatile("" : "+s"(lyr)); pg8::EpiResid<true> E{xsB, xsA, XP, (float*)(ws + WS_SS) + 2 * SS_STRIDE, ws + WS_X8}; run_gemm(F, ws + WS_TT, FF * 2, ws + WS_W2, FF * 2, MTOK, DM, FF, E); }
            GRID_BAR();
        } else {
            { PH_BEGIN; int lyr = layer; asm volatile("" : "+s"(lyr)); p0_moe_weights(F, a, 2 * CONV_PHASE_ITEMS, MOE_NITEMS, F.vcu * NWAVES + F.wave, F.G * NWAVES); __syncthreads();
              norm_router_phase(F, xsB, a.in[6] + DM, ws + WS_H2B, a.in[10], a.in[11], (int*)(ws + WS_SEL), (float*)(ws + WS_WTS), (int*)(ws + WS_CNT)); }
            GRID_BAR();
            { PH_BEGIN; int lyr = layer; asm volatile("" : "+s"(lyr)); route2_phase(F, (const int*)(ws + WS_SEL), (const float*)(ws + WS_WTS), (const int*)(ws + WS_CNT), (int*)(ws + WS_ROWTOK), (float*)(ws + WS_ROWW), (int*)(ws + WS_PLAN)); }
            GRID_BAR();
            { PH_BEGIN; int G_ = F.G, c_ = (int)blockIdx.x; asm volatile("" : "+s"(G_), "+s"(c_));
              const int* plan = (const int*)(ws + WS_PLAN); const int nT0 = __builtin_amdgcn_readfirstlane(plan[0]), nT1 = __builtin_amdgcn_readfirstlane(plan[1]);
              pg8::Gemm g{(const char*)(ws + WS_H2B), (const char*)(ws + WS_M13), DM, DM, DM / 2, (const int*)(ws + WS_ROWTOK)};
              MoeOrder S{nT0, nT0 + nT1, 2 * FF / 256, (nT0 + nT1) * (2 * FF / 256), G_, c_, DM, DM, plan + 16, (size_t)2 * FF * DM, true};
              pg8::EpiSwigluF8 E{ws + WS_TTB, FF, 1.0f / W13_SCALE}; pg8::gemm_phase<pg8::EpiSwigluF8, MoeOrder, true, 0, 0, true>(F.lds, g, S, E); }
            GRID_BAR();
            { PH_BEGIN; int G_ = F.G, c_ = (int)blockIdx.x; asm volatile("" : "+s"(G_), "+s"(c_));
              const int* plan = (const int*)(ws + WS_PLAN); const int nT0 = __builtin_amdgcn_readfirstlane(plan[0]), nT1 = __builtin_amdgcn_readfirstlane(plan[1]);
              pg8::Gemm g{(const char*)(ws + WS_TTB), (const char*)(ws + WS_M2), FF, FF, FF / 2, nullptr};
              MoeOrder S{nT0, nT0 + nT1, DM / 256, (nT0 + nT1) * (DM / 256), G_, c_, FF, FF, plan + 16, (size_t)DM * FF, false};
              pg8::EpiScatterY E{(bf16*)(ws + WS_Y), (const int*)(ws + WS_ROWTOK), (const float*)(ws + WS_ROWW), 1.0f / W2_SCALE, MOE_ROWS, (size_t)MTOK * DM};
              pg8::gemm_phase<pg8::EpiScatterY, MoeOrder, false, 0, 0, true>(F.lds, g, S, E); }
            GRID_BAR();
        }
    }
    { PH_BEGIN; final_norm_phase(F, xout, xsB, a.in[15], (const bf16*)(ws + WS_Y)); }
#undef GRID_BAR
}

extern "C" void kernel_launch(void* const* d_in, const int* in_sizes, int n_in, void* d_out, int out_size, void* d_ws, size_t ws_size, hipStream_t stream) {
    static int grid = 0;
    if (grid == 0) {
        if (n_in != 16 || out_size != MTOK * DM || ws_size < WS_END) { fprintf(stderr, "kernel_launch: unexpected problem (n_in %d, out %d, ws %zu); nothing launched\n", n_in, out_size, ws_size); grid = -1; return; }
        int dev = 0, cus = 0;
        if (hipGetDevice(&dev) != hipSuccess || hipDeviceGetAttribute(&cus, hipDeviceAttributeMultiprocessorCount, dev) != hipSuccess) { grid = -1; return; }
        if (hipFuncSetAttribute((const void*)fwd_kernel, hipFuncAttributeMaxDynamicSharedMemorySize, LDS_BYTES) != hipSuccess) { fprintf(stderr, "kernel_launch: hipFuncSetAttribute failed\n"); grid = -1; return; }
        int per_cu = 0;
        if (hipOccupancyMaxActiveBlocksPerMultiprocessor(&per_cu, (const void*)fwd_kernel, NWAVES * 64, LDS_BYTES) != hipSuccess || per_cu < 1) fprintf(stderr, "kernel_launch: occupancy query reports %d\n", per_cu);
        (void)hipGetLastError();
        if (cus != 256) { fprintf(stderr, "kernel_launch: %d CUs; the router / attention unit maps assume a grid of 256\n", cus); grid = -1; return; }
        grid = cus;
    }
    if (grid < 0) return;
    (void)hipMemsetAsync((char*)d_ws + WS_CTL, 0, CTL_ZERO_BYTES, stream);
    Args a{};
    for (int i = 0; i < 16; ++i) a.in[i] = (const float*)d_in[i];
    a.out = (float*)d_out; a.ws = (unsigned char*)d_ws; a.G = grid; a.pad = 0;
    hipLaunchKernelGGL(fwd_kernel, dim3(grid), dim3(NWAVES * 64), LDS_BYTES, stream, a);
}
```

```cpp
#include <hip/hip_runtime.h>
#include <cstdio>
#include <cstdint>

namespace pg8 {
#define PG8_LAS __attribute__((address_space(3)))
typedef unsigned short bf16_t;
typedef short bf16x8 __attribute__((ext_vector_type(8)));
typedef float f32x4 __attribute__((ext_vector_type(4)));
typedef unsigned u32x4 __attribute__((ext_vector_type(4)));
typedef unsigned u32x2 __attribute__((ext_vector_type(2)));
typedef int v4i_t __attribute__((ext_vector_type(4)));
typedef int v8i_t __attribute__((ext_vector_type(8)));
constexpr int BM = 256, BK = 64, HALF = 128, HTB = HALF * BK * 2  , STAGE_BYTES = 8 * HTB, NXCD = 8, WGM = 4;

__host__ __device__ __forceinline__ int lds_byte(int r, int c) { const int st = (r >> 4) * 2 + (c >> 5), rr = r & 15, cc = c & 31, ob = rr * 64 + cc * 2; return st * 1024 + (ob ^ (((ob >> 9) & 1) << 5)); }
__host__ __device__ __forceinline__ void stage_rc(int b, int& R, int& C) { const int st = b / 1024, sb = b % 1024, swz = sb ^ (((sb >> 9) & 1) << 5); R = (st >> 1) * 16 + swz / 64; C = (st & 1) * 32 + (swz % 64) / 2; }
__host__ __device__ __forceinline__ int perm32(int rho) { const int n = rho >> 4, i = rho & 15; return 8 * (i >> 2) + 4 * n + (i & 3); }

struct Unit { int pm, pn, z; size_t aoff, boff; };
struct Gemm { const char* A; const char* B; unsigned lda, ldb; int K; const int* rows; };

struct PlainOrder {
    int nM, nN, nwg, G, c; unsigned lda, ldb; int bmap, alay;
    __device__ void init(int M, int N, int G_, int c_, unsigned lda_, unsigned ldb_, int bmap_ = 0, int alay_ = 0) { nM = M / BM; nN = N / BM; nwg = nM * nN; G = G_; c = c_; lda = lda_; ldb = ldb_; bmap = bmap_; alay = alay_; }
    __device__ bool next(int i, Unit& u) const {
        const long L = (long)i * G + c; if (L >= nwg) return false;
        int wgid = (int)L; { const int q = nwg / NXCD, r = nwg % NXCD, xcd = wgid % NXCD, off = wgid / NXCD; wgid = (xcd < r ? xcd * (q + 1) : r * (q + 1) + (xcd - r) * q) + off; }
        const int nig = WGM * nN, gid = wgid / nig, fm = gid * WGM, gsz = (nM - fm) < WGM ? (nM - fm) : WGM;
        u.pm = fm + ((wgid % nig) % gsz); u.pn = (wgid % nig) / gsz; u.z = 0;
        u.aoff = alay ? (size_t)u.pm * BM * 16 : (size_t)u.pm * BM * lda;
        if (bmap == 0) u.boff = (size_t)u.pn * BM * ldb;
        else { const int kind = bmap == 1 ? 1 : (u.pm < 2 ? 1 : (u.pm == 2 ? 0 : u.pm - 1)), bb = u.pn >> 4, t = u.pn & 15; u.z = kind;
            const int base = kind == 0 ? 256 * t : (kind == 1 ? 4 * t : (kind == 2 ? 1024 * (t & 3) + (t >> 2) : t));
            u.boff = (size_t)(bb * 4096 + base) * ldb; }
        return true;
    }
};

typedef float f32x2v_t __attribute__((ext_vector_type(2))); typedef __bf16 bf16x2v_t __attribute__((ext_vector_type(2)));
__device__ __forceinline__ unsigned cvt_pk_bf16(float lo, float hi) { const f32x2v_t v = {lo, hi}; return __builtin_bit_cast(unsigned, __builtin_convertvector(v, bf16x2v_t)); }
__device__ __forceinline__ float bf_lo(unsigned w) { return __uint_as_float(w << 16); }
__device__ __forceinline__ float bf_hi(unsigned w) { return __uint_as_float(w & 0xffff0000u); }
__device__ __forceinline__ f32x4 bf4_lo(const u32x4& w) { return (f32x4){bf_lo(w.x), bf_hi(w.x), bf_lo(w.y), bf_hi(w.y)}; }
__device__ __forceinline__ f32x4 bf4_hi(const u32x4& w) { return (f32x4){bf_lo(w.z), bf_hi(w.z), bf_lo(w.w), bf_hi(w.w)}; }
__device__ __forceinline__ float fast_sigmoid(float x) { return __builtin_amdgcn_rcpf(1.0f + __builtin_amdgcn_exp2f(-1.4426950408889634f * x)); }
__device__ __forceinline__ u32x4 pack8(const f32x4& v0, const f32x4& v1) { u32x4 w; w.x = cvt_pk_bf16(v0[0], v0[1]); w.y = cvt_pk_bf16(v0[2], v0[3]); w.z = cvt_pk_bf16(v1[0], v1[1]); w.w = cvt_pk_bf16(v1[2], v1[3]); return w; }

__device__ __forceinline__ float rstd_of(const float* ss, int row) { const f32x4 p = *(const f32x4*)(ss + (size_t)row * 4); return __builtin_amdgcn_rsqf(((p[0] + p[1]) + (p[2] + p[3])) * (1.0f / 1024.0f) + 1e-6f); }
__device__ __forceinline__ unsigned pk_fp8(float a, float b, unsigned old, bool hi) { a = __builtin_fminf(__builtin_fmaxf(a, -448.f), 448.f); b = __builtin_fminf(__builtin_fmaxf(b, -448.f), 448.f);
    return hi ? (unsigned)__builtin_amdgcn_cvt_pk_fp8_f32(a, b, (int)old, true) : (unsigned)__builtin_amdgcn_cvt_pk_fp8_f32(a, b, (int)old, false); }

struct EpiBf16 {
    static constexpr bool PERM = true;
    bf16_t* O; int ldc; bf16_t* O2; int split; const float* ss;
    __device__ __forceinline__ void operator()(const f32x4 (&acc)[2][2][4][2], const Unit& u, int wr, int wc, int fr, int fq) const {
        bf16_t* const O = u.pm >= split ? O2 : this->O;
        const int row0 = (u.pm >= split ? u.pm - split : u.pm) * BM + wr * 64 + fr, col0 = u.pn * BM + wc * 32 + 8 * fq;
        f32x4 cs[2][2]; const int kind = u.z, bb = u.pn >> 4;
#pragma unroll
        for (int bj = 0; bj < 2; ++bj)
#pragma unroll
            for (int e = 0; e < 8; ++e) { const int v = (col0 & 4095) + bj * HALF + e;
                const int pos = kind == 0 ? v : (kind == 1 ? 64 * (v & 63) + (v >> 6) : (kind == 2 ? 4 * (v & 1023) + (v >> 10) : 16 * (v & 255) + (v >> 8)));
                cs[bj][e >> 2][e & 3] = rstd_of(ss, bb * 4096 + pos); }
#pragma unroll
        for (int ai = 0; ai < 2; ++ai)
#pragma unroll
            for (int m = 0; m < 4; ++m) { const size_t eo = (size_t)(row0 + ai * HALF + m * 16) * ldc + col0;
#pragma unroll
                for (int bj = 0; bj < 2; ++bj) { const f32x4 v0 = acc[ai][bj][m][0] * cs[bj][0], v1 = acc[ai][bj][m][1] * cs[bj][1];
                    if (u.pm >= split) { u32x2 w8; w8.x = pk_fp8(v0[0], v0[1], 0u, false); w8.x = pk_fp8(v0[2], v0[3], w8.x, true); w8.y = pk_fp8(v1[0], v1[1], 0u, false); w8.y = pk_fp8(v1[2], v1[3], w8.y, true);
                        *(u32x2*)((unsigned char*)O + eo + bj * HALF) = w8; }
                    else *(u32x4*)(O + eo + bj * HALF) = pack8(v0, v1); } }
    }
};
struct EpiInproj {
    static constexpr bool PERM = true;
    unsigned char* ws; size_t oV, oQ, oK, oGF, oGA, oRope; float qscale; const float* ss; float ascale;
    __device__ __forceinline__ void operator()(const f32x4 (&acc)[2][2][4][2], const Unit& u, int wr, int wc, int fr, int fq) const {
        const int row0 = u.pm * BM + wr * 64 + fr, pn = u.pn;
        {
            const bool isq = pn < 3; bf16_t* base = (bf16_t*)(ws + (isq ? oQ : oK)); const float* rope = (const float*)(ws + oRope); const int colt = (isq ? pn : pn - 3) * 256; const float sc = isq ? qscale : 1.0f;
            const int col0 = colt + wc * 32 + 8 * fq, i0 = 16 * (wc & 1) + 4 * fq;
#pragma unroll
            for (int ai = 0; ai < 2; ++ai)
#pragma unroll
                for (int m = 0; m < 4; ++m) { const int row = row0 + ai * HALF + m * 16, pos = row & 4095;
                    const f32x4 cs0 = *(const f32x4*)(rope + (size_t)(pos * 32 + i0) * 2), cs1 = *(const f32x4*)(rope + (size_t)(pos * 32 + i0) * 2 + 4);
                    bf16_t* rowp = base + (size_t)row * 768 + col0; const float rs = rstd_of(ss, row) * ascale;
#pragma unroll
                    for (int bj = 0; bj < 2; ++bj) { const f32x4 v0 = acc[ai][bj][m][0] * rs, v1 = acc[ai][bj][m][1] * rs; f32x4 o0, o1;
                        o0[0] = (v0[0] * cs0[0] - v0[1] * cs0[1]) * sc; o0[1] = (v0[1] * cs0[0] + v0[0] * cs0[1]) * sc;
                        o0[2] = (v0[2] * cs0[2] - v0[3] * cs0[3]) * sc; o0[3] = (v0[3] * cs0[2] + v0[2] * cs0[3]) * sc;
                        o1[0] = (v1[0] * cs1[0] - v1[1] * cs1[1]) * sc; o1[1] = (v1[1] * cs1[0] + v1[0] * cs1[1]) * sc;
                        o1[2] = (v1[2] * cs1[2] - v1[3] * cs1[3]) * sc; o1[3] = (v1[3] * cs1[2] + v1[2] * cs1[3]) * sc;
                        { u32x2 w8; w8.x = pk_fp8(o0[0], o0[1], 0u, false); w8.x = pk_fp8(o0[2], o0[3], w8.x, true); w8.y = pk_fp8(o1[0], o1[1], 0u, false); w8.y = pk_fp8(o1[2], o1[3], w8.y, true);
                               *(u32x2*)((unsigned char*)base + (size_t)row * 768 + col0 + bj * HALF) = w8; } }
                    if (m == 3) asm volatile("" ::: "memory"); }
        }
    }
};
constexpr float WG8_SCALE = 32.0f;
struct EpiGates8 {
    static constexpr bool PERM = true;
    unsigned char* ws; size_t oGF, oGA; const float* ss;
    __device__ __forceinline__ void operator()(const f32x4 (&acc)[2][2][4][2], const Unit& u, int wr, int wc, int fr, int fq) const {
        const int row0 = u.pm * BM + wr * 64 + fr;
        {
            bf16_t* const gfp = (bf16_t*)(ws + oGF); bf16_t* const grp = (bf16_t*)(ws + oGA); const int col0 = u.pn * 128 + wc * 32 + 8 * fq;
#pragma unroll
            for (int ai = 0; ai < 2; ++ai)
#pragma unroll
                for (int m = 0; m < 4; ++m) { const size_t off = (size_t)(row0 + ai * HALF + m * 16) * 1024 + col0; const float rs = (-1.4426950408889634f / WG8_SCALE) * rstd_of(ss, row0 + ai * HALF + m * 16);
                    f32x4 g[2], r[2];
#pragma unroll
                    for (int n = 0; n < 2; ++n) { const f32x4 xf = acc[ai][0][m][n] * rs, xa = acc[ai][1][m][n] * rs; f32x4 ef, ea, ia;
#pragma unroll
                        for (int j = 0; j < 4; ++j) { ef[j] = __builtin_fminf(__builtin_amdgcn_exp2f(xf[j]), 1.0e18f); ea[j] = __builtin_amdgcn_exp2f(xa[j]); }
                        ef = ef + 1.0f; ea = ea + 1.0f;
#pragma unroll
                        for (int j = 0; j < 4; ++j) { g[n][j] = __builtin_amdgcn_rcpf(ef[j]); ia[j] = __builtin_amdgcn_rcpf(ea[j]); }
                        r[n] = ef * ia; }
                    *(u32x4*)(gfp + off) = pack8(g[0], g[1]); *(u32x4*)(grp + off) = pack8(r[0], r[1]); }
        }
    }
};
struct EpiMix {
    static constexpr bool PERM = true; static constexpr int RESCALE_T = 4;
    const bf16_t* G; const bf16_t* R; bf16_t* O;
    __device__ __forceinline__ void rescale(f32x4 (&acc)[2][2][4][2], const Unit& u, int wr, int wc, int fr, int fq) const {
        asm volatile("" : "+v"(fr), "+v"(fq));
        const int row0 = u.pm * BM + wr * 64 + fr, col0 = u.pn * BM + wc * 32 + 8 * fq;
#pragma unroll
        for (int ai = 0; ai < 2; ++ai)
#pragma unroll
            for (int m = 0; m < 4; ++m) { const unsigned off = (unsigned)(row0 + ai * HALF + m * 16) * 1024u + (unsigned)col0;
#pragma unroll
                for (int bj = 0; bj < 2; ++bj) { const u32x4 g = *(const u32x4*)(R + off + bj * HALF);
                    acc[ai][bj][m][0] = acc[ai][bj][m][0] * bf4_lo(g); acc[ai][bj][m][1] = acc[ai][bj][m][1] * bf4_hi(g); }
                if (m == 3) asm volatile("" ::: "memory"); }
    }
    __device__ __forceinline__ void operator()(const f32x4 (&acc)[2][2][4][2], const Unit& u, int wr, int wc, int fr, int fq) const {
        const int row0 = u.pm * BM + wr * 64 + fr, col0 = u.pn * BM + wc * 32 + 8 * fq;
#pragma unroll
        for (int ai = 0; ai < 2; ++ai) { u32x4 gq[4][2];
#pragma unroll
            for (int m = 0; m < 4; ++m)
#pragma unroll
                for (int bj = 0; bj < 2; ++bj) gq[m][bj] = *(const u32x4*)(G + (unsigned)(row0 + ai * HALF + m * 16) * 1024u + (unsigned)col0 + bj * HALF);
#pragma unroll
            for (int m = 0; m < 4; ++m) { const unsigned off = (unsigned)(row0 + ai * HALF + m * 16) * 1024u + (unsigned)col0;
#pragma unroll
                for (int bj = 0; bj < 2; ++bj) { const u32x4 g = gq[m][bj]; const f32x4 v0 = acc[ai][bj][m][0] * bf4_lo(g), v1 = acc[ai][bj][m][1] * bf4_hi(g);
                    *(u32x4*)(O + off + bj * HALF) = pack8(v0, v1); } }
            asm volatile("" ::: "memory"); }
    }
};
template <class E, class = void> struct rescale_at { static constexpr int t = -1; };
template <class E> struct rescale_at<E, decltype((void)E::RESCALE_T)> { static constexpr int t = E::RESCALE_T; };
template <bool SS> struct EpiResid {
    static constexpr bool PERM = true;
    const bf16_t* res; bf16_t* out; int ld; float* ssout; unsigned char* x8;
    __device__ __forceinline__ void operator()(const f32x4 (&acc)[2][2][4][2], const Unit& u, int wr, int wc, int fr, int fq) const {
        const int row0 = u.pm * BM + wr * 64 + fr, col0 = u.pn * BM + wc * 32 + 8 * fq, lane = fq * 16 + fr;
        PG8_LAS float* const part = (PG8_LAS float*)(unsigned)131072;
#pragma unroll
        for (int ai = 0; ai < 2; ++ai) { u32x4 rq[4][2];
#pragma unroll
            for (int m = 0; m < 4; ++m)
#pragma unroll
                for (int bj = 0; bj < 2; ++bj) rq[m][bj] = *(const u32x4*)(res + (size_t)(row0 + ai * HALF + m * 16) * ld + col0 + bj * HALF);
#pragma unroll
            for (int m = 0; m < 4; ++m) { const int row = row0 + ai * HALF + m * 16; const size_t off = (size_t)row * ld + col0; float sq = 0.f;
#pragma unroll
                for (int bj = 0; bj < 2; ++bj) { const u32x4 r = rq[m][bj]; const f32x4 v0 = acc[ai][bj][m][0] + bf4_lo(r), v1 = acc[ai][bj][m][1] + bf4_hi(r);
                    if (SS) { const f32x4 q = v0 * v0 + v1 * v1; sq += (q[0] + q[1]) + (q[2] + q[3]); }
                    *(u32x4*)(out + off + bj * HALF) = pack8(v0, v1);
                    if (x8) { u32x2 w8; w8.x = pk_fp8(v0[0], v0[1], 0u, false); w8.x = pk_fp8(v0[2], v0[3], w8.x, true); w8.y = pk_fp8(v1[0], v1[1], 0u, false); w8.y = pk_fp8(v1[2], v1[3], w8.y, true);
                        *(u32x2*)(x8 + (size_t)row * 1024 + col0 + bj * HALF) = w8; } }
                if (SS) { sq += __int_as_float(__builtin_amdgcn_ds_bpermute((lane ^ 16) << 2, __float_as_int(sq))); sq += __int_as_float(__builtin_amdgcn_ds_bpermute((lane ^ 32) << 2, __float_as_int(sq)));
                    if (fq == 0) part[wc * 256 + wr * 64 + fr + ai * HALF + m * 16] = sq; } }
            asm volatile("" ::: "memory"); }
        if (SS) {
            asm volatile("s_waitcnt lgkmcnt(0)" ::: "memory"); __builtin_amdgcn_s_barrier(); asm volatile("" ::: "memory");
            const int t = (wr * 4 + wc) * 64 + lane;
            if (t < 256) ssout[(size_t)(u.pm * BM + t) * 4 + u.pn] = (part[t] + part[256 + t]) + (part[512 + t] + part[768 + t]);
            asm volatile("s_waitcnt lgkmcnt(0)" ::: "memory"); __builtin_amdgcn_s_barrier(); asm volatile("" ::: "memory");
        }
    }
};
struct EpiSwiglu {
    static constexpr bool PERM = true;
    bf16_t* T; int ldc; const float* ss;
    __device__ __forceinline__ void operator()(const f32x4 (&acc)[2][2][4][2], const Unit& u, int wr, int wc, int fr, int fq) const {
        const int row0 = u.pm * BM + wr * 64 + fr, col0 = u.pn * 128 + wc * 32 + 8 * fq;
#pragma unroll
        for (int ai = 0; ai < 2; ++ai)
#pragma unroll
            for (int m = 0; m < 4; ++m) { const int r = row0 + ai * HALF + m * 16; const float rs = rstd_of(ss, r), rs2 = rs * rs, rse = -1.4426950408889634f * rs; f32x4 o[2];
#pragma unroll
                for (int n = 0; n < 2; ++n) { const f32x4 x = acc[ai][0][m][n] * rse; f32x4 e, q;
#pragma unroll
                    for (int j = 0; j < 4; ++j) e[j] = __builtin_amdgcn_exp2f(x[j]);
                    e = e + 1.0f;
#pragma unroll
                    for (int j = 0; j < 4; ++j) q[j] = __builtin_amdgcn_rcpf(e[j]);
                    o[n] = (acc[ai][0][m][n] * acc[ai][1][m][n]) * (q * rs2); }
                *(u32x4*)(T + (size_t)r * ldc + col0) = pack8(o[0], o[1]); }
    }
};
struct EpiSwigluF8 {
    static constexpr bool PERM = true;
    unsigned char* T; int ldc; float ascale;
    __device__ __forceinline__ void operator()(const f32x4 (&acc)[2][2][4][2], const Unit& u, int wr, int wc, int fr, int fq) const {
        const int row0 = u.pm * BM + wr * 64 + fr, col0 = u.pn * 128 + wc * 32 + 8 * fq;
#pragma unroll
        for (int ai = 0; ai < 2; ++ai)
#pragma unroll
            for (int m = 0; m < 4; ++m) { unsigned char* rowp = T + (size_t)(row0 + ai * HALF + m * 16) * ldc + col0; f32x4 o4[2];
#pragma unroll
                for (int n = 0; n < 2; ++n) { const f32x4 x = acc[ai][0][m][n] * (-1.4426950408889634f * ascale); f32x4 e;
#pragma unroll
                    for (int j = 0; j < 4; ++j) e[j] = __builtin_amdgcn_exp2f(x[j]);
                    e = e + 1.0f; f32x4 r;
#pragma unroll
                    for (int j = 0; j < 4; ++j) r[j] = __builtin_amdgcn_rcpf(e[j]);
                    o4[n] = (acc[ai][0][m][n] * acc[ai][1][m][n]) * (r * (ascale * ascale)); }
                const float* o = (const float*)o4;
                u32x2 w; w.x = pk_fp8(o4[0][0], o4[0][1], 0u, false); w.x = pk_fp8(o4[0][2], o4[0][3], w.x, true); w.y = pk_fp8(o4[1][0], o4[1][1], 0u, false); w.y = pk_fp8(o4[1][2], o4[1][3], w.y, true); (void)o;
                *(u32x2*)rowp = w; }
    }
};
struct EpiScatterY {
    static constexpr bool PERM = true;
    bf16_t* y; const int* rows; const float* w; float ascale; int slot_rows; size_t slot_stride;
    __device__ __forceinline__ void operator()(const f32x4 (&acc)[2][2][4][2], const Unit& u, int wr, int wc, int fr, int fq) const {
        const int row0 = u.pm * BM + wr * 64 + fr, col0 = u.pn * BM + wc * 32 + 8 * fq; bf16_t* const yb = y + (row0 >= slot_rows ? slot_stride : (size_t)0);
#pragma unroll
        for (int ai = 0; ai < 2; ++ai)
#pragma unroll
            for (int m = 0; m < 4; ++m) { const int r = row0 + ai * HALF + m * 16, tok = rows[r]; const float rs = w[r] * ascale;
                if (tok >= 0) { bf16_t* yp = yb + (size_t)tok * 1024 + col0;
#pragma unroll
                    for (int bj = 0; bj < 2; ++bj) *(u32x4*)(yp + bj * HALF) = pack8(acc[ai][bj][m][0] * rs, acc[ai][bj][m][1] * rs); } }
    }
};
template <class Epi, class Sched, bool GATHER = false, int BMAP = 0, int ALAY = 0, bool FP8 = false, bool ALIGN_EPI = true, bool SP2 = true>
__device__ __forceinline__ void gemm_phase(PG8_LAS unsigned char* lds, const Gemm g, const Sched& S, const Epi& E) {
    int tid_ = threadIdx.x; asm volatile("" : "+v"(tid_));
    const int tid = tid_, wid = __builtin_amdgcn_readfirstlane(tid >> 6), lane = tid & 63, wr = wid >> 2, wc = wid & 3, fr = lane & 15, fq = lane >> 4;
    const int K = g.K, nt = K / BK;
    unsigned voffA[2], voffA1[2], nvA0[2], nvA1[2], voffB[2], nvB[2]; int Rg[2], Cg[2], RbS[2];
#pragma unroll
    for (int i = 0; i < 2; ++i) { int R, C; stage_rc(tid * 16 + i * 8192, R, C); const int Rb = Epi::PERM ? ((R & ~31) + perm32(R & 31)) : R; Rg[i] = R; Cg[i] = C * 2;
        voffA[i] = ALAY == 1 ? (unsigned)(C >> 3) * g.lda + (unsigned)R * 16u : (unsigned)R * g.lda + (unsigned)C * 2u; voffA1[i] = voffA[i]; nvA0[i] = voffA[i]; nvA1[i] = voffA[i];
        voffB[i] = (BMAP == 1 ? (unsigned)(64 * (Rb & 63) + (Rb >> 6)) : (unsigned)Rb) * g.ldb + (unsigned)C * 2u; RbS[i] = Rb; }
#define PG8_BKIND(kind_, dv, dh) do { const int _k = (kind_); _Pragma("unroll") for (int _i = 0; _i < 2; ++_i) { const int _r = RbS[_i]; \
        dv[_i] = (unsigned)(_k == 0 ? _r : (_k == 1 ? 64 * (_r & 63) + (_r >> 6) : (_k == 2 ? 4 * _r : 16 * _r))) * g.ldb + (unsigned)Cg[_i]; } \
        dh = (size_t)(_k == 0 ? 128 : (_k == 1 ? 2 : (_k == 2 ? 512 : 2048))) * g.ldb; } while (0)
#define PG8_GROWS(pm_, d0, d1) do { _Pragma("unroll") for (int _i = 0; _i < 2; ++_i) { int _t0 = g.rows[(pm_) * BM + Rg[_i]], _t1 = g.rows[(pm_) * BM + HALF + Rg[_i]]; _t0 = _t0 < 0 ? 0 : _t0; _t1 = _t1 < 0 ? 0 : _t1; \
        d0[_i] = (unsigned)_t0 * g.lda + (unsigned)Cg[_i]; d1[_i] = (unsigned)_t1 * g.lda + (unsigned)Cg[_i]; } } while (0)
    const size_t kstepB = (size_t)(BK * 2), kstepA = ALAY == 1 ? (size_t)8 * g.lda : kstepB;
    const size_t hstepA = GATHER ? (size_t)0 : (ALAY == 1 ? (size_t)HALF * 16 : (size_t)HALF * g.lda); size_t hstepB = (BMAP == 1 ? (size_t)2 : (size_t)HALF) * g.ldb, nhB = hstepB;
    const unsigned ldsw = (unsigned)wid * 1024u;
    const int aoff = lds_byte(wr * 64 + fr, fq * 8), boff = lds_byte(wc * 32 + fr, fq * 8);
#define PG8_SA(b, h) (((b) * 2 + (h)) * HTB)
#define PG8_SB(b, h) ((4 + (b) * 2 + (h)) * HTB)
#define PG8_STAGE(bufoff, gbase, voff) do { _Pragma("unroll") for (int _i = 0; _i < 2; ++_i) \
        __builtin_amdgcn_global_load_lds((const unsigned*)((const char*)(gbase) + (voff)[_i]), (PG8_LAS unsigned*)(lds + (bufoff) + ldsw + _i * 8192), 16, 0, 0); } while (0)
#define PG8_LDA(dst, b, h) do { if constexpr (FP8) { _Pragma("unroll") for (int m = 0; m < 4; ++m) dst##8[m] = PG8_CAT8(*(const PG8_LAS bf16x8*)(lds + PG8_SA(b, h) + aoff + m * 2048), *(const PG8_LAS bf16x8*)(lds + PG8_SA(b, h) + aoff + m * 2048 + 1024)); } \
    else { _Pragma("unroll") for (int m = 0; m < 4; ++m) _Pragma("unroll") for (int k = 0; k < 2; ++k) dst[m][k] = *(const PG8_LAS bf16x8*)(lds + PG8_SA(b, h) + aoff + m * 2048 + k * 1024); } } while (0)
#define PG8_LDB(dst, b, h) do { if constexpr (FP8) { _Pragma("unroll") for (int n = 0; n < 2; ++n) dst##8[n] = PG8_CAT8(*(const PG8_LAS bf16x8*)(lds + PG8_SB(b, h) + boff + n * 2048), *(const PG8_LAS bf16x8*)(lds + PG8_SB(b, h) + boff + n * 2048 + 1024)); } \
    else { _Pragma("unroll") for (int n = 0; n < 2; ++n) _Pragma("unroll") for (int k = 0; k < 2; ++k) dst[n][k] = *(const PG8_LAS bf16x8*)(lds + PG8_SB(b, h) + boff + n * 2048 + k * 1024); } } while (0)
#define PG8_CAT8(lo, hi) __builtin_shufflevector(__builtin_bit_cast(v4i_t, lo), __builtin_bit_cast(v4i_t, hi), 0, 1, 2, 3, 4, 5, 6, 7)
#define PG8_MMA(ai, bj, At, Bt) do { __builtin_amdgcn_s_setprio(1); if constexpr (FP8) { _Pragma("unroll") for (int m = 0; m < 4; ++m) _Pragma("unroll") for (int n = 0; n < 2; ++n) \
        asm volatile("v_mfma_f32_16x16x128_f8f6f4 %0, %1, %2, %0" : "+v"(acc[ai][bj][m][n]) : "v"(Bt##8[n]), "v"(At##8[m])); } else { \
        _Pragma("unroll") for (int m = 0; m < 4; ++m) _Pragma("unroll") for (int n = 0; n < 2; ++n) _Pragma("unroll") for (int k = 0; k < 2; ++k) \
        acc[ai][bj][m][n] = __builtin_amdgcn_mfma_f32_16x16x32_bf16(Bt[n][k], At[m][k], acc[ai][bj][m][n], 0, 0, 0); } __builtin_amdgcn_s_setprio(0); } while (0)
#define PG8_WAIT_V(n) asm volatile("s_waitcnt vmcnt(" #n ")" ::: "memory")
#define PG8_WAIT_L(n) asm volatile("s_waitcnt lgkmcnt(" #n ")" ::: "memory")
#define PG8_BAR __builtin_amdgcn_s_barrier()
#define PG8_SCHED __builtin_amdgcn_sched_barrier(0)
    Unit cur, nxt; int ui = 0;
    if (!S.next(0, cur)) return;
    f32x4 acc[2][2][4][2];
#pragma unroll
    for (int a = 0; a < 2; ++a)
#pragma unroll
        for (int b = 0; b < 2; ++b)
#pragma unroll
            for (int m = 0; m < 4; ++m)
#pragma unroll
                for (int n = 0; n < 2; ++n) acc[a][b][m][n] = (f32x4){0.f, 0.f, 0.f, 0.f};
    bf16x8 At[4][2], B0[2][2], B1[2][2]; v8i_t At8[4], B08[2], B18[2];
    const char* cA = g.A + cur.aoff; const char* cB = g.B + cur.boff;
    if constexpr (GATHER) PG8_GROWS(cur.pm, voffA, voffA1);
    if constexpr (BMAP == 2) { PG8_BKIND(cur.z, voffB, hstepB); nvB[0] = voffB[0]; nvB[1] = voffB[1]; nhB = hstepB; }
    if constexpr (SP2) {
        PG8_STAGE(PG8_SB(0, 0), cB, voffB); PG8_STAGE(PG8_SB(0, 1), cB + hstepB, voffB); PG8_STAGE(PG8_SA(0, 0), cA, voffA); PG8_STAGE(PG8_SA(0, 1), cA + hstepA, voffA1);
        if (wr == 1) PG8_BAR;
        PG8_WAIT_V(2); PG8_BAR;
        PG8_STAGE(PG8_SB(1, 0), cB + kstepB, voffB); PG8_STAGE(PG8_SA(1, 0), cA + kstepA, voffA); PG8_STAGE(PG8_SB(1, 1), cB + hstepB + kstepB, voffB);
        PG8_WAIT_V(6); PG8_BAR;
    } else {
        PG8_STAGE(PG8_SB(0, 0), cB, voffB); PG8_STAGE(PG8_SA(0, 0), cA, voffA); PG8_STAGE(PG8_SB(0, 1), cB + hstepB, voffB); PG8_STAGE(PG8_SA(0, 1), cA + hstepA, voffA);
        if (wr == 1) PG8_BAR;
        PG8_WAIT_V(4); PG8_BAR;
        PG8_STAGE(PG8_SB(1, 0), cB + kstepB, voffB); PG8_STAGE(PG8_SA(1, 0), cA + kstepA, voffA); PG8_STAGE(PG8_SB(1, 1), cB + hstepB + kstepB, voffB);
        PG8_WAIT_V(6); PG8_BAR;
    }
    for (;;) {
        const bool has_next = S.next(ui + 1, nxt);
        const char* nA = has_next ? g.A + nxt.aoff : cA; const char* nB = has_next ? g.B + nxt.boff : cB;
        if constexpr (BMAP == 2) { if (has_next) PG8_BKIND(nxt.z, nvB, nhB); else { nvB[0] = voffB[0]; nvB[1] = voffB[1]; nhB = hstepB; } }
        if constexpr (GATHER) { if (has_next) PG8_GROWS(nxt.pm, nvA0, nvA1); else {
#pragma unroll
            for (int i = 0; i < 2; ++i) { nvA0[i] = voffA[i]; nvA1[i] = voffA1[i]; } } }
#pragma unroll 1
        for (int t = 0; t < nt; t += 2) {
            if constexpr (rescale_at<Epi>::t >= 0) { if (t == rescale_at<Epi>::t) E.rescale(acc, cur, wr, wc, fr, fq); }
            const bool last = (t == nt - 2);
            const char* a1 = cA + (size_t)(t + 1) * kstepA;
            const char* a2 = last ? nA : cA + (size_t)(t + 2) * kstepA; const char* b2 = last ? nB : cB + (size_t)(t + 2) * kstepB;
            const char* a3 = a2 + kstepA; const char* b3 = b2 + kstepB;
            unsigned w0[2], w1[2];
#pragma unroll
            for (int i = 0; i < 2; ++i) { w0[i] = voffA[i]; w1[i] = voffA1[i]; }
            unsigned wB[2] = {voffB[0], voffB[1]}; size_t hB = hstepB;
            if (BMAP == 2 && last) { asm volatile("; next unit's B row map" ::: ); wB[0] = nvB[0]; wB[1] = nvB[1]; hB = nhB; }
            if (GATHER && last) { asm volatile("; next unit's gathered rows" ::: );
#pragma unroll
                for (int i = 0; i < 2; ++i) { w0[i] = nvA0[i]; w1[i] = nvA1[i]; } }
            if constexpr (SP2) {
            PG8_LDB(B0, 0, 0); PG8_LDB(B1, 0, 1); PG8_SCHED; PG8_LDA(At, 0, 0); PG8_STAGE(PG8_SA(1, 1), a1 + hstepA, voffA1);
            PG8_WAIT_V(8); PG8_WAIT_L(0); PG8_BAR; PG8_MMA(0, 0, At, B0); PG8_MMA(0, 1, At, B1); PG8_BAR; PG8_SCHED;
            PG8_LDA(At, 0, 1); PG8_STAGE(PG8_SB(0, 0), b2, wB); PG8_STAGE(PG8_SB(0, 1), b2 + hB, wB); PG8_STAGE(PG8_SA(0, 0), a2, w0);
            PG8_WAIT_V(8); PG8_WAIT_L(0); PG8_BAR; PG8_MMA(1, 0, At, B0); PG8_MMA(1, 1, At, B1); PG8_BAR; PG8_SCHED;
            PG8_LDB(B0, 1, 0); PG8_LDB(B1, 1, 1); PG8_SCHED; PG8_LDA(At, 1, 0); PG8_STAGE(PG8_SA(0, 1), a2 + hstepA, w1);
            PG8_WAIT_V(8); PG8_WAIT_L(0); PG8_BAR; PG8_MMA(0, 0, At, B0); PG8_MMA(0, 1, At, B1); PG8_BAR; PG8_SCHED;
            PG8_LDA(At, 1, 1); PG8_STAGE(PG8_SB(1, 0), b3, wB); PG8_STAGE(PG8_SB(1, 1), b3 + hB, wB); PG8_STAGE(PG8_SA(1, 0), a3, w0);
            PG8_WAIT_V(8); PG8_WAIT_L(0); PG8_BAR; PG8_MMA(1, 0, At, B0); PG8_MMA(1, 1, At, B1); PG8_BAR; PG8_SCHED;
            } else { static_assert(SP2 || (!GATHER && BMAP != 2), "GATHER / BMAP 2 need the SP2 loop");
            PG8_LDB(B0, 0, 0); PG8_SCHED; PG8_LDA(At, 0, 0); PG8_STAGE(PG8_SA(1, 1), a1 + hstepA, voffA);
            PG8_WAIT_L(8); PG8_BAR; PG8_WAIT_L(0); PG8_MMA(0, 0, At, B0); PG8_BAR; PG8_SCHED;
            PG8_LDB(B1, 0, 1); PG8_STAGE(PG8_SB(0, 0), b2, voffB);
            PG8_BAR; PG8_WAIT_L(0); PG8_MMA(0, 1, At, B1); PG8_BAR;
            PG8_LDA(At, 0, 1); PG8_STAGE(PG8_SA(0, 0), a2, voffA);
            PG8_BAR; PG8_WAIT_L(0); PG8_MMA(1, 0, At, B0); PG8_BAR; PG8_SCHED;
            PG8_STAGE(PG8_SB(0, 1), b2 + hstepB, voffB);
            PG8_WAIT_V(6); PG8_BAR; PG8_MMA(1, 1, At, B1); PG8_BAR;
            PG8_LDB(B0, 1, 0); PG8_SCHED; PG8_LDA(At, 1, 0); PG8_STAGE(PG8_SA(0, 1), a2 + hstepA, voffA);
            PG8_WAIT_L(8); PG8_BAR; PG8_WAIT_L(0); PG8_MMA(0, 0, At, B0); PG8_BAR; PG8_SCHED;
            PG8_LDB(B1, 1, 1); PG8_STAGE(PG8_SB(1, 0), b3, voffB);
            PG8_BAR; PG8_WAIT_L(0); PG8_MMA(0, 1, At, B1); PG8_BAR;
            PG8_LDA(At, 1, 1); PG8_STAGE(PG8_SA(1, 0), a3, voffA);
            PG8_BAR; PG8_WAIT_L(0); PG8_MMA(1, 0, At, B0); PG8_BAR; PG8_SCHED;
            PG8_STAGE(PG8_SB(1, 1), b3 + hstepB, voffB);
            PG8_WAIT_V(6); PG8_BAR; PG8_MMA(1, 1, At, B1); PG8_BAR;
            }
        }
        if constexpr (ALIGN_EPI) { if (wr == 0) PG8_BAR; }
        if constexpr (FP8) {
            asm volatile("s_nop 15\n\ts_nop 15\n\ts_nop 15\n\ts_nop 15\n\ts_nop 15\n\ts_nop 15\n\ts_nop 15\n\ts_nop 15" ::: "memory");
#pragma unroll
            for (int a = 0; a < 2; ++a)
#pragma unroll
                for (int b = 0; b < 2; ++b)
#pragma unroll
                    for (int m = 0; m < 4; ++m) asm volatile("" : "+v"(acc[a][b][m][0]), "+v"(acc[a][b][m][1])); }
        E(acc, cur, wr, wc, fr, fq);
        if (!has_next) break;
#pragma unroll
        for (int a = 0; a < 2; ++a)
#pragma unroll
            for (int b = 0; b < 2; ++b)
#pragma unroll
                for (int m = 0; m < 4; ++m)
#pragma unroll
                    for (int n = 0; n < 2; ++n) acc[a][b][m][n] = (f32x4){0.f, 0.f, 0.f, 0.f};
        cur = nxt; cA = nA; cB = nB; ++ui;
        if constexpr (BMAP == 2) { voffB[0] = nvB[0]; voffB[1] = nvB[1]; hstepB = nhB; }
        if constexpr (GATHER) {
#pragma unroll
            for (int i = 0; i < 2; ++i) { voffA[i] = nvA0[i]; voffA1[i] = nvA1[i]; } }
        if constexpr (ALIGN_EPI) { if (wr == 1) PG8_BAR; }
    }
    PG8_WAIT_V(0);
    if constexpr (!ALIGN_EPI) { if (wr == 0) PG8_BAR; }
    PG8_BAR;
#undef PG8_GROWS
#undef PG8_BKIND
#undef PG8_SA
#undef PG8_SB
#undef PG8_STAGE
#undef PG8_LDA
#undef PG8_LDB
#undef PG8_MMA
#undef PG8_CAT8
#undef PG8_WAIT_V
#undef PG8_WAIT_L
#undef PG8_BAR
#undef PG8_SCHED
}
}
#define GAS __attribute__((address_space(1)))
#define LAS __attribute__((address_space(3)))
typedef unsigned short bf16;
typedef unsigned v4u __attribute__((ext_vector_type(4)));
typedef float f32x4 __attribute__((ext_vector_type(4)));
typedef short bf16x8 __attribute__((ext_vector_type(8)));
typedef GAS unsigned gu32;
typedef GAS unsigned long long gu64;
#define RLX_AGENT __ATOMIC_RELAXED, __HIP_MEMORY_SCOPE_AGENT
#define LDS_WAIT() asm volatile("s_waitcnt lgkmcnt(0)" ::: "memory")
#define VM_WAIT() asm volatile("s_waitcnt vmcnt(0)" ::: "memory")
__device__ __forceinline__ unsigned long long rt() { return __builtin_amdgcn_s_memrealtime(); }
__device__ __forceinline__ unsigned f2bf(float f) { unsigned u = __builtin_bit_cast(unsigned, f); return (u + 0x7fffu + ((u >> 16) & 1u)) >> 16; }
__device__ __forceinline__ unsigned pk2(float lo, float hi) { return f2bf(lo) | (f2bf(hi) << 16); }

#define XB_TMO      128
#define XB_XCNT(j)  (256  + 64 * (j))
#define XB_XSUB(j)  (1280 + 64 * (j))
#define XB_XGEN(j)  (2304 + 64 * (j))
#define XB_TOP      3328
#define XB_TOPGEN   3392
#define XCD_BAR_WORDS 3456
#define XB_SPIN_CAP (1u << 18)

__device__ __forceinline__ unsigned xb_ld(unsigned* p)              { return __hip_atomic_load(p, __ATOMIC_RELAXED, __HIP_MEMORY_SCOPE_AGENT); }
__device__ __forceinline__ unsigned xb_add(unsigned* p, unsigned v) { return __hip_atomic_fetch_add(p, v, __ATOMIC_RELAXED, __HIP_MEMORY_SCOPE_AGENT); }
__device__ __forceinline__ unsigned xb_xcc_id() { return (unsigned)__builtin_amdgcn_s_getreg((3 << 11) | 20) & 0xFu; }
#define XB_SPIN(cond, bar) do { unsigned _sp = 0; while (cond) { __builtin_amdgcn_s_sleep(1); \
    if ((++_sp & 255u) == 0u) { if (xb_ld(&(bar)[XB_TMO])) break; if (_sp > XB_SPIN_CAP) { atomicAdd(&(bar)[XB_TMO], 1u); break; } } } } while (0)

struct XcdBarrier {
    unsigned* bar; unsigned x; unsigned G;
    volatile LAS unsigned* st;
};

__device__ __forceinline__ XcdBarrier xcd_barrier_post(unsigned* bar, volatile LAS unsigned* st) {
    XcdBarrier b; b.bar = bar; b.x = xb_xcc_id(); b.st = st; b.G = 0u;
    if (threadIdx.x == 0) (void)xb_add(&bar[XB_XCNT(b.x)], 1u);
    return b;
}
__device__ __forceinline__ void xcd_barrier_complete(unsigned* bar, unsigned x, const unsigned G, unsigned& nloc, unsigned& nx) {
    unsigned sum, cnt, mine, sp = 0u;
    for (;;) {
        sum = 0u; cnt = 0u; mine = 0u;
#pragma nounroll
        for (unsigned j = 0; j < 16; ++j) { const unsigned c = xb_ld(&bar[XB_XCNT(j)]); sum += c; cnt += (c > 0u) ? 1u : 0u; mine = (j == x) ? c : mine; }
        if (sum == G) break;
        __builtin_amdgcn_s_sleep(1);
        if ((++sp & 255u) == 0u) { if (xb_ld(&bar[XB_TMO])) break; if (sp > XB_SPIN_CAP) { atomicAdd(&bar[XB_TMO], 1u); break; } }
    }
    nloc = mine > 0u ? mine : 1u; nx = cnt > 0u ? cnt : 1u;
}

__device__ __forceinline__ void xcd_barrier(const XcdBarrier& b) {
    asm volatile("s_waitcnt vmcnt(0)" ::: "memory");
    __syncthreads();
    if (threadIdx.x == 0) {
        unsigned* bar = b.bar;
        __builtin_amdgcn_s_waitcnt(0);
        unsigned nloc = b.st[0], nx = b.st[1];
        if (nloc == 0u) { xcd_barrier_complete(bar, b.x, b.G, nloc, nx); b.st[0] = nloc; b.st[1] = nx; }
        const unsigned old = xb_add(&bar[XB_XSUB(b.x)], 1u);
        const unsigned gen = old / nloc;
        if (old + 1u == (gen + 1u) * nloc) {
            __builtin_amdgcn_fence(__ATOMIC_RELEASE, "agent");
            asm volatile("s_waitcnt vmcnt(0)" ::: "memory");
            const unsigned og = xb_add(&bar[XB_TOP], 1u);
            const unsigned tg = og / nx;
            if (og + 1u == (tg + 1u) * nx) xb_add(&bar[XB_TOPGEN], 1u);
            else XB_SPIN(xb_ld(&bar[XB_TOPGEN]) == tg, bar);
            __builtin_amdgcn_fence(__ATOMIC_ACQUIRE, "agent");
            xb_add(&bar[XB_XGEN(b.x)], 1u);
            asm volatile("s_waitcnt vmcnt(0)" ::: "memory");
        } else {
            XB_SPIN(xb_ld(&bar[XB_XGEN(b.x)]) == gen, bar);
            __builtin_amdgcn_fence(__ATOMIC_ACQUIRE, "agent");
            asm volatile("s_waitcnt vmcnt(0)" ::: "memory");
        }
    }
    __syncthreads();
}

constexpr int NWAVES = 8;
constexpr int BATCH = 8, SEQ = 4096, DM = 1024, MTOK = BATCH * SEQ, INC = 4864, FF = 3584, NEXP = 8, AW = 768, AOW = 256;
constexpr float RMS_EPS = 1e-6f;
constexpr float QSCALE = 0.125f * 1.4426950408889634f;

constexpr size_t MiB = 1u << 20;
constexpr size_t WS_CTL = 0, CTL_ZERO_BYTES = 1 * MiB;
constexpr size_t WS_WIN = 1 * MiB;
constexpr size_t WIN_L = (size_t)INC * DM * 2;
constexpr size_t WS_WM = 20 * MiB; constexpr int KMIX = AOW + DM;
constexpr size_t WS_WOUT = 25 * MiB;
constexpr size_t WS_W13 = 29 * MiB;
constexpr size_t WS_W2 = 43 * MiB;
constexpr size_t WS_ROPE = 50 * MiB;
constexpr size_t WS_SS = 502 * MiB, SS_STRIDE = (size_t)MTOK * 4;
constexpr size_t WS_H = 118 * MiB;
constexpr size_t WS_Z = WS_H;
constexpr size_t WS_UT = 182 * MiB;
constexpr size_t WS_OATT = WS_Z - (size_t)(AOW / 8) * MTOK * 16;
constexpr size_t WS_Q = 214 * MiB, WS_K = 262 * MiB, WS_V = 310 * MiB;
constexpr size_t WS_GF = 358 * MiB, WS_GA = 422 * MiB;
constexpr size_t WS_MIX = 278 * MiB;
constexpr size_t WS_H2 = 118 * MiB, WS_TT = 182 * MiB;
constexpr size_t WS_M13 = 54 * MiB, WS_M2 = 110 * MiB;
constexpr size_t WS_H2B = 138 * MiB, WS_TTB = 170 * MiB;
constexpr float W13_SCALE = 32.0f, W2_SCALE = 64.0f;
constexpr int MOE_ROWS = MTOK + 2048;
constexpr int MOE_TILES = MOE_ROWS / 256;
constexpr size_t WS_ROWTOK = 52 * MiB, WS_ROWW = WS_ROWTOK + 512 * 1024;
constexpr size_t WS_SEL = 53 * MiB, WS_WTS = WS_SEL + 128 * 1024;
constexpr size_t WS_CNT = WS_WTS + 256 * 1024, WS_PLAN = WS_CNT + 64 * 1024;
constexpr size_t WS_WG8 = 96 * MiB;
constexpr size_t WS_WQK8 = 486 * MiB;
constexpr size_t WS_X8 = 504 * MiB;
constexpr float WG_SCALE = pg8::WG8_SCALE;
constexpr size_t WS_Y = 408 * MiB;
constexpr size_t WS_END = 536 * MiB;
static_assert(WS_TTB + (size_t)2 * MOE_ROWS * FF <= WS_Y && WS_Y + (size_t)2 * MTOK * DM * 2 <= WS_END && 2 * MOE_ROWS * 4 <= 512 * 1024 && WS_PLAN + 4096 <= 54 * MiB, "moe map");
static_assert(WS_M13 + (size_t)8 * 2 * FF * DM <= WS_M2 && WS_M2 + (size_t)8 * DM * FF <= WS_H2B && WS_H2B + (size_t)MTOK * DM <= WS_TTB && WS_MIX + (size_t)MTOK * DM * 2 <= WS_GF, "d_ws map");

constexpr int XP = 2 * DM;
constexpr int CW_BAR = 4096;
constexpr int RING_BYTES = 131072, LDS_BYTES = 147456, LDSCTL_OFF = LDS_BYTES - 1024, MISC_OFF = LDSCTL_OFF + 320;
static_assert(512 * 68 * 4 <= LDSCTL_OFF, "attention state fits under the control words");

struct Args { const float* in[16]; float* out; unsigned char* ws; int G, pad; };

struct Frame { LAS unsigned char* lds; volatile LAS unsigned* MISC; gu32* ctl; int tid, lane, wave, vcu, G; };

__device__ __forceinline__ float wave_sum(float v, int lane) {
#pragma unroll
    for (int o = 1; o < 64; o <<= 1) v += __int_as_float(__builtin_amdgcn_ds_bpermute((lane ^ o) << 2, __float_as_int(v)));
    return v;
}
__device__ __forceinline__ float bflo(unsigned w) { return __uint_as_float(w << 16); }
__device__ __forceinline__ float bfhi(unsigned w) { return __uint_as_float(w & 0xffff0000u); }

struct RowMap { int kind, base;
    __device__ __forceinline__ int operator()(int n) const {
        if (kind == 0) return n + base;
        if (kind == 2) return (n >> 2) * 8 + (n & 3) + base;
        if (kind == 5) { const int isk = n >= 768, c = n - (isk ? 768 : 0), hd = c >> 6, d = c & 63; return (isk ? 768 : 0) + hd * 64 + 2 * (d & 31) + (d >> 5); }
        if (kind == 4) { const int gch = n & 1023; return (gch >> 7) * 256 + (gch & 127) + (n >= 1024 ? 128 : 0); }
        if (kind == 3) return (n >> 7) * 256 + (n & 127) + base;
        if (n < 512) return n;
        if (n < 2048) { const int isk = n >= 1280, c = n - (isk ? 1280 : 512), hd = c >> 6, d = c & 63; return (isk ? 2048 : 1280) + hd * 64 + 2 * (d & 31) + (d >> 5); }
        if (n < 2816) return 512 + (n - 2048);
        { const int gch = (n - 2816) & 1023; return 2816 + (gch >> 7) * 256 + (gch & 127) + (n >= 3840 ? 128 : 0); }
    } };
struct TrJob { const float* W; int N; void* WT; int ldk; RowMap rm; const float* gain; float scale; int item; int ldw; int f8; };
__device__ __forceinline__ void tr_load(const TrJob& j, int lane, float (&r)[32]) {
    const int nblk = j.N / 32, kb = j.item / nblk, nb = j.item % nblk, k0 = 64 * kb, n0 = 32 * nb;
#pragma unroll
    for (int i = 0; i < 32; ++i) { const int kk = 2 * i + (lane >> 5); r[i] = j.W[(size_t)(k0 + kk) * (j.ldw ? j.ldw : j.N) + n0 + (lane & 31)]; }
}
template <bool F8> __device__ __forceinline__ void tr_store(const TrJob& j, int lane, const float (&r)[32], LAS float* scr) {
    const int nblk = j.N / 32, kb = j.item / nblk, nb = j.item % nblk, k0 = 64 * kb, n0 = 32 * nb;
#pragma unroll
    for (int i = 0; i < 32; ++i) { const int kk = 2 * i + (lane >> 5); scr[kk * 33 + (lane & 31)] = r[i] * (j.gain ? j.scale * j.gain[k0 + kk] : j.scale); }
    LDS_WAIT(); asm volatile("" ::: "memory");
    const int c = lane & 7;
#pragma unroll
    for (int q = 0; q < 4; ++q) { const int n = (lane >> 3) + 8 * q; const LAS float* sp = scr + (8 * c) * 33 + n; const size_t drow = (size_t)j.rm(n0 + n) * j.ldk + k0 + 8 * c;
        if (F8) { unsigned lo = pg8::pk_fp8(sp[0 * 33], sp[1 * 33], 0u, false); lo = pg8::pk_fp8(sp[2 * 33], sp[3 * 33], lo, true);
                  unsigned hi = pg8::pk_fp8(sp[4 * 33], sp[5 * 33], 0u, false); hi = pg8::pk_fp8(sp[6 * 33], sp[7 * 33], hi, true);
                  *(GAS unsigned long long*)((unsigned char*)j.WT + drow) = (unsigned long long)lo | ((unsigned long long)hi << 32); }
        else { v4u o; o.x = pk2(sp[0 * 33], sp[1 * 33]); o.y = pk2(sp[2 * 33], sp[3 * 33]); o.z = pk2(sp[4 * 33], sp[5 * 33]); o.w = pk2(sp[6 * 33], sp[7 * 33]);
               *(GAS v4u*)((bf16*)j.WT + drow) = o; } }
    LDS_WAIT(); asm volatile("" ::: "memory");
}
__device__ __forceinline__ void rms_row(const bf16* xrow, const f32x4 (&gn)[4], f32x4 (&v)[4], int lane) {
    const GAS unsigned long long* xr = (const GAS unsigned long long*)xrow + lane; float s = 0.f;
#pragma unroll
    for (int j = 0; j < 4; ++j) { const unsigned long long w = xr[64 * j]; v[j].x = bflo((unsigned)w); v[j].y = bfhi((unsigned)w); v[j].z = bflo((unsigned)(w >> 32)); v[j].w = bfhi((unsigned)(w >> 32)); s += (v[j].x * v[j].x + v[j].y * v[j].y) + (v[j].z * v[j].z + v[j].w * v[j].w); }
    const float rstd = 1.0f / sqrtf(wave_sum(s, lane) * (1.0f / DM) + RMS_EPS);
#pragma unroll
    for (int j = 0; j < 4; ++j) v[j] = v[j] * rstd * gn[j];
}
__device__ __forceinline__ void prep_x_phase(Frame& F, const float* x, bf16* xb, float* ss, unsigned char* x8) {
    const int gw = F.vcu * NWAVES + F.wave, NGW = F.G * NWAVES;
    for (int m = gw; m < MTOK; m += NGW) { const GAS f32x4* xr = (const GAS f32x4*)(x + (size_t)m * DM) + F.lane; f32x4 v[4]; float sq = 0.f;
#pragma unroll
        for (int j = 0; j < 4; ++j) { v[j] = xr[64 * j]; sq += (v[j].x * v[j].x + v[j].y * v[j].y) + (v[j].z * v[j].z + v[j].w * v[j].w); }
        sq = wave_sum(sq, F.lane); if (F.lane < 4) ss[(size_t)m * 4 + F.lane] = F.lane == 0 ? sq : 0.f;
        GAS unsigned long long* o8 = (GAS unsigned long long*)(xb + (size_t)m * XP) + F.lane;
#pragma unroll
        for (int j = 0; j < 4; ++j) o8[64 * j] = (unsigned long long)pk2(v[j].x, v[j].y) | ((unsigned long long)pk2(v[j].z, v[j].w) << 32);
        GAS unsigned* q8 = (GAS unsigned*)(x8 + (size_t)m * DM) + F.lane;
#pragma unroll
        for (int j = 0; j < 4; ++j) { unsigned w8 = pg8::pk_fp8(v[j].x, v[j].y, 0u, false); w8 = pg8::pk_fp8(v[j].z, v[j].w, w8, true); q8[64 * j] = w8; } }
}

__device__ __forceinline__ TrJob dense_job(const Args& a, int it) {
    unsigned char* ws = a.ws;
    constexpr int I_U = 16 * (512 / 32), I_V = 16 * (768 / 32), I_AT = 4 * 32, I_OUT = 16 * 32, I_W1 = 16 * (FF / 32), I_G = 16 * (2048 / 32), I_QK = 16 * (1536 / 32);
    constexpr int PER_L = I_U + I_V + I_AT + I_OUT;
    int r = it; TrJob j; j.gain = nullptr; j.scale = 1.0f; j.rm = RowMap{0, 0}; j.ldw = 0; j.f8 = 0;
    if (r < 2 * PER_L) { const int l = r / PER_L; r -= l * PER_L;
        if (r < I_U) { j.W = a.in[2] + (size_t)l * DM * INC; j.N = 512; j.ldw = INC; j.WT = ws + WS_WIN + l * WIN_L; j.ldk = DM; j.gain = a.in[1] + l * DM; }
        else if (r < I_U + I_V) { r -= I_U; j.W = a.in[2] + (size_t)l * DM * INC + 2048; j.N = 768; j.ldw = INC; j.WT = ws + WS_WIN + l * WIN_L; j.ldk = DM; j.rm = RowMap{0, 512}; j.gain = a.in[1] + l * DM; }
        else if (r < I_U + I_V + I_AT) { r -= I_U + I_V; j.W = a.in[4] + (size_t)l * AOW * DM; j.N = DM; j.WT = (bf16*)(ws + WS_WM) + (size_t)l * DM * KMIX; j.ldk = KMIX; }
        else { r -= I_U + I_V + I_AT; j.W = a.in[5] + (size_t)l * DM * DM; j.N = DM; j.WT = (bf16*)(ws + WS_WOUT) + (size_t)l * DM * DM; j.ldk = DM; } }
    else { r -= 2 * PER_L;
        if (r < I_W1) { j.W = a.in[7]; j.N = FF; j.WT = ws + WS_W13; j.ldk = DM; j.rm = RowMap{3, 0}; j.gain = a.in[6]; }
        else if (r < 2 * I_W1) { r -= I_W1; j.W = a.in[8]; j.N = FF; j.WT = ws + WS_W13; j.ldk = DM; j.rm = RowMap{3, 128}; j.gain = a.in[6]; }
        else if (r < 3 * I_W1) { r -= 2 * I_W1; j.W = a.in[9]; j.N = DM; j.WT = ws + WS_W2; j.ldk = FF; }
        else if (r < 3 * I_W1 + 2 * I_G) { r -= 3 * I_W1; const int l = r / I_G; r -= l * I_G; j.W = a.in[2] + (size_t)l * DM * INC + 2816; j.N = 2048; j.ldw = INC; j.WT = ws + WS_WG8 + (size_t)l * 2048 * DM; j.ldk = DM; j.rm = RowMap{4, 0};
               j.gain = a.in[1] + l * DM; j.scale = WG_SCALE; j.f8 = 1; }
        else { r -= 3 * I_W1 + 2 * I_G; const int l = r / I_QK; r -= l * I_QK; j.W = a.in[2] + (size_t)l * DM * INC + 512; j.N = 1536; j.ldw = INC; j.WT = ws + WS_WQK8 + (size_t)l * 1536 * DM; j.ldk = DM; j.rm = RowMap{5, 0};
               j.gain = a.in[1] + l * DM; j.scale = WG_SCALE; j.f8 = 1; } }
    j.item = r; return j;
}
constexpr int MOE_I_W1 = 16 * (FF / 32), MOE_I_W2 = (FF / 64) * 32, MOE_NITEMS = NEXP * (2 * MOE_I_W1 + MOE_I_W2), MOE_EARLY_E = 6, MOE_EARLY = MOE_EARLY_E * 2 * MOE_I_W1;
constexpr int CONV_WGS = 40, GEMM_WGS = 256 - CONV_WGS, CONV_PER_WAVE = 22, CONV_PHASE_ITEMS = CONV_WGS * NWAVES * CONV_PER_WAVE;
static_assert(2 * CONV_PHASE_ITEMS <= MOE_EARLY && GEMM_WGS % 8 == 0 && (640 + GEMM_WGS - 1) / GEMM_WGS == 3, "early conversion");
__device__ __forceinline__ TrJob moe_job(const Args& a, int v) {
    unsigned char* ws = a.ws;
    constexpr int I_W1 = MOE_I_W1;
    int e, r;
    if (v < MOE_EARLY) { e = v / (2 * I_W1); r = v - e * (2 * I_W1); }
    else { v -= MOE_EARLY; if (v < (NEXP - MOE_EARLY_E) * 2 * I_W1) { const int q = v / (2 * I_W1); e = MOE_EARLY_E + q; r = v - q * (2 * I_W1); } else { v -= (NEXP - MOE_EARLY_E) * 2 * I_W1; e = v / MOE_I_W2; r = 2 * I_W1 + (v - e * MOE_I_W2); } }
    TrJob j; j.gain = nullptr; j.scale = W13_SCALE; j.rm = RowMap{3, 0}; j.ldw = 0; j.f8 = 1;
    if (r < I_W1) { j.W = a.in[12] + (size_t)e * DM * FF; j.N = FF; j.WT = ws + WS_M13 + (size_t)e * 2 * FF * DM; j.ldk = DM; }
    else if (r < 2 * I_W1) { r -= I_W1; j.W = a.in[13] + (size_t)e * DM * FF; j.N = FF; j.WT = ws + WS_M13 + (size_t)e * 2 * FF * DM; j.ldk = DM; j.rm = RowMap{3, 128}; }
    else { r -= 2 * I_W1; j.W = a.in[14] + (size_t)e * FF * DM; j.N = DM; j.WT = ws + WS_M2 + (size_t)e * DM * FF; j.ldk = FF; j.scale = W2_SCALE; j.rm = RowMap{0, 0}; }
    j.item = r; return j;
}
__device__ __forceinline__ void p0_weights(Frame& F, const Args& a) {
    LAS float* scr = (LAS float*)(F.lds + F.wave * 16384);
    const int gw = F.vcu * NWAVES + F.wave, NGW = F.G * NWAVES;
    constexpr int I_IN = 16 * (512 / 32) + 16 * (768 / 32), I_AT = 4 * 32, I_OUT = 16 * 32, I_W1 = 16 * (FF / 32), I_W2 = (FF / 64) * 32, I_G = 16 * (2048 / 32), I_QK = 16 * (1536 / 32), NITEMS = 2 * (I_IN + I_AT + I_OUT) + 2 * I_W1 + I_W2 + 2 * I_G + 2 * I_QK;
    static_assert(I_W2 == I_W1, "dense_job counts w2's items as I_W1");
    if (gw >= NITEMS) return;
    TrJob cur = dense_job(a, gw); float rc[32]; tr_load(cur, F.lane, rc);
#pragma unroll 1
    for (int it = gw; it < NITEMS; it += NGW) { const int nx = it + NGW; const bool more = nx < NITEMS; TrJob nj = cur; float rn[32];
        if (more) { nj = dense_job(a, nx); tr_load(nj, F.lane, rn); }
        if (cur.f8) tr_store<true>(cur, F.lane, rc, scr); else tr_store<false>(cur, F.lane, rc, scr);
        if (more) { cur = nj;
#pragma unroll
            for (int i = 0; i < 32; ++i) rc[i] = rn[i]; } }
}
__device__ __forceinline__ void p0_moe_weights(Frame& F, const Args& a, int first, int NITEMS, int gw, int NGW) {
    LAS float* scr = (LAS float*)(F.lds + F.wave * 16384);
    gw += first;
    if (gw >= NITEMS) return;
    TrJob cur = moe_job(a, gw), nx1 = cur; float rc[32], r1[32];
    tr_load(cur, F.lane, rc);
    if (gw + NGW < NITEMS) { nx1 = moe_job(a, gw + NGW); tr_load(nx1, F.lane, r1); }
#pragma unroll 1
    for (int it = gw; it < NITEMS; it += NGW) { const int n2 = it + 2 * NGW; const bool more2 = n2 < NITEMS, more1 = it + NGW < NITEMS; TrJob nx2 = cur; float r2[32];
        if (more2) { nx2 = moe_job(a, n2); tr_load(nx2, F.lane, r2); }
        tr_store<true>(cur, F.lane, rc, scr);
        if (more1) { cur = nx1;
#pragma unroll
            for (int i = 0; i < 32; ++i) rc[i] = r1[i]; }
        if (more2) { nx1 = nx2;
#pragma unroll
            for (int i = 0; i < 32; ++i) r1[i] = r2[i]; } }
}
__device__ __forceinline__ void p0_tables(Frame& F, const Args& a) {
    unsigned char* ws = a.ws;
    const int gt = F.vcu * (NWAVES * 64) + F.tid, NGT = F.G * NWAVES * 64;
    float* rope = (float*)(ws + WS_ROPE);
    for (int i = gt; i < SEQ * 32; i += NGT) { const int pos = i >> 5, f = i & 31; const float inv = powf(10000.0f, -(float)f * 2.0f / 64.0f); const float ang = (float)pos * inv;
        rope[2 * i] = cosf(ang); rope[2 * i + 1] = sinf(ang); }
    LAS float* tab = (LAS float*)F.lds;
    LAS float* wl = (LAS float*)(F.lds + 1024 + F.wave * 2048);
    if (F.tid < 128) tab[F.tid] = cospif((float)F.tid * (1.0f / 64.0f));
    __syncthreads();
    const int gw = F.vcu * NWAVES + F.wave, NGW = F.G * NWAVES;
    for (int it = gw; it < 2 * DM; it += NGW) { const int l = it >> 10, j = it & 1023; const float* wf = a.in[3] + (size_t)l * 512 * DM + j;
#pragma unroll
        for (int q = 0; q < 8; ++q) wl[F.lane + 64 * q] = wf[(size_t)(F.lane + 64 * q) * DM];
        LDS_WAIT(); asm volatile("" ::: "memory");
#pragma unroll 1
        for (int o = 0; o < 16; ++o) { const int kk = o * 64 + F.lane, part = kk & 1, cf = 4 * (kk >> 3) + ((kk >> 1) & 3), g = cf >> 7, c = cf & 127, sh = part ? 96 : 0;
            const float c1 = tab[c], tw = 2.0f * c1; float u0 = part ? 0.f : 1.f, u1 = part ? tab[(c + sh) & 127] : c1;
            float acc = 0.f, acc2 = 0.f; const LAS float* wg = wl + g * 128;
#pragma unroll 4
            for (int kc = 0; kc < 128; kc += 4) { const f32x4 w4 = *(const LAS f32x4*)(wg + kc);
                const float u2 = tw * u1 - u0, u3 = tw * u2 - u1; acc += u0 * w4[0]; acc2 += u1 * w4[1]; acc += u2 * w4[2]; acc2 += u3 * w4[3]; u0 = tw * u3 - u2; u1 = tw * u0 - u3; }
            acc += acc2;
            ((bf16*)(ws + WS_WM))[(size_t)l * DM * KMIX + (size_t)j * KMIX + AOW + kk] = (bf16)f2bf(acc * 0.08838834764831845f); }
        LDS_WAIT(); asm volatile("" ::: "memory");
    }
}

__device__ __forceinline__ void fft_phase(Frame& F, const bf16* UT, bf16* Zb) {
    const int lane = F.lane, w = F.wave & 3, cg = F.wave >> 2, lr = lane & 15, lg = lane >> 4;
    LAS unsigned char* f2 = F.lds; LAS unsigned char* f1 = F.lds + 16384; LAS float* tw = (LAS float*)(F.lds + 32768);
#pragma unroll 1
    for (int idx = F.tid; idx < 4096; idx += NWAVES * 64) {
        { const int f = idx >> 8, l = (idx >> 2) & 63, e2 = idx & 3, q = f >> 2, KK = (f >> 1) & 1, cs = f & 1, llr = l & 15, llg = l >> 4; float v[2];
#pragma unroll
          for (int h = 0; h < 2; ++h) { const int e = 2 * e2 + h, n2 = 32 * KK + (e < 4 ? 4 * llg + e : 16 + 4 * llg + e - 4), k2 = 16 * q + llr; const float x = (float)((n2 * k2) & 63) * (1.0f / 32.0f); v[h] = (cs ? sinpif(x) : cospif(x)) * 0.125f; }
          *(LAS unsigned*)(f2 + f * 1024 + l * 16 + e2 * 4) = pk2(v[0], v[1]); }
        { const int f = idx >> 8, l = (idx >> 2) & 63, e2 = idx & 3, ww = f >> 2, kk = (f >> 1) & 1, cs = f & 1, llr = l & 15, llg = l >> 4; float v[2];
#pragma unroll
          for (int h = 0; h < 2; ++h) { const int n1 = 32 * kk + 8 * llg + 2 * e2 + h, k1 = 16 * ww + llr; const float x = (float)((n1 * k1) & 63) * (1.0f / 32.0f); v[h] = (cs ? -sinpif(x) : cospif(x)) * 0.125f; }
          *(LAS unsigned*)(f1 + f * 1024 + l * 16 + e2 * 4) = pk2(v[0], v[1]); }
        { const int ww = idx >> 10, l = (idx >> 4) & 63, ir = idx & 15, n2 = 16 * (ir >> 2) + 4 * (l >> 4) + (ir & 3), k1 = 16 * ww + (l & 15); const float x = (float)(n2 * k1) * (1.0f / 2048.0f);
          tw[(ww * 64 + l) * 32 + ir] = cospif(x); tw[(ww * 64 + l) * 32 + 16 + ir] = sinpif(x); }
    }
    __syncthreads();
    bf16x8 F1c[2], F1s[2];
#pragma unroll
    for (int kk = 0; kk < 2; ++kk) { F1c[kk] = *(const LAS bf16x8*)(f1 + ((w * 2 + kk) * 2) * 1024 + lane * 16); F1s[kk] = *(const LAS bf16x8*)(f1 + ((w * 2 + kk) * 2 + 1) * 1024 + lane * 16); }
    float twc[4][4], tws[4][4];
#pragma unroll
    for (int I = 0; I < 4; ++I) { const f32x4 tc = *(const LAS f32x4*)(tw + (w * 64 + lane) * 32 + 4 * I), ts = *(const LAS f32x4*)(tw + (w * 64 + lane) * 32 + 16 + 4 * I);
#pragma unroll
        for (int r = 0; r < 4; ++r) { twc[I][r] = tc[r]; tws[I][r] = ts[r]; } }
    for (int it = F.vcu * 2 + cg; it < BATCH * 128; it += F.G * 2) {
        const int b = it >> 7, quad = it & 127;
        unsigned outp[4][4][4];
#pragma unroll
        for (int cc = 0; cc < 4; ++cc) {
            const bf16* xp = UT + (size_t)(quad * 4 + cc) * MTOK + b * SEQ + 64 * lr + 8 * lg;
            bf16x8 xa[4][2];
#pragma unroll
            for (int I = 0; I < 4; ++I)
#pragma unroll
                for (int kk = 0; kk < 2; ++kk) xa[I][kk] = *(const GAS bf16x8*)(xp + 1024 * I + 32 * kk);
            f32x4 d1r[4], d1i[4];
#pragma unroll
            for (int I = 0; I < 4; ++I) { d1r[I] = (f32x4){0.f, 0.f, 0.f, 0.f}; d1i[I] = (f32x4){0.f, 0.f, 0.f, 0.f};
#pragma unroll
                for (int kk = 0; kk < 2; ++kk) { d1r[I] = __builtin_amdgcn_mfma_f32_16x16x32_bf16(xa[I][kk], F1c[kk], d1r[I], 0, 0, 0); d1i[I] = __builtin_amdgcn_mfma_f32_16x16x32_bf16(xa[I][kk], F1s[kk], d1i[I], 0, 0, 0); } }
            bf16x8 yr[2], yi[2], yn[2];
#pragma unroll
            for (int KK = 0; KK < 2; ++KK) { float vr[8], vi[8];
#pragma unroll
                for (int e = 0; e < 8; ++e) { const int I = 2 * KK + (e >> 2), r = e & 3; const float a = d1r[I][r], bb = d1i[I][r]; vr[e] = a * twc[I][r] + bb * tws[I][r]; vi[e] = bb * twc[I][r] - a * tws[I][r]; }
                v4u pr, pi, pn; pr.x = pg8::cvt_pk_bf16(vr[0], vr[1]); pr.y = pg8::cvt_pk_bf16(vr[2], vr[3]); pr.z = pg8::cvt_pk_bf16(vr[4], vr[5]); pr.w = pg8::cvt_pk_bf16(vr[6], vr[7]);
                pi.x = pg8::cvt_pk_bf16(vi[0], vi[1]); pi.y = pg8::cvt_pk_bf16(vi[2], vi[3]); pi.z = pg8::cvt_pk_bf16(vi[4], vi[5]); pi.w = pg8::cvt_pk_bf16(vi[6], vi[7]);
                pn.x = pr.x ^ 0x80008000u; pn.y = pr.y ^ 0x80008000u; pn.z = pr.z ^ 0x80008000u; pn.w = pr.w ^ 0x80008000u;
                yr[KK] = __builtin_bit_cast(bf16x8, pr); yi[KK] = __builtin_bit_cast(bf16x8, pi); yn[KK] = __builtin_bit_cast(bf16x8, pn); }
#pragma unroll
            for (int q = 0; q < 4; ++q) { f32x4 zr = (f32x4){0.f, 0.f, 0.f, 0.f}, zi = (f32x4){0.f, 0.f, 0.f, 0.f};
#pragma unroll
                for (int KK = 0; KK < 2; ++KK) { const bf16x8 fc = *(const LAS bf16x8*)(f2 + ((q * 2 + KK) * 2) * 1024 + lane * 16), fs = *(const LAS bf16x8*)(f2 + ((q * 2 + KK) * 2 + 1) * 1024 + lane * 16);
                    zr = __builtin_amdgcn_mfma_f32_16x16x32_bf16(yr[KK], fc, zr, 0, 0, 0); zr = __builtin_amdgcn_mfma_f32_16x16x32_bf16(yi[KK], fs, zr, 0, 0, 0);
                    zi = __builtin_amdgcn_mfma_f32_16x16x32_bf16(yi[KK], fc, zi, 0, 0, 0); zi = __builtin_amdgcn_mfma_f32_16x16x32_bf16(yn[KK], fs, zi, 0, 0, 0); }
#pragma unroll
                for (int r = 0; r < 4; ++r) outp[q][r][cc] = pg8::cvt_pk_bf16(zr[r], zi[r]); }
        }
#pragma unroll
        for (int q = 0; q < 4; ++q)
#pragma unroll
            for (int r = 0; r < 4; ++r) { const int k = 16 * w + 4 * lg + r + 64 * (16 * q + lr); v4u o; o.x = outp[q][r][0]; o.y = outp[q][r][1]; o.z = outp[q][r][2]; o.w = outp[q][r][3];
                *(GAS v4u*)(Zb + ((size_t)quad * MTOK + (size_t)b * SEQ + k) * 8) = o; }
    }
    __syncthreads();
}

__device__ __forceinline__ bf16x8 f8x8_bf16(unsigned long long w) {
    typedef float f32x2_t __attribute__((ext_vector_type(2)));
    const f32x2_t a = __builtin_amdgcn_cvt_pk_f32_fp8((int)(unsigned)w, false), b = __builtin_amdgcn_cvt_pk_f32_fp8((int)(unsigned)w, true),
                  c = __builtin_amdgcn_cvt_pk_f32_fp8((int)(unsigned)(w >> 32), false), d = __builtin_amdgcn_cvt_pk_f32_fp8((int)(unsigned)(w >> 32), true);
    v4u o; o.x = pg8::cvt_pk_bf16(a.x, a.y); o.y = pg8::cvt_pk_bf16(b.x, b.y); o.z = pg8::cvt_pk_bf16(c.x, c.y); o.w = pg8::cvt_pk_bf16(d.x, d.y); return __builtin_bit_cast(bf16x8, o); }
__device__ __forceinline__ void attn_mfma_phase(Frame& F, const unsigned char* Q, const unsigned char* K, const unsigned char* VT, bf16* OA) {
    LAS float* st = (LAS float*)F.lds;
    const int lane = F.lane, lr = lane & 15, lg = lane >> 4, bp16 = (lane ^ 16) << 2, bp32 = (lane ^ 32) << 2;
    for (int unit = F.vcu; unit < 256; unit += F.G) {
        const int b = unit >> 5, pb = (unit >> 2) & 7, j = unit & 3, P0 = pb * 512;
#pragma unroll 1
        for (int pass = 0; pass < 3; ++pass) {
            const int g = 2 - pass, dsh = 2 * g, dl = 1 << dsh, L = SEQ >> dsh, head = g * 4 + j, lns = 4 - dsh;
#pragma unroll 1
            for (int tt = 0; tt < 2; ++tt) {
                const int tau = F.wave * 2 + tt, r = tau >> lns, sblk = tau & ((1 << lns) - 1), iq0 = (P0 >> dsh) + 32 * sblk;
                const unsigned char* Kh = K + (size_t)b * SEQ * AW + head * 64 + 8 * lg;
                const unsigned char* Vh = VT + (size_t)(head * 64 + lr) * MTOK + (size_t)b * SEQ + r * L;
                long qf[2][2]; int prow[2]; f32x4 o[4][2]; float m[2], l[2];
#pragma unroll
                for (int qb = 0; qb < 2; ++qb) { const int pl = dl * (32 * sblk + 16 * qb + lr) + r; prow[qb] = pl;
                    const unsigned char* qp = Q + (size_t)(b * SEQ + P0 + pl) * AW + head * 64 + 8 * lg;
                    qf[qb][0] = *(const GAS long*)qp; qf[qb][1] = *(const GAS long*)(qp + 32); }
                if (pass == 0) {
#pragma unroll
                    for (int qb = 0; qb < 2; ++qb) { m[qb] = -1e30f; l[qb] = 0.f;
#pragma unroll
                        for (int t = 0; t < 4; ++t) o[t][qb] = (f32x4){0.f, 0.f, 0.f, 0.f}; }
                } else {
#pragma unroll
                    for (int qb = 0; qb < 2; ++qb) { const LAS float* sp = st + prow[qb] * 68; m[qb] = sp[64]; l[qb] = lg == 0 ? sp[65] : 0.f;
#pragma unroll
                        for (int t = 0; t < 4; ++t) o[t][qb] = *(const LAS f32x4*)(sp + 16 * t + 4 * lg); }
                }
                typedef unsigned long long u64t; u64t kf[2][2], vf[4], kfn[2][2], vfn[4];
#define ATT_LOAD(c_, kd, vd) do { const int kb_ = iq0 - 64 + 32 * (c_); int ia_ = kb_ + 8 * (lr >> 2) + (lr & 3), ib_ = ia_ + 4; ia_ = ia_ < 0 ? 0 : (ia_ >= L ? L - 1 : ia_); ib_ = ib_ < 0 ? 0 : (ib_ >= L ? L - 1 : ib_); \
        const unsigned char* ka_ = Kh + (size_t)(dl * ia_ + r) * AW; const unsigned char* kb2_ = Kh + (size_t)(dl * ib_ + r) * AW; \
        kd[0][0] = *(const GAS u64t*)ka_; kd[0][1] = *(const GAS u64t*)(ka_ + 32); kd[1][0] = *(const GAS u64t*)kb2_; kd[1][1] = *(const GAS u64t*)(kb2_ + 32); \
        int vk_ = kb_ + 8 * lg; vk_ = vk_ < 0 ? 0 : (vk_ > L - 8 ? L - 8 : vk_); \
        _Pragma("unroll") for (int t_ = 0; t_ < 4; ++t_) vd[t_] = *(const GAS u64t*)(Vh + (size_t)(16 * t_) * MTOK + vk_); } while (0)
                ATT_LOAD(0, kf, vf);
#pragma unroll 1
                for (int c = 0; c < 5; ++c) {
                    if (c < 4) ATT_LOAD(c + 1, kfn, vfn);
                    const int kb = iq0 - 64 + 32 * c;
                    f32x4 s[2][2];
#pragma unroll
                    for (int tl = 0; tl < 2; ++tl) {
#pragma unroll
                        for (int qb = 0; qb < 2; ++qb) { s[tl][qb] = __builtin_amdgcn_mfma_f32_16x16x32_fp8_fp8((long)kf[tl][0], qf[qb][0], (f32x4){0.f, 0.f, 0.f, 0.f}, 0, 0, 0);
                            s[tl][qb] = __builtin_amdgcn_mfma_f32_16x16x32_fp8_fp8((long)kf[tl][1], qf[qb][1], s[tl][qb], 0, 0, 0); } }
                    bf16x8 pf[2];
                    if (c == 0 || c == 4 || kb < 0 || kb + 32 > L) {
#pragma unroll
                        for (int qb = 0; qb < 2; ++qb) { const int iq = iq0 + 16 * qb + lr, lo = iq - 64 < 0 ? 0 : iq - 64, hi = iq + 64 > L - 1 ? L - 1 : iq + 64; const unsigned span = (unsigned)(hi - lo); const int k0 = kb + 8 * lg - lo;
#pragma unroll
                            for (int e = 0; e < 8; ++e) s[e >> 2][qb][e & 3] = (unsigned)(k0 + e) <= span ? s[e >> 2][qb][e & 3] : -__builtin_inff(); } }
#pragma unroll
                    for (int qb = 0; qb < 2; ++qb) { float sv[8]; float mx = -__builtin_inff();
#pragma unroll
                        for (int e = 0; e < 8; ++e) { sv[e] = s[e >> 2][qb][e & 3]; mx = fmaxf(mx, sv[e]); }
                        mx = fmaxf(mx, __int_as_float(__builtin_amdgcn_ds_bpermute(bp16, __float_as_int(mx)))); mx = fmaxf(mx, __int_as_float(__builtin_amdgcn_ds_bpermute(bp32, __float_as_int(mx))));
                        const float mn = fmaxf(m[qb], mx), al = __builtin_amdgcn_exp2f(m[qb] - mn); m[qb] = mn; float ps = 0.f; float p[8];
#pragma unroll
                        for (int e = 0; e < 8; ++e) { p[e] = __builtin_amdgcn_exp2f(sv[e] - mn); ps += p[e]; }
                        l[qb] = l[qb] * al + ps;
#pragma unroll
                        for (int t = 0; t < 4; ++t) o[t][qb] = o[t][qb] * al;
                        v4u pw; pw.x = pg8::cvt_pk_bf16(p[0], p[1]); pw.y = pg8::cvt_pk_bf16(p[2], p[3]); pw.z = pg8::cvt_pk_bf16(p[4], p[5]); pw.w = pg8::cvt_pk_bf16(p[6], p[7]); pf[qb] = __builtin_bit_cast(bf16x8, pw); }
#pragma unroll
                    for (int t = 0; t < 4; ++t) { const bf16x8 vt = f8x8_bf16(vf[t]);
#pragma unroll
                        for (int qb = 0; qb < 2; ++qb) o[t][qb] = __builtin_amdgcn_mfma_f32_16x16x32_bf16(vt, pf[qb], o[t][qb], 0, 0, 0); }
#pragma unroll
                    for (int tl = 0; tl < 2; ++tl) { kf[tl][0] = kfn[tl][0]; kf[tl][1] = kfn[tl][1]; }
#pragma unroll
                    for (int t = 0; t < 4; ++t) vf[t] = vfn[t];
                }
#undef ATT_LOAD
#pragma unroll
                for (int qb = 0; qb < 2; ++qb) { float lt = l[qb]; lt += __int_as_float(__builtin_amdgcn_ds_bpermute(bp16, __float_as_int(lt))); lt += __int_as_float(__builtin_amdgcn_ds_bpermute(bp32, __float_as_int(lt)));
                    if (pass < 2) { LAS float* sp = st + prow[qb] * 68;
#pragma unroll
                        for (int t = 0; t < 4; ++t) *(LAS f32x4*)(sp + 16 * t + 4 * lg) = o[t][qb];
                        if (lg == 0) { sp[64] = m[qb]; sp[65] = lt; } }
                    else { const float il = 1.0f / lt; bf16* op = OA + ((size_t)(8 * j + (lg >> 1)) * MTOK + (size_t)(b * SEQ + P0 + prow[qb])) * 8 + 4 * (lg & 1);
#pragma unroll
                        for (int t = 0; t < 4; ++t) { const f32x4 x = o[t][qb] * il; *(GAS unsigned long long*)(op + (size_t)(2 * t) * MTOK * 8) = (unsigned long long)pg8::cvt_pk_bf16(x[0], x[1]) | ((unsigned long long)pg8::cvt_pk_bf16(x[2], x[3]) << 32); } } }
            }
            __syncthreads();
        }
    }
}

__device__ __forceinline__ void norm_router_phase(Frame& F, const bf16* x, const float* gain, unsigned char* out8, const float* rw, const float* rb, int* SEL, float* WTS, int* CNT) {
    LAS float* wr = (LAS float*)F.lds;
    LAS int* sel_l = (LAS int*)(F.lds + 32768);
    for (int i = F.tid; i < DM * NEXP; i += NWAVES * 64) { const int k = i >> 3, e = i & 7; wr[(((e >> 2) * 1024) + (k & 3) * 256 + (k >> 2)) * 4 + (e & 3)] = rw[i]; }
    __syncthreads();
    f32x4 gn[4];
#pragma unroll
    for (int j = 0; j < 4; ++j) gn[j] = ((const GAS f32x4*)gain)[F.lane + 64 * j];
    typedef unsigned long long u64r;
    u64r rw_[4];
    { const GAS u64r* xr = (const GAS u64r*)(x + (size_t)(F.vcu * 128 + F.wave * 16) * XP) + F.lane;
#pragma unroll
      for (int j = 0; j < 4; ++j) rw_[j] = xr[64 * j]; }
    const bool b0 = F.lane & 1, b1 = F.lane & 2, b2 = F.lane & 4;
#pragma unroll 1
    for (int i = 0; i < 16; ++i) { const int tl = F.wave * 16 + i, m = F.vcu * 128 + tl; f32x4 v[4]; float ssq = 0.f;
#pragma unroll
        for (int j = 0; j < 4; ++j) { const u64r w = rw_[j]; v[j].x = bflo((unsigned)w); v[j].y = bfhi((unsigned)w); v[j].z = bflo((unsigned)(w >> 32)); v[j].w = bfhi((unsigned)(w >> 32));
            ssq += (v[j].x * v[j].x + v[j].y * v[j].y) + (v[j].z * v[j].z + v[j].w * v[j].w); }
        if (i < 15) { const GAS u64r* xr = (const GAS u64r*)(x + (size_t)(m + 1) * XP) + F.lane;
#pragma unroll
            for (int j = 0; j < 4; ++j) rw_[j] = xr[64 * j]; }
        const float rstd = 1.0f / sqrtf(wave_sum(ssq, F.lane) * (1.0f / DM) + RMS_EPS);
#pragma unroll
        for (int j = 0; j < 4; ++j) v[j] = v[j] * rstd * gn[j];
        GAS unsigned* o4 = (GAS unsigned*)(out8 + (size_t)m * DM) + F.lane;
#pragma unroll
        for (int j = 0; j < 4; ++j) { unsigned w8 = pg8::pk_fp8(v[j].x, v[j].y, 0u, false); w8 = pg8::pk_fp8(v[j].z, v[j].w, w8, true); o4[64 * j] = w8; }
        float lg[8];
#pragma unroll
        for (int e = 0; e < 8; ++e) lg[e] = 0.f;
#pragma unroll
        for (int j = 0; j < 4; ++j)
#pragma unroll
            for (int cc = 0; cc < 4; ++cc) { const int sl = cc * 256 + F.lane + 64 * j; const f32x4 wa = *(const LAS f32x4*)(wr + sl * 4), wb = *(const LAS f32x4*)(wr + 4096 + sl * 4); const float xv = v[j][cc];
                lg[0] += xv * wa[0]; lg[1] += xv * wa[1]; lg[2] += xv * wa[2]; lg[3] += xv * wa[3]; lg[4] += xv * wb[0]; lg[5] += xv * wb[1]; lg[6] += xv * wb[2]; lg[7] += xv * wb[3]; }
#define XCH(v_, o_) __int_as_float(__builtin_amdgcn_ds_bpermute((F.lane ^ (o_)) << 2, __float_as_int(v_)))
        float ra[4], rb2[2], rc;
#pragma unroll
        for (int t = 0; t < 4; ++t) { const float send = b0 ? lg[t] : lg[t + 4], keep = b0 ? lg[t + 4] : lg[t]; ra[t] = keep + XCH(send, 1); }
#pragma unroll
        for (int t = 0; t < 2; ++t) { const float send = b1 ? ra[t] : ra[t + 2], keep = b1 ? ra[t + 2] : ra[t]; rb2[t] = keep + XCH(send, 2); }
        { const float send = b2 ? rb2[0] : rb2[1], keep = b2 ? rb2[1] : rb2[0]; rc = keep + XCH(send, 4); }
        rc += XCH(rc, 8); rc += XCH(rc, 16); rc += XCH(rc, 32);
#undef XCH
        lg[0] = __int_as_float(__builtin_amdgcn_readlane(__float_as_int(rc), 0)) + rb[0]; lg[1] = __int_as_float(__builtin_amdgcn_readlane(__float_as_int(rc), 4)) + rb[1];
        lg[2] = __int_as_float(__builtin_amdgcn_readlane(__float_as_int(rc), 2)) + rb[2]; lg[3] = __int_as_float(__builtin_amdgcn_readlane(__float_as_int(rc), 6)) + rb[3];
        lg[4] = __int_as_float(__builtin_amdgcn_readlane(__float_as_int(rc), 1)) + rb[4]; lg[5] = __int_as_float(__builtin_amdgcn_readlane(__float_as_int(rc), 5)) + rb[5];
        lg[6] = __int_as_float(__builtin_amdgcn_readlane(__float_as_int(rc), 3)) + rb[6]; lg[7] = __int_as_float(__builtin_amdgcn_readlane(__float_as_int(rc), 7)) + rb[7];
        int e0 = 0; float v0 = lg[0];
#pragma unroll
        for (int e = 1; e < 8; ++e) if (lg[e] > v0) { v0 = lg[e]; e0 = e; }
        int e1 = 0; float v1 = -__builtin_inff();
#pragma unroll
        for (int e = 0; e < 8; ++e) if (e != e0 && lg[e] > v1) { v1 = lg[e]; e1 = e; }
        const float w0 = 1.0f / (1.0f + expf(v1 - v0)), w1 = 1.0f - w0;
        if (F.lane == 0) { sel_l[tl] = e0 | (e1 << 8); WTS[2 * (size_t)m] = w0; WTS[2 * (size_t)m + 1] = w1; }
    }
    __syncthreads();
    if (F.tid < 128) { const int me = sel_l[F.tid], e0 = me & 255, e1 = me >> 8; int r0 = 0, r1 = 0;
        for (int t = 0; t < F.tid; ++t) { const int o = sel_l[t]; r0 += ((o & 255) == e0); r1 += ((o >> 8) == e1); }
        SEL[F.vcu * 128 + F.tid] = me | (r0 << 16) | (r1 << 24); }
    else if (F.tid < 144) { const int q = F.tid - 128, s = q >> 3, e = q & 7; int n = 0;
        for (int t = 0; t < 128; ++t) { const int o = sel_l[t]; n += ((s ? (o >> 8) : (o & 255)) == e); }
        CNT[F.vcu * 16 + q] = n; }
    __syncthreads();
}
__device__ __forceinline__ void route2_phase(Frame& F, const int* SEL, const float* WTS, const int* CNT, int* ROWTOK, float* ROWW, int* PLAN) {
    LAS int* call = (LAS int*)F.lds;
    LAS int* tot = call + 4096; LAS int* basew = tot + 16; LAS int* segst = basew + 16; LAS int* ntile = segst + 16;
    for (int i = F.tid; i < 4096; i += NWAVES * 64) call[i] = CNT[i];
    __syncthreads();
    if (F.tid < 16) { int t = 0, bsum = 0; for (int w = 0; w < 256; ++w) { const int c = call[w * 16 + F.tid]; t += c; bsum += (w < F.vcu) ? c : 0; } tot[F.tid] = t; basew[F.tid] = bsum; }
    __syncthreads();
    if (F.tid < 2) { int run = 0; for (int e = 0; e < 8; ++e) { segst[F.tid * 8 + e] = run; run += (tot[F.tid * 8 + e] + 255) & ~255; } ntile[F.tid] = run >> 8; }
    __syncthreads();
    if (F.tid < 128) { const int m = F.vcu * 128 + F.tid, sl = SEL[m], e0 = sl & 255, e1 = (sl >> 8) & 255, r0 = (sl >> 16) & 255, r1 = (sl >> 24) & 255;
        const int p0 = segst[e0] + basew[e0] + r0, p1 = segst[8 + e1] + basew[8 + e1] + r1;
        ROWTOK[p0] = m; ROWW[p0] = WTS[2 * (size_t)m]; ROWTOK[MOE_ROWS + p1] = m; ROWW[MOE_ROWS + p1] = WTS[2 * (size_t)m + 1]; }
    if (F.vcu < 8) {
        for (int s = 0; s < 2; ++s) { const int q = s * 8 + F.vcu, n = tot[q], np = (n + 255) & ~255;
            for (int p = n + F.tid; p < np; p += NWAVES * 64) { ROWTOK[s * MOE_ROWS + segst[q] + p] = -1; ROWW[s * MOE_ROWS + segst[q] + p] = 0.f; } } }
    if (F.vcu == 8) {
        if (F.tid < 2) PLAN[F.tid] = ntile[F.tid];
        if (F.tid < 2 * MOE_TILES) { const int s = F.tid / MOE_TILES, t = F.tid % MOE_TILES; int e = 0;
            for (int k = 1; k < 8; ++k) if ((segst[s * 8 + k] >> 8) <= t) e = k;
            PLAN[16 + MOE_TILES * s + t] = e; } }
    __syncthreads();
}
__device__ __forceinline__ void final_norm_phase(Frame& F, float* xio, const bf16* xb, const float* gain, const bf16* y) {
    const int gw = F.vcu * NWAVES + F.wave, NGW = F.G * NWAVES;
    f32x4 gn[4];
#pragma unroll
    for (int j = 0; j < 4; ++j) gn[j] = ((const GAS f32x4*)gain)[F.lane + 64 * j];
    for (int m = gw; m < MTOK; m += NGW) { f32x4 v[4]; float s = 0.f;
        const GAS unsigned long long* xr = (const GAS unsigned long long*)(xb + (size_t)m * XP) + F.lane;
        const GAS unsigned long long* y0 = (const GAS unsigned long long*)(y + (size_t)m * DM) + F.lane; const GAS unsigned long long* y1 = (const GAS unsigned long long*)(y + ((size_t)MTOK + m) * DM) + F.lane;
#pragma unroll
        for (int j = 0; j < 4; ++j) { const unsigned long long xw = xr[64 * j]; v[j].x = bflo((unsigned)xw); v[j].y = bfhi((unsigned)xw); v[j].z = bflo((unsigned)(xw >> 32)); v[j].w = bfhi((unsigned)(xw >> 32));
            const unsigned long long a0 = y0[64 * j], a1 = y1[64 * j];
            v[j].x += bflo((unsigned)a0) + bflo((unsigned)a1); v[j].y += bfhi((unsigned)a0) + bfhi((unsigned)a1);
            v[j].z += bflo((unsigned)(a0 >> 32)) + bflo((unsigned)(a1 >> 32)); v[j].w += bfhi((unsigned)(a0 >> 32)) + bfhi((unsigned)(a1 >> 32));
            s += (v[j].x * v[j].x + v[j].y * v[j].y) + (v[j].z * v[j].z + v[j].w * v[j].w); }
        const float rstd = 1.0f / sqrtf(wave_sum(s, F.lane) * (1.0f / DM) + RMS_EPS);
        GAS f32x4* o = (GAS f32x4*)(xio + (size_t)m * DM) + F.lane;
#pragma unroll
        for (int j = 0; j < 4; ++j) o[64 * j] = v[j] * rstd * gn[j]; }
}

struct MoeOrder { int nT0, nM, nN, nwg, G, c; unsigned lda, ldb; const int* tile_e; size_t estride; bool gather;
    __device__ bool next(int i, pg8::Unit& u) const {
        const long L = (long)i * G + c; if (L >= nwg) return false;
        int wgid = (int)L; { const int q = nwg / pg8::NXCD, r = nwg % pg8::NXCD, xcd = wgid % pg8::NXCD, off = wgid / pg8::NXCD; wgid = (xcd < r ? xcd * (q + 1) : r * (q + 1) + (xcd - r) * q) + off; }
        const int nig = pg8::WGM * nN, gid = wgid / nig, fm = gid * pg8::WGM, gsz = (nM - fm) < pg8::WGM ? (nM - fm) : pg8::WGM;
        const int lin = fm + ((wgid % nig) % gsz); u.pm = lin < nT0 ? lin : MOE_TILES + (lin - nT0); u.pn = (wgid % nig) / gsz; u.z = __builtin_amdgcn_readfirstlane(tile_e[u.pm]);
        u.aoff = gather ? (size_t)0 : (size_t)u.pm * 256 * lda; u.boff = (size_t)u.z * estride + (size_t)u.pn * 256 * ldb; return true; } };

template <class Epi, int BMAP = 0, int ALAY = 0> __device__ __forceinline__ void run_gemm(Frame& F, const void* A, unsigned lda, const void* B, unsigned ldb, int Mrows, int Ncols, int K, const Epi& E, int geff = 0) {
    int G_ = geff ? geff : F.G, c_ = (int)blockIdx.x; asm volatile("" : "+s"(G_), "+s"(c_));
    pg8::Gemm g{(const char*)A, (const char*)B, lda, ldb, K, nullptr}; pg8::PlainOrder S; S.init(Mrows, Ncols, G_, c_, lda, ldb, BMAP, ALAY);
    pg8::gemm_phase<Epi, pg8::PlainOrder, false, BMAP, ALAY>(F.lds, g, S, E);
}

__device__ __forceinline__ Args load_args() {
    Args r{};
#if defined(__HIP_DEVICE_COMPILE__)
    typedef const __attribute__((address_space(4))) Args CArgs;
    auto p = __builtin_amdgcn_kernarg_segment_ptr(); asm volatile("" : "+s"(p)); CArgs* q = (CArgs*)p;
#pragma unroll
    for (int i = 0; i < 16; ++i) r.in[i] = q->in[i];
    r.out = q->out; r.ws = q->ws; r.G = q->G;
#endif
    return r;
}
__device__ __forceinline__ Frame make_frame(LAS unsigned char* lds, unsigned char* ws, int G) {
    Frame F; int t = threadIdx.x, g = G, bx = blockIdx.x; asm volatile("" : "+v"(t), "+s"(g), "+s"(bx));
    F.lds = lds; F.MISC = (volatile LAS unsigned*)(lds + MISC_OFF); F.ctl = (gu32*)(ws + WS_CTL);
    F.tid = t; F.lane = t & 63; F.wave = __builtin_amdgcn_readfirstlane(t >> 6); F.G = g; F.vcu = (g % 8 == 0) ? (bx % 8) * (g / 8) + bx / 8 : bx; return F; }
#define PH_BEGIN const Args a = load_args(); unsigned char* const ws = a.ws; float* const xout = a.out; bf16* const xsA = (bf16*)a.out; bf16* const xsB = xsA + DM; Frame F = make_frame((LAS unsigned char*)lds, ws, a.G); (void)xout; (void)xsA; (void)xsB
__global__ void __launch_bounds__(NWAVES * 64, 2) fwd_kernel(Args args) {
    extern __shared__ __attribute__((aligned(16))) unsigned char lds[];
    for (int u = threadIdx.x; u < (LDS_BYTES - LDSCTL_OFF) / 4; u += NWAVES * 64) ((LAS unsigned*)((LAS unsigned char*)lds + LDSCTL_OFF))[u] = 0u;
    __syncthreads();
    XcdBarrier bar = xcd_barrier_post((unsigned*)(args.ws + WS_CTL) + CW_BAR, (volatile LAS unsigned*)((LAS unsigned char*)lds + MISC_OFF) + 8);
    bar.G = (unsigned)args.G;
#define GRID_BAR() do { XcdBarrier b2_ = bar; asm volatile("" : "+s"(b2_.bar), "+s"(b2_.x), "+s"(b2_.G)); xcd_barrier(b2_); } while (0)

    { PH_BEGIN; p0_weights(F, a); __syncthreads(); p0_tables(F, a); prep_x_phase(F, a.in[0], xsA, (float*)(ws + WS_SS), ws + WS_X8); }
    GRID_BAR();

    for (int layer = 0; layer < 2; ++layer) {
        asm volatile("" : "+s"(layer));
        { PH_BEGIN; int lyr = layer; asm volatile("" : "+s"(lyr)); const bf16* WinT = (const bf16*)(ws + WS_WIN + lyr * WIN_L);
          pg8::EpiInproj E{ws, WS_V, WS_Q, WS_K, WS_GF, WS_GA, WS_ROPE, QSCALE, (const float*)(ws + WS_SS) + (size_t)(2 * lyr) * SS_STRIDE, 1.0f / WG_SCALE};
          int G_ = F.G, c_ = (int)blockIdx.x; asm volatile("" : "+s"(G_), "+s"(c_));
          pg8::Gemm g{(const char*)(ws + WS_X8), (const char*)(ws + WS_WQK8 + (size_t)lyr * 1536 * DM), DM, DM, DM / 2, nullptr}; pg8::PlainOrder S; S.init(MTOK, 1536, G_, c_, DM, DM, 0, 0);
          pg8::gemm_phase<pg8::EpiInproj, pg8::PlainOrder, false, 0, 0, true>(F.lds, g, S, E); }
        { PH_BEGIN; int lyr = layer; asm volatile("" : "+s"(lyr)); const bf16* WinT = (const bf16*)(ws + WS_WIN + lyr * WIN_L);
          pg8::EpiBf16 E{(bf16*)(ws + WS_UT), MTOK, (bf16*)(ws + WS_V), 2, (const float*)(ws + WS_SS) + (size_t)(2 * lyr) * SS_STRIDE}; int bx_ = (int)blockIdx.x; asm volatile("" : "+s"(bx_));
          if (bx_ < GEMM_WGS) run_gemm<pg8::EpiBf16, 2, 0>(F, WinT, DM * 2, xsA, XP * 2, 1280, MTOK, DM, E, GEMM_WGS);
          else p0_moe_weights(F, a, lyr * CONV_PHASE_ITEMS, (lyr + 1) * CONV_PHASE_ITEMS, (bx_ - GEMM_WGS) * NWAVES + F.wave, CONV_WGS * NWAVES); }
        GRID_BAR();
        { PH_BEGIN; fft_phase(F, (const bf16*)(ws + WS_UT), (bf16*)(ws + WS_Z)); }
        { PH_BEGIN; attn_mfma_phase(F, ws + WS_Q, ws + WS_K, ws + WS_V, (bf16*)(ws + WS_OATT)); }
        { PH_BEGIN; int lyr = layer; asm volatile("" : "+s"(lyr)); int G_ = F.G, c_ = (int)blockIdx.x; asm volatile("" : "+s"(G_), "+s"(c_));
          pg8::Gemm g{(const char*)(ws + WS_X8), (const char*)(ws + WS_WG8 + (size_t)lyr * 2048 * DM), DM, DM, DM / 2, nullptr}; pg8::PlainOrder S; S.init(MTOK, 2048, G_, c_, DM, DM, 0, 0);
          pg8::EpiGates8 E{ws, WS_GF, WS_GA, (const float*)(ws + WS_SS) + (size_t)(2 * lyr) * SS_STRIDE}; pg8::gemm_phase<pg8::EpiGates8, pg8::PlainOrder, false, 0, 0, true>(F.lds, g, S, E); }
        GRID_BAR();
        { PH_BEGIN; int lyr = layer; asm volatile("" : "+s"(lyr)); pg8::EpiMix E{(const bf16*)(ws + WS_GF), (const bf16*)(ws + WS_GA), (bf16*)(ws + WS_MIX)};
          run_gemm<pg8::EpiMix, 0, 1>(F, ws + WS_OATT, MTOK * 16, (const bf16*)(ws + WS_WM) + (size_t)lyr * DM * KMIX, KMIX * 2, MTOK, DM, KMIX, E); }
        GRID_BAR();
        if (layer == 0) { PH_BEGIN; pg8::EpiResid<true> E{xsA, xsB, XP, (float*)(ws + WS_SS) + SS_STRIDE, nullptr};
          run_gemm(F, ws + WS_MIX, DM * 2, ws + WS_WOUT, DM * 2, MTOK, DM, DM, E); }
        else { PH_BEGIN; pg8::EpiResid<false> E{xsA, xsB, XP, nullptr, nullptr};
          run_gemm(F, ws + WS_MIX, DM * 2, (const bf16*)(ws + WS_WOUT) + (size_t)DM * DM, DM * 2, MTOK, DM, DM, E); }
        GRID_BAR();
        if (layer == 0) {
            { PH_BEGIN; int lyr = layer; asm volatile("" : "+s"(lyr)); pg8::EpiSwiglu E{(bf16*)(ws + WS_TT), FF, (const float*)(ws + WS_SS) + SS_STRIDE}; run_gemm(F, xsB, XP * 2, ws + WS_W13, DM * 2, MTOK, 2 * FF, DM, E); }
            GRID_BAR();
            { PH_BEGIN; int lyr = layer; asm volatile("" : "+s"(lyr)); pg8::EpiResid<true> E{xsB, xsA, XP, (float*)(ws + WS_SS) + 2 * SS_STRIDE, ws + WS_X8}; run_gemm(F, ws + WS_TT, FF * 2, ws + WS_W2, FF * 2, MTOK, DM, FF, E); }
            GRID_BAR();
        } else {
            { PH_BEGIN; int lyr = layer; asm volatile("" : "+s"(lyr)); p0_moe_weights(F, a, 2 * CONV_PHASE_ITEMS, MOE_NITEMS, F.vcu * NWAVES + F.wave, F.G * NWAVES); __syncthreads();
              norm_router_phase(F, xsB, a.in[6] + DM, ws + WS_H2B, a.in[10], a.in[11], (int*)(ws + WS_SEL), (float*)(ws + WS_WTS), (int*)(ws + WS_CNT)); }
            GRID_BAR();
            { PH_BEGIN; int lyr = layer; asm volatile("" : "+s"(lyr)); route2_phase(F, (const int*)(ws + WS_SEL), (const float*)(ws + WS_WTS), (const int*)(ws + WS_CNT), (int*)(ws + WS_ROWTOK), (float*)(ws + WS_ROWW), (int*)(ws + WS_PLAN)); }
            GRID_BAR();
            { PH_BEGIN; int G_ = F.G, c_ = (int)blockIdx.x; asm volatile("" : "+s"(G_), "+s"(c_));
              const int* plan = (const int*)(ws + WS_PLAN); const int nT0 = __builtin_amdgcn_readfirstlane(plan[0]), nT1 = __builtin_amdgcn_readfirstlane(plan[1]);
              pg8::Gemm g{(const char*)(ws + WS_H2B), (const char*)(ws + WS_M13), DM, DM, DM / 2, (const int*)(ws + WS_ROWTOK)};
              MoeOrder S{nT0, nT0 + nT1, 2 * FF / 256, (nT0 + nT1) * (2 * FF / 256), G_, c_, DM, DM, plan + 16, (size_t)2 * FF * DM, true};
              pg8::EpiSwigluF8 E{ws + WS_TTB, FF, 1.0f / W13_SCALE}; pg8::gemm_phase<pg8::EpiSwigluF8, MoeOrder, true, 0, 0, true>(F.lds, g, S, E); }
            GRID_BAR();
            { PH_BEGIN; int G_ = F.G, c_ = (int)blockIdx.x; asm volatile("" : "+s"(G_), "+s"(c_));
              const int* plan = (const int*)(ws + WS_PLAN); const int nT0 = __builtin_amdgcn_readfirstlane(plan[0]), nT1 = __builtin_amdgcn_readfirstlane(plan[1]);
              pg8::Gemm g{(const char*)(ws + WS_TTB), (const char*)(ws + WS_M2), FF, FF, FF / 2, nullptr};
              MoeOrder S{nT0, nT0 + nT1, DM / 256, (nT0 + nT1) * (DM / 256), G_, c_, FF, FF, plan + 16, (size_t)DM * FF, false};
              pg8::EpiScatterY E{(bf16*)(ws + WS_Y), (const int*)(ws + WS_ROWTOK), (const float*)(ws + WS_ROWW), 1.0f / W2_SCALE, MOE_ROWS, (size_t)MTOK * DM};
              pg8::gemm_phase<pg8::EpiScatterY, MoeOrder, false, 0, 0, true>(F.lds, g, S, E); }
            GRID_BAR();
        }
    }
    { PH_BEGIN; final_norm_phase(F, xout, xsB, a.in[15], (const bf16*)(ws + WS_Y)); }
#undef GRID_BAR
}

extern "C" void kernel_launch(void* const* d_in, const int* in_sizes, int n_in, void* d_out, int out_size, void* d_ws, size_t ws_size, hipStream_t stream) {
    static int grid = 0;
    if (grid == 0) {
        if (n_in != 16 || out_size != MTOK * DM || ws_size < WS_END) { fprintf(stderr, "kernel_launch: unexpected problem (n_in %d, out %d, ws %zu); nothing launched\n", n_in, out_size, ws_size); grid = -1; return; }
        int dev = 0, cus = 0;
        if (hipGetDevice(&dev) != hipSuccess || hipDeviceGetAttribute(&cus, hipDeviceAttributeMultiprocessorCount, dev) != hipSuccess) { grid = -1; return; }
        if (hipFuncSetAttribute((const void*)fwd_kernel, hipFuncAttributeMaxDynamicSharedMemorySize, LDS_BYTES) != hipSuccess) { fprintf(stderr, "kernel_launch: hipFuncSetAttribute failed\n"); grid = -1; return; }
        int per_cu = 0;
        if (hipOccupancyMaxActiveBlocksPerMultiprocessor(&per_cu, (const void*)fwd_kernel, NWAVES * 64, LDS_BYTES) != hipSuccess || per_cu < 1) fprintf(stderr, "kernel_launch: occupancy query reports %d\n", per_cu);
        (void)hipGetLastError();
        if (cus != 256) { fprintf(stderr, "kernel_launch: %d CUs; the router / attention unit maps assume a grid of 256\n", cus); grid = -1; return; }
        grid = cus;
    }
    if (grid < 0) return;
    (void)hipMemsetAsync((char*)d_ws + WS_CTL, 0, CTL_ZERO_BYTES, stream);
    Args a{};
    for (int i = 0; i < 16; ++i) a.in[i] = (const float*)d_in[i];
    a.out = (float*)d_out; a.ws = (unsigned char*)d_ws; a.G = grid; a.pad = 0;
    hipLaunchKernelGGL(fwd_kernel, dim3(grid), dim3(NWAVES * 64), LDS_BYTES, stream, a);
}
```

```cpp
#include <hip/hip_runtime.h>
#include <cstdio>
#include <cstdint>

namespace pg8 {
#define PG8_LAS __attribute__((address_space(3)))
typedef unsigned short bf16_t;
typedef short bf16x8 __attribute__((ext_vector_type(8)));
typedef float f32x4 __attribute__((ext_vector_type(4)));
typedef unsigned u32x4 __attribute__((ext_vector_type(4)));
typedef unsigned u32x2 __attribute__((ext_vector_type(2)));
typedef int v4i_t __attribute__((ext_vector_type(4)));
typedef int v8i_t __attribute__((ext_vector_type(8)));
constexpr int BM = 256, BK = 64, HALF = 128, HTB = HALF * BK * 2  , STAGE_BYTES = 8 * HTB, NXCD = 8, WGM = 4;

__host__ __device__ __forceinline__ int lds_byte(int r, int c) { const int st = (r >> 4) * 2 + (c >> 5), rr = r & 15, cc = c & 31, ob = rr * 64 + cc * 2; return st * 1024 + (ob ^ (((ob >> 9) & 1) << 5)); }
__host__ __device__ __forceinline__ void stage_rc(int b, int& R, int& C) { const int st = b / 1024, sb = b % 1024, swz = sb ^ (((sb >> 9) & 1) << 5); R = (st >> 1) * 16 + swz / 64; C = (st & 1) * 32 + (swz % 64) / 2; }
__host__ __device__ __forceinline__ int perm32(int rho) { const int n = rho >> 4, i = rho & 15; return 8 * (i >> 2) + 4 * n + (i & 3); }

struct Unit { int pm, pn, z; size_t aoff, boff; };
struct Gemm { const char* A; const char* B; unsigned lda, ldb; int K; const int* rows; };

struct PlainOrder {
    int nM, nN, nwg, G, c; unsigned lda, ldb; int bmap, alay, pmoff = 0;
    __device__ void init(int M, int N, int G_, int c_, unsigned lda_, unsigned ldb_, int bmap_ = 0, int alay_ = 0) { nM = M / BM; nN = N / BM; nwg = nM * nN; G = G_; c = c_; lda = lda_; ldb = ldb_; bmap = bmap_; alay = alay_; }
    __device__ bool next(int i, Unit& u) const {
        const long L = (long)i * G + c; if (L >= nwg) return false;
        int wgid = (int)L; { const int q = nwg / NXCD, r = nwg % NXCD, xcd = wgid % NXCD, off = wgid / NXCD; wgid = (xcd < r ? xcd * (q + 1) : r * (q + 1) + (xcd - r) * q) + off; }
        const int nig = WGM * nN, gid = wgid / nig, fm = gid * WGM, gsz = (nM - fm) < WGM ? (nM - fm) : WGM;
        u.pm = fm + ((wgid % nig) % gsz); u.pn = (wgid % nig) / gsz; u.z = 0;
        u.aoff = alay ? (size_t)u.pm * BM * 16 : (size_t)u.pm * BM * lda; u.pm += pmoff;
        if (bmap == 0) u.boff = (size_t)u.pn * BM * ldb;
        else { const int kind = bmap == 1 ? 1 : (u.pm < 2 ? 1 : (u.pm == 2 ? 0 : u.pm - 1)), bb = u.pn >> 4, t = u.pn & 15; u.z = kind;
            const int base = kind == 0 ? 256 * t : (kind == 1 ? 4 * t : (kind == 2 ? 1024 * (t & 3) + (t >> 2) : t));
            u.boff = (size_t)(bb * 4096 + base) * ldb; }
        return true;
    }
};

typedef float f32x2v_t __attribute__((ext_vector_type(2))); typedef __bf16 bf16x2v_t __attribute__((ext_vector_type(2)));
__device__ __forceinline__ unsigned cvt_pk_bf16(float lo, float hi) { const f32x2v_t v = {lo, hi}; return __builtin_bit_cast(unsigned, __builtin_convertvector(v, bf16x2v_t)); }
__device__ __forceinline__ float bf_lo(unsigned w) { return __uint_as_float(w << 16); }
__device__ __forceinline__ float bf_hi(unsigned w) { return __uint_as_float(w & 0xffff0000u); }
__device__ __forceinline__ f32x4 bf4_lo(const u32x4& w) { return (f32x4){bf_lo(w.x), bf_hi(w.x), bf_lo(w.y), bf_hi(w.y)}; }
__device__ __forceinline__ f32x4 bf4_hi(const u32x4& w) { return (f32x4){bf_lo(w.z), bf_hi(w.z), bf_lo(w.w), bf_hi(w.w)}; }
__device__ __forceinline__ float fast_sigmoid(float x) { return __builtin_amdgcn_rcpf(1.0f + __builtin_amdgcn_exp2f(-1.4426950408889634f * x)); }
__device__ __forceinline__ u32x4 pack8(const f32x4& v0, const f32x4& v1) { u32x4 w; w.x = cvt_pk_bf16(v0[0], v0[1]); w.y = cvt_pk_bf16(v0[2], v0[3]); w.z = cvt_pk_bf16(v1[0], v1[1]); w.w = cvt_pk_bf16(v1[2], v1[3]); return w; }

__device__ __forceinline__ float rstd_of(const float* ss, int row) { const f32x4 p = *(const f32x4*)(ss + (size_t)row * 4); return __builtin_amdgcn_rsqf(((p[0] + p[1]) + (p[2] + p[3])) * (1.0f / 1024.0f) + 1e-6f); }
__device__ __forceinline__ unsigned pk_fp8(float a, float b, unsigned old, bool hi) { a = __builtin_fminf(__builtin_fmaxf(a, -448.f), 448.f); b = __builtin_fminf(__builtin_fmaxf(b, -448.f), 448.f);
    return hi ? (unsigned)__builtin_amdgcn_cvt_pk_fp8_f32(a, b, (int)old, true) : (unsigned)__builtin_amdgcn_cvt_pk_fp8_f32(a, b, (int)old, false); }

struct EpiBf16 {
    static constexpr bool PERM = true;
    bf16_t* O; int ldc; bf16_t* O2; int split; const float* ss; float ascale;
    __device__ __forceinline__ void operator()(const f32x4 (&acc)[2][2][4][2], const Unit& u, int wr, int wc, int fr, int fq) const {
        bf16_t* const O = u.pm >= split ? O2 : this->O;
        const int row0 = (u.pm >= split ? u.pm - split : u.pm) * BM + wr * 64 + fr, col0 = u.pn * BM + wc * 32 + 8 * fq;
        f32x4 cs[2][2]; const int kind = u.z, bb = u.pn >> 4;
#pragma unroll
        for (int bj = 0; bj < 2; ++bj)
#pragma unroll
            for (int e = 0; e < 8; ++e) { const int v = (col0 & 4095) + bj * HALF + e;
                const int pos = kind == 0 ? v : (kind == 1 ? 64 * (v & 63) + (v >> 6) : (kind == 2 ? 4 * (v & 1023) + (v >> 10) : 16 * (v & 255) + (v >> 8)));
                cs[bj][e >> 2][e & 3] = rstd_of(ss, bb * 4096 + pos) * ascale; }
#pragma unroll
        for (int ai = 0; ai < 2; ++ai)
#pragma unroll
            for (int m = 0; m < 4; ++m) { const size_t eo = (size_t)(row0 + ai * HALF + m * 16) * ldc + col0;
#pragma unroll
                for (int bj = 0; bj < 2; ++bj) { const f32x4 v0 = acc[ai][bj][m][0] * cs[bj][0], v1 = acc[ai][bj][m][1] * cs[bj][1];
                    if (u.pm >= split) { u32x2 w8; w8.x = pk_fp8(v0[0], v0[1], 0u, false); w8.x = pk_fp8(v0[2], v0[3], w8.x, true); w8.y = pk_fp8(v1[0], v1[1], 0u, false); w8.y = pk_fp8(v1[2], v1[3], w8.y, true);
                        *(u32x2*)((unsigned char*)O + eo + bj * HALF) = w8; }
                    else *(u32x4*)(O + eo + bj * HALF) = pack8(v0, v1); } }
    }
};
struct EpiInproj {
    static constexpr bool PERM = true;
    unsigned char* ws; size_t oV, oQ, oK, oGF, oGA, oRope; float qscale; const float* ss; float ascale;
    __device__ __forceinline__ void operator()(const f32x4 (&acc)[2][2][4][2], const Unit& u, int wr, int wc, int fr, int fq) const {
        const int row0 = u.pm * BM + wr * 64 + fr, pn = u.pn;
        {
            const bool isq = pn < 3; bf16_t* base = (bf16_t*)(ws + (isq ? oQ : oK)); const float* rope = (const float*)(ws + oRope); const int colt = (isq ? pn : pn - 3) * 256; const float sc = isq ? qscale : 1.0f;
            const int col0 = colt + wc * 32 + 8 * fq, i0 = 16 * (wc & 1) + 4 * fq;
#pragma unroll
            for (int ai = 0; ai < 2; ++ai)
#pragma unroll
                for (int m = 0; m < 4; ++m) { const int row = row0 + ai * HALF + m * 16, pos = row & 4095;
                    const f32x4 cs0 = *(const f32x4*)(rope + (size_t)(pos * 32 + i0) * 2), cs1 = *(const f32x4*)(rope + (size_t)(pos * 32 + i0) * 2 + 4);
                    bf16_t* rowp = base + (size_t)row * 768 + col0; const float rs = rstd_of(ss, row) * ascale;
#pragma unroll
                    for (int bj = 0; bj < 2; ++bj) { const f32x4 v0 = acc[ai][bj][m][0] * rs, v1 = acc[ai][bj][m][1] * rs; f32x4 o0, o1;
                        o0[0] = (v0[0] * cs0[0] - v0[1] * cs0[1]) * sc; o0[1] = (v0[1] * cs0[0] + v0[0] * cs0[1]) * sc;
                        o0[2] = (v0[2] * cs0[2] - v0[3] * cs0[3]) * sc; o0[3] = (v0[3] * cs0[2] + v0[2] * cs0[3]) * sc;
                        o1[0] = (v1[0] * cs1[0] - v1[1] * cs1[1]) * sc; o1[1] = (v1[1] * cs1[0] + v1[0] * cs1[1]) * sc;
                        o1[2] = (v1[2] * cs1[2] - v1[3] * cs1[3]) * sc; o1[3] = (v1[3] * cs1[2] + v1[2] * cs1[3]) * sc;
                        { u32x2 w8; w8.x = pk_fp8(o0[0], o0[1], 0u, false); w8.x = pk_fp8(o0[2], o0[3], w8.x, true); w8.y = pk_fp8(o1[0], o1[1], 0u, false); w8.y = pk_fp8(o1[2], o1[3], w8.y, true);
                               *(u32x2*)((unsigned char*)base + (size_t)row * 768 + col0 + bj * HALF) = w8; } }
                    if (m == 3) asm volatile("" ::: "memory"); }
        }
    }
};
constexpr float WG8_SCALE = 32.0f;
struct EpiGates8 {
    static constexpr bool PERM = true;
    unsigned char* ws; size_t oGF, oGA; const float* ss;
    __device__ __forceinline__ void operator()(const f32x4 (&acc)[2][2][4][2], const Unit& u, int wr, int wc, int fr, int fq) const {
        const int row0 = u.pm * BM + wr * 64 + fr;
        {
            bf16_t* const gfp = (bf16_t*)(ws + oGF); bf16_t* const grp = (bf16_t*)(ws + oGA); const int col0 = u.pn * 128 + wc * 32 + 8 * fq;
#pragma unroll
            for (int ai = 0; ai < 2; ++ai)
#pragma unroll
                for (int m = 0; m < 4; ++m) { const size_t off = (size_t)(row0 + ai * HALF + m * 16) * 1024 + col0; const float rs = (-1.4426950408889634f / WG8_SCALE) * rstd_of(ss, row0 + ai * HALF + m * 16);
                    f32x4 g[2], r[2];
#pragma unroll
                    for (int n = 0; n < 2; ++n) { const f32x4 xf = acc[ai][0][m][n] * rs, xa = acc[ai][1][m][n] * rs; f32x4 ef, ea, ia;
#pragma unroll
                        for (int j = 0; j < 4; ++j) { ef[j] = __builtin_fminf(__builtin_amdgcn_exp2f(xf[j]), 1.0e18f); ea[j] = __builtin_amdgcn_exp2f(xa[j]); }
                        ef = ef + 1.0f; ea = ea + 1.0f;
#pragma unroll
                        for (int j = 0; j < 4; ++j) { g[n][j] = __builtin_amdgcn_rcpf(ef[j]); ia[j] = __builtin_amdgcn_rcpf(ea[j]); }
                        r[n] = ef * ia; }
                    *(u32x4*)(gfp + off) = pack8(g[0], g[1]); *(u32x4*)(grp + off) = pack8(r[0], r[1]); }
        }
    }
};
struct EpiMix {
    static constexpr bool PERM = true; static constexpr int RESCALE_T = 4;
    const bf16_t* G; const bf16_t* R; bf16_t* O;
    __device__ __forceinline__ void rescale(f32x4 (&acc)[2][2][4][2], const Unit& u, int wr, int wc, int fr, int fq) const {
        asm volatile("" : "+v"(fr), "+v"(fq));
        const int row0 = u.pm * BM + wr * 64 + fr, col0 = u.pn * BM + wc * 32 + 8 * fq;
#pragma unroll
        for (int ai = 0; ai < 2; ++ai)
#pragma unroll
            for (int m = 0; m < 4; ++m) { const unsigned off = (unsigned)(row0 + ai * HALF + m * 16) * 1024u + (unsigned)col0;
#pragma unroll
                for (int bj = 0; bj < 2; ++bj) { const u32x4 g = *(const u32x4*)(R + off + bj * HALF);
                    acc[ai][bj][m][0] = acc[ai][bj][m][0] * bf4_lo(g); acc[ai][bj][m][1] = acc[ai][bj][m][1] * bf4_hi(g); }
                if (m == 3) asm volatile("" ::: "memory"); }
    }
    __device__ __forceinline__ void operator()(const f32x4 (&acc)[2][2][4][2], const Unit& u, int wr, int wc, int fr, int fq) const {
        const int row0 = u.pm * BM + wr * 64 + fr, col0 = u.pn * BM + wc * 32 + 8 * fq;
#pragma unroll
        for (int ai = 0; ai < 2; ++ai) { u32x4 gq[4][2];
#pragma unroll
            for (int m = 0; m < 4; ++m)
#pragma unroll
                for (int bj = 0; bj < 2; ++bj) gq[m][bj] = *(const u32x4*)(G + (unsigned)(row0 + ai * HALF + m * 16) * 1024u + (unsigned)col0 + bj * HALF);
#pragma unroll
            for (int m = 0; m < 4; ++m) { const unsigned off = (unsigned)(row0 + ai * HALF + m * 16) * 1024u + (unsigned)col0;
#pragma unroll
                for (int bj = 0; bj < 2; ++bj) { const u32x4 g = gq[m][bj]; const f32x4 v0 = acc[ai][bj][m][0] * bf4_lo(g), v1 = acc[ai][bj][m][1] * bf4_hi(g);
                    *(u32x4*)(O + off + bj * HALF) = pack8(v0, v1); } }
            asm volatile("" ::: "memory"); }
    }
};
template <class E, class = void> struct rescale_at { static constexpr int t = -1; };
template <class E> struct rescale_at<E, decltype((void)E::RESCALE_T)> { static constexpr int t = E::RESCALE_T; };
template <bool SS> struct EpiResid {
    static constexpr bool PERM = true;
    const bf16_t* res; bf16_t* out; int ld; float* ssout; unsigned char* x8;
    __device__ __forceinline__ void operator()(const f32x4 (&acc)[2][2][4][2], const Unit& u, int wr, int wc, int fr, int fq) const {
        const int row0 = u.pm * BM + wr * 64 + fr, col0 = u.pn * BM + wc * 32 + 8 * fq, lane = fq * 16 + fr;
        PG8_LAS float* const part = (PG8_LAS float*)(unsigned)131072;
#pragma unroll
        for (int ai = 0; ai < 2; ++ai) { u32x4 rq[4][2];
#pragma unroll
            for (int m = 0; m < 4; ++m)
#pragma unroll
                for (int bj = 0; bj < 2; ++bj) rq[m][bj] = *(const u32x4*)(res + (size_t)(row0 + ai * HALF + m * 16) * ld + col0 + bj * HALF);
#pragma unroll
            for (int m = 0; m < 4; ++m) { const int row = row0 + ai * HALF + m * 16; const size_t off = (size_t)row * ld + col0; float sq = 0.f;
#pragma unroll
                for (int bj = 0; bj < 2; ++bj) { const u32x4 r = rq[m][bj]; const f32x4 v0 = acc[ai][bj][m][0] + bf4_lo(r), v1 = acc[ai][bj][m][1] + bf4_hi(r);
                    if (SS) { const f32x4 q = v0 * v0 + v1 * v1; sq += (q[0] + q[1]) + (q[2] + q[3]); }
                    *(u32x4*)(out + off + bj * HALF) = pack8(v0, v1);
                    if (x8) { u32x2 w8; w8.x = pk_fp8(v0[0], v0[1], 0u, false); w8.x = pk_fp8(v0[2], v0[3], w8.x, true); w8.y = pk_fp8(v1[0], v1[1], 0u, false); w8.y = pk_fp8(v1[2], v1[3], w8.y, true);
                        *(u32x2*)(x8 + (size_t)row * 1024 + col0 + bj * HALF) = w8; } }
                if (SS) { sq += __int_as_float(__builtin_amdgcn_ds_bpermute((lane ^ 16) << 2, __float_as_int(sq))); sq += __int_as_float(__builtin_amdgcn_ds_bpermute((lane ^ 32) << 2, __float_as_int(sq)));
                    if (fq == 0) part[wc * 256 + wr * 64 + fr + ai * HALF + m * 16] = sq; } }
            asm volatile("" ::: "memory"); }
        if (SS) {
            asm volatile("s_waitcnt lgkmcnt(0)" ::: "memory"); __builtin_amdgcn_s_barrier(); asm volatile("" ::: "memory");
            const int t = (wr * 4 + wc) * 64 + lane;
            if (t < 256) ssout[(size_t)(u.pm * BM + t) * 4 + u.pn] = (part[t] + part[256 + t]) + (part[512 + t] + part[768 + t]);
            asm volatile("s_waitcnt lgkmcnt(0)" ::: "memory"); __builtin_amdgcn_s_barrier(); asm volatile("" ::: "memory");
        }
    }
};
struct EpiSwiglu {
    static constexpr bool PERM = true;
    bf16_t* T; int ldc; const float* ss;
    __device__ __forceinline__ void operator()(const f32x4 (&acc)[2][2][4][2], const Unit& u, int wr, int wc, int fr, int fq) const {
        const int row0 = u.pm * BM + wr * 64 + fr, col0 = u.pn * 128 + wc * 32 + 8 * fq;
#pragma unroll
        for (int ai = 0; ai < 2; ++ai)
#pragma unroll
            for (int m = 0; m < 4; ++m) { const int r = row0 + ai * HALF + m * 16; const float rs = rstd_of(ss, r), rs2 = rs * rs, rse = -1.4426950408889634f * rs; f32x4 o[2];
#pragma unroll
                for (int n = 0; n < 2; ++n) { const f32x4 x = acc[ai][0][m][n] * rse; f32x4 e, q;
#pragma unroll
                    for (int j = 0; j < 4; ++j) e[j] = __builtin_amdgcn_exp2f(x[j]);
                    e = e + 1.0f;
#pragma unroll
                    for (int j = 0; j < 4; ++j) q[j] = __builtin_amdgcn_rcpf(e[j]);
                    o[n] = (acc[ai][0][m][n] * acc[ai][1][m][n]) * (q * rs2); }
                *(u32x4*)(T + (size_t)r * ldc + col0) = pack8(o[0], o[1]); }
    }
};
struct EpiSwigluF8 {
    static constexpr bool PERM = true;
    unsigned char* T; int ldc; float ascale;
    __device__ __forceinline__ void operator()(const f32x4 (&acc)[2][2][4][2], const Unit& u, int wr, int wc, int fr, int fq) const {
        const int row0 = u.pm * BM + wr * 64 + fr, col0 = u.pn * 128 + wc * 32 + 8 * fq;
#pragma unroll
        for (int ai = 0; ai < 2; ++ai)
#pragma unroll
            for (int m = 0; m < 4; ++m) { unsigned char* rowp = T + (size_t)(row0 + ai * HALF + m * 16) * ldc + col0; f32x4 o4[2];
#pragma unroll
                for (int n = 0; n < 2; ++n) { const f32x4 x = acc[ai][0][m][n] * (-1.4426950408889634f * ascale); f32x4 e;
#pragma unroll
                    for (int j = 0; j < 4; ++j) e[j] = __builtin_amdgcn_exp2f(x[j]);
                    e = e + 1.0f; f32x4 r;
#pragma unroll
                    for (int j = 0; j < 4; ++j) r[j] = __builtin_amdgcn_rcpf(e[j]);
                    o4[n] = (acc[ai][0][m][n] * acc[ai][1][m][n]) * (r * (ascale * ascale)); }
                const float* o = (const float*)o4;
                u32x2 w; w.x = pk_fp8(o4[0][0], o4[0][1], 0u, false); w.x = pk_fp8(o4[0][2], o4[0][3], w.x, true); w.y = pk_fp8(o4[1][0], o4[1][1], 0u, false); w.y = pk_fp8(o4[1][2], o4[1][3], w.y, true); (void)o;
                *(u32x2*)rowp = w; }
    }
};
struct EpiScatterY {
    static constexpr bool PERM = true;
    bf16_t* y; const int* rows; const float* w; float ascale; int slot_rows; size_t slot_stride;
    __device__ __forceinline__ void operator()(const f32x4 (&acc)[2][2][4][2], const Unit& u, int wr, int wc, int fr, int fq) const {
        const int row0 = u.pm * BM + wr * 64 + fr, col0 = u.pn * BM + wc * 32 + 8 * fq; bf16_t* const yb = y + (row0 >= slot_rows ? slot_stride : (size_t)0);
#pragma unroll
        for (int ai = 0; ai < 2; ++ai)
#pragma unroll
            for (int m = 0; m < 4; ++m) { const int r = row0 + ai * HALF + m * 16, tok = rows[r]; const float rs = w[r] * ascale;
                if (tok >= 0) { bf16_t* yp = yb + (size_t)tok * 1024 + col0;
#pragma unroll
                    for (int bj = 0; bj < 2; ++bj) *(u32x4*)(yp + bj * HALF) = pack8(acc[ai][bj][m][0] * rs, acc[ai][bj][m][1] * rs); } }
    }
};
template <class Epi, class Sched, bool GATHER = false, int BMAP = 0, int ALAY = 0, bool FP8 = false, bool ALIGN_EPI = true, bool SP2 = true>
__device__ __forceinline__ void gemm_phase(PG8_LAS unsigned char* lds, const Gemm g, const Sched& S, const Epi& E) {
    int tid_ = threadIdx.x; asm volatile("" : "+v"(tid_));
    const int tid = tid_, wid = __builtin_amdgcn_readfirstlane(tid >> 6), lane = tid & 63, wr = wid >> 2, wc = wid & 3, fr = lane & 15, fq = lane >> 4;
    const int K = g.K, nt = K / BK;
    unsigned voffA[2], voffA1[2], nvA0[2], nvA1[2], voffB[2], nvB[2]; int Rg[2], Cg[2], RbS[2];
#pragma unroll
    for (int i = 0; i < 2; ++i) { int R, C; stage_rc(tid * 16 + i * 8192, R, C); const int Rb = Epi::PERM ? ((R & ~31) + perm32(R & 31)) : R; Rg[i] = R; Cg[i] = C * 2;
        voffA[i] = ALAY == 1 ? (unsigned)(C >> 3) * g.lda + (unsigned)R * 16u : (unsigned)R * g.lda + (unsigned)C * 2u; voffA1[i] = voffA[i]; nvA0[i] = voffA[i]; nvA1[i] = voffA[i];
        voffB[i] = (BMAP == 1 ? (unsigned)(64 * (Rb & 63) + (Rb >> 6)) : (unsigned)Rb) * g.ldb + (unsigned)C * 2u; RbS[i] = Rb; }
#define PG8_BKIND(kind_, dv, dh) do { const int _k = (kind_); _Pragma("unroll") for (int _i = 0; _i < 2; ++_i) { const int _r = RbS[_i]; \
        dv[_i] = (unsigned)(_k == 0 ? _r : (_k == 1 ? 64 * (_r & 63) + (_r >> 6) : (_k == 2 ? 4 * _r : 16 * _r))) * g.ldb + (unsigned)Cg[_i]; } \
        dh = (size_t)(_k == 0 ? 128 : (_k == 1 ? 2 : (_k == 2 ? 512 : 2048))) * g.ldb; } while (0)
#define PG8_GROWS(pm_, d0, d1) do { _Pragma("unroll") for (int _i = 0; _i < 2; ++_i) { int _t0 = g.rows[(pm_) * BM + Rg[_i]], _t1 = g.rows[(pm_) * BM + HALF + Rg[_i]]; _t0 = _t0 < 0 ? 0 : _t0; _t1 = _t1 < 0 ? 0 : _t1; \
        d0[_i] = (unsigned)_t0 * g.lda + (unsigned)Cg[_i]; d1[_i] = (unsigned)_t1 * g.lda + (unsigned)Cg[_i]; } } while (0)
    const size_t kstepB = (size_t)(BK * 2), kstepA = ALAY == 1 ? (size_t)8 * g.lda : kstepB;
    const size_t hstepA = GATHER ? (size_t)0 : (ALAY == 1 ? (size_t)HALF * 16 : (size_t)HALF * g.lda); size_t hstepB = (BMAP == 1 ? (size_t)2 : (size_t)HALF) * g.ldb, nhB = hstepB;
    const unsigned ldsw = (unsigned)wid * 1024u;
    const int aoff = lds_byte(wr * 64 + fr, fq * 8), boff = lds_byte(wc * 32 + fr, fq * 8);
#define PG8_SA(b, h) (((b) * 2 + (h)) * HTB)
#define PG8_SB(b, h) ((4 + (b) * 2 + (h)) * HTB)
#define PG8_STAGE(bufoff, gbase, voff) do { _Pragma("unroll") for (int _i = 0; _i < 2; ++_i) \
        __builtin_amdgcn_global_load_lds((const unsigned*)((const char*)(gbase) + (voff)[_i]), (PG8_LAS unsigned*)(lds + (bufoff) + ldsw + _i * 8192), 16, 0, 0); } while (0)
#define PG8_LDA(dst, b, h) do { if constexpr (FP8) { _Pragma("unroll") for (int m = 0; m < 4; ++m) dst##8[m] = PG8_CAT8(*(const PG8_LAS bf16x8*)(lds + PG8_SA(b, h) + aoff + m * 2048), *(const PG8_LAS bf16x8*)(lds + PG8_SA(b, h) + aoff + m * 2048 + 1024)); } \
    else { _Pragma("unroll") for (int m = 0; m < 4; ++m) _Pragma("unroll") for (int k = 0; k < 2; ++k) dst[m][k] = *(const PG8_LAS bf16x8*)(lds + PG8_SA(b, h) + aoff + m * 2048 + k * 1024); } } while (0)
#define PG8_LDB(dst, b, h) do { if constexpr (FP8) { _Pragma("unroll") for (int n = 0; n < 2; ++n) dst##8[n] = PG8_CAT8(*(const PG8_LAS bf16x8*)(lds + PG8_SB(b, h) + boff + n * 2048), *(const PG8_LAS bf16x8*)(lds + PG8_SB(b, h) + boff + n * 2048 + 1024)); } \
    else { _Pragma("unroll") for (int n = 0; n < 2; ++n) _Pragma("unroll") for (int k = 0; k < 2; ++k) dst[n][k] = *(const PG8_LAS bf16x8*)(lds + PG8_SB(b, h) + boff + n * 2048 + k * 1024); } } while (0)
#define PG8_CAT8(lo, hi) __builtin_shufflevector(__builtin_bit_cast(v4i_t, lo), __builtin_bit_cast(v4i_t, hi), 0, 1, 2, 3, 4, 5, 6, 7)
#define PG8_MMA(ai, bj, At, Bt) do { __builtin_amdgcn_s_setprio(1); if constexpr (FP8) { _Pragma("unroll") for (int m = 0; m < 4; ++m) _Pragma("unroll") for (int n = 0; n < 2; ++n) \
        asm volatile("v_mfma_f32_16x16x128_f8f6f4 %0, %1, %2, %0" : "+v"(acc[ai][bj][m][n]) : "v"(Bt##8[n]), "v"(At##8[m])); } else { \
        _Pragma("unroll") for (int m = 0; m < 4; ++m) _Pragma("unroll") for (int n = 0; n < 2; ++n) _Pragma("unroll") for (int k = 0; k < 2; ++k) \
        acc[ai][bj][m][n] = __builtin_amdgcn_mfma_f32_16x16x32_bf16(Bt[n][k], At[m][k], acc[ai][bj][m][n], 0, 0, 0); } __builtin_amdgcn_s_setprio(0); } while (0)
#define PG8_WAIT_V(n) asm volatile("s_waitcnt vmcnt(" #n ")" ::: "memory")
#define PG8_WAIT_L(n) asm volatile("s_waitcnt lgkmcnt(" #n ")" ::: "memory")
#define PG8_BAR __builtin_amdgcn_s_barrier()
#define PG8_SCHED __builtin_amdgcn_sched_barrier(0)
    Unit cur, nxt; int ui = 0;
    if (!S.next(0, cur)) return;
    f32x4 acc[2][2][4][2];
#pragma unroll
    for (int a = 0; a < 2; ++a)
#pragma unroll
        for (int b = 0; b < 2; ++b)
#pragma unroll
            for (int m = 0; m < 4; ++m)
#pragma unroll
                for (int n = 0; n < 2; ++n) acc[a][b][m][n] = (f32x4){0.f, 0.f, 0.f, 0.f};
    bf16x8 At[4][2], B0[2][2], B1[2][2]; v8i_t At8[4], B08[2], B18[2];
    const char* cA = g.A + cur.aoff; const char* cB = g.B + cur.boff;
    if constexpr (GATHER) PG8_GROWS(cur.pm, voffA, voffA1);
    if constexpr (BMAP == 2) { PG8_BKIND(cur.z, voffB, hstepB); nvB[0] = voffB[0]; nvB[1] = voffB[1]; nhB = hstepB; }
    if constexpr (SP2) {
        PG8_STAGE(PG8_SB(0, 0), cB, voffB); PG8_STAGE(PG8_SB(0, 1), cB + hstepB, voffB); PG8_STAGE(PG8_SA(0, 0), cA, voffA); PG8_STAGE(PG8_SA(0, 1), cA + hstepA, voffA1);
        if (wr == 1) PG8_BAR;
        PG8_WAIT_V(2); PG8_BAR;
        PG8_STAGE(PG8_SB(1, 0), cB + kstepB, voffB); PG8_STAGE(PG8_SA(1, 0), cA + kstepA, voffA); PG8_STAGE(PG8_SB(1, 1), cB + hstepB + kstepB, voffB);
        PG8_WAIT_V(6); PG8_BAR;
    } else {
        PG8_STAGE(PG8_SB(0, 0), cB, voffB); PG8_STAGE(PG8_SA(0, 0), cA, voffA); PG8_STAGE(PG8_SB(0, 1), cB + hstepB, voffB); PG8_STAGE(PG8_SA(0, 1), cA + hstepA, voffA);
        if (wr == 1) PG8_BAR;
        PG8_WAIT_V(4); PG8_BAR;
        PG8_STAGE(PG8_SB(1, 0), cB + kstepB, voffB); PG8_STAGE(PG8_SA(1, 0), cA + kstepA, voffA); PG8_STAGE(PG8_SB(1, 1), cB + hstepB + kstepB, voffB);
        PG8_WAIT_V(6); PG8_BAR;
    }
    for (;;) {
        const bool has_next = S.next(ui + 1, nxt);
        const char* nA = has_next ? g.A + nxt.aoff : cA; const char* nB = has_next ? g.B + nxt.boff : cB;
        if constexpr (BMAP == 2) { if (has_next) PG8_BKIND(nxt.z, nvB, nhB); else { nvB[0] = voffB[0]; nvB[1] = voffB[1]; nhB = hstepB; } }
        if constexpr (GATHER) { if (has_next) PG8_GROWS(nxt.pm, nvA0, nvA1); else {
#pragma unroll
            for (int i = 0; i < 2; ++i) { nvA0[i] = voffA[i]; nvA1[i] = voffA1[i]; } } }
#pragma unroll 1
        for (int t = 0; t < nt; t += 2) {
            if constexpr (rescale_at<Epi>::t >= 0) { if (t == rescale_at<Epi>::t) E.rescale(acc, cur, wr, wc, fr, fq); }
            const bool last = (t == nt - 2);
            const char* a1 = cA + (size_t)(t + 1) * kstepA;
            const char* a2 = last ? nA : cA + (size_t)(t + 2) * kstepA; const char* b2 = last ? nB : cB + (size_t)(t + 2) * kstepB;
            const char* a3 = a2 + kstepA; const char* b3 = b2 + kstepB;
            unsigned w0[2], w1[2];
#pragma unroll
            for (int i = 0; i < 2; ++i) { w0[i] = voffA[i]; w1[i] = voffA1[i]; }
            unsigned wB[2] = {voffB[0], voffB[1]}; size_t hB = hstepB;
            if (BMAP == 2 && last) { asm volatile("; next unit's B row map" ::: ); wB[0] = nvB[0]; wB[1] = nvB[1]; hB = nhB; }
            if (GATHER && last) { asm volatile("; next unit's gathered rows" ::: );
#pragma unroll
                for (int i = 0; i < 2; ++i) { w0[i] = nvA0[i]; w1[i] = nvA1[i]; } }
            if constexpr (SP2) {
            PG8_LDB(B0, 0, 0); PG8_LDB(B1, 0, 1); PG8_SCHED; PG8_LDA(At, 0, 0); PG8_STAGE(PG8_SA(1, 1), a1 + hstepA, voffA1);
            PG8_WAIT_V(8); PG8_WAIT_L(0); PG8_BAR; PG8_MMA(0, 0, At, B0); PG8_MMA(0, 1, At, B1); PG8_BAR; PG8_SCHED;
            PG8_LDA(At, 0, 1); PG8_STAGE(PG8_SB(0, 0), b2, wB); PG8_STAGE(PG8_SB(0, 1), b2 + hB, wB); PG8_STAGE(PG8_SA(0, 0), a2, w0);
            PG8_WAIT_V(8); PG8_WAIT_L(0); PG8_BAR; PG8_MMA(1, 0, At, B0); PG8_MMA(1, 1, At, B1); PG8_BAR; PG8_SCHED;
            PG8_LDB(B0, 1, 0); PG8_LDB(B1, 1, 1); PG8_SCHED; PG8_LDA(At, 1, 0); PG8_STAGE(PG8_SA(0, 1), a2 + hstepA, w1);
            PG8_WAIT_V(8); PG8_WAIT_L(0); PG8_BAR; PG8_MMA(0, 0, At, B0); PG8_MMA(0, 1, At, B1); PG8_BAR; PG8_SCHED;
            PG8_LDA(At, 1, 1); PG8_STAGE(PG8_SB(1, 0), b3, wB); PG8_STAGE(PG8_SB(1, 1), b3 + hB, wB); PG8_STAGE(PG8_SA(1, 0), a3, w0);
            PG8_WAIT_V(8); PG8_WAIT_L(0); PG8_BAR; PG8_MMA(1, 0, At, B0); PG8_MMA(1, 1, At, B1); PG8_BAR; PG8_SCHED;
            } else { static_assert(SP2 || (!GATHER && BMAP != 2), "GATHER / BMAP 2 need the SP2 loop");
            PG8_LDB(B0, 0, 0); PG8_SCHED; PG8_LDA(At, 0, 0); PG8_STAGE(PG8_SA(1, 1), a1 + hstepA, voffA);
            PG8_WAIT_L(8); PG8_BAR; PG8_WAIT_L(0); PG8_MMA(0, 0, At, B0); PG8_BAR; PG8_SCHED;
            PG8_LDB(B1, 0, 1); PG8_STAGE(PG8_SB(0, 0), b2, voffB);
            PG8_BAR; PG8_WAIT_L(0); PG8_MMA(0, 1, At, B1); PG8_BAR;
            PG8_LDA(At, 0, 1); PG8_STAGE(PG8_SA(0, 0), a2, voffA);
            PG8_BAR; PG8_WAIT_L(0); PG8_MMA(1, 0, At, B0); PG8_BAR; PG8_SCHED;
            PG8_STAGE(PG8_SB(0, 1), b2 + hstepB, voffB);
            PG8_WAIT_V(6); PG8_BAR; PG8_MMA(1, 1, At, B1); PG8_BAR;
            PG8_LDB(B0, 1, 0); PG8_SCHED; PG8_LDA(At, 1, 0); PG8_STAGE(PG8_SA(0, 1), a2 + hstepA, voffA);
            PG8_WAIT_L(8); PG8_BAR; PG8_WAIT_L(0); PG8_MMA(0, 0, At, B0); PG8_BAR; PG8_SCHED;
            PG8_LDB(B1, 1, 1); PG8_STAGE(PG8_SB(1, 0), b3, voffB);
            PG8_BAR; PG8_WAIT_L(0); PG8_MMA(0, 1, At, B1); PG8_BAR;
            PG8_LDA(At, 1, 1); PG8_STAGE(PG8_SA(1, 0), a3, voffA);
            PG8_BAR; PG8_WAIT_L(0); PG8_MMA(1, 0, At, B0); PG8_BAR; PG8_SCHED;
            PG8_STAGE(PG8_SB(1, 1), b3 + hstepB, voffB);
            PG8_WAIT_V(6); PG8_BAR; PG8_MMA(1, 1, At, B1); PG8_BAR;
            }
        }
        if constexpr (ALIGN_EPI) { if (wr == 0) PG8_BAR; }
        if constexpr (FP8) {
            asm volatile("s_nop 15\n\ts_nop 15\n\ts_nop 15\n\ts_nop 15\n\ts_nop 15\n\ts_nop 15\n\ts_nop 15\n\ts_nop 15" ::: "memory");
#pragma unroll
            for (int a = 0; a < 2; ++a)
#pragma unroll
                for (int b = 0; b < 2; ++b)
#pragma unroll
                    for (int m = 0; m < 4; ++m) asm volatile("" : "+v"(acc[a][b][m][0]), "+v"(acc[a][b][m][1])); }
        E(acc, cur, wr, wc, fr, fq);
        if (!has_next) break;
#pragma unroll
        for (int a = 0; a < 2; ++a)
#pragma unroll
            for (int b = 0; b < 2; ++b)
#pragma unroll
                for (int m = 0; m < 4; ++m)
#pragma unroll
                    for (int n = 0; n < 2; ++n) acc[a][b][m][n] = (f32x4){0.f, 0.f, 0.f, 0.f};
        cur = nxt; cA = nA; cB = nB; ++ui;
        if constexpr (BMAP == 2) { voffB[0] = nvB[0]; voffB[1] = nvB[1]; hstepB = nhB; }
        if constexpr (GATHER) {
#pragma unroll
            for (int i = 0; i < 2; ++i) { voffA[i] = nvA0[i]; voffA1[i] = nvA1[i]; } }
        if constexpr (ALIGN_EPI) { if (wr == 1) PG8_BAR; }
    }
    PG8_WAIT_V(0);
    if constexpr (!ALIGN_EPI) { if (wr == 0) PG8_BAR; }
    PG8_BAR;
#undef PG8_GROWS
#undef PG8_BKIND
#undef PG8_SA
#undef PG8_SB
#undef PG8_STAGE
#undef PG8_LDA
#undef PG8_LDB
#undef PG8_MMA
#undef PG8_CAT8
#undef PG8_WAIT_V
#undef PG8_WAIT_L
#undef PG8_BAR
#undef PG8_SCHED
}
}
#define GAS __attribute__((address_space(1)))
#define LAS __attribute__((address_space(3)))
typedef unsigned short bf16;
typedef unsigned v4u __attribute__((ext_vector_type(4)));
typedef float f32x4 __attribute__((ext_vector_type(4)));
typedef short bf16x8 __attribute__((ext_vector_type(8)));
typedef GAS unsigned gu32;
typedef GAS unsigned long long gu64;
#define RLX_AGENT __ATOMIC_RELAXED, __HIP_MEMORY_SCOPE_AGENT
#define LDS_WAIT() asm volatile("s_waitcnt lgkmcnt(0)" ::: "memory")
#define VM_WAIT() asm volatile("s_waitcnt vmcnt(0)" ::: "memory")
__device__ __forceinline__ unsigned long long rt() { return __builtin_amdgcn_s_memrealtime(); }
__device__ __forceinline__ unsigned f2bf(float f) { unsigned u = __builtin_bit_cast(unsigned, f); return (u + 0x7fffu + ((u >> 16) & 1u)) >> 16; }
__device__ __forceinline__ unsigned pk2(float lo, float hi) { return f2bf(lo) | (f2bf(hi) << 16); }

#define XB_TMO      128
#define XB_XCNT(j)  (256  + 64 * (j))
#define XB_XSUB(j)  (1280 + 64 * (j))
#define XB_XGEN(j)  (2304 + 64 * (j))
#define XB_TOP      3328
#define XB_TOPGEN   3392
#define XCD_BAR_WORDS 3456
#define XB_SPIN_CAP (1u << 18)

__device__ __forceinline__ unsigned xb_ld(unsigned* p)              { return __hip_atomic_load(p, __ATOMIC_RELAXED, __HIP_MEMORY_SCOPE_AGENT); }
__device__ __forceinline__ unsigned xb_add(unsigned* p, unsigned v) { return __hip_atomic_fetch_add(p, v, __ATOMIC_RELAXED, __HIP_MEMORY_SCOPE_AGENT); }
__device__ __forceinline__ unsigned xb_xcc_id() { return (unsigned)__builtin_amdgcn_s_getreg((3 << 11) | 20) & 0xFu; }
#define XB_SPIN(cond, bar) do { unsigned _sp = 0; while (cond) { __builtin_amdgcn_s_sleep(1); \
    if ((++_sp & 255u) == 0u) { if (xb_ld(&(bar)[XB_TMO])) break; if (_sp > XB_SPIN_CAP) { atomicAdd(&(bar)[XB_TMO], 1u); break; } } } } while (0)

struct XcdBarrier {
    unsigned* bar; unsigned x; unsigned G;
    volatile LAS unsigned* st;
};

__device__ __forceinline__ XcdBarrier xcd_barrier_post(unsigned* bar, volatile LAS unsigned* st) {
    XcdBarrier b; b.bar = bar; b.x = xb_xcc_id(); b.st = st; b.G = 0u;
    if (threadIdx.x == 0) (void)xb_add(&bar[XB_XCNT(b.x)], 1u);
    return b;
}
__device__ __forceinline__ void xcd_barrier_complete(unsigned* bar, unsigned x, const unsigned G, unsigned& nloc, unsigned& nx) {
    unsigned sum, cnt, mine, sp = 0u;
    for (;;) {
        sum = 0u; cnt = 0u; mine = 0u;
#pragma nounroll
        for (unsigned j = 0; j < 16; ++j) { const unsigned c = xb_ld(&bar[XB_XCNT(j)]); sum += c; cnt += (c > 0u) ? 1u : 0u; mine = (j == x) ? c : mine; }
        if (sum == G) break;
        __builtin_amdgcn_s_sleep(1);
        if ((++sp & 255u) == 0u) { if (xb_ld(&bar[XB_TMO])) break; if (sp > XB_SPIN_CAP) { atomicAdd(&bar[XB_TMO], 1u); break; } }
    }
    nloc = mine > 0u ? mine : 1u; nx = cnt > 0u ? cnt : 1u;
}

__device__ __forceinline__ void xcd_barrier(const XcdBarrier& b) {
    asm volatile("s_waitcnt vmcnt(0)" ::: "memory");
    __syncthreads();
    if (threadIdx.x == 0) {
        unsigned* bar = b.bar;
        __builtin_amdgcn_s_waitcnt(0);
        unsigned nloc = b.st[0], nx = b.st[1];
        if (nloc == 0u) { xcd_barrier_complete(bar, b.x, b.G, nloc, nx); b.st[0] = nloc; b.st[1] = nx; }
        const unsigned old = xb_add(&bar[XB_XSUB(b.x)], 1u);
        const unsigned gen = old / nloc;
        if (old + 1u == (gen + 1u) * nloc) {
            __builtin_amdgcn_fence(__ATOMIC_RELEASE, "agent");
            asm volatile("s_waitcnt vmcnt(0)" ::: "memory");
            const unsigned og = xb_add(&bar[XB_TOP], 1u);
            const unsigned tg = og / nx;
            if (og + 1u == (tg + 1u) * nx) xb_add(&bar[XB_TOPGEN], 1u);
            else XB_SPIN(xb_ld(&bar[XB_TOPGEN]) == tg, bar);
            __builtin_amdgcn_fence(__ATOMIC_ACQUIRE, "agent");
            xb_add(&bar[XB_XGEN(b.x)], 1u);
            asm volatile("s_waitcnt vmcnt(0)" ::: "memory");
        } else {
            XB_SPIN(xb_ld(&bar[XB_XGEN(b.x)]) == gen, bar);
            __builtin_amdgcn_fence(__ATOMIC_ACQUIRE, "agent");
            asm volatile("s_waitcnt vmcnt(0)" ::: "memory");
        }
    }
    __syncthreads();
}

constexpr int NWAVES = 8;
constexpr int BATCH = 8, SEQ = 4096, DM = 1024, MTOK = BATCH * SEQ, INC = 4864, FF = 3584, NEXP = 8, AW = 768, AOW = 256;
constexpr float RMS_EPS = 1e-6f;
constexpr float QSCALE = 0.125f * 1.4426950408889634f;

constexpr size_t MiB = 1u << 20;
constexpr size_t WS_CTL = 0, CTL_ZERO_BYTES = 1 * MiB;
constexpr size_t WS_WIN = 1 * MiB;
constexpr size_t WIN_L = (size_t)INC * DM * 2;
constexpr size_t WS_WM = 20 * MiB; constexpr int KMIX = AOW + DM;
constexpr size_t WS_WOUT = 25 * MiB;
constexpr size_t WS_W13 = 29 * MiB;
constexpr size_t WS_W2 = 43 * MiB;
constexpr size_t WS_ROPE = 50 * MiB;
constexpr size_t WS_SS = 502 * MiB, SS_STRIDE = (size_t)MTOK * 4;
constexpr size_t WS_H = 118 * MiB;
constexpr size_t WS_Z = WS_H;
constexpr size_t WS_UT = 182 * MiB;
constexpr size_t WS_OATT = WS_Z - (size_t)(AOW / 8) * MTOK * 16;
constexpr size_t WS_Q = 214 * MiB, WS_K = 262 * MiB, WS_V = 310 * MiB;
constexpr size_t WS_GF = 358 * MiB, WS_GA = 422 * MiB;
constexpr size_t WS_MIX = 278 * MiB;
constexpr size_t WS_H2 = 118 * MiB, WS_TT = 182 * MiB;
constexpr size_t WS_M13 = 54 * MiB, WS_M2 = 110 * MiB;
constexpr size_t WS_H2B = 138 * MiB, WS_TTB = 170 * MiB;
constexpr float W13_SCALE = 32.0f, W2_SCALE = 64.0f;
constexpr int MOE_ROWS = MTOK + 2048;
constexpr int MOE_TILES = MOE_ROWS / 256;
constexpr size_t WS_ROWTOK = 52 * MiB, WS_ROWW = WS_ROWTOK + 512 * 1024;
constexpr size_t WS_SEL = 53 * MiB, WS_WTS = WS_SEL + 128 * 1024;
constexpr size_t WS_CNT = WS_WTS + 256 * 1024, WS_PLAN = WS_CNT + 64 * 1024;
constexpr size_t WS_WG8 = 96 * MiB;
constexpr size_t WS_WQK8 = 486 * MiB;
constexpr size_t WS_WV8 = 490 * MiB;
constexpr size_t WS_X8 = 504 * MiB;
constexpr float WG_SCALE = pg8::WG8_SCALE;
constexpr size_t WS_Y = 408 * MiB;
constexpr size_t WS_END = 536 * MiB;
static_assert(WS_TTB + (size_t)2 * MOE_ROWS * FF <= WS_Y && WS_Y + (size_t)2 * MTOK * DM * 2 <= WS_END && 2 * MOE_ROWS * 4 <= 512 * 1024 && WS_PLAN + 4096 <= 54 * MiB, "moe map");
static_assert(WS_M13 + (size_t)8 * 2 * FF * DM <= WS_M2 && WS_M2 + (size_t)8 * DM * FF <= WS_H2B && WS_H2B + (size_t)MTOK * DM <= WS_TTB && WS_MIX + (size_t)MTOK * DM * 2 <= WS_GF, "d_ws map");

constexpr int XP = 2 * DM;
constexpr int CW_BAR = 4096;
constexpr int RING_BYTES = 131072, LDS_BYTES = 147456, LDSCTL_OFF = LDS_BYTES - 1024, MISC_OFF = LDSCTL_OFF + 320;
static_assert(512 * 68 * 4 <= LDSCTL_OFF, "attention state fits under the control words");

struct Args { const float* in[16]; float* out; unsigned char* ws; int G, pad; };

struct Frame { LAS unsigned char* lds; volatile LAS unsigned* MISC; gu32* ctl; int tid, lane, wave, vcu, G; };

__device__ __forceinline__ float wave_sum(float v, int lane) {
#pragma unroll
    for (int o = 1; o < 64; o <<= 1) v += __int_as_float(__builtin_amdgcn_ds_bpermute((lane ^ o) << 2, __float_as_int(v)));
    return v;
}
__device__ __forceinline__ float bflo(unsigned w) { return __uint_as_float(w << 16); }
__device__ __forceinline__ float bfhi(unsigned w) { return __uint_as_float(w & 0xffff0000u); }

struct RowMap { int kind, base;
    __device__ __forceinline__ int operator()(int n) const {
        if (kind == 0) return n + base;
        if (kind == 2) return (n >> 2) * 8 + (n & 3) + base;
        if (kind == 5) { const int isk = n >= 768, c = n - (isk ? 768 : 0), hd = c >> 6, d = c & 63; return (isk ? 768 : 0) + hd * 64 + 2 * (d & 31) + (d >> 5); }
        if (kind == 4) { const int gch = n & 1023; return (gch >> 7) * 256 + (gch & 127) + (n >= 1024 ? 128 : 0); }
        if (kind == 3) return (n >> 7) * 256 + (n & 127) + base;
        if (n < 512) return n;
        if (n < 2048) { const int isk = n >= 1280, c = n - (isk ? 1280 : 512), hd = c >> 6, d = c & 63; return (isk ? 2048 : 1280) + hd * 64 + 2 * (d & 31) + (d >> 5); }
        if (n < 2816) return 512 + (n - 2048);
        { const int gch = (n - 2816) & 1023; return 2816 + (gch >> 7) * 256 + (gch & 127) + (n >= 3840 ? 128 : 0); }
    } };
struct TrJob { const float* W; int N; void* WT; int ldk; RowMap rm; const float* gain; float scale; int item; int ldw; int f8; };
__device__ __forceinline__ void tr_load(const TrJob& j, int lane, float (&r)[32]) {
    const int nblk = j.N / 32, kb = j.item / nblk, nb = j.item % nblk, k0 = 64 * kb, n0 = 32 * nb;
#pragma unroll
    for (int i = 0; i < 32; ++i) { const int kk = 2 * i + (lane >> 5); r[i] = j.W[(size_t)(k0 + kk) * (j.ldw ? j.ldw : j.N) + n0 + (lane & 31)]; }
}
template <bool F8> __device__ __forceinline__ void tr_store(const TrJob& j, int lane, const float (&r)[32], LAS float* scr) {
    const int nblk = j.N / 32, kb = j.item / nblk, nb = j.item % nblk, k0 = 64 * kb, n0 = 32 * nb;
#pragma unroll
    for (int i = 0; i < 32; ++i) { const int kk = 2 * i + (lane >> 5); scr[kk * 33 + (lane & 31)] = r[i] * (j.gain ? j.scale * j.gain[k0 + kk] : j.scale); }
    LDS_WAIT(); asm volatile("" ::: "memory");
    const int c = lane & 7;
#pragma unroll
    for (int q = 0; q < 4; ++q) { const int n = (lane >> 3) + 8 * q; const LAS float* sp = scr + (8 * c) * 33 + n; const size_t drow = (size_t)j.rm(n0 + n) * j.ldk + k0 + 8 * c;
        if (F8) { unsigned lo = pg8::pk_fp8(sp[0 * 33], sp[1 * 33], 0u, false); lo = pg8::pk_fp8(sp[2 * 33], sp[3 * 33], lo, true);
                  unsigned hi = pg8::pk_fp8(sp[4 * 33], sp[5 * 33], 0u, false); hi = pg8::pk_fp8(sp[6 * 33], sp[7 * 33], hi, true);
                  *(GAS unsigned long long*)((unsigned char*)j.WT + drow) = (unsigned long long)lo | ((unsigned long long)hi << 32); }
        else { v4u o; o.x = pk2(sp[0 * 33], sp[1 * 33]); o.y = pk2(sp[2 * 33], sp[3 * 33]); o.z = pk2(sp[4 * 33], sp[5 * 33]); o.w = pk2(sp[6 * 33], sp[7 * 33]);
               *(GAS v4u*)((bf16*)j.WT + drow) = o; } }
    LDS_WAIT(); asm volatile("" ::: "memory");
}
__device__ __forceinline__ void rms_row(const bf16* xrow, const f32x4 (&gn)[4], f32x4 (&v)[4], int lane) {
    const GAS unsigned long long* xr = (const GAS unsigned long long*)xrow + lane; float s = 0.f;
#pragma unroll
    for (int j = 0; j < 4; ++j) { const unsigned long long w = xr[64 * j]; v[j].x = bflo((unsigned)w); v[j].y = bfhi((unsigned)w); v[j].z = bflo((unsigned)(w >> 32)); v[j].w = bfhi((unsigned)(w >> 32)); s += (v[j].x * v[j].x + v[j].y * v[j].y) + (v[j].z * v[j].z + v[j].w * v[j].w); }
    const float rstd = 1.0f / sqrtf(wave_sum(s, lane) * (1.0f / DM) + RMS_EPS);
#pragma unroll
    for (int j = 0; j < 4; ++j) v[j] = v[j] * rstd * gn[j];
}
__device__ __forceinline__ void prep_x_phase(Frame& F, const float* x, bf16* xb, float* ss, unsigned char* x8) {
    const int gw = F.vcu * NWAVES + F.wave, NGW = F.G * NWAVES;
    for (int m = gw; m < MTOK; m += NGW) { const GAS f32x4* xr = (const GAS f32x4*)(x + (size_t)m * DM) + F.lane; f32x4 v[4]; float sq = 0.f;
#pragma unroll
        for (int j = 0; j < 4; ++j) { v[j] = xr[64 * j]; sq += (v[j].x * v[j].x + v[j].y * v[j].y) + (v[j].z * v[j].z + v[j].w * v[j].w); }
        sq = wave_sum(sq, F.lane); if (F.lane < 4) ss[(size_t)m * 4 + F.lane] = F.lane == 0 ? sq : 0.f;
        GAS unsigned long long* o8 = (GAS unsigned long long*)(xb + (size_t)m * XP) + F.lane;
#pragma unroll
        for (int j = 0; j < 4; ++j) o8[64 * j] = (unsigned long long)pk2(v[j].x, v[j].y) | ((unsigned long long)pk2(v[j].z, v[j].w) << 32);
        GAS unsigned* q8 = (GAS unsigned*)(x8 + (size_t)m * DM) + F.lane;
#pragma unroll
        for (int j = 0; j < 4; ++j) { unsigned w8 = pg8::pk_fp8(v[j].x, v[j].y, 0u, false); w8 = pg8::pk_fp8(v[j].z, v[j].w, w8, true); q8[64 * j] = w8; } }
}

__device__ __forceinline__ TrJob dense_job(const Args& a, int it) {
    unsigned char* ws = a.ws;
    constexpr int I_U = 16 * (512 / 32), I_V = 16 * (768 / 32), I_AT = 4 * 32, I_OUT = 16 * 32, I_W1 = 16 * (FF / 32), I_G = 16 * (2048 / 32), I_QK = 16 * (1536 / 32);
    constexpr int PER_L = I_U + I_V + I_AT + I_OUT;
    int r = it; TrJob j; j.gain = nullptr; j.scale = 1.0f; j.rm = RowMap{0, 0}; j.ldw = 0; j.f8 = 0;
    if (r < 2 * PER_L) { const int l = r / PER_L; r -= l * PER_L;
        if (r < I_U) { j.W = a.in[2] + (size_t)l * DM * INC; j.N = 512; j.ldw = INC; j.WT = ws + WS_WIN + l * WIN_L; j.ldk = DM; j.gain = a.in[1] + l * DM; }
        else if (r < I_U + I_V) { r -= I_U; j.W = a.in[2] + (size_t)l * DM * INC + 2048; j.N = 768; j.ldw = INC; j.WT = ws + WS_WV8 + (size_t)l * 768 * DM; j.ldk = DM; j.gain = a.in[1] + l * DM; j.scale = WG_SCALE; j.f8 = 1; }
        else if (r < I_U + I_V + I_AT) { r -= I_U + I_V; j.W = a.in[4] + (size_t)l * AOW * DM; j.N = DM; j.WT = (bf16*)(ws + WS_WM) + (size_t)l * DM * KMIX; j.ldk = KMIX; }
        else { r -= I_U + I_V + I_AT; j.W = a.in[5] + (size_t)l * DM * DM; j.N = DM; j.WT = (bf16*)(ws + WS_WOUT) + (size_t)l * DM * DM; j.ldk = DM; } }
    else { r -= 2 * PER_L;
        if (r < I_W1) { j.W = a.in[7]; j.N = FF; j.WT = ws + WS_W13; j.ldk = DM; j.rm = RowMap{3, 0}; j.gain = a.in[6]; }
        else if (r < 2 * I_W1) { r -= I_W1; j.W = a.in[8]; j.N = FF; j.WT = ws + WS_W13; j.ldk = DM; j.rm = RowMap{3, 128}; j.gain = a.in[6]; }
        else if (r < 3 * I_W1) { r -= 2 * I_W1; j.W = a.in[9]; j.N = DM; j.WT = ws + WS_W2; j.ldk = FF; }
        else if (r < 3 * I_W1 + 2 * I_G) { r -= 3 * I_W1; const int l = r / I_G; r -= l * I_G; j.W = a.in[2] + (size_t)l * DM * INC + 2816; j.N = 2048; j.ldw = INC; j.WT = ws + WS_WG8 + (size_t)l * 2048 * DM; j.ldk = DM; j.rm = RowMap{4, 0};
               j.gain = a.in[1] + l * DM; j.scale = WG_SCALE; j.f8 = 1; }
        else { r -= 3 * I_W1 + 2 * I_G; const int l = r / I_QK; r -= l * I_QK; j.W = a.in[2] + (size_t)l * DM * INC + 512; j.N = 1536; j.ldw = INC; j.WT = ws + WS_WQK8 + (size_t)l * 1536 * DM; j.ldk = DM; j.rm = RowMap{5, 0};
               j.gain = a.in[1] + l * DM; j.scale = WG_SCALE; j.f8 = 1; } }
    j.item = r; return j;
}
constexpr int MOE_I_W1 = 16 * (FF / 32), MOE_I_W2 = (FF / 64) * 32, MOE_NITEMS = NEXP * (2 * MOE_I_W1 + MOE_I_W2), MOE_EARLY_E = 6, MOE_EARLY = MOE_EARLY_E * 2 * MOE_I_W1;
constexpr int CONV_WGS = 40, GEMM_WGS = 256 - CONV_WGS, CONV_PER_WAVE = 0, CONV_PHASE_ITEMS = CONV_WGS * NWAVES * CONV_PER_WAVE;
static_assert(2 * CONV_PHASE_ITEMS <= MOE_EARLY && GEMM_WGS % 8 == 0 && (640 + GEMM_WGS - 1) / GEMM_WGS == 3, "early conversion");
__device__ __forceinline__ TrJob moe_job(const Args& a, int v) {
    unsigned char* ws = a.ws;
    constexpr int I_W1 = MOE_I_W1;
    int e, r;
    if (v < MOE_EARLY) { e = v / (2 * I_W1); r = v - e * (2 * I_W1); }
    else { v -= MOE_EARLY; if (v < (NEXP - MOE_EARLY_E) * 2 * I_W1) { const int q = v / (2 * I_W1); e = MOE_EARLY_E + q; r = v - q * (2 * I_W1); } else { v -= (NEXP - MOE_EARLY_E) * 2 * I_W1; e = v / MOE_I_W2; r = 2 * I_W1 + (v - e * MOE_I_W2); } }
    TrJob j; j.gain = nullptr; j.scale = W13_SCALE; j.rm = RowMap{3, 0}; j.ldw = 0; j.f8 = 1;
    if (r < I_W1) { j.W = a.in[12] + (size_t)e * DM * FF; j.N = FF; j.WT = ws + WS_M13 + (size_t)e * 2 * FF * DM; j.ldk = DM; }
    else if (r < 2 * I_W1) { r -= I_W1; j.W = a.in[13] + (size_t)e * DM * FF; j.N = FF; j.WT = ws + WS_M13 + (size_t)e * 2 * FF * DM; j.ldk = DM; j.rm = RowMap{3, 128}; }
    else { r -= 2 * I_W1; j.W = a.in[14] + (size_t)e * FF * DM; j.N = DM; j.WT = ws + WS_M2 + (size_t)e * DM * FF; j.ldk = FF; j.scale = W2_SCALE; j.rm = RowMap{0, 0}; }
    j.item = r; return j;
}
__device__ __forceinline__ void p0_weights(Frame& F, const Args& a) {
    LAS float* scr = (LAS float*)(F.lds + F.wave * 16384);
    const int gw = F.vcu * NWAVES + F.wave, NGW = F.G * NWAVES;
    constexpr int I_IN = 16 * (512 / 32) + 16 * (768 / 32), I_AT = 4 * 32, I_OUT = 16 * 32, I_W1 = 16 * (FF / 32), I_W2 = (FF / 64) * 32, I_G = 16 * (2048 / 32), I_QK = 16 * (1536 / 32), NITEMS = 2 * (I_IN + I_AT + I_OUT) + 2 * I_W1 + I_W2 + 2 * I_G + 2 * I_QK;
    static_assert(I_W2 == I_W1, "dense_job counts w2's items as I_W1");
    if (gw >= NITEMS) return;
    TrJob cur = dense_job(a, gw); float rc[32]; tr_load(cur, F.lane, rc);
#pragma unroll 1
    for (int it = gw; it < NITEMS; it += NGW) { const int nx = it + NGW; const bool more = nx < NITEMS; TrJob nj = cur; float rn[32];
        if (more) { nj = dense_job(a, nx); tr_load(nj, F.lane, rn); }
        if (cur.f8) tr_store<true>(cur, F.lane, rc, scr); else tr_store<false>(cur, F.lane, rc, scr);
        if (more) { cur = nj;
#pragma unroll
            for (int i = 0; i < 32; ++i) rc[i] = rn[i]; } }
}
__device__ __forceinline__ void p0_moe_weights(Frame& F, const Args& a, int first, int NITEMS, int gw, int NGW) {
    LAS float* scr = (LAS float*)(F.lds + F.wave * 16384);
    gw += first;
    if (gw >= NITEMS) return;
    TrJob cur = moe_job(a, gw), nx1 = cur; float rc[32], r1[32];
    tr_load(cur, F.lane, rc);
    if (gw + NGW < NITEMS) { nx1 = moe_job(a, gw + NGW); tr_load(nx1, F.lane, r1); }
#pragma unroll 1
    for (int it = gw; it < NITEMS; it += NGW) { const int n2 = it + 2 * NGW; const bool more2 = n2 < NITEMS, more1 = it + NGW < NITEMS; TrJob nx2 = cur; float r2[32];
        if (more2) { nx2 = moe_job(a, n2); tr_load(nx2, F.lane, r2); }
        tr_store<true>(cur, F.lane, rc, scr);
        if (more1) { cur = nx1;
#pragma unroll
            for (int i = 0; i < 32; ++i) rc[i] = r1[i]; }
        if (more2) { nx1 = nx2;
#pragma unroll
            for (int i = 0; i < 32; ++i) r1[i] = r2[i]; } }
}
__device__ __forceinline__ void p0_tables(Frame& F, const Args& a) {
    unsigned char* ws = a.ws;
    const int gt = F.vcu * (NWAVES * 64) + F.tid, NGT = F.G * NWAVES * 64;
    float* rope = (float*)(ws + WS_ROPE);
    for (int i = gt; i < SEQ * 32; i += NGT) { const int pos = i >> 5, f = i & 31; const float inv = powf(10000.0f, -(float)f * 2.0f / 64.0f); const float ang = (float)pos * inv;
        rope[2 * i] = cosf(ang); rope[2 * i + 1] = sinf(ang); }
    LAS float* tab = (LAS float*)F.lds;
    LAS float* wl = (LAS float*)(F.lds + 1024 + F.wave * 2048);
    if (F.tid < 128) tab[F.tid] = cospif((float)F.tid * (1.0f / 64.0f));
    __syncthreads();
    const int gw = F.vcu * NWAVES + F.wave, NGW = F.G * NWAVES;
    for (int it = gw; it < 2 * DM; it += NGW) { const int l = it >> 10, j = it & 1023; const float* wf = a.in[3] + (size_t)l * 512 * DM + j;
#pragma unroll
        for (int q = 0; q < 8; ++q) wl[F.lane + 64 * q] = wf[(size_t)(F.lane + 64 * q) * DM];
        LDS_WAIT(); asm volatile("" ::: "memory");
#pragma unroll 1
        for (int o = 0; o < 16; ++o) { const int kk = o * 64 + F.lane, part = kk & 1, cf = 4 * (kk >> 3) + ((kk >> 1) & 3), g = cf >> 7, c = cf & 127, sh = part ? 96 : 0;
            const float c1 = tab[c], tw = 2.0f * c1; float u0 = part ? 0.f : 1.f, u1 = part ? tab[(c + sh) & 127] : c1;
            float acc = 0.f, acc2 = 0.f; const LAS float* wg = wl + g * 128;
#pragma unroll 4
            for (int kc = 0; kc < 128; kc += 4) { const f32x4 w4 = *(const LAS f32x4*)(wg + kc);
                const float u2 = tw * u1 - u0, u3 = tw * u2 - u1; acc += u0 * w4[0]; acc2 += u1 * w4[1]; acc += u2 * w4[2]; acc2 += u3 * w4[3]; u0 = tw * u3 - u2; u1 = tw * u0 - u3; }
            acc += acc2;
            ((bf16*)(ws + WS_WM))[(size_t)l * DM * KMIX + (size_t)j * KMIX + AOW + kk] = (bf16)f2bf(acc * 0.08838834764831845f); }
        LDS_WAIT(); asm volatile("" ::: "memory");
    }
}

__device__ __forceinline__ void fft_phase(Frame& F, const bf16* UT, bf16* Zb) {
    const int lane = F.lane, w = F.wave & 3, cg = F.wave >> 2, lr = lane & 15, lg = lane >> 4;
    LAS unsigned char* f2 = F.lds; LAS unsigned char* f1 = F.lds + 16384; LAS float* tw = (LAS float*)(F.lds + 32768);
#pragma unroll 1
    for (int idx = F.tid; idx < 4096; idx += NWAVES * 64) {
        { const int f = idx >> 8, l = (idx >> 2) & 63, e2 = idx & 3, q = f >> 2, KK = (f >> 1) & 1, cs = f & 1, llr = l & 15, llg = l >> 4; float v[2];
#pragma unroll
          for (int h = 0; h < 2; ++h) { const int e = 2 * e2 + h, n2 = 32 * KK + (e < 4 ? 4 * llg + e : 16 + 4 * llg + e - 4), k2 = 16 * q + llr; const float x = (float)((n2 * k2) & 63) * (1.0f / 32.0f); v[h] = (cs ? sinpif(x) : cospif(x)) * 0.125f; }
          *(LAS unsigned*)(f2 + f * 1024 + l * 16 + e2 * 4) = pk2(v[0], v[1]); }
        { const int f = idx >> 8, l = (idx >> 2) & 63, e2 = idx & 3, ww = f >> 2, kk = (f >> 1) & 1, cs = f & 1, llr = l & 15, llg = l >> 4; float v[2];
#pragma unroll
          for (int h = 0; h < 2; ++h) { const int n1 = 32 * kk + 8 * llg + 2 * e2 + h, k1 = 16 * ww + llr; const float x = (float)((n1 * k1) & 63) * (1.0f / 32.0f); v[h] = (cs ? -sinpif(x) : cospif(x)) * 0.125f; }
          *(LAS unsigned*)(f1 + f * 1024 + l * 16 + e2 * 4) = pk2(v[0], v[1]); }
        { const int ww = idx >> 10, l = (idx >> 4) & 63, ir = idx & 15, n2 = 16 * (ir >> 2) + 4 * (l >> 4) + (ir & 3), k1 = 16 * ww + (l & 15); const float x = (float)(n2 * k1) * (1.0f / 2048.0f);
          tw[(ww * 64 + l) * 32 + ir] = cospif(x); tw[(ww * 64 + l) * 32 + 16 + ir] = sinpif(x); }
    }
    __syncthreads();
    bf16x8 F1c[2], F1s[2];
#pragma unroll
    for (int kk = 0; kk < 2; ++kk) { F1c[kk] = *(const LAS bf16x8*)(f1 + ((w * 2 + kk) * 2) * 1024 + lane * 16); F1s[kk] = *(const LAS bf16x8*)(f1 + ((w * 2 + kk) * 2 + 1) * 1024 + lane * 16); }
    float twc[4][4], tws[4][4];
#pragma unroll
    for (int I = 0; I < 4; ++I) { const f32x4 tc = *(const LAS f32x4*)(tw + (w * 64 + lane) * 32 + 4 * I), ts = *(const LAS f32x4*)(tw + (w * 64 + lane) * 32 + 16 + 4 * I);
#pragma unroll
        for (int r = 0; r < 4; ++r) { twc[I][r] = tc[r]; tws[I][r] = ts[r]; } }
    for (int it = F.vcu * 2 + cg; it < BATCH * 128; it += F.G * 2) {
        const int b = it >> 7, quad = it & 127;
        unsigned outp[4][4][4];
#pragma unroll
        for (int cc = 0; cc < 4; ++cc) {
            const bf16* xp = UT + (size_t)(quad * 4 + cc) * MTOK + b * SEQ + 64 * lr + 8 * lg;
            bf16x8 xa[4][2];
#pragma unroll
            for (int I = 0; I < 4; ++I)
#pragma unroll
                for (int kk = 0; kk < 2; ++kk) xa[I][kk] = *(const GAS bf16x8*)(xp + 1024 * I + 32 * kk);
            f32x4 d1r[4], d1i[4];
#pragma unroll
            for (int I = 0; I < 4; ++I) { d1r[I] = (f32x4){0.f, 0.f, 0.f, 0.f}; d1i[I] = (f32x4){0.f, 0.f, 0.f, 0.f};
#pragma unroll
                for (int kk = 0; kk < 2; ++kk) { d1r[I] = __builtin_amdgcn_mfma_f32_16x16x32_bf16(xa[I][kk], F1c[kk], d1r[I], 0, 0, 0); d1i[I] = __builtin_amdgcn_mfma_f32_16x16x32_bf16(xa[I][kk], F1s[kk], d1i[I], 0, 0, 0); } }
            bf16x8 yr[2], yi[2], yn[2];
#pragma unroll
            for (int KK = 0; KK < 2; ++KK) { float vr[8], vi[8];
#pragma unroll
                for (int e = 0; e < 8; ++e) { const int I = 2 * KK + (e >> 2), r = e & 3; const float a = d1r[I][r], bb = d1i[I][r]; vr[e] = a * twc[I][r] + bb * tws[I][r]; vi[e] = bb * twc[I][r] - a * tws[I][r]; }
                v4u pr, pi, pn; pr.x = pg8::cvt_pk_bf16(vr[0], vr[1]); pr.y = pg8::cvt_pk_bf16(vr[2], vr[3]); pr.z = pg8::cvt_pk_bf16(vr[4], vr[5]); pr.w = pg8::cvt_pk_bf16(vr[6], vr[7]);
                pi.x = pg8::cvt_pk_bf16(vi[0], vi[1]); pi.y = pg8::cvt_pk_bf16(vi[2], vi[3]); pi.z = pg8::cvt_pk_bf16(vi[4], vi[5]); pi.w = pg8::cvt_pk_bf16(vi[6], vi[7]);
                pn.x = pr.x ^ 0x80008000u; pn.y = pr.y ^ 0x80008000u; pn.z = pr.z ^ 0x80008000u; pn.w = pr.w ^ 0x80008000u;
                yr[KK] = __builtin_bit_cast(bf16x8, pr); yi[KK] = __builtin_bit_cast(bf16x8, pi); yn[KK] = __builtin_bit_cast(bf16x8, pn); }
#pragma unroll
            for (int q = 0; q < 4; ++q) { f32x4 zr = (f32x4){0.f, 0.f, 0.f, 0.f}, zi = (f32x4){0.f, 0.f, 0.f, 0.f};
#pragma unroll
                for (int KK = 0; KK < 2; ++KK) { const bf16x8 fc = *(const LAS bf16x8*)(f2 + ((q * 2 + KK) * 2) * 1024 + lane * 16), fs = *(const LAS bf16x8*)(f2 + ((q * 2 + KK) * 2 + 1) * 1024 + lane * 16);
                    zr = __builtin_amdgcn_mfma_f32_16x16x32_bf16(yr[KK], fc, zr, 0, 0, 0); zr = __builtin_amdgcn_mfma_f32_16x16x32_bf16(yi[KK], fs, zr, 0, 0, 0);
                    zi = __builtin_amdgcn_mfma_f32_16x16x32_bf16(yi[KK], fc, zi, 0, 0, 0); zi = __builtin_amdgcn_mfma_f32_16x16x32_bf16(yn[KK], fs, zi, 0, 0, 0); }
#pragma unroll
                for (int r = 0; r < 4; ++r) outp[q][r][cc] = pg8::cvt_pk_bf16(zr[r], zi[r]); }
        }
#pragma unroll
        for (int q = 0; q < 4; ++q)
#pragma unroll
            for (int r = 0; r < 4; ++r) { const int k = 16 * w + 4 * lg + r + 64 * (16 * q + lr); v4u o; o.x = outp[q][r][0]; o.y = outp[q][r][1]; o.z = outp[q][r][2]; o.w = outp[q][r][3];
                *(GAS v4u*)(Zb + ((size_t)quad * MTOK + (size_t)b * SEQ + k) * 8) = o; }
    }
    __syncthreads();
}

__device__ __forceinline__ bf16x8 f8x8_bf16(unsigned long long w) {
    typedef float f32x2_t __attribute__((ext_vector_type(2)));
    const f32x2_t a = __builtin_amdgcn_cvt_pk_f32_fp8((int)(unsigned)w, false), b = __builtin_amdgcn_cvt_pk_f32_fp8((int)(unsigned)w, true),
                  c = __builtin_amdgcn_cvt_pk_f32_fp8((int)(unsigned)(w >> 32), false), d = __builtin_amdgcn_cvt_pk_f32_fp8((int)(unsigned)(w >> 32), true);
    v4u o; o.x = pg8::cvt_pk_bf16(a.x, a.y); o.y = pg8::cvt_pk_bf16(b.x, b.y); o.z = pg8::cvt_pk_bf16(c.x, c.y); o.w = pg8::cvt_pk_bf16(d.x, d.y); return __builtin_bit_cast(bf16x8, o); }
__device__ __forceinline__ void attn_mfma_phase(Frame& F, const unsigned char* Q, const unsigned char* K, const unsigned char* VT, bf16* OA) {
    LAS float* st = (LAS float*)F.lds;
    const int lane = F.lane, lr = lane & 15, lg = lane >> 4, bp16 = (lane ^ 16) << 2, bp32 = (lane ^ 32) << 2;
    for (int unit = F.vcu; unit < 256; unit += F.G) {
        const int b = unit >> 5, pb = (unit >> 2) & 7, j = unit & 3, P0 = pb * 512;
#pragma unroll 1
        for (int pass = 0; pass < 3; ++pass) {
            const int g = 2 - pass, dsh = 2 * g, dl = 1 << dsh, L = SEQ >> dsh, head = g * 4 + j, lns = 4 - dsh;
#pragma unroll 1
            for (int tt = 0; tt < 2; ++tt) {
                const int tau = F.wave * 2 + tt, r = tau >> lns, sblk = tau & ((1 << lns) - 1), iq0 = (P0 >> dsh) + 32 * sblk;
                const unsigned char* Kh = K + (size_t)b * SEQ * AW + head * 64 + 8 * lg;
                const unsigned char* Vh = VT + (size_t)(head * 64 + lr) * MTOK + (size_t)b * SEQ + r * L;
                long qf[2][2]; int prow[2]; f32x4 o[4][2]; float m[2], l[2];
#pragma unroll
                for (int qb = 0; qb < 2; ++qb) { const int pl = dl * (32 * sblk + 16 * qb + lr) + r; prow[qb] = pl;
                    const unsigned char* qp = Q + (size_t)(b * SEQ + P0 + pl) * AW + head * 64 + 8 * lg;
                    qf[qb][0] = *(const GAS long*)qp; qf[qb][1] = *(const GAS long*)(qp + 32); }
                if (pass == 0) {
#pragma unroll
                    for (int qb = 0; qb < 2; ++qb) { m[qb] = -1e30f; l[qb] = 0.f;
#pragma unroll
                        for (int t = 0; t < 4; ++t) o[t][qb] = (f32x4){0.f, 0.f, 0.f, 0.f}; }
                } else {
#pragma unroll
                    for (int qb = 0; qb < 2; ++qb) { const LAS float* sp = st + prow[qb] * 68; m[qb] = sp[64]; l[qb] = lg == 0 ? sp[65] : 0.f;
#pragma unroll
                        for (int t = 0; t < 4; ++t) o[t][qb] = *(const LAS f32x4*)(sp + 16 * t + 4 * lg); }
                }
                typedef unsigned long long u64t; u64t kf[2][2], vf[4], kfn[2][2], vfn[4];
#define ATT_LOAD(c_, kd, vd) do { const int kb_ = iq0 - 64 + 32 * (c_); int ia_ = kb_ + 8 * (lr >> 2) + (lr & 3), ib_ = ia_ + 4; ia_ = ia_ < 0 ? 0 : (ia_ >= L ? L - 1 : ia_); ib_ = ib_ < 0 ? 0 : (ib_ >= L ? L - 1 : ib_); \
        const unsigned char* ka_ = Kh + (size_t)(dl * ia_ + r) * AW; const unsigned char* kb2_ = Kh + (size_t)(dl * ib_ + r) * AW; \
        kd[0][0] = *(const GAS u64t*)ka_; kd[0][1] = *(const GAS u64t*)(ka_ + 32); kd[1][0] = *(const GAS u64t*)kb2_; kd[1][1] = *(const GAS u64t*)(kb2_ + 32); \
        int vk_ = kb_ + 8 * lg; vk_ = vk_ < 0 ? 0 : (vk_ > L - 8 ? L - 8 : vk_); \
        _Pragma("unroll") for (int t_ = 0; t_ < 4; ++t_) vd[t_] = *(const GAS u64t*)(Vh + (size_t)(16 * t_) * MTOK + vk_); } while (0)
                ATT_LOAD(0, kf, vf);
#pragma unroll 1
                for (int c = 0; c < 5; ++c) {
                    if (c < 4) ATT_LOAD(c + 1, kfn, vfn);
                    const int kb = iq0 - 64 + 32 * c;
                    f32x4 s[2][2];
#pragma unroll
                    for (int tl = 0; tl < 2; ++tl) {
#pragma unroll
                        for (int qb = 0; qb < 2; ++qb) { s[tl][qb] = __builtin_amdgcn_mfma_f32_16x16x32_fp8_fp8((long)kf[tl][0], qf[qb][0], (f32x4){0.f, 0.f, 0.f, 0.f}, 0, 0, 0);
                            s[tl][qb] = __builtin_amdgcn_mfma_f32_16x16x32_fp8_fp8((long)kf[tl][1], qf[qb][1], s[tl][qb], 0, 0, 0); } }
                    bf16x8 pf[2];
                    if (c == 0 || c == 4 || kb < 0 || kb + 32 > L) {
#pragma unroll
                        for (int qb = 0; qb < 2; ++qb) { const int iq = iq0 + 16 * qb + lr, lo = iq - 64 < 0 ? 0 : iq - 64, hi = iq + 64 > L - 1 ? L - 1 : iq + 64; const unsigned span = (unsigned)(hi - lo); const int k0 = kb + 8 * lg - lo;
#pragma unroll
                            for (int e = 0; e < 8; ++e) s[e >> 2][qb][e & 3] = (unsigned)(k0 + e) <= span ? s[e >> 2][qb][e & 3] : -__builtin_inff(); } }
#pragma unroll
                    for (int qb = 0; qb < 2; ++qb) { float sv[8]; float mx = -__builtin_inff();
#pragma unroll
                        for (int e = 0; e < 8; ++e) { sv[e] = s[e >> 2][qb][e & 3]; mx = fmaxf(mx, sv[e]); }
                        mx = fmaxf(mx, __int_as_float(__builtin_amdgcn_ds_bpermute(bp16, __float_as_int(mx)))); mx = fmaxf(mx, __int_as_float(__builtin_amdgcn_ds_bpermute(bp32, __float_as_int(mx))));
                        const float mn = fmaxf(m[qb], mx), al = __builtin_amdgcn_exp2f(m[qb] - mn); m[qb] = mn; float ps = 0.f; float p[8];
#pragma unroll
                        for (int e = 0; e < 8; ++e) { p[e] = __builtin_amdgcn_exp2f(sv[e] - mn); ps += p[e]; }
                        l[qb] = l[qb] * al + ps;
#pragma unroll
                        for (int t = 0; t < 4; ++t) o[t][qb] = o[t][qb] * al;
                        v4u pw; pw.x = pg8::cvt_pk_bf16(p[0], p[1]); pw.y = pg8::cvt_pk_bf16(p[2], p[3]); pw.z = pg8::cvt_pk_bf16(p[4], p[5]); pw.w = pg8::cvt_pk_bf16(p[6], p[7]); pf[qb] = __builtin_bit_cast(bf16x8, pw); }
#pragma unroll
                    for (int t = 0; t < 4; ++t) { const bf16x8 vt = f8x8_bf16(vf[t]);
#pragma unroll
                        for (int qb = 0; qb < 2; ++qb) o[t][qb] = __builtin_amdgcn_mfma_f32_16x16x32_bf16(vt, pf[qb], o[t][qb], 0, 0, 0); }
#pragma unroll
                    for (int tl = 0; tl < 2; ++tl) { kf[tl][0] = kfn[tl][0]; kf[tl][1] = kfn[tl][1]; }
#pragma unroll
                    for (int t = 0; t < 4; ++t) vf[t] = vfn[t];
                }
#undef ATT_LOAD
#pragma unroll
                for (int qb = 0; qb < 2; ++qb) { float lt = l[qb]; lt += __int_as_float(__builtin_amdgcn_ds_bpermute(bp16, __float_as_int(lt))); lt += __int_as_float(__builtin_amdgcn_ds_bpermute(bp32, __float_as_int(lt)));
                    if (pass < 2) { LAS float* sp = st + prow[qb] * 68;
#pragma unroll
                        for (int t = 0; t < 4; ++t) *(LAS f32x4*)(sp + 16 * t + 4 * lg) = o[t][qb];
                        if (lg == 0) { sp[64] = m[qb]; sp[65] = lt; } }
                    else { const float il = 1.0f / lt; bf16* op = OA + ((size_t)(8 * j + (lg >> 1)) * MTOK + (size_t)(b * SEQ + P0 + prow[qb])) * 8 + 4 * (lg & 1);
#pragma unroll
                        for (int t = 0; t < 4; ++t) { const f32x4 x = o[t][qb] * il; *(GAS unsigned long long*)(op + (size_t)(2 * t) * MTOK * 8) = (unsigned long long)pg8::cvt_pk_bf16(x[0], x[1]) | ((unsigned long long)pg8::cvt_pk_bf16(x[2], x[3]) << 32); } } }
            }
            __syncthreads();
        }
    }
}

__device__ __forceinline__ void norm_router_phase(Frame& F, const bf16* x, const float* gain, unsigned char* out8, const float* rw, const float* rb, int* SEL, float* WTS, int* CNT) {
    LAS float* wr = (LAS float*)F.lds;
    LAS int* sel_l = (LAS int*)(F.lds + 32768);
    for (int i = F.tid; i < DM * NEXP; i += NWAVES * 64) { const int k = i >> 3, e = i & 7; wr[(((e >> 2) * 1024) + (k & 3) * 256 + (k >> 2)) * 4 + (e & 3)] = rw[i]; }
    __syncthreads();
    f32x4 gn[4];
#pragma unroll
    for (int j = 0; j < 4; ++j) gn[j] = ((const GAS f32x4*)gain)[F.lane + 64 * j];
    typedef unsigned long long u64r;
    u64r rw_[4];
    { const GAS u64r* xr = (const GAS u64r*)(x + (size_t)(F.vcu * 128 + F.wave * 16) * XP) + F.lane;
#pragma unroll
      for (int j = 0; j < 4; ++j) rw_[j] = xr[64 * j]; }
    const bool b0 = F.lane & 1, b1 = F.lane & 2, b2 = F.lane & 4;
#pragma unroll 1
    for (int i = 0; i < 16; ++i) { const int tl = F.wave * 16 + i, m = F.vcu * 128 + tl; f32x4 v[4]; float ssq = 0.f;
#pragma unroll
        for (int j = 0; j < 4; ++j) { const u64r w = rw_[j]; v[j].x = bflo((unsigned)w); v[j].y = bfhi((unsigned)w); v[j].z = bflo((unsigned)(w >> 32)); v[j].w = bfhi((unsigned)(w >> 32));
            ssq += (v[j].x * v[j].x + v[j].y * v[j].y) + (v[j].z * v[j].z + v[j].w * v[j].w); }
        if (i < 15) { const GAS u64r* xr = (const GAS u64r*)(x + (size_t)(m + 1) * XP) + F.lane;
#pragma unroll
            for (int j = 0; j < 4; ++j) rw_[j] = xr[64 * j]; }
        const float rstd = 1.0f / sqrtf(wave_sum(ssq, F.lane) * (1.0f / DM) + RMS_EPS);
#pragma unroll
        for (int j = 0; j < 4; ++j) v[j] = v[j] * rstd * gn[j];
        GAS unsigned* o4 = (GAS unsigned*)(out8 + (size_t)m * DM) + F.lane;
#pragma unroll
        for (int j = 0; j < 4; ++j) { unsigned w8 = pg8::pk_fp8(v[j].x, v[j].y, 0u, false); w8 = pg8::pk_fp8(v[j].z, v[j].w, w8, true); o4[64 * j] = w8; }
        float lg[8];
#pragma unroll
        for (int e = 0; e < 8; ++e) lg[e] = 0.f;
#pragma unroll
        for (int j = 0; j < 4; ++j)
#pragma unroll
            for (int cc = 0; cc < 4; ++cc) { const int sl = cc * 256 + F.lane + 64 * j; const f32x4 wa = *(const LAS f32x4*)(wr + sl * 4), wb = *(const LAS f32x4*)(wr + 4096 + sl * 4); const float xv = v[j][cc];
                lg[0] += xv * wa[0]; lg[1] += xv * wa[1]; lg[2] += xv * wa[2]; lg[3] += xv * wa[3]; lg[4] += xv * wb[0]; lg[5] += xv * wb[1]; lg[6] += xv * wb[2]; lg[7] += xv * wb[3]; }
#define XCH(v_, o_) __int_as_float(__builtin_amdgcn_ds_bpermute((F.lane ^ (o_)) << 2, __float_as_int(v_)))
        float ra[4], rb2[2], rc;
#pragma unroll
        for (int t = 0; t < 4; ++t) { const float send = b0 ? lg[t] : lg[t + 4], keep = b0 ? lg[t + 4] : lg[t]; ra[t] = keep + XCH(send, 1); }
#pragma unroll
        for (int t = 0; t < 2; ++t) { const float send = b1 ? ra[t] : ra[t + 2], keep = b1 ? ra[t + 2] : ra[t]; rb2[t] = keep + XCH(send, 2); }
        { const float send = b2 ? rb2[0] : rb2[1], keep = b2 ? rb2[1] : rb2[0]; rc = keep + XCH(send, 4); }
        rc += XCH(rc, 8); rc += XCH(rc, 16); rc += XCH(rc, 32);
#undef XCH
        lg[0] = __int_as_float(__builtin_amdgcn_readlane(__float_as_int(rc), 0)) + rb[0]; lg[1] = __int_as_float(__builtin_amdgcn_readlane(__float_as_int(rc), 4)) + rb[1];
        lg[2] = __int_as_float(__builtin_amdgcn_readlane(__float_as_int(rc), 2)) + rb[2]; lg[3] = __int_as_float(__builtin_amdgcn_readlane(__float_as_int(rc), 6)) + rb[3];
        lg[4] = __int_as_float(__builtin_amdgcn_readlane(__float_as_int(rc), 1)) + rb[4]; lg[5] = __int_as_float(__builtin_amdgcn_readlane(__float_as_int(rc), 5)) + rb[5];
        lg[6] = __int_as_float(__builtin_amdgcn_readlane(__float_as_int(rc), 3)) + rb[6]; lg[7] = __int_as_float(__builtin_amdgcn_readlane(__float_as_int(rc), 7)) + rb[7];
        int e0 = 0; float v0 = lg[0];
#pragma unroll
        for (int e = 1; e < 8; ++e) if (lg[e] > v0) { v0 = lg[e]; e0 = e; }
        int e1 = 0; float v1 = -__builtin_inff();
#pragma unroll
        for (int e = 0; e < 8; ++e) if (e != e0 && lg[e] > v1) { v1 = lg[e]; e1 = e; }
        const float w0 = 1.0f / (1.0f + expf(v1 - v0)), w1 = 1.0f - w0;
        if (F.lane == 0) { sel_l[tl] = e0 | (e1 << 8); WTS[2 * (size_t)m] = w0; WTS[2 * (size_t)m + 1] = w1; }
    }
    __syncthreads();
    if (F.tid < 128) { const int me = sel_l[F.tid], e0 = me & 255, e1 = me >> 8; int r0 = 0, r1 = 0;
        for (int t = 0; t < F.tid; ++t) { const int o = sel_l[t]; r0 += ((o & 255) == e0); r1 += ((o >> 8) == e1); }
        SEL[F.vcu * 128 + F.tid] = me | (r0 << 16) | (r1 << 24); }
    else if (F.tid < 144) { const int q = F.tid - 128, s = q >> 3, e = q & 7; int n = 0;
        for (int t = 0; t < 128; ++t) { const int o = sel_l[t]; n += ((s ? (o >> 8) : (o & 255)) == e); }
        CNT[F.vcu * 16 + q] = n; }
    __syncthreads();
}
__device__ __forceinline__ void route2_phase(Frame& F, const int* SEL, const float* WTS, const int* CNT, int* ROWTOK, float* ROWW, int* PLAN) {
    LAS int* call = (LAS int*)F.lds;
    LAS int* tot = call + 4096; LAS int* basew = tot + 16; LAS int* segst = basew + 16; LAS int* ntile = segst + 16;
    for (int i = F.tid; i < 4096; i += NWAVES * 64) call[i] = CNT[i];
    __syncthreads();
    if (F.tid < 16) { int t = 0, bsum = 0; for (int w = 0; w < 256; ++w) { const int c = call[w * 16 + F.tid]; t += c; bsum += (w < F.vcu) ? c : 0; } tot[F.tid] = t; basew[F.tid] = bsum; }
    __syncthreads();
    if (F.tid < 2) { int run = 0; for (int e = 0; e < 8; ++e) { segst[F.tid * 8 + e] = run; run += (tot[F.tid * 8 + e] + 255) & ~255; } ntile[F.tid] = run >> 8; }
    __syncthreads();
    if (F.tid < 128) { const int m = F.vcu * 128 + F.tid, sl = SEL[m], e0 = sl & 255, e1 = (sl >> 8) & 255, r0 = (sl >> 16) & 255, r1 = (sl >> 24) & 255;
        const int p0 = segst[e0] + basew[e0] + r0, p1 = segst[8 + e1] + basew[8 + e1] + r1;
        ROWTOK[p0] = m; ROWW[p0] = WTS[2 * (size_t)m]; ROWTOK[MOE_ROWS + p1] = m; ROWW[MOE_ROWS + p1] = WTS[2 * (size_t)m + 1]; }
    if (F.vcu < 8) {
        for (int s = 0; s < 2; ++s) { const int q = s * 8 + F.vcu, n = tot[q], np = (n + 255) & ~255;
            for (int p = n + F.tid; p < np; p += NWAVES * 64) { ROWTOK[s * MOE_ROWS + segst[q] + p] = -1; ROWW[s * MOE_ROWS + segst[q] + p] = 0.f; } } }
    if (F.vcu == 8) {
        if (F.tid < 2) PLAN[F.tid] = ntile[F.tid];
        if (F.tid < 2 * MOE_TILES) { const int s = F.tid / MOE_TILES, t = F.tid % MOE_TILES; int e = 0;
            for (int k = 1; k < 8; ++k) if ((segst[s * 8 + k] >> 8) <= t) e = k;
            PLAN[16 + MOE_TILES * s + t] = e; } }
    __syncthreads();
}
__device__ __forceinline__ void final_norm_phase(Frame& F, float* xio, const bf16* xb, const float* gain, const bf16* y) {
    const int gw = F.vcu * NWAVES + F.wave, NGW = F.G * NWAVES;
    f32x4 gn[4];
#pragma unroll
    for (int j = 0; j < 4; ++j) gn[j] = ((const GAS f32x4*)gain)[F.lane + 64 * j];
    for (int m = gw; m < MTOK; m += NGW) { f32x4 v[4]; float s = 0.f;
        const GAS unsigned long long* xr = (const GAS unsigned long long*)(xb + (size_t)m * XP) + F.lane;
        const GAS unsigned long long* y0 = (const GAS unsigned long long*)(y + (size_t)m * DM) + F.lane; const GAS unsigned long long* y1 = (const GAS unsigned long long*)(y + ((size_t)MTOK + m) * DM) + F.lane;
#pragma unroll
        for (int j = 0; j < 4; ++j) { const unsigned long long xw = xr[64 * j]; v[j].x = bflo((unsigned)xw); v[j].y = bfhi((unsigned)xw); v[j].z = bflo((unsigned)(xw >> 32)); v[j].w = bfhi((unsigned)(xw >> 32));
            const unsigned long long a0 = y0[64 * j], a1 = y1[64 * j];
            v[j].x += bflo((unsigned)a0) + bflo((unsigned)a1); v[j].y += bfhi((unsigned)a0) + bfhi((unsigned)a1);
            v[j].z += bflo((unsigned)(a0 >> 32)) + bflo((unsigned)(a1 >> 32)); v[j].w += bfhi((unsigned)(a0 >> 32)) + bfhi((unsigned)(a1 >> 32));
            s += (v[j].x * v[j].x + v[j].y * v[j].y) + (v[j].z * v[j].z + v[j].w * v[j].w); }
        const float rstd = 1.0f / sqrtf(wave_sum(s, F.lane) * (1.0f / DM) + RMS_EPS);
        GAS f32x4* o = (GAS f32x4*)(xio + (size_t)m * DM) + F.lane;
#pragma unroll
        for (int j = 0; j < 4; ++j) o[64 * j] = v[j] * rstd * gn[j]; }
}

struct MoeOrder { int nT0, nM, nN, nwg, G, c; unsigned lda, ldb; const int* tile_e; size_t estride; bool gather;
    __device__ bool next(int i, pg8::Unit& u) const {
        const long L = (long)i * G + c; if (L >= nwg) return false;
        int wgid = (int)L; { const int q = nwg / pg8::NXCD, r = nwg % pg8::NXCD, xcd = wgid % pg8::NXCD, off = wgid / pg8::NXCD; wgid = (xcd < r ? xcd * (q + 1) : r * (q + 1) + (xcd - r) * q) + off; }
        const int nig = pg8::WGM * nN, gid = wgid / nig, fm = gid * pg8::WGM, gsz = (nM - fm) < pg8::WGM ? (nM - fm) : pg8::WGM;
        const int lin = fm + ((wgid % nig) % gsz); u.pm = lin < nT0 ? lin : MOE_TILES + (lin - nT0); u.pn = (wgid % nig) / gsz; u.z = __builtin_amdgcn_readfirstlane(tile_e[u.pm]);
        u.aoff = gather ? (size_t)0 : (size_t)u.pm * 256 * lda; u.boff = (size_t)u.z * estride + (size_t)u.pn * 256 * ldb; return true; } };

template <class Epi, int BMAP = 0, int ALAY = 0> __device__ __forceinline__ void run_gemm(Frame& F, const void* A, unsigned lda, const void* B, unsigned ldb, int Mrows, int Ncols, int K, const Epi& E, int geff = 0) {
    int G_ = geff ? geff : F.G, c_ = (int)blockIdx.x; asm volatile("" : "+s"(G_), "+s"(c_));
    pg8::Gemm g{(const char*)A, (const char*)B, lda, ldb, K, nullptr}; pg8::PlainOrder S; S.init(Mrows, Ncols, G_, c_, lda, ldb, BMAP, ALAY);
    pg8::gemm_phase<Epi, pg8::PlainOrder, false, BMAP, ALAY>(F.lds, g, S, E);
}

__device__ __forceinline__ Args load_args() {
    Args r{};
#if defined(__HIP_DEVICE_COMPILE__)
    typedef const __attribute__((address_space(4))) Args CArgs;
    auto p = __builtin_amdgcn_kernarg_segment_ptr(); asm volatile("" : "+s"(p)); CArgs* q = (CArgs*)p;
#pragma unroll
    for (int i = 0; i < 16; ++i) r.in[i] = q->in[i];
    r.out = q->out; r.ws = q->ws; r.G = q->G;
#endif
    return r;
}
__device__ __forceinline__ Frame make_frame(LAS unsigned char* lds, unsigned char* ws, int G) {
    Frame F; int t = threadIdx.x, g = G, bx = blockIdx.x; asm volatile("" : "+v"(t), "+s"(g), "+s"(bx));
    F.lds = lds; F.MISC = (volatile LAS unsigned*)(lds + MISC_OFF); F.ctl = (gu32*)(ws + WS_CTL);
    F.tid = t; F.lane = t & 63; F.wave = __builtin_amdgcn_readfirstlane(t >> 6); F.G = g; F.vcu = (g % 8 == 0) ? (bx % 8) * (g / 8) + bx / 8 : bx; return F; }
#define PH_BEGIN const Args a = load_args(); unsigned char* const ws = a.ws; float* const xout = a.out; bf16* const xsA = (bf16*)a.out; bf16* const xsB = xsA + DM; Frame F = make_frame((LAS unsigned char*)lds, ws, a.G); (void)xout; (void)xsA; (void)xsB
__global__ void __launch_bounds__(NWAVES * 64, 2) fwd_kernel(Args args) {
    extern __shared__ __attribute__((aligned(16))) unsigned char lds[];
    for (int u = threadIdx.x; u < (LDS_BYTES - LDSCTL_OFF) / 4; u += NWAVES * 64) ((LAS unsigned*)((LAS unsigned char*)lds + LDSCTL_OFF))[u] = 0u;
    __syncthreads();
    XcdBarrier bar = xcd_barrier_post((unsigned*)(args.ws + WS_CTL) + CW_BAR, (volatile LAS unsigned*)((LAS unsigned char*)lds + MISC_OFF) + 8);
    bar.G = (unsigned)args.G;
#define GRID_BAR() do { XcdBarrier b2_ = bar; asm volatile("" : "+s"(b2_.bar), "+s"(b2_.x), "+s"(b2_.G)); xcd_barrier(b2_); } while (0)

    { PH_BEGIN; p0_weights(F, a); __syncthreads(); p0_tables(F, a); prep_x_phase(F, a.in[0], xsA, (float*)(ws + WS_SS), ws + WS_X8); }
    GRID_BAR();

    for (int layer = 0; layer < 2; ++layer) {
        asm volatile("" : "+s"(layer));
        { PH_BEGIN; int lyr = layer; asm volatile("" : "+s"(lyr)); const bf16* WinT = (const bf16*)(ws + WS_WIN + lyr * WIN_L);
          pg8::EpiInproj E{ws, WS_V, WS_Q, WS_K, WS_GF, WS_GA, WS_ROPE, QSCALE, (const float*)(ws + WS_SS) + (size_t)(2 * lyr) * SS_STRIDE, 1.0f / WG_SCALE};
          int G_ = F.G, c_ = (int)blockIdx.x; asm volatile("" : "+s"(G_), "+s"(c_));
          pg8::Gemm g{(const char*)(ws + WS_X8), (const char*)(ws + WS_WQK8 + (size_t)lyr * 1536 * DM), DM, DM, DM / 2, nullptr}; pg8::PlainOrder S; S.init(MTOK, 1536, G_, c_, DM, DM, 0, 0);
          pg8::gemm_phase<pg8::EpiInproj, pg8::PlainOrder, false, 0, 0, true>(F.lds, g, S, E); }
        { PH_BEGIN; int lyr = layer; asm volatile("" : "+s"(lyr)); const bf16* WinT = (const bf16*)(ws + WS_WIN + lyr * WIN_L);
          int bx_ = (int)blockIdx.x; asm volatile("" : "+s"(bx_));
          if (bx_ < 128) { pg8::EpiBf16 E{(bf16*)(ws + WS_UT), MTOK, (bf16*)(ws + WS_V), 2, (const float*)(ws + WS_SS) + (size_t)(2 * lyr) * SS_STRIDE, 1.0f};
            run_gemm<pg8::EpiBf16, 2, 0>(F, WinT, DM * 2, xsA, XP * 2, 512, MTOK, DM, E, 128); }
          else { pg8::EpiBf16 E{(bf16*)(ws + WS_UT), MTOK, (bf16*)(ws + WS_V), 2, (const float*)(ws + WS_SS) + (size_t)(2 * lyr) * SS_STRIDE, 1.0f / WG_SCALE};
            int G_ = 128, c_ = bx_ - 128; asm volatile("" : "+s"(G_), "+s"(c_));
            pg8::Gemm g{(const char*)(ws + WS_WV8 + (size_t)lyr * 768 * DM), (const char*)(ws + WS_X8), DM, DM, DM / 2, nullptr}; pg8::PlainOrder S; S.init(768, MTOK, G_, c_, DM, DM, 2, 0); S.pmoff = 2;
            pg8::gemm_phase<pg8::EpiBf16, pg8::PlainOrder, false, 2, 0, true>(F.lds, g, S, E); } }
        GRID_BAR();
        { PH_BEGIN; fft_phase(F, (const bf16*)(ws + WS_UT), (bf16*)(ws + WS_Z)); }
        { PH_BEGIN; attn_mfma_phase(F, ws + WS_Q, ws + WS_K, ws + WS_V, (bf16*)(ws + WS_OATT)); }
        { PH_BEGIN; int lyr = layer; asm volatile("" : "+s"(lyr)); int G_ = F.G, c_ = (int)blockIdx.x; asm volatile("" : "+s"(G_), "+s"(c_));
          pg8::Gemm g{(const char*)(ws + WS_X8), (const char*)(ws + WS_WG8 + (size_t)lyr * 2048 * DM), DM, DM, DM / 2, nullptr}; pg8::PlainOrder S; S.init(MTOK, 2048, G_, c_, DM, DM, 0, 0);
          pg8::EpiGates8 E{ws, WS_GF, WS_GA, (const float*)(ws + WS_SS) + (size_t)(2 * lyr) * SS_STRIDE}; pg8::gemm_phase<pg8::EpiGates8, pg8::PlainOrder, false, 0, 0, true>(F.lds, g, S, E); }
        GRID_BAR();
        { PH_BEGIN; int lyr = layer; asm volatile("" : "+s"(lyr)); pg8::EpiMix E{(const bf16*)(ws + WS_GF), (const bf16*)(ws + WS_GA), (bf16*)(ws + WS_MIX)};
          run_gemm<pg8::EpiMix, 0, 1>(F, ws + WS_OATT, MTOK * 16, (const bf16*)(ws + WS_WM) + (size_t)lyr * DM * KMIX, KMIX * 2, MTOK, DM, KMIX, E); }
        GRID_BAR();
        if (layer == 0) { PH_BEGIN; pg8::EpiResid<true> E{xsA, xsB, XP, (float*)(ws + WS_SS) + SS_STRIDE, nullptr};
          run_gemm(F, ws + WS_MIX, DM * 2, ws + WS_WOUT, DM * 2, MTOK, DM, DM, E); }
        else { PH_BEGIN; pg8::EpiResid<false> E{xsA, xsB, XP, nullptr, nullptr};
          run_gemm(F, ws + WS_MIX, DM * 2, (const bf16*)(ws + WS_WOUT) + (size_t)DM * DM, DM * 2, MTOK, DM, DM, E); }
        GRID_BAR();
        if (layer == 0) {
            { PH_BEGIN; int lyr = layer; asm volatile("" : "+s"(lyr)); pg8::EpiSwiglu E{(bf16*)(ws + WS_TT), FF, (const float*)(ws + WS_SS) + SS_STRIDE}; run_gemm(F, xsB, XP * 2, ws + WS_W13, DM * 2, MTOK, 2 * FF, DM, E); }
            GRID_BAR();
            { PH_BEGIN; int lyr = layer; asm volatile("" : "+s"(lyr)); pg8::EpiResid<true> E{xsB, xsA, XP, (float*)(ws + WS_SS) + 2 * SS_STRIDE, ws + WS_X8}; run_gemm(F, ws + WS_TT, FF * 2, ws + WS_W2, FF * 2, MTOK, DM, FF, E); }
            GRID_BAR();
        } else {
            { PH_BEGIN; int lyr = layer; asm volatile("" : "+s"(lyr)); p0_moe_weights(F, a, 2 * CONV_PHASE_ITEMS, MOE_NITEMS, F.vcu * NWAVES + F.wave, F.G * NWAVES); __syncthreads();
              norm_router_phase(F, xsB, a.in[6] + DM, ws + WS_H2B, a.in[10], a.in[11], (int*)(ws + WS_SEL), (float*)(ws + WS_WTS), (int*)(ws + WS_CNT)); }
            GRID_BAR();
            { PH_BEGIN; int lyr = layer; asm volatile("" : "+s"(lyr)); route2_phase(F, (const int*)(ws + WS_SEL), (const float*)(ws + WS_WTS), (const int*)(ws + WS_CNT), (int*)(ws + WS_ROWTOK), (float*)(ws + WS_ROWW), (int*)(ws + WS_PLAN)); }
            GRID_BAR();
            { PH_BEGIN; int G_ = F.G, c_ = (int)blockIdx.x; asm volatile("" : "+s"(G_), "+s"(c_));
              const int* plan = (const int*)(ws + WS_PLAN); const int nT0 = __builtin_amdgcn_readfirstlane(plan[0]), nT1 = __builtin_amdgcn_readfirstlane(plan[1]);
              pg8::Gemm g{(const char*)(ws + WS_H2B), (const char*)(ws + WS_M13), DM, DM, DM / 2, (const int*)(ws + WS_ROWTOK)};
              MoeOrder S{nT0, nT0 + nT1, 2 * FF / 256, (nT0 + nT1) * (2 * FF / 256), G_, c_, DM, DM, plan + 16, (size_t)2 * FF * DM, true};
              pg8::EpiSwigluF8 E{ws + WS_TTB, FF, 1.0f / W13_SCALE}; pg8::gemm_phase<pg8::EpiSwigluF8, MoeOrder, true, 0, 0, true>(F.lds, g, S, E); }
            GRID_BAR();
            { PH_BEGIN; int G_ = F.G, c_ = (int)blockIdx.x; asm volatile("" : "+s"(G_), "+s"(c_));
              const int* plan = (const int*)(ws + WS_PLAN); const int nT0 = __builtin_amdgcn_readfirstlane(plan[0]), nT1 = __builtin_amdgcn_readfirstlane(plan[1]);
              pg8::Gemm g{(const char*)(ws + WS_TTB), (const char*)(ws + WS_M2), FF, FF, FF / 2, nullptr};
              MoeOrder S{nT0, nT0 + nT1, DM / 256, (nT0 + nT1) * (DM / 256), G_, c_, FF, FF, plan + 16, (size_t)DM * FF, false};
              pg8::EpiScatterY E{(bf16*)(ws + WS_Y), (const int*)(ws + WS_ROWTOK), (const float*)(ws + WS_ROWW), 1.0f / W2_SCALE, MOE_ROWS, (size_t)MTOK * DM};
              pg8::gemm_phase<pg8::EpiScatterY, MoeOrder, false, 0, 0, true>(F.lds, g, S, E); }
            GRID_BAR();
        }
    }
    { PH_BEGIN; final_norm_phase(F, xout, xsB, a.in[15], (const bf16*)(ws + WS_Y)); }
#undef GRID_BAR
}

extern "C" void kernel_launch(void* const* d_in, const int* in_sizes, int n_in, void* d_out, int out_size, void* d_ws, size_t ws_size, hipStream_t stream) {
    static int grid = 0;
    if (grid == 0) {
        if (n_in != 16 || out_size != MTOK * DM || ws_size < WS_END) { fprintf(stderr, "kernel_launch: unexpected problem (n_in %d, out %d, ws %zu); nothing launched\n", n_in, out_size, ws_size); grid = -1; return; }
        int dev = 0, cus = 0;
        if (hipGetDevice(&dev) != hipSuccess || hipDeviceGetAttribute(&cus, hipDeviceAttributeMultiprocessorCount, dev) != hipSuccess) { grid = -1; return; }
        if (hipFuncSetAttribute((const void*)fwd_kernel, hipFuncAttributeMaxDynamicSharedMemorySize, LDS_BYTES) != hipSuccess) { fprintf(stderr, "kernel_launch: hipFuncSetAttribute failed\n"); grid = -1; return; }
        int per_cu = 0;
        if (hipOccupancyMaxActiveBlocksPerMultiprocessor(&per_cu, (const void*)fwd_kernel, NWAVES * 64, LDS_BYTES) != hipSuccess || per_cu < 1) fprintf(stderr, "kernel_launch: occupancy query reports %d\n", per_cu);
        (void)hipGetLastError();
        if (cus != 256) { fprintf(stderr, "kernel_launch: %d CUs; the router / attention unit maps assume a grid of 256\n", cus); grid = -1; return; }
        grid = cus;
    }
    if (grid < 0) return;
    (void)hipMemsetAsync((char*)d_ws + WS_CTL, 0, CTL_ZERO_BYTES, stream);
    Args a{};
    for (int i = 0; i < 16; ++i) a.in[i] = (const float*)d_in[i];
    a.out = (float*)d_out; a.ws = (unsigned char*)d_ws; a.G = grid; a.pad = 0;
    hipLaunchKernelGGL(fwd_kernel, dim3(grid), dim3(NWAVES * 64), LDS_BYTES, stream, a);
}
```

```cpp
#include <hip/hip_runtime.h>
#include <cstdio>
#include <cstdint>

namespace pg8 {
#define PG8_LAS __attribute__((address_space(3)))
typedef unsigned short bf16_t;
typedef short bf16x8 __attribute__((ext_vector_type(8)));
typedef float f32x4 __attribute__((ext_vector_type(4)));
typedef unsigned u32x4 __attribute__((ext_vector_type(4)));
typedef unsigned u32x2 __attribute__((ext_vector_type(2)));
typedef int v4i_t __attribute__((ext_vector_type(4)));
typedef int v8i_t __attribute__((ext_vector_type(8)));
constexpr int BM = 256, BK = 64, HALF = 128, HTB = HALF * BK * 2  , STAGE_BYTES = 8 * HTB, NXCD = 8, WGM = 4;

__host__ __device__ __forceinline__ int lds_byte(int r, int c) { const int st = (r >> 4) * 2 + (c >> 5), rr = r & 15, cc = c & 31, ob = rr * 64 + cc * 2; return st * 1024 + (ob ^ (((ob >> 9) & 1) << 5)); }
__host__ __device__ __forceinline__ void stage_rc(int b, int& R, int& C) { const int st = b / 1024, sb = b % 1024, swz = sb ^ (((sb >> 9) & 1) << 5); R = (st >> 1) * 16 + swz / 64; C = (st & 1) * 32 + (swz % 64) / 2; }
__host__ __device__ __forceinline__ int perm32(int rho) { const int n = rho >> 4, i = rho & 15; return 8 * (i >> 2) + 4 * n + (i & 3); }

struct Unit { int pm, pn, z; size_t aoff, boff; };
struct Gemm { const char* A; const char* B; unsigned lda, ldb; int K; const int* rows; };

struct PlainOrder {
    int nM, nN, nwg, G, c; unsigned lda, ldb; int bmap, alay, pmoff = 0;
    __device__ void init(int M, int N, int G_, int c_, unsigned lda_, unsigned ldb_, int bmap_ = 0, int alay_ = 0) { nM = M / BM; nN = N / BM; nwg = nM * nN; G = G_; c = c_; lda = lda_; ldb = ldb_; bmap = bmap_; alay = alay_; }
    __device__ bool next(int i, Unit& u) const {
        const long L = (long)i * G + c; if (L >= nwg) return false;
        int wgid = (int)L; { const int q = nwg / NXCD, r = nwg % NXCD, xcd = wgid % NXCD, off = wgid / NXCD; wgid = (xcd < r ? xcd * (q + 1) : r * (q + 1) + (xcd - r) * q) + off; }
        const int nig = WGM * nN, gid = wgid / nig, fm = gid * WGM, gsz = (nM - fm) < WGM ? (nM - fm) : WGM;
        u.pm = fm + ((wgid % nig) % gsz); u.pn = (wgid % nig) / gsz; u.z = 0;
        u.aoff = alay ? (size_t)u.pm * BM * 16 : (size_t)u.pm * BM * lda; u.pm += pmoff;
        if (bmap == 0) u.boff = (size_t)u.pn * BM * ldb;
        else { const int kind = bmap == 1 ? 1 : (u.pm < 2 ? 1 : (u.pm == 2 ? 0 : u.pm - 1)), bb = u.pn >> 4, t = u.pn & 15; u.z = kind;
            const int base = kind == 0 ? 256 * t : (kind == 1 ? 4 * t : (kind == 2 ? 1024 * (t & 3) + (t >> 2) : t));
            u.boff = (size_t)(bb * 4096 + base) * ldb; }
        return true;
    }
};

typedef float f32x2v_t __attribute__((ext_vector_type(2))); typedef __bf16 bf16x2v_t __attribute__((ext_vector_type(2)));
__device__ __forceinline__ unsigned cvt_pk_bf16(float lo, float hi) { const f32x2v_t v = {lo, hi}; return __builtin_bit_cast(unsigned, __builtin_convertvector(v, bf16x2v_t)); }
__device__ __forceinline__ float bf_lo(unsigned w) { return __uint_as_float(w << 16); }
__device__ __forceinline__ float bf_hi(unsigned w) { return __uint_as_float(w & 0xffff0000u); }
__device__ __forceinline__ f32x4 bf4_lo(const u32x4& w) { return (f32x4){bf_lo(w.x), bf_hi(w.x), bf_lo(w.y), bf_hi(w.y)}; }
__device__ __forceinline__ f32x4 bf4_hi(const u32x4& w) { return (f32x4){bf_lo(w.z), bf_hi(w.z), bf_lo(w.w), bf_hi(w.w)}; }
__device__ __forceinline__ unsigned pk_u8x4(const f32x4& g) { const f32x4 t = g * 255.0f; unsigned w = __builtin_amdgcn_cvt_pk_u8_f32(t[0], 0, 0u); w = __builtin_amdgcn_cvt_pk_u8_f32(t[1], 1, w); w = __builtin_amdgcn_cvt_pk_u8_f32(t[2], 2, w); return __builtin_amdgcn_cvt_pk_u8_f32(t[3], 3, w); }
__device__ __forceinline__ f32x4 u8x4_f(unsigned w) { return (f32x4){(float)(w & 0xffu), (float)((w >> 8) & 0xffu), (float)((w >> 16) & 0xffu), (float)(w >> 24)}; }
__device__ __forceinline__ float fast_sigmoid(float x) { return __builtin_amdgcn_rcpf(1.0f + __builtin_amdgcn_exp2f(-1.4426950408889634f * x)); }
__device__ __forceinline__ u32x4 pack8(const f32x4& v0, const f32x4& v1) { u32x4 w; w.x = cvt_pk_bf16(v0[0], v0[1]); w.y = cvt_pk_bf16(v0[2], v0[3]); w.z = cvt_pk_bf16(v1[0], v1[1]); w.w = cvt_pk_bf16(v1[2], v1[3]); return w; }

__device__ __forceinline__ float rstd_of(const float* ss, int row) { const f32x4 p = *(const f32x4*)(ss + (size_t)row * 4); return __builtin_amdgcn_rsqf(((p[0] + p[1]) + (p[2] + p[3])) * (1.0f / 1024.0f) + 1e-6f); }
__device__ __forceinline__ unsigned pk_fp8(float a, float b, unsigned old, bool hi) { a = __builtin_fminf(__builtin_fmaxf(a, -448.f), 448.f); b = __builtin_fminf(__builtin_fmaxf(b, -448.f), 448.f);
    return hi ? (unsigned)__builtin_amdgcn_cvt_pk_fp8_f32(a, b, (int)old, true) : (unsigned)__builtin_amdgcn_cvt_pk_fp8_f32(a, b, (int)old, false); }

struct EpiBf16 {
    static constexpr bool PERM = true;
    bf16_t* O; int ldc; bf16_t* O2; int split; const float* ss; float ascale;
    __device__ __forceinline__ void operator()(const f32x4 (&acc)[2][2][4][2], const Unit& u, int wr, int wc, int fr, int fq) const {
        bf16_t* const O = u.pm >= split ? O2 : this->O;
        const int row0 = (u.pm >= split ? u.pm - split : u.pm) * BM + wr * 64 + fr, col0 = u.pn * BM + wc * 32 + 8 * fq;
        f32x4 cs[2][2]; const int kind = u.z, bb = u.pn >> 4;
#pragma unroll
        for (int bj = 0; bj < 2; ++bj)
#pragma unroll
            for (int e = 0; e < 8; ++e) { const int v = (col0 & 4095) + bj * HALF + e;
                const int pos = kind == 0 ? v : (kind == 1 ? 64 * (v & 63) + (v >> 6) : (kind == 2 ? 4 * (v & 1023) + (v >> 10) : 16 * (v & 255) + (v >> 8)));
                cs[bj][e >> 2][e & 3] = rstd_of(ss, bb * 4096 + pos) * ascale; }
#pragma unroll
        for (int ai = 0; ai < 2; ++ai)
#pragma unroll
            for (int m = 0; m < 4; ++m) { const size_t eo = (size_t)(row0 + ai * HALF + m * 16) * ldc + col0;
#pragma unroll
                for (int bj = 0; bj < 2; ++bj) { const f32x4 v0 = acc[ai][bj][m][0] * cs[bj][0], v1 = acc[ai][bj][m][1] * cs[bj][1];
                    if (u.pm >= split) { u32x2 w8; w8.x = pk_fp8(v0[0], v0[1], 0u, false); w8.x = pk_fp8(v0[2], v0[3], w8.x, true); w8.y = pk_fp8(v1[0], v1[1], 0u, false); w8.y = pk_fp8(v1[2], v1[3], w8.y, true);
                        *(u32x2*)((unsigned char*)O + eo + bj * HALF) = w8; }
                    else *(u32x4*)(O + eo + bj * HALF) = pack8(v0, v1); } }
    }
};
struct EpiInproj {
    static constexpr bool PERM = true;
    unsigned char* ws; size_t oV, oQ, oK, oGF, oGA, oRope; float qscale; const float* ss; float ascale;
    __device__ __forceinline__ void operator()(const f32x4 (&acc)[2][2][4][2], const Unit& u, int wr, int wc, int fr, int fq) const {
        const int row0 = u.pm * BM + wr * 64 + fr, pn = u.pn;
        {
            const bool isq = pn < 3; bf16_t* base = (bf16_t*)(ws + (isq ? oQ : oK)); const float* rope = (const float*)(ws + oRope); const int colt = (isq ? pn : pn - 3) * 256; const float sc = isq ? qscale : 1.0f;
            const int col0 = colt + wc * 32 + 8 * fq, i0 = 16 * (wc & 1) + 4 * fq;
#pragma unroll
            for (int ai = 0; ai < 2; ++ai)
#pragma unroll
                for (int m = 0; m < 4; ++m) { const int row = row0 + ai * HALF + m * 16, pos = row & 4095;
                    const f32x4 cs0 = *(const f32x4*)(rope + (size_t)(pos * 32 + i0) * 2), cs1 = *(const f32x4*)(rope + (size_t)(pos * 32 + i0) * 2 + 4);
                    bf16_t* rowp = base + (size_t)row * 768 + col0; const float rs = rstd_of(ss, row) * ascale;
#pragma unroll
                    for (int bj = 0; bj < 2; ++bj) { const f32x4 v0 = acc[ai][bj][m][0] * rs, v1 = acc[ai][bj][m][1] * rs; f32x4 o0, o1;
                        o0[0] = (v0[0] * cs0[0] - v0[1] * cs0[1]) * sc; o0[1] = (v0[1] * cs0[0] + v0[0] * cs0[1]) * sc;
                        o0[2] = (v0[2] * cs0[2] - v0[3] * cs0[3]) * sc; o0[3] = (v0[3] * cs0[2] + v0[2] * cs0[3]) * sc;
                        o1[0] = (v1[0] * cs1[0] - v1[1] * cs1[1]) * sc; o1[1] = (v1[1] * cs1[0] + v1[0] * cs1[1]) * sc;
                        o1[2] = (v1[2] * cs1[2] - v1[3] * cs1[3]) * sc; o1[3] = (v1[3] * cs1[2] + v1[2] * cs1[3]) * sc;
                        { u32x2 w8; w8.x = pk_fp8(o0[0], o0[1], 0u, false); w8.x = pk_fp8(o0[2], o0[3], w8.x, true); w8.y = pk_fp8(o1[0], o1[1], 0u, false); w8.y = pk_fp8(o1[2], o1[3], w8.y, true);
                               *(u32x2*)((unsigned char*)base + (size_t)row * 768 + col0 + bj * HALF) = w8; } }
                    if (m == 3) asm volatile("" ::: "memory"); }
        }
    }
};
constexpr float WG8_SCALE = 32.0f;
struct EpiGates8 {
    static constexpr bool PERM = true;
    unsigned char* ws; size_t oGF, oGA; const float* ss;
    __device__ __forceinline__ void operator()(const f32x4 (&acc)[2][2][4][2], const Unit& u, int wr, int wc, int fr, int fq) const {
        const int row0 = u.pm * BM + wr * 64 + fr;
        {
            unsigned char* const gfp = ws + oGF; unsigned char* const gap = ws + oGA; const int col0 = u.pn * 128 + wc * 32 + 8 * fq;
#pragma unroll
            for (int ai = 0; ai < 2; ++ai)
#pragma unroll
                for (int m = 0; m < 4; ++m) { const size_t off = (size_t)(row0 + ai * HALF + m * 16) * 1024 + col0; const float rs = (-1.4426950408889634f / WG8_SCALE) * rstd_of(ss, row0 + ai * HALF + m * 16);
                    f32x4 g[2], ga[2];
#pragma unroll
                    for (int n = 0; n < 2; ++n) { const f32x4 xf = acc[ai][0][m][n] * rs, xa = acc[ai][1][m][n] * rs; f32x4 ef, ea, ia;
#pragma unroll
                        for (int j = 0; j < 4; ++j) { ef[j] = __builtin_fminf(__builtin_amdgcn_exp2f(xf[j]), 1.0e18f); ea[j] = __builtin_amdgcn_exp2f(xa[j]); }
                        ef = ef + 1.0f; ea = ea + 1.0f;
#pragma unroll
                        for (int j = 0; j < 4; ++j) { g[n][j] = __builtin_amdgcn_rcpf(ef[j]); ia[j] = __builtin_amdgcn_rcpf(ea[j]); }
                        ga[n] = ia; }
                    u32x2 wf, wa; wf.x = pk_u8x4(g[0]); wf.y = pk_u8x4(g[1]); wa.x = pk_u8x4(ga[0]); wa.y = pk_u8x4(ga[1]);
                    *(u32x2*)(gfp + off) = wf; *(u32x2*)(gap + off) = wa; }
        }
    }
};
struct EpiMix {
    static constexpr bool PERM = true; static constexpr int RESCALE_T = 4;
    const unsigned char* G; const unsigned char* R; bf16_t* O;
    __device__ __forceinline__ void rescale(f32x4 (&acc)[2][2][4][2], const Unit& u, int wr, int wc, int fr, int fq) const {
        asm volatile("" : "+v"(fr), "+v"(fq));
        const int row0 = u.pm * BM + wr * 64 + fr, col0 = u.pn * BM + wc * 32 + 8 * fq;
#pragma unroll
        for (int ai = 0; ai < 2; ++ai)
#pragma unroll
            for (int m = 0; m < 4; ++m) { const unsigned off = (unsigned)(row0 + ai * HALF + m * 16) * 1024u + (unsigned)col0;
#pragma unroll
                for (int bj = 0; bj < 2; ++bj) { const u32x2 ga = *(const u32x2*)(R + off + bj * HALF), gf = *(const u32x2*)(G + off + bj * HALF);
#pragma unroll
                    for (int n = 0; n < 2; ++n) { const f32x4 a4 = u8x4_f(n ? ga.y : ga.x); f32x4 f4 = u8x4_f(n ? gf.y : gf.x), q4;
#pragma unroll
                        for (int j = 0; j < 4; ++j) q4[j] = __builtin_amdgcn_rcpf(__builtin_fmaxf(f4[j], 0.25f));
                        acc[ai][bj][m][n] = acc[ai][bj][m][n] * (a4 * q4); } }
                if (m == 3) asm volatile("" ::: "memory"); }
    }
    __device__ __forceinline__ void operator()(const f32x4 (&acc)[2][2][4][2], const Unit& u, int wr, int wc, int fr, int fq) const {
        const int row0 = u.pm * BM + wr * 64 + fr, col0 = u.pn * BM + wc * 32 + 8 * fq;
#pragma unroll
        for (int ai = 0; ai < 2; ++ai) { u32x2 gq[4][2];
#pragma unroll
            for (int m = 0; m < 4; ++m)
#pragma unroll
                for (int bj = 0; bj < 2; ++bj) gq[m][bj] = *(const u32x2*)(G + (unsigned)(row0 + ai * HALF + m * 16) * 1024u + (unsigned)col0 + bj * HALF);
#pragma unroll
            for (int m = 0; m < 4; ++m) { const unsigned off = (unsigned)(row0 + ai * HALF + m * 16) * 1024u + (unsigned)col0;
#pragma unroll
                for (int bj = 0; bj < 2; ++bj) { f32x4 f0 = u8x4_f(gq[m][bj].x), f1 = u8x4_f(gq[m][bj].y);
#pragma unroll
                    for (int j = 0; j < 4; ++j) { f0[j] = __builtin_fmaxf(f0[j], 0.25f); f1[j] = __builtin_fmaxf(f1[j], 0.25f); }
                    const f32x4 v0 = acc[ai][bj][m][0] * (f0 * (1.0f / 255.0f)), v1 = acc[ai][bj][m][1] * (f1 * (1.0f / 255.0f));
                    *(u32x4*)(O + off + bj * HALF) = pack8(v0, v1); } }
            asm volatile("" ::: "memory"); }
    }
};
template <class E, class = void> struct rescale_at { static constexpr int t = -1; };
template <class E> struct rescale_at<E, decltype((void)E::RESCALE_T)> { static constexpr int t = E::RESCALE_T; };
template <bool SS> struct EpiResid {
    static constexpr bool PERM = true;
    const bf16_t* res; bf16_t* out; int ld; float* ssout; unsigned char* x8;
    __device__ __forceinline__ void operator()(const f32x4 (&acc)[2][2][4][2], const Unit& u, int wr, int wc, int fr, int fq) const {
        const int row0 = u.pm * BM + wr * 64 + fr, col0 = u.pn * BM + wc * 32 + 8 * fq, lane = fq * 16 + fr;
        PG8_LAS float* const part = (PG8_LAS float*)(unsigned)131072;
#pragma unroll
        for (int ai = 0; ai < 2; ++ai) { u32x4 rq[4][2];
#pragma unroll
            for (int m = 0; m < 4; ++m)
#pragma unroll
                for (int bj = 0; bj < 2; ++bj) rq[m][bj] = *(const u32x4*)(res + (size_t)(row0 + ai * HALF + m * 16) * ld + col0 + bj * HALF);
#pragma unroll
            for (int m = 0; m < 4; ++m) { const int row = row0 + ai * HALF + m * 16; const size_t off = (size_t)row * ld + col0; float sq = 0.f;
#pragma unroll
                for (int bj = 0; bj < 2; ++bj) { const u32x4 r = rq[m][bj]; const f32x4 v0 = acc[ai][bj][m][0] + bf4_lo(r), v1 = acc[ai][bj][m][1] + bf4_hi(r);
                    if (SS) { const f32x4 q = v0 * v0 + v1 * v1; sq += (q[0] + q[1]) + (q[2] + q[3]); }
                    *(u32x4*)(out + off + bj * HALF) = pack8(v0, v1);
                    if (x8) { u32x2 w8; w8.x = pk_fp8(v0[0], v0[1], 0u, false); w8.x = pk_fp8(v0[2], v0[3], w8.x, true); w8.y = pk_fp8(v1[0], v1[1], 0u, false); w8.y = pk_fp8(v1[2], v1[3], w8.y, true);
                        *(u32x2*)(x8 + (size_t)row * 1024 + col0 + bj * HALF) = w8; } }
                if (SS) { sq += __int_as_float(__builtin_amdgcn_ds_bpermute((lane ^ 16) << 2, __float_as_int(sq))); sq += __int_as_float(__builtin_amdgcn_ds_bpermute((lane ^ 32) << 2, __float_as_int(sq)));
                    if (fq == 0) part[wc * 256 + wr * 64 + fr + ai * HALF + m * 16] = sq; } }
            asm volatile("" ::: "memory"); }
        if (SS) {
            asm volatile("s_waitcnt lgkmcnt(0)" ::: "memory"); __builtin_amdgcn_s_barrier(); asm volatile("" ::: "memory");
            const int t = (wr * 4 + wc) * 64 + lane;
            if (t < 256) ssout[(size_t)(u.pm * BM + t) * 4 + u.pn] = (part[t] + part[256 + t]) + (part[512 + t] + part[768 + t]);
            asm volatile("s_waitcnt lgkmcnt(0)" ::: "memory"); __builtin_amdgcn_s_barrier(); asm volatile("" ::: "memory");
        }
    }
};
struct EpiSwiglu {
    static constexpr bool PERM = true;
    bf16_t* T; int ldc; const float* ss;
    __device__ __forceinline__ void operator()(const f32x4 (&acc)[2][2][4][2], const Unit& u, int wr, int wc, int fr, int fq) const {
        const int row0 = u.pm * BM + wr * 64 + fr, col0 = u.pn * 128 + wc * 32 + 8 * fq;
#pragma unroll
        for (int ai = 0; ai < 2; ++ai)
#pragma unroll
            for (int m = 0; m < 4; ++m) { const int r = row0 + ai * HALF + m * 16; const float rs = rstd_of(ss, r), rs2 = rs * rs, rse = -1.4426950408889634f * rs; f32x4 o[2];
#pragma unroll
                for (int n = 0; n < 2; ++n) { const f32x4 x = acc[ai][0][m][n] * rse; f32x4 e, q;
#pragma unroll
                    for (int j = 0; j < 4; ++j) e[j] = __builtin_amdgcn_exp2f(x[j]);
                    e = e + 1.0f;
#pragma unroll
                    for (int j = 0; j < 4; ++j) q[j] = __builtin_amdgcn_rcpf(e[j]);
                    o[n] = (acc[ai][0][m][n] * acc[ai][1][m][n]) * (q * rs2); }
                *(u32x4*)(T + (size_t)r * ldc + col0) = pack8(o[0], o[1]); }
    }
};
struct EpiSwigluF8 {
    static constexpr bool PERM = true;
    unsigned char* T; int ldc; float ascale;
    __device__ __forceinline__ void operator()(const f32x4 (&acc)[2][2][4][2], const Unit& u, int wr, int wc, int fr, int fq) const {
        const int row0 = u.pm * BM + wr * 64 + fr, col0 = u.pn * 128 + wc * 32 + 8 * fq;
#pragma unroll
        for (int ai = 0; ai < 2; ++ai)
#pragma unroll
            for (int m = 0; m < 4; ++m) { unsigned char* rowp = T + (size_t)(row0 + ai * HALF + m * 16) * ldc + col0; f32x4 o4[2];
#pragma unroll
                for (int n = 0; n < 2; ++n) { const f32x4 x = acc[ai][0][m][n] * (-1.4426950408889634f * ascale); f32x4 e;
#pragma unroll
                    for (int j = 0; j < 4; ++j) e[j] = __builtin_amdgcn_exp2f(x[j]);
                    e = e + 1.0f; f32x4 r;
#pragma unroll
                    for (int j = 0; j < 4; ++j) r[j] = __builtin_amdgcn_rcpf(e[j]);
                    o4[n] = (acc[ai][0][m][n] * acc[ai][1][m][n]) * (r * (ascale * ascale)); }
                const float* o = (const float*)o4;
                u32x2 w; w.x = pk_fp8(o4[0][0], o4[0][1], 0u, false); w.x = pk_fp8(o4[0][2], o4[0][3], w.x, true); w.y = pk_fp8(o4[1][0], o4[1][1], 0u, false); w.y = pk_fp8(o4[1][2], o4[1][3], w.y, true); (void)o;
                *(u32x2*)rowp = w; }
    }
};
struct EpiScatterY {
    static constexpr bool PERM = true;
    bf16_t* y; const int* rows; const float* w; float ascale; int slot_rows; size_t slot_stride;
    __device__ __forceinline__ void operator()(const f32x4 (&acc)[2][2][4][2], const Unit& u, int wr, int wc, int fr, int fq) const {
        const int row0 = u.pm * BM + wr * 64 + fr, col0 = u.pn * BM + wc * 32 + 8 * fq; bf16_t* const yb = y + (row0 >= slot_rows ? slot_stride : (size_t)0);
#pragma unroll
        for (int ai = 0; ai < 2; ++ai)
#pragma unroll
            for (int m = 0; m < 4; ++m) { const int r = row0 + ai * HALF + m * 16, tok = rows[r]; const float rs = w[r] * ascale;
                if (tok >= 0) { bf16_t* yp = yb + (size_t)tok * 1024 + col0;
#pragma unroll
                    for (int bj = 0; bj < 2; ++bj) *(u32x4*)(yp + bj * HALF) = pack8(acc[ai][bj][m][0] * rs, acc[ai][bj][m][1] * rs); } }
    }
};
template <class Epi, class Sched, bool GATHER = false, int BMAP = 0, int ALAY = 0, bool FP8 = false, bool ALIGN_EPI = true, bool SP2 = true>
__device__ __forceinline__ void gemm_phase(PG8_LAS unsigned char* lds, const Gemm g, const Sched& S, const Epi& E) {
    int tid_ = threadIdx.x; asm volatile("" : "+v"(tid_));
    const int tid = tid_, wid = __builtin_amdgcn_readfirstlane(tid >> 6), lane = tid & 63, wr = wid >> 2, wc = wid & 3, fr = lane & 15, fq = lane >> 4;
    const int K = g.K, nt = K / BK;
    unsigned voffA[2], voffA1[2], nvA0[2], nvA1[2], voffB[2], nvB[2]; int Rg[2], Cg[2], RbS[2];
#pragma unroll
    for (int i = 0; i < 2; ++i) { int R, C; stage_rc(tid * 16 + i * 8192, R, C); const int Rb = Epi::PERM ? ((R & ~31) + perm32(R & 31)) : R; Rg[i] = R; Cg[i] = C * 2;
        voffA[i] = ALAY == 1 ? (unsigned)(C >> 3) * g.lda + (unsigned)R * 16u : (unsigned)R * g.lda + (unsigned)C * 2u; voffA1[i] = voffA[i]; nvA0[i] = voffA[i]; nvA1[i] = voffA[i];
        voffB[i] = (BMAP == 1 ? (unsigned)(64 * (Rb & 63) + (Rb >> 6)) : (unsigned)Rb) * g.ldb + (unsigned)C * 2u; RbS[i] = Rb; }
#define PG8_BKIND(kind_, dv, dh) do { const int _k = (kind_); _Pragma("unroll") for (int _i = 0; _i < 2; ++_i) { const int _r = RbS[_i]; \
        dv[_i] = (unsigned)(_k == 0 ? _r : (_k == 1 ? 64 * (_r & 63) + (_r >> 6) : (_k == 2 ? 4 * _r : 16 * _r))) * g.ldb + (unsigned)Cg[_i]; } \
        dh = (size_t)(_k == 0 ? 128 : (_k == 1 ? 2 : (_k == 2 ? 512 : 2048))) * g.ldb; } while (0)
#define PG8_GROWS(pm_, d0, d1) do { _Pragma("unroll") for (int _i = 0; _i < 2; ++_i) { int _t0 = g.rows[(pm_) * BM + Rg[_i]], _t1 = g.rows[(pm_) * BM + HALF + Rg[_i]]; _t0 = _t0 < 0 ? 0 : _t0; _t1 = _t1 < 0 ? 0 : _t1; \
        d0[_i] = (unsigned)_t0 * g.lda + (unsigned)Cg[_i]; d1[_i] = (unsigned)_t1 * g.lda + (unsigned)Cg[_i]; } } while (0)
    const size_t kstepB = (size_t)(BK * 2), kstepA = ALAY == 1 ? (size_t)8 * g.lda : kstepB;
    const size_t hstepA = GATHER ? (size_t)0 : (ALAY == 1 ? (size_t)HALF * 16 : (size_t)HALF * g.lda); size_t hstepB = (BMAP == 1 ? (size_t)2 : (size_t)HALF) * g.ldb, nhB = hstepB;
    const unsigned ldsw = (unsigned)wid * 1024u;
    const int aoff = lds_byte(wr * 64 + fr, fq * 8), boff = lds_byte(wc * 32 + fr, fq * 8);
#define PG8_SA(b, h) (((b) * 2 + (h)) * HTB)
#define PG8_SB(b, h) ((4 + (b) * 2 + (h)) * HTB)
#define PG8_STAGE(bufoff, gbase, voff) do { _Pragma("unroll") for (int _i = 0; _i < 2; ++_i) \
        __builtin_amdgcn_global_load_lds((const unsigned*)((const char*)(gbase) + (voff)[_i]), (PG8_LAS unsigned*)(lds + (bufoff) + ldsw + _i * 8192), 16, 0, 0); } while (0)
#define PG8_LDA(dst, b, h) do { if constexpr (FP8) { _Pragma("unroll") for (int m = 0; m < 4; ++m) dst##8[m] = PG8_CAT8(*(const PG8_LAS bf16x8*)(lds + PG8_SA(b, h) + aoff + m * 2048), *(const PG8_LAS bf16x8*)(lds + PG8_SA(b, h) + aoff + m * 2048 + 1024)); } \
    else { _Pragma("unroll") for (int m = 0; m < 4; ++m) _Pragma("unroll") for (int k = 0; k < 2; ++k) dst[m][k] = *(const PG8_LAS bf16x8*)(lds + PG8_SA(b, h) + aoff + m * 2048 + k * 1024); } } while (0)
#define PG8_LDB(dst, b, h) do { if constexpr (FP8) { _Pragma("unroll") for (int n = 0; n < 2; ++n) dst##8[n] = PG8_CAT8(*(const PG8_LAS bf16x8*)(lds + PG8_SB(b, h) + boff + n * 2048), *(const PG8_LAS bf16x8*)(lds + PG8_SB(b, h) + boff + n * 2048 + 1024)); } \
    else { _Pragma("unroll") for (int n = 0; n < 2; ++n) _Pragma("unroll") for (int k = 0; k < 2; ++k) dst[n][k] = *(const PG8_LAS bf16x8*)(lds + PG8_SB(b, h) + boff + n * 2048 + k * 1024); } } while (0)
#define PG8_CAT8(lo, hi) __builtin_shufflevector(__builtin_bit_cast(v4i_t, lo), __builtin_bit_cast(v4i_t, hi), 0, 1, 2, 3, 4, 5, 6, 7)
#define PG8_MMA(ai, bj, At, Bt) do { __builtin_amdgcn_s_setprio(1); if constexpr (FP8) { _Pragma("unroll") for (int m = 0; m < 4; ++m) _Pragma("unroll") for (int n = 0; n < 2; ++n) \
        asm volatile("v_mfma_f32_16x16x128_f8f6f4 %0, %1, %2, %0" : "+v"(acc[ai][bj][m][n]) : "v"(Bt##8[n]), "v"(At##8[m])); } else { \
        _Pragma("unroll") for (int m = 0; m < 4; ++m) _Pragma("unroll") for (int n = 0; n < 2; ++n) _Pragma("unroll") for (int k = 0; k < 2; ++k) \
        acc[ai][bj][m][n] = __builtin_amdgcn_mfma_f32_16x16x32_bf16(Bt[n][k], At[m][k], acc[ai][bj][m][n], 0, 0, 0); } __builtin_amdgcn_s_setprio(0); } while (0)
#define PG8_WAIT_V(n) asm volatile("s_waitcnt vmcnt(" #n ")" ::: "memory")
#define PG8_WAIT_L(n) asm volatile("s_waitcnt lgkmcnt(" #n ")" ::: "memory")
#define PG8_BAR __builtin_amdgcn_s_barrier()
#define PG8_SCHED __builtin_amdgcn_sched_barrier(0)
    Unit cur, nxt; int ui = 0;
    if (!S.next(0, cur)) return;
    f32x4 acc[2][2][4][2];
#pragma unroll
    for (int a = 0; a < 2; ++a)
#pragma unroll
        for (int b = 0; b < 2; ++b)
#pragma unroll
            for (int m = 0; m < 4; ++m)
#pragma unroll
                for (int n = 0; n < 2; ++n) acc[a][b][m][n] = (f32x4){0.f, 0.f, 0.f, 0.f};
    bf16x8 At[4][2], B0[2][2], B1[2][2]; v8i_t At8[4], B08[2], B18[2];
    const char* cA = g.A + cur.aoff; const char* cB = g.B + cur.boff;
    if constexpr (GATHER) PG8_GROWS(cur.pm, voffA, voffA1);
    if constexpr (BMAP == 2) { PG8_BKIND(cur.z, voffB, hstepB); nvB[0] = voffB[0]; nvB[1] = voffB[1]; nhB = hstepB; }
    if constexpr (SP2) {
        PG8_STAGE(PG8_SB(0, 0), cB, voffB); PG8_STAGE(PG8_SB(0, 1), cB + hstepB, voffB); PG8_STAGE(PG8_SA(0, 0), cA, voffA); PG8_STAGE(PG8_SA(0, 1), cA + hstepA, voffA1);
        if (wr == 1) PG8_BAR;
        PG8_WAIT_V(2); PG8_BAR;
        PG8_STAGE(PG8_SB(1, 0), cB + kstepB, voffB); PG8_STAGE(PG8_SA(1, 0), cA + kstepA, voffA); PG8_STAGE(PG8_SB(1, 1), cB + hstepB + kstepB, voffB);
        PG8_WAIT_V(6); PG8_BAR;
    } else {
        PG8_STAGE(PG8_SB(0, 0), cB, voffB); PG8_STAGE(PG8_SA(0, 0), cA, voffA); PG8_STAGE(PG8_SB(0, 1), cB + hstepB, voffB); PG8_STAGE(PG8_SA(0, 1), cA + hstepA, voffA);
        if (wr == 1) PG8_BAR;
        PG8_WAIT_V(4); PG8_BAR;
        PG8_STAGE(PG8_SB(1, 0), cB + kstepB, voffB); PG8_STAGE(PG8_SA(1, 0), cA + kstepA, voffA); PG8_STAGE(PG8_SB(1, 1), cB + hstepB + kstepB, voffB);
        PG8_WAIT_V(6); PG8_BAR;
    }
    for (;;) {
        const bool has_next = S.next(ui + 1, nxt);
        const char* nA = has_next ? g.A + nxt.aoff : cA; const char* nB = has_next ? g.B + nxt.boff : cB;
        if constexpr (BMAP == 2) { if (has_next) PG8_BKIND(nxt.z, nvB, nhB); else { nvB[0] = voffB[0]; nvB[1] = voffB[1]; nhB = hstepB; } }
        if constexpr (GATHER) { if (has_next) PG8_GROWS(nxt.pm, nvA0, nvA1); else {
#pragma unroll
            for (int i = 0; i < 2; ++i) { nvA0[i] = voffA[i]; nvA1[i] = voffA1[i]; } } }
#pragma unroll 1
        for (int t = 0; t < nt; t += 2) {
            if constexpr (rescale_at<Epi>::t >= 0) { if (t == rescale_at<Epi>::t) E.rescale(acc, cur, wr, wc, fr, fq); }
            const bool last = (t == nt - 2);
            const char* a1 = cA + (size_t)(t + 1) * kstepA;
            const char* a2 = last ? nA : cA + (size_t)(t + 2) * kstepA; const char* b2 = last ? nB : cB + (size_t)(t + 2) * kstepB;
            const char* a3 = a2 + kstepA; const char* b3 = b2 + kstepB;
            unsigned w0[2], w1[2];
#pragma unroll
            for (int i = 0; i < 2; ++i) { w0[i] = voffA[i]; w1[i] = voffA1[i]; }
            unsigned wB[2] = {voffB[0], voffB[1]}; size_t hB = hstepB;
            if (BMAP == 2 && last) { asm volatile("; next unit's B row map" ::: ); wB[0] = nvB[0]; wB[1] = nvB[1]; hB = nhB; }
            if (GATHER && last) { asm volatile("; next unit's gathered rows" ::: );
#pragma unroll
                for (int i = 0; i < 2; ++i) { w0[i] = nvA0[i]; w1[i] = nvA1[i]; } }
            if constexpr (SP2) {
            PG8_LDB(B0, 0, 0); PG8_LDB(B1, 0, 1); PG8_SCHED; PG8_LDA(At, 0, 0); PG8_STAGE(PG8_SA(1, 1), a1 + hstepA, voffA1);
            PG8_WAIT_V(8); PG8_WAIT_L(0); PG8_BAR; PG8_MMA(0, 0, At, B0); PG8_MMA(0, 1, At, B1); PG8_BAR; PG8_SCHED;
            PG8_LDA(At, 0, 1); PG8_STAGE(PG8_SB(0, 0), b2, wB); PG8_STAGE(PG8_SB(0, 1), b2 + hB, wB); PG8_STAGE(PG8_SA(0, 0), a2, w0);
            PG8_WAIT_V(8); PG8_WAIT_L(0); PG8_BAR; PG8_MMA(1, 0, At, B0); PG8_MMA(1, 1, At, B1); PG8_BAR; PG8_SCHED;
            PG8_LDB(B0, 1, 0); PG8_LDB(B1, 1, 1); PG8_SCHED; PG8_LDA(At, 1, 0); PG8_STAGE(PG8_SA(0, 1), a2 + hstepA, w1);
            PG8_WAIT_V(8); PG8_WAIT_L(0); PG8_BAR; PG8_MMA(0, 0, At, B0); PG8_MMA(0, 1, At, B1); PG8_BAR; PG8_SCHED;
            PG8_LDA(At, 1, 1); PG8_STAGE(PG8_SB(1, 0), b3, wB); PG8_STAGE(PG8_SB(1, 1), b3 + hB, wB); PG8_STAGE(PG8_SA(1, 0), a3, w0);
            PG8_WAIT_V(8); PG8_WAIT_L(0); PG8_BAR; PG8_MMA(1, 0, At, B0); PG8_MMA(1, 1, At, B1); PG8_BAR; PG8_SCHED;
            } else { static_assert(SP2 || (!GATHER && BMAP != 2), "GATHER / BMAP 2 need the SP2 loop");
            PG8_LDB(B0, 0, 0); PG8_SCHED; PG8_LDA(At, 0, 0); PG8_STAGE(PG8_SA(1, 1), a1 + hstepA, voffA);
            PG8_WAIT_L(8); PG8_BAR; PG8_WAIT_L(0); PG8_MMA(0, 0, At, B0); PG8_BAR; PG8_SCHED;
            PG8_LDB(B1, 0, 1); PG8_STAGE(PG8_SB(0, 0), b2, voffB);
            PG8_BAR; PG8_WAIT_L(0); PG8_MMA(0, 1, At, B1); PG8_BAR;
            PG8_LDA(At, 0, 1); PG8_STAGE(PG8_SA(0, 0), a2, voffA);
            PG8_BAR; PG8_WAIT_L(0); PG8_MMA(1, 0, At, B0); PG8_BAR; PG8_SCHED;
            PG8_STAGE(PG8_SB(0, 1), b2 + hstepB, voffB);
            PG8_WAIT_V(6); PG8_BAR; PG8_MMA(1, 1, At, B1); PG8_BAR;
            PG8_LDB(B0, 1, 0); PG8_SCHED; PG8_LDA(At, 1, 0); PG8_STAGE(PG8_SA(0, 1), a2 + hstepA, voffA);
            PG8_WAIT_L(8); PG8_BAR; PG8_WAIT_L(0); PG8_MMA(0, 0, At, B0); PG8_BAR; PG8_SCHED;
            PG8_LDB(B1, 1, 1); PG8_STAGE(PG8_SB(1, 0), b3, voffB);
            PG8_BAR; PG8_WAIT_L(0); PG8_MMA(0, 1, At, B1); PG8_BAR;
            PG8_LDA(At, 1, 1); PG8_STAGE(PG8_SA(1, 0), a3, voffA);
            PG8_BAR; PG8_WAIT_L(0); PG8_MMA(1, 0, At, B0); PG8_BAR; PG8_SCHED;
            PG8_STAGE(PG8_SB(1, 1), b3 + hstepB, voffB);
            PG8_WAIT_V(6); PG8_BAR; PG8_MMA(1, 1, At, B1); PG8_BAR;
            }
        }
        if constexpr (ALIGN_EPI) { if (wr == 0) PG8_BAR; }
        if constexpr (FP8) {
            asm volatile("s_nop 15\n\ts_nop 15\n\ts_nop 15\n\ts_nop 15\n\ts_nop 15\n\ts_nop 15\n\ts_nop 15\n\ts_nop 15" ::: "memory");
#pragma unroll
            for (int a = 0; a < 2; ++a)
#pragma unroll
                for (int b = 0; b < 2; ++b)
#pragma unroll
                    for (int m = 0; m < 4; ++m) asm volatile("" : "+v"(acc[a][b][m][0]), "+v"(acc[a][b][m][1])); }
        E(acc, cur, wr, wc, fr, fq);
        if (!has_next) break;
#pragma unroll
        for (int a = 0; a < 2; ++a)
#pragma unroll
            for (int b = 0; b < 2; ++b)
#pragma unroll
                for (int m = 0; m < 4; ++m)
#pragma unroll
                    for (int n = 0; n < 2; ++n) acc[a][b][m][n] = (f32x4){0.f, 0.f, 0.f, 0.f};
        cur = nxt; cA = nA; cB = nB; ++ui;
        if constexpr (BMAP == 2) { voffB[0] = nvB[0]; voffB[1] = nvB[1]; hstepB = nhB; }
        if constexpr (GATHER) {
#pragma unroll
            for (int i = 0; i < 2; ++i) { voffA[i] = nvA0[i]; voffA1[i] = nvA1[i]; } }
        if constexpr (ALIGN_EPI) { if (wr == 1) PG8_BAR; }
    }
    PG8_WAIT_V(0);
    if constexpr (!ALIGN_EPI) { if (wr == 0) PG8_BAR; }
    PG8_BAR;
#undef PG8_GROWS
#undef PG8_BKIND
#undef PG8_SA
#undef PG8_SB
#undef PG8_STAGE
#undef PG8_LDA
#undef PG8_LDB
#undef PG8_MMA
#undef PG8_CAT8
#undef PG8_WAIT_V
#undef PG8_WAIT_L
#undef PG8_BAR
#undef PG8_SCHED
}
}
#define GAS __attribute__((address_space(1)))
#define LAS __attribute__((address_space(3)))
typedef unsigned short bf16;
typedef unsigned v4u __attribute__((ext_vector_type(4)));
typedef float f32x4 __attribute__((ext_vector_type(4)));
typedef short bf16x8 __attribute__((ext_vector_type(8)));
typedef GAS unsigned gu32;
typedef GAS unsigned long long gu64;
#define RLX_AGENT __ATOMIC_RELAXED, __HIP_MEMORY_SCOPE_AGENT
#define LDS_WAIT() asm volatile("s_waitcnt lgkmcnt(0)" ::: "memory")
#define VM_WAIT() asm volatile("s_waitcnt vmcnt(0)" ::: "memory")
__device__ __forceinline__ unsigned long long rt() { return __builtin_amdgcn_s_memrealtime(); }
__device__ __forceinline__ unsigned f2bf(float f) { unsigned u = __builtin_bit_cast(unsigned, f); return (u + 0x7fffu + ((u >> 16) & 1u)) >> 16; }
__device__ __forceinline__ unsigned pk2(float lo, float hi) { return f2bf(lo) | (f2bf(hi) << 16); }

#define XB_TMO      128
#define XB_XCNT(j)  (256  + 64 * (j))
#define XB_XSUB(j)  (1280 + 64 * (j))
#define XB_XGEN(j)  (2304 + 64 * (j))
#define XB_TOP      3328
#define XB_TOPGEN   3392
#define XCD_BAR_WORDS 3456
#define XB_SPIN_CAP (1u << 18)

__device__ __forceinline__ unsigned xb_ld(unsigned* p)              { return __hip_atomic_load(p, __ATOMIC_RELAXED, __HIP_MEMORY_SCOPE_AGENT); }
__device__ __forceinline__ unsigned xb_add(unsigned* p, unsigned v) { return __hip_atomic_fetch_add(p, v, __ATOMIC_RELAXED, __HIP_MEMORY_SCOPE_AGENT); }
__device__ __forceinline__ unsigned xb_xcc_id() { return (unsigned)__builtin_amdgcn_s_getreg((3 << 11) | 20) & 0xFu; }
#define XB_SPIN(cond, bar) do { unsigned _sp = 0; while (cond) { __builtin_amdgcn_s_sleep(1); \
    if ((++_sp & 255u) == 0u) { if (xb_ld(&(bar)[XB_TMO])) break; if (_sp > XB_SPIN_CAP) { atomicAdd(&(bar)[XB_TMO], 1u); break; } } } } while (0)

struct XcdBarrier {
    unsigned* bar; unsigned x; unsigned G;
    volatile LAS unsigned* st;
};

__device__ __forceinline__ XcdBarrier xcd_barrier_post(unsigned* bar, volatile LAS unsigned* st) {
    XcdBarrier b; b.bar = bar; b.x = xb_xcc_id(); b.st = st; b.G = 0u;
    if (threadIdx.x == 0) (void)xb_add(&bar[XB_XCNT(b.x)], 1u);
    return b;
}
__device__ __forceinline__ void xcd_barrier_complete(unsigned* bar, unsigned x, const unsigned G, unsigned& nloc, unsigned& nx) {
    unsigned sum, cnt, mine, sp = 0u;
    for (;;) {
        sum = 0u; cnt = 0u; mine = 0u;
#pragma nounroll
        for (unsigned j = 0; j < 16; ++j) { const unsigned c = xb_ld(&bar[XB_XCNT(j)]); sum += c; cnt += (c > 0u) ? 1u : 0u; mine = (j == x) ? c : mine; }
        if (sum == G) break;
        __builtin_amdgcn_s_sleep(1);
        if ((++sp & 255u) == 0u) { if (xb_ld(&bar[XB_TMO])) break; if (sp > XB_SPIN_CAP) { atomicAdd(&bar[XB_TMO], 1u); break; } }
    }
    nloc = mine > 0u ? mine : 1u; nx = cnt > 0u ? cnt : 1u;
}

__device__ __forceinline__ void xcd_barrier(const XcdBarrier& b) {
    asm volatile("s_waitcnt vmcnt(0)" ::: "memory");
    __syncthreads();
    if (threadIdx.x == 0) {
        unsigned* bar = b.bar;
        __builtin_amdgcn_s_waitcnt(0);
        unsigned nloc = b.st[0], nx = b.st[1];
        if (nloc == 0u) { xcd_barrier_complete(bar, b.x, b.G, nloc, nx); b.st[0] = nloc; b.st[1] = nx; }
        const unsigned old = xb_add(&bar[XB_XSUB(b.x)], 1u);
        const unsigned gen = old / nloc;
        if (old + 1u == (gen + 1u) * nloc) {
            __builtin_amdgcn_fence(__ATOMIC_RELEASE, "agent");
            asm volatile("s_waitcnt vmcnt(0)" ::: "memory");
            const unsigned og = xb_add(&bar[XB_TOP], 1u);
            const unsigned tg = og / nx;
            if (og + 1u == (tg + 1u) * nx) xb_add(&bar[XB_TOPGEN], 1u);
            else XB_SPIN(xb_ld(&bar[XB_TOPGEN]) == tg, bar);
            __builtin_amdgcn_fence(__ATOMIC_ACQUIRE, "agent");
            xb_add(&bar[XB_XGEN(b.x)], 1u);
            asm volatile("s_waitcnt vmcnt(0)" ::: "memory");
        } else {
            XB_SPIN(xb_ld(&bar[XB_XGEN(b.x)]) == gen, bar);
            __builtin_amdgcn_fence(__ATOMIC_ACQUIRE, "agent");
            asm volatile("s_waitcnt vmcnt(0)" ::: "memory");
        }
    }
    __syncthreads();
}

constexpr int NWAVES = 8;
constexpr int BATCH = 8, SEQ = 4096, DM = 1024, MTOK = BATCH * SEQ, INC = 4864, FF = 3584, NEXP = 8, AW = 768, AOW = 256;
constexpr float RMS_EPS = 1e-6f;
constexpr float QSCALE = 0.125f * 1.4426950408889634f;

constexpr size_t MiB = 1u << 20;
constexpr size_t WS_CTL = 0, CTL_ZERO_BYTES = 1 * MiB;
constexpr size_t WS_WIN = 1 * MiB;
constexpr size_t WIN_L = (size_t)INC * DM * 2;
constexpr size_t WS_WM = 20 * MiB; constexpr int KMIX = AOW + DM;
constexpr size_t WS_WOUT = 25 * MiB;
constexpr size_t WS_W13 = 29 * MiB;
constexpr size_t WS_W2 = 43 * MiB;
constexpr size_t WS_ROPE = 50 * MiB;
constexpr size_t WS_SS = 502 * MiB, SS_STRIDE = (size_t)MTOK * 4;
constexpr size_t WS_H = 118 * MiB;
constexpr size_t WS_Z = WS_H;
constexpr size_t WS_UT = 182 * MiB;
constexpr size_t WS_OATT = WS_Z - (size_t)(AOW / 8) * MTOK * 16;
constexpr size_t WS_Q = 214 * MiB, WS_K = 262 * MiB, WS_V = 310 * MiB;
constexpr size_t WS_GF = 358 * MiB, WS_GA = 422 * MiB;
constexpr size_t WS_MIX = 278 * MiB;
constexpr size_t WS_H2 = 118 * MiB, WS_TT = 182 * MiB;
constexpr size_t WS_M13 = 54 * MiB, WS_M2 = 110 * MiB;
constexpr size_t WS_H2B = 138 * MiB, WS_TTB = 170 * MiB;
constexpr float W13_SCALE = 32.0f, W2_SCALE = 64.0f;
constexpr int MOE_ROWS = MTOK + 2048;
constexpr int MOE_TILES = MOE_ROWS / 256;
constexpr size_t WS_ROWTOK = 52 * MiB, WS_ROWW = WS_ROWTOK + 512 * 1024;
constexpr size_t WS_SEL = 53 * MiB, WS_WTS = WS_SEL + 128 * 1024;
constexpr size_t WS_CNT = WS_WTS + 256 * 1024, WS_PLAN = WS_CNT + 64 * 1024;
constexpr size_t WS_WG8 = 96 * MiB;
constexpr size_t WS_WQK8 = 486 * MiB;
constexpr size_t WS_WV8 = 490 * MiB;
constexpr size_t WS_X8 = 504 * MiB;
constexpr float WG_SCALE = pg8::WG8_SCALE;
constexpr size_t WS_Y = 408 * MiB;
constexpr size_t WS_END = 536 * MiB;
static_assert(WS_TTB + (size_t)2 * MOE_ROWS * FF <= WS_Y && WS_Y + (size_t)2 * MTOK * DM * 2 <= WS_END && 2 * MOE_ROWS * 4 <= 512 * 1024 && WS_PLAN + 4096 <= 54 * MiB, "moe map");
static_assert(WS_M13 + (size_t)8 * 2 * FF * DM <= WS_M2 && WS_M2 + (size_t)8 * DM * FF <= WS_H2B && WS_H2B + (size_t)MTOK * DM <= WS_TTB && WS_MIX + (size_t)MTOK * DM * 2 <= WS_GF, "d_ws map");

constexpr int XP = 2 * DM;
constexpr int CW_BAR = 4096;
constexpr int RING_BYTES = 131072, LDS_BYTES = 147456, LDSCTL_OFF = LDS_BYTES - 1024, MISC_OFF = LDSCTL_OFF + 320;
static_assert(512 * 68 * 4 <= LDSCTL_OFF, "attention state fits under the control words");

struct Args { const float* in[16]; float* out; unsigned char* ws; int G, pad; };

struct Frame { LAS unsigned char* lds; volatile LAS unsigned* MISC; gu32* ctl; int tid, lane, wave, vcu, G; };

__device__ __forceinline__ float wave_sum(float v, int lane) {
#pragma unroll
    for (int o = 1; o < 64; o <<= 1) v += __int_as_float(__builtin_amdgcn_ds_bpermute((lane ^ o) << 2, __float_as_int(v)));
    return v;
}
__device__ __forceinline__ float bflo(unsigned w) { return __uint_as_float(w << 16); }
__device__ __forceinline__ float bfhi(unsigned w) { return __uint_as_float(w & 0xffff0000u); }

struct RowMap { int kind, base;
    __device__ __forceinline__ int operator()(int n) const {
        if (kind == 0) return n + base;
        if (kind == 2) return (n >> 2) * 8 + (n & 3) + base;
        if (kind == 5) { const int isk = n >= 768, c = n - (isk ? 768 : 0), hd = c >> 6, d = c & 63; return (isk ? 768 : 0) + hd * 64 + 2 * (d & 31) + (d >> 5); }
        if (kind == 4) { const int gch = n & 1023; return (gch >> 7) * 256 + (gch & 127) + (n >= 1024 ? 128 : 0); }
        if (kind == 3) return (n >> 7) * 256 + (n & 127) + base;
        if (n < 512) return n;
        if (n < 2048) { const int isk = n >= 1280, c = n - (isk ? 1280 : 512), hd = c >> 6, d = c & 63; return (isk ? 2048 : 1280) + hd * 64 + 2 * (d & 31) + (d >> 5); }
        if (n < 2816) return 512 + (n - 2048);
        { const int gch = (n - 2816) & 1023; return 2816 + (gch >> 7) * 256 + (gch & 127) + (n >= 3840 ? 128 : 0); }
    } };
struct TrJob { const float* W; int N; void* WT; int ldk; RowMap rm; const float* gain; float scale; int item; int ldw; int f8; };
__device__ __forceinline__ void tr_load(const TrJob& j, int lane, float (&r)[32]) {
    const int nblk = j.N / 32, kb = j.item / nblk, nb = j.item % nblk, k0 = 64 * kb, n0 = 32 * nb;
#pragma unroll
    for (int i = 0; i < 32; ++i) { const int kk = 2 * i + (lane >> 5); r[i] = j.W[(size_t)(k0 + kk) * (j.ldw ? j.ldw : j.N) + n0 + (lane & 31)]; }
}
template <bool F8> __device__ __forceinline__ void tr_store(const TrJob& j, int lane, const float (&r)[32], LAS float* scr) {
    const int nblk = j.N / 32, kb = j.item / nblk, nb = j.item % nblk, k0 = 64 * kb, n0 = 32 * nb;
#pragma unroll
    for (int i = 0; i < 32; ++i) { const int kk = 2 * i + (lane >> 5); scr[kk * 33 + (lane & 31)] = r[i] * (j.gain ? j.scale * j.gain[k0 + kk] : j.scale); }
    LDS_WAIT(); asm volatile("" ::: "memory");
    const int c = lane & 7;
#pragma unroll
    for (int q = 0; q < 4; ++q) { const int n = (lane >> 3) + 8 * q; const LAS float* sp = scr + (8 * c) * 33 + n; const size_t drow = (size_t)j.rm(n0 + n) * j.ldk + k0 + 8 * c;
        if (F8) { unsigned lo = pg8::pk_fp8(sp[0 * 33], sp[1 * 33], 0u, false); lo = pg8::pk_fp8(sp[2 * 33], sp[3 * 33], lo, true);
                  unsigned hi = pg8::pk_fp8(sp[4 * 33], sp[5 * 33], 0u, false); hi = pg8::pk_fp8(sp[6 * 33], sp[7 * 33], hi, true);
                  *(GAS unsigned long long*)((unsigned char*)j.WT + drow) = (unsigned long long)lo | ((unsigned long long)hi << 32); }
        else { v4u o; o.x = pk2(sp[0 * 33], sp[1 * 33]); o.y = pk2(sp[2 * 33], sp[3 * 33]); o.z = pk2(sp[4 * 33], sp[5 * 33]); o.w = pk2(sp[6 * 33], sp[7 * 33]);
               *(GAS v4u*)((bf16*)j.WT + drow) = o; } }
    LDS_WAIT(); asm volatile("" ::: "memory");
}
__device__ __forceinline__ void rms_row(const bf16* xrow, const f32x4 (&gn)[4], f32x4 (&v)[4], int lane) {
    const GAS unsigned long long* xr = (const GAS unsigned long long*)xrow + lane; float s = 0.f;
#pragma unroll
    for (int j = 0; j < 4; ++j) { const unsigned long long w = xr[64 * j]; v[j].x = bflo((unsigned)w); v[j].y = bfhi((unsigned)w); v[j].z = bflo((unsigned)(w >> 32)); v[j].w = bfhi((unsigned)(w >> 32)); s += (v[j].x * v[j].x + v[j].y * v[j].y) + (v[j].z * v[j].z + v[j].w * v[j].w); }
    const float rstd = 1.0f / sqrtf(wave_sum(s, lane) * (1.0f / DM) + RMS_EPS);
#pragma unroll
    for (int j = 0; j < 4; ++j) v[j] = v[j] * rstd * gn[j];
}
__device__ __forceinline__ void prep_x_phase(Frame& F, const float* x, bf16* xb, float* ss, unsigned char* x8) {
    const int gw = F.vcu * NWAVES + F.wave, NGW = F.G * NWAVES;
    for (int m = gw; m < MTOK; m += NGW) { const GAS f32x4* xr = (const GAS f32x4*)(x + (size_t)m * DM) + F.lane; f32x4 v[4]; float sq = 0.f;
#pragma unroll
        for (int j = 0; j < 4; ++j) { v[j] = xr[64 * j]; sq += (v[j].x * v[j].x + v[j].y * v[j].y) + (v[j].z * v[j].z + v[j].w * v[j].w); }
        sq = wave_sum(sq, F.lane); if (F.lane < 4) ss[(size_t)m * 4 + F.lane] = F.lane == 0 ? sq : 0.f;
        GAS unsigned long long* o8 = (GAS unsigned long long*)(xb + (size_t)m * XP) + F.lane;
#pragma unroll
        for (int j = 0; j < 4; ++j) o8[64 * j] = (unsigned long long)pk2(v[j].x, v[j].y) | ((unsigned long long)pk2(v[j].z, v[j].w) << 32);
        GAS unsigned* q8 = (GAS unsigned*)(x8 + (size_t)m * DM) + F.lane;
#pragma unroll
        for (int j = 0; j < 4; ++j) { unsigned w8 = pg8::pk_fp8(v[j].x, v[j].y, 0u, false); w8 = pg8::pk_fp8(v[j].z, v[j].w, w8, true); q8[64 * j] = w8; } }
}

__device__ __forceinline__ TrJob dense_job(const Args& a, int it) {
    unsigned char* ws = a.ws;
    constexpr int I_U = 16 * (512 / 32), I_V = 16 * (768 / 32), I_AT = 4 * 32, I_OUT = 16 * 32, I_W1 = 16 * (FF / 32), I_G = 16 * (2048 / 32), I_QK = 16 * (1536 / 32);
    constexpr int PER_L = I_U + I_V + I_AT + I_OUT;
    int r = it; TrJob j; j.gain = nullptr; j.scale = 1.0f; j.rm = RowMap{0, 0}; j.ldw = 0; j.f8 = 0;
    if (r < 2 * PER_L) { const int l = r / PER_L; r -= l * PER_L;
        if (r < I_U) { j.W = a.in[2] + (size_t)l * DM * INC; j.N = 512; j.ldw = INC; j.WT = ws + WS_WIN + l * WIN_L; j.ldk = DM; j.gain = a.in[1] + l * DM; }
        else if (r < I_U + I_V) { r -= I_U; j.W = a.in[2] + (size_t)l * DM * INC + 2048; j.N = 768; j.ldw = INC; j.WT = ws + WS_WV8 + (size_t)l * 768 * DM; j.ldk = DM; j.gain = a.in[1] + l * DM; j.scale = WG_SCALE; j.f8 = 1; }
        else if (r < I_U + I_V + I_AT) { r -= I_U + I_V; j.W = a.in[4] + (size_t)l * AOW * DM; j.N = DM; j.WT = (bf16*)(ws + WS_WM) + (size_t)l * DM * KMIX; j.ldk = KMIX; }
        else { r -= I_U + I_V + I_AT; j.W = a.in[5] + (size_t)l * DM * DM; j.N = DM; j.WT = (bf16*)(ws + WS_WOUT) + (size_t)l * DM * DM; j.ldk = DM; } }
    else { r -= 2 * PER_L;
        if (r < I_W1) { j.W = a.in[7]; j.N = FF; j.WT = ws + WS_W13; j.ldk = DM; j.rm = RowMap{3, 0}; j.gain = a.in[6]; }
        else if (r < 2 * I_W1) { r -= I_W1; j.W = a.in[8]; j.N = FF; j.WT = ws + WS_W13; j.ldk = DM; j.rm = RowMap{3, 128}; j.gain = a.in[6]; }
        else if (r < 3 * I_W1) { r -= 2 * I_W1; j.W = a.in[9]; j.N = DM; j.WT = ws + WS_W2; j.ldk = FF; }
        else if (r < 3 * I_W1 + 2 * I_G) { r -= 3 * I_W1; const int l = r / I_G; r -= l * I_G; j.W = a.in[2] + (size_t)l * DM * INC + 2816; j.N = 2048; j.ldw = INC; j.WT = ws + WS_WG8 + (size_t)l * 2048 * DM; j.ldk = DM; j.rm = RowMap{4, 0};
               j.gain = a.in[1] + l * DM; j.scale = WG_SCALE; j.f8 = 1; }
        else { r -= 3 * I_W1 + 2 * I_G; const int l = r / I_QK; r -= l * I_QK; j.W = a.in[2] + (size_t)l * DM * INC + 512; j.N = 1536; j.ldw = INC; j.WT = ws + WS_WQK8 + (size_t)l * 1536 * DM; j.ldk = DM; j.rm = RowMap{5, 0};
               j.gain = a.in[1] + l * DM; j.scale = WG_SCALE; j.f8 = 1; } }
    j.item = r; return j;
}
constexpr int MOE_I_W1 = 16 * (FF / 32), MOE_I_W2 = (FF / 64) * 32, MOE_NITEMS = NEXP * (2 * MOE_I_W1 + MOE_I_W2), MOE_EARLY_E = 6, MOE_EARLY = MOE_EARLY_E * 2 * MOE_I_W1;
constexpr int CONV_WGS = 40, GEMM_WGS = 256 - CONV_WGS, CONV_PER_WAVE = 0, CONV_PHASE_ITEMS = CONV_WGS * NWAVES * CONV_PER_WAVE;
static_assert(2 * CONV_PHASE_ITEMS <= MOE_EARLY && GEMM_WGS % 8 == 0 && (640 + GEMM_WGS - 1) / GEMM_WGS == 3, "early conversion");
__device__ __forceinline__ TrJob moe_job(const Args& a, int v) {
    unsigned char* ws = a.ws;
    constexpr int I_W1 = MOE_I_W1;
    int e, r;
    if (v < MOE_EARLY) { e = v / (2 * I_W1); r = v - e * (2 * I_W1); }
    else { v -= MOE_EARLY; if (v < (NEXP - MOE_EARLY_E) * 2 * I_W1) { const int q = v / (2 * I_W1); e = MOE_EARLY_E + q; r = v - q * (2 * I_W1); } else { v -= (NEXP - MOE_EARLY_E) * 2 * I_W1; e = v / MOE_I_W2; r = 2 * I_W1 + (v - e * MOE_I_W2); } }
    TrJob j; j.gain = nullptr; j.scale = W13_SCALE; j.rm = RowMap{3, 0}; j.ldw = 0; j.f8 = 1;
    if (r < I_W1) { j.W = a.in[12] + (size_t)e * DM * FF; j.N = FF; j.WT = ws + WS_M13 + (size_t)e * 2 * FF * DM; j.ldk = DM; }
    else if (r < 2 * I_W1) { r -= I_W1; j.W = a.in[13] + (size_t)e * DM * FF; j.N = FF; j.WT = ws + WS_M13 + (size_t)e * 2 * FF * DM; j.ldk = DM; j.rm = RowMap{3, 128}; }
    else { r -= 2 * I_W1; j.W = a.in[14] + (size_t)e * FF * DM; j.N = DM; j.WT = ws + WS_M2 + (size_t)e * DM * FF; j.ldk = FF; j.scale = W2_SCALE; j.rm = RowMap{0, 0}; }
    j.item = r; return j;
}
__device__ __forceinline__ void p0_weights(Frame& F, const Args& a) {
    LAS float* scr = (LAS float*)(F.lds + F.wave * 16384);
    const int gw = F.vcu * NWAVES + F.wave, NGW = F.G * NWAVES;
    constexpr int I_IN = 16 * (512 / 32) + 16 * (768 / 32), I_AT = 4 * 32, I_OUT = 16 * 32, I_W1 = 16 * (FF / 32), I_W2 = (FF / 64) * 32, I_G = 16 * (2048 / 32), I_QK = 16 * (1536 / 32), NITEMS = 2 * (I_IN + I_AT + I_OUT) + 2 * I_W1 + I_W2 + 2 * I_G + 2 * I_QK;
    static_assert(I_W2 == I_W1, "dense_job counts w2's items as I_W1");
    if (gw >= NITEMS) return;
    TrJob cur = dense_job(a, gw); float rc[32]; tr_load(cur, F.lane, rc);
#pragma unroll 1
    for (int it = gw; it < NITEMS; it += NGW) { const int nx = it + NGW; const bool more = nx < NITEMS; TrJob nj = cur; float rn[32];
        if (more) { nj = dense_job(a, nx); tr_load(nj, F.lane, rn); }
        if (cur.f8) tr_store<true>(cur, F.lane, rc, scr); else tr_store<false>(cur, F.lane, rc, scr);
        if (more) { cur = nj;
#pragma unroll
            for (int i = 0; i < 32; ++i) rc[i] = rn[i]; } }
}
__device__ __forceinline__ void p0_moe_weights(Frame& F, const Args& a, int first, int NITEMS, int gw, int NGW) {
    LAS float* scr = (LAS float*)(F.lds + F.wave * 16384);
    gw += first;
    if (gw >= NITEMS) return;
    TrJob cur = moe_job(a, gw), nx1 = cur; float rc[32], r1[32];
    tr_load(cur, F.lane, rc);
    if (gw + NGW < NITEMS) { nx1 = moe_job(a, gw + NGW); tr_load(nx1, F.lane, r1); }
#pragma unroll 1
    for (int it = gw; it < NITEMS; it += NGW) { const int n2 = it + 2 * NGW; const bool more2 = n2 < NITEMS, more1 = it + NGW < NITEMS; TrJob nx2 = cur; float r2[32];
        if (more2) { nx2 = moe_job(a, n2); tr_load(nx2, F.lane, r2); }
        tr_store<true>(cur, F.lane, rc, scr);
        if (more1) { cur = nx1;
#pragma unroll
            for (int i = 0; i < 32; ++i) rc[i] = r1[i]; }
        if (more2) { nx1 = nx2;
#pragma unroll
            for (int i = 0; i < 32; ++i) r1[i] = r2[i]; } }
}
__device__ __forceinline__ void p0_tables(Frame& F, const Args& a) {
    unsigned char* ws = a.ws;
    const int gt = F.vcu * (NWAVES * 64) + F.tid, NGT = F.G * NWAVES * 64;
    float* rope = (float*)(ws + WS_ROPE);
    for (int i = gt; i < SEQ * 32; i += NGT) { const int pos = i >> 5, f = i & 31; const float inv = powf(10000.0f, -(float)f * 2.0f / 64.0f); const float ang = (float)pos * inv;
        rope[2 * i] = cosf(ang); rope[2 * i + 1] = sinf(ang); }
    LAS float* tab = (LAS float*)F.lds;
    LAS float* wl = (LAS float*)(F.lds + 1024 + F.wave * 2048);
    if (F.tid < 128) tab[F.tid] = cospif((float)F.tid * (1.0f / 64.0f));
    __syncthreads();
    const int gw = F.vcu * NWAVES + F.wave, NGW = F.G * NWAVES;
    for (int it = gw; it < 2 * DM; it += NGW) { const int l = it >> 10, j = it & 1023; const float* wf = a.in[3] + (size_t)l * 512 * DM + j;
#pragma unroll
        for (int q = 0; q < 8; ++q) wl[F.lane + 64 * q] = wf[(size_t)(F.lane + 64 * q) * DM];
        LDS_WAIT(); asm volatile("" ::: "memory");
#pragma unroll 1
        for (int o = 0; o < 16; ++o) { const int kk = o * 64 + F.lane, part = kk & 1, cf = 4 * (kk >> 3) + ((kk >> 1) & 3), g = cf >> 7, c = cf & 127, sh = part ? 96 : 0;
            const float c1 = tab[c], tw = 2.0f * c1; float u0 = part ? 0.f : 1.f, u1 = part ? tab[(c + sh) & 127] : c1;
            float acc = 0.f, acc2 = 0.f; const LAS float* wg = wl + g * 128;
#pragma unroll 4
            for (int kc = 0; kc < 128; kc += 4) { const f32x4 w4 = *(const LAS f32x4*)(wg + kc);
                const float u2 = tw * u1 - u0, u3 = tw * u2 - u1; acc += u0 * w4[0]; acc2 += u1 * w4[1]; acc += u2 * w4[2]; acc2 += u3 * w4[3]; u0 = tw * u3 - u2; u1 = tw * u0 - u3; }
            acc += acc2;
            ((bf16*)(ws + WS_WM))[(size_t)l * DM * KMIX + (size_t)j * KMIX + AOW + kk] = (bf16)f2bf(acc * 0.08838834764831845f); }
        LDS_WAIT(); asm volatile("" ::: "memory");
    }
}

__device__ __forceinline__ void fft_phase(Frame& F, const bf16* UT, bf16* Zb) {
    const int lane = F.lane, w = F.wave & 3, cg = F.wave >> 2, lr = lane & 15, lg = lane >> 4;
    LAS unsigned char* f2 = F.lds; LAS unsigned char* f1 = F.lds + 16384; LAS float* tw = (LAS float*)(F.lds + 32768);
#pragma unroll 1
    for (int idx = F.tid; idx < 4096; idx += NWAVES * 64) {
        { const int f = idx >> 8, l = (idx >> 2) & 63, e2 = idx & 3, q = f >> 2, KK = (f >> 1) & 1, cs = f & 1, llr = l & 15, llg = l >> 4; float v[2];
#pragma unroll
          for (int h = 0; h < 2; ++h) { const int e = 2 * e2 + h, n2 = 32 * KK + (e < 4 ? 4 * llg + e : 16 + 4 * llg + e - 4), k2 = 16 * q + llr; const float x = (float)((n2 * k2) & 63) * (1.0f / 32.0f); v[h] = (cs ? sinpif(x) : cospif(x)) * 0.125f; }
          *(LAS unsigned*)(f2 + f * 1024 + l * 16 + e2 * 4) = pk2(v[0], v[1]); }
        { const int f = idx >> 8, l = (idx >> 2) & 63, e2 = idx & 3, ww = f >> 2, kk = (f >> 1) & 1, cs = f & 1, llr = l & 15, llg = l >> 4; float v[2];
#pragma unroll
          for (int h = 0; h < 2; ++h) { const int n1 = 32 * kk + 8 * llg + 2 * e2 + h, k1 = 16 * ww + llr; const float x = (float)((n1 * k1) & 63) * (1.0f / 32.0f); v[h] = (cs ? -sinpif(x) : cospif(x)) * 0.125f; }
          *(LAS unsigned*)(f1 + f * 1024 + l * 16 + e2 * 4) = pk2(v[0], v[1]); }
        { const int ww = idx >> 10, l = (idx >> 4) & 63, ir = idx & 15, n2 = 16 * (ir >> 2) + 4 * (l >> 4) + (ir & 3), k1 = 16 * ww + (l & 15); const float x = (float)(n2 * k1) * (1.0f / 2048.0f);
          tw[(ww * 64 + l) * 32 + ir] = cospif(x); tw[(ww * 64 + l) * 32 + 16 + ir] = sinpif(x); }
    }
    __syncthreads();
    bf16x8 F1c[2], F1s[2];
#pragma unroll
    for (int kk = 0; kk < 2; ++kk) { F1c[kk] = *(const LAS bf16x8*)(f1 + ((w * 2 + kk) * 2) * 1024 + lane * 16); F1s[kk] = *(const LAS bf16x8*)(f1 + ((w * 2 + kk) * 2 + 1) * 1024 + lane * 16); }
    float twc[4][4], tws[4][4];
#pragma unroll
    for (int I = 0; I < 4; ++I) { const f32x4 tc = *(const LAS f32x4*)(tw + (w * 64 + lane) * 32 + 4 * I), ts = *(const LAS f32x4*)(tw + (w * 64 + lane) * 32 + 16 + 4 * I);
#pragma unroll
        for (int r = 0; r < 4; ++r) { twc[I][r] = tc[r]; tws[I][r] = ts[r]; } }
    for (int it = F.vcu * 2 + cg; it < BATCH * 128; it += F.G * 2) {
        const int b = it >> 7, quad = it & 127;
        unsigned outp[4][4][4];
#pragma unroll
        for (int cc = 0; cc < 4; ++cc) {
            const bf16* xp = UT + (size_t)(quad * 4 + cc) * MTOK + b * SEQ + 64 * lr + 8 * lg;
            bf16x8 xa[4][2];
#pragma unroll
            for (int I = 0; I < 4; ++I)
#pragma unroll
                for (int kk = 0; kk < 2; ++kk) xa[I][kk] = *(const GAS bf16x8*)(xp + 1024 * I + 32 * kk);
            f32x4 d1r[4], d1i[4];
#pragma unroll
            for (int I = 0; I < 4; ++I) { d1r[I] = (f32x4){0.f, 0.f, 0.f, 0.f}; d1i[I] = (f32x4){0.f, 0.f, 0.f, 0.f};
#pragma unroll
                for (int kk = 0; kk < 2; ++kk) { d1r[I] = __builtin_amdgcn_mfma_f32_16x16x32_bf16(xa[I][kk], F1c[kk], d1r[I], 0, 0, 0); d1i[I] = __builtin_amdgcn_mfma_f32_16x16x32_bf16(xa[I][kk], F1s[kk], d1i[I], 0, 0, 0); } }
            bf16x8 yr[2], yi[2], yn[2];
#pragma unroll
            for (int KK = 0; KK < 2; ++KK) { float vr[8], vi[8];
#pragma unroll
                for (int e = 0; e < 8; ++e) { const int I = 2 * KK + (e >> 2), r = e & 3; const float a = d1r[I][r], bb = d1i[I][r]; vr[e] = a * twc[I][r] + bb * tws[I][r]; vi[e] = bb * twc[I][r] - a * tws[I][r]; }
                v4u pr, pi, pn; pr.x = pg8::cvt_pk_bf16(vr[0], vr[1]); pr.y = pg8::cvt_pk_bf16(vr[2], vr[3]); pr.z = pg8::cvt_pk_bf16(vr[4], vr[5]); pr.w = pg8::cvt_pk_bf16(vr[6], vr[7]);
                pi.x = pg8::cvt_pk_bf16(vi[0], vi[1]); pi.y = pg8::cvt_pk_bf16(vi[2], vi[3]); pi.z = pg8::cvt_pk_bf16(vi[4], vi[5]); pi.w = pg8::cvt_pk_bf16(vi[6], vi[7]);
                pn.x = pr.x ^ 0x80008000u; pn.y = pr.y ^ 0x80008000u; pn.z = pr.z ^ 0x80008000u; pn.w = pr.w ^ 0x80008000u;
                yr[KK] = __builtin_bit_cast(bf16x8, pr); yi[KK] = __builtin_bit_cast(bf16x8, pi); yn[KK] = __builtin_bit_cast(bf16x8, pn); }
#pragma unroll
            for (int q = 0; q < 4; ++q) { f32x4 zr = (f32x4){0.f, 0.f, 0.f, 0.f}, zi = (f32x4){0.f, 0.f, 0.f, 0.f};
#pragma unroll
                for (int KK = 0; KK < 2; ++KK) { const bf16x8 fc = *(const LAS bf16x8*)(f2 + ((q * 2 + KK) * 2) * 1024 + lane * 16), fs = *(const LAS bf16x8*)(f2 + ((q * 2 + KK) * 2 + 1) * 1024 + lane * 16);
                    zr = __builtin_amdgcn_mfma_f32_16x16x32_bf16(yr[KK], fc, zr, 0, 0, 0); zr = __builtin_amdgcn_mfma_f32_16x16x32_bf16(yi[KK], fs, zr, 0, 0, 0);
                    zi = __builtin_amdgcn_mfma_f32_16x16x32_bf16(yi[KK], fc, zi, 0, 0, 0); zi = __builtin_amdgcn_mfma_f32_16x16x32_bf16(yn[KK], fs, zi, 0, 0, 0); }
#pragma unroll
                for (int r = 0; r < 4; ++r) outp[q][r][cc] = pg8::cvt_pk_bf16(zr[r], zi[r]); }
        }
#pragma unroll
        for (int q = 0; q < 4; ++q)
#pragma unroll
            for (int r = 0; r < 4; ++r) { const int k = 16 * w + 4 * lg + r + 64 * (16 * q + lr); v4u o; o.x = outp[q][r][0]; o.y = outp[q][r][1]; o.z = outp[q][r][2]; o.w = outp[q][r][3];
                *(GAS v4u*)(Zb + ((size_t)quad * MTOK + (size_t)b * SEQ + k) * 8) = o; }
    }
    __syncthreads();
}

__device__ __forceinline__ bf16x8 f8x8_bf16(unsigned long long w) {
    typedef float f32x2_t __attribute__((ext_vector_type(2)));
    const f32x2_t a = __builtin_amdgcn_cvt_pk_f32_fp8((int)(unsigned)w, false), b = __builtin_amdgcn_cvt_pk_f32_fp8((int)(unsigned)w, true),
                  c = __builtin_amdgcn_cvt_pk_f32_fp8((int)(unsigned)(w >> 32), false), d = __builtin_amdgcn_cvt_pk_f32_fp8((int)(unsigned)(w >> 32), true);
    v4u o; o.x = pg8::cvt_pk_bf16(a.x, a.y); o.y = pg8::cvt_pk_bf16(b.x, b.y); o.z = pg8::cvt_pk_bf16(c.x, c.y); o.w = pg8::cvt_pk_bf16(d.x, d.y); return __builtin_bit_cast(bf16x8, o); }
__device__ __forceinline__ void attn_mfma_phase(Frame& F, const unsigned char* Q, const unsigned char* K, const unsigned char* VT, bf16* OA) {
    LAS float* st = (LAS float*)F.lds;
    const int lane = F.lane, lr = lane & 15, lg = lane >> 4, bp16 = (lane ^ 16) << 2, bp32 = (lane ^ 32) << 2;
    for (int unit = F.vcu; unit < 256; unit += F.G) {
        const int b = unit >> 5, pb = (unit >> 2) & 7, j = unit & 3, P0 = pb * 512;
#pragma unroll 1
        for (int pass = 0; pass < 3; ++pass) {
            const int g = 2 - pass, dsh = 2 * g, dl = 1 << dsh, L = SEQ >> dsh, head = g * 4 + j, lns = 4 - dsh;
#pragma unroll 1
            for (int tt = 0; tt < 2; ++tt) {
                const int tau = F.wave * 2 + tt, r = tau >> lns, sblk = tau & ((1 << lns) - 1), iq0 = (P0 >> dsh) + 32 * sblk;
                const unsigned char* Kh = K + (size_t)b * SEQ * AW + head * 64 + 8 * lg;
                const unsigned char* Vh = VT + (size_t)(head * 64 + lr) * MTOK + (size_t)b * SEQ + r * L;
                long qf[2][2]; int prow[2]; f32x4 o[4][2]; float m[2], l[2];
#pragma unroll
                for (int qb = 0; qb < 2; ++qb) { const int pl = dl * (32 * sblk + 16 * qb + lr) + r; prow[qb] = pl;
                    const unsigned char* qp = Q + (size_t)(b * SEQ + P0 + pl) * AW + head * 64 + 8 * lg;
                    qf[qb][0] = *(const GAS long*)qp; qf[qb][1] = *(const GAS long*)(qp + 32); }
                if (pass == 0) {
#pragma unroll
                    for (int qb = 0; qb < 2; ++qb) { m[qb] = -1e30f; l[qb] = 0.f;
#pragma unroll
                        for (int t = 0; t < 4; ++t) o[t][qb] = (f32x4){0.f, 0.f, 0.f, 0.f}; }
                } else {
#pragma unroll
                    for (int qb = 0; qb < 2; ++qb) { const LAS float* sp = st + prow[qb] * 68; m[qb] = sp[64]; l[qb] = lg == 0 ? sp[65] : 0.f;
#pragma unroll
                        for (int t = 0; t < 4; ++t) o[t][qb] = *(const LAS f32x4*)(sp + 16 * t + 4 * lg); }
                }
                typedef unsigned long long u64t; u64t kf[2][2], vf[4], kfn[2][2], vfn[4];
#define ATT_LOAD(c_, kd, vd) do { const int kb_ = iq0 - 64 + 32 * (c_); int ia_ = kb_ + 8 * (lr >> 2) + (lr & 3), ib_ = ia_ + 4; ia_ = ia_ < 0 ? 0 : (ia_ >= L ? L - 1 : ia_); ib_ = ib_ < 0 ? 0 : (ib_ >= L ? L - 1 : ib_); \
        const unsigned char* ka_ = Kh + (size_t)(dl * ia_ + r) * AW; const unsigned char* kb2_ = Kh + (size_t)(dl * ib_ + r) * AW; \
        kd[0][0] = *(const GAS u64t*)ka_; kd[0][1] = *(const GAS u64t*)(ka_ + 32); kd[1][0] = *(const GAS u64t*)kb2_; kd[1][1] = *(const GAS u64t*)(kb2_ + 32); \
        int vk_ = kb_ + 8 * lg; vk_ = vk_ < 0 ? 0 : (vk_ > L - 8 ? L - 8 : vk_); \
        _Pragma("unroll") for (int t_ = 0; t_ < 4; ++t_) vd[t_] = *(const GAS u64t*)(Vh + (size_t)(16 * t_) * MTOK + vk_); } while (0)
                ATT_LOAD(0, kf, vf);
#pragma unroll 1
                for (int c = 0; c < 5; ++c) {
                    if (c < 4) ATT_LOAD(c + 1, kfn, vfn);
                    const int kb = iq0 - 64 + 32 * c;
                    f32x4 s[2][2];
#pragma unroll
                    for (int tl = 0; tl < 2; ++tl) {
#pragma unroll
                        for (int qb = 0; qb < 2; ++qb) { s[tl][qb] = __builtin_amdgcn_mfma_f32_16x16x32_fp8_fp8((long)kf[tl][0], qf[qb][0], (f32x4){0.f, 0.f, 0.f, 0.f}, 0, 0, 0);
                            s[tl][qb] = __builtin_amdgcn_mfma_f32_16x16x32_fp8_fp8((long)kf[tl][1], qf[qb][1], s[tl][qb], 0, 0, 0); } }
                    bf16x8 pf[2];
                    if (c == 0 || c == 4 || kb < 0 || kb + 32 > L) {
#pragma unroll
                        for (int qb = 0; qb < 2; ++qb) { const int iq = iq0 + 16 * qb + lr, lo = iq - 64 < 0 ? 0 : iq - 64, hi = iq + 64 > L - 1 ? L - 1 : iq + 64; const unsigned span = (unsigned)(hi - lo); const int k0 = kb + 8 * lg - lo;
#pragma unroll
                            for (int e = 0; e < 8; ++e) s[e >> 2][qb][e & 3] = (unsigned)(k0 + e) <= span ? s[e >> 2][qb][e & 3] : -__builtin_inff(); } }
#pragma unroll
                    for (int qb = 0; qb < 2; ++qb) { float sv[8]; float mx = -__builtin_inff();
#pragma unroll
                        for (int e = 0; e < 8; ++e) { sv[e] = s[e >> 2][qb][e & 3]; mx = fmaxf(mx, sv[e]); }
                        mx = fmaxf(mx, __int_as_float(__builtin_amdgcn_ds_bpermute(bp16, __float_as_int(mx)))); mx = fmaxf(mx, __int_as_float(__builtin_amdgcn_ds_bpermute(bp32, __float_as_int(mx))));
                        const float mn = fmaxf(m[qb], mx), al = __builtin_amdgcn_exp2f(m[qb] - mn); m[qb] = mn; float ps = 0.f; float p[8];
#pragma unroll
                        for (int e = 0; e < 8; ++e) { p[e] = __builtin_amdgcn_exp2f(sv[e] - mn); ps += p[e]; }
                        l[qb] = l[qb] * al + ps;
#pragma unroll
                        for (int t = 0; t < 4; ++t) o[t][qb] = o[t][qb] * al;
                        v4u pw; pw.x = pg8::cvt_pk_bf16(p[0], p[1]); pw.y = pg8::cvt_pk_bf16(p[2], p[3]); pw.z = pg8::cvt_pk_bf16(p[4], p[5]); pw.w = pg8::cvt_pk_bf16(p[6], p[7]); pf[qb] = __builtin_bit_cast(bf16x8, pw); }
#pragma unroll
                    for (int t = 0; t < 4; ++t) { const bf16x8 vt = f8x8_bf16(vf[t]);
#pragma unroll
                        for (int qb = 0; qb < 2; ++qb) o[t][qb] = __builtin_amdgcn_mfma_f32_16x16x32_bf16(vt, pf[qb], o[t][qb], 0, 0, 0); }
#pragma unroll
                    for (int tl = 0; tl < 2; ++tl) { kf[tl][0] = kfn[tl][0]; kf[tl][1] = kfn[tl][1]; }
#pragma unroll
                    for (int t = 0; t < 4; ++t) vf[t] = vfn[t];
                }
#undef ATT_LOAD
#pragma unroll
                for (int qb = 0; qb < 2; ++qb) { float lt = l[qb]; lt += __int_as_float(__builtin_amdgcn_ds_bpermute(bp16, __float_as_int(lt))); lt += __int_as_float(__builtin_amdgcn_ds_bpermute(bp32, __float_as_int(lt)));
                    if (pass < 2) { LAS float* sp = st + prow[qb] * 68;
#pragma unroll
                        for (int t = 0; t < 4; ++t) *(LAS f32x4*)(sp + 16 * t + 4 * lg) = o[t][qb];
                        if (lg == 0) { sp[64] = m[qb]; sp[65] = lt; } }
                    else { const float il = 1.0f / lt; bf16* op = OA + ((size_t)(8 * j + (lg >> 1)) * MTOK + (size_t)(b * SEQ + P0 + prow[qb])) * 8 + 4 * (lg & 1);
#pragma unroll
                        for (int t = 0; t < 4; ++t) { const f32x4 x = o[t][qb] * il; *(GAS unsigned long long*)(op + (size_t)(2 * t) * MTOK * 8) = (unsigned long long)pg8::cvt_pk_bf16(x[0], x[1]) | ((unsigned long long)pg8::cvt_pk_bf16(x[2], x[3]) << 32); } } }
            }
            __syncthreads();
        }
    }
}

__device__ __forceinline__ void norm_router_phase(Frame& F, const bf16* x, const float* gain, unsigned char* out8, const float* rw, const float* rb, int* SEL, float* WTS, int* CNT) {
    LAS float* wr = (LAS float*)F.lds;
    LAS int* sel_l = (LAS int*)(F.lds + 32768);
    for (int i = F.tid; i < DM * NEXP; i += NWAVES * 64) { const int k = i >> 3, e = i & 7; wr[(((e >> 2) * 1024) + (k & 3) * 256 + (k >> 2)) * 4 + (e & 3)] = rw[i]; }
    __syncthreads();
    f32x4 gn[4];
#pragma unroll
    for (int j = 0; j < 4; ++j) gn[j] = ((const GAS f32x4*)gain)[F.lane + 64 * j];
    typedef unsigned long long u64r;
    u64r rw_[4];
    { const GAS u64r* xr = (const GAS u64r*)(x + (size_t)(F.vcu * 128 + F.wave * 16) * XP) + F.lane;
#pragma unroll
      for (int j = 0; j < 4; ++j) rw_[j] = xr[64 * j]; }
    const bool b0 = F.lane & 1, b1 = F.lane & 2, b2 = F.lane & 4;
#pragma unroll 1
    for (int i = 0; i < 16; ++i) { const int tl = F.wave * 16 + i, m = F.vcu * 128 + tl; f32x4 v[4]; float ssq = 0.f;
#pragma unroll
        for (int j = 0; j < 4; ++j) { const u64r w = rw_[j]; v[j].x = bflo((unsigned)w); v[j].y = bfhi((unsigned)w); v[j].z = bflo((unsigned)(w >> 32)); v[j].w = bfhi((unsigned)(w >> 32));
            ssq += (v[j].x * v[j].x + v[j].y * v[j].y) + (v[j].z * v[j].z + v[j].w * v[j].w); }
        if (i < 15) { const GAS u64r* xr = (const GAS u64r*)(x + (size_t)(m + 1) * XP) + F.lane;
#pragma unroll
            for (int j = 0; j < 4; ++j) rw_[j] = xr[64 * j]; }
        const float rstd = 1.0f / sqrtf(wave_sum(ssq, F.lane) * (1.0f / DM) + RMS_EPS);
#pragma unroll
        for (int j = 0; j < 4; ++j) v[j] = v[j] * rstd * gn[j];
        GAS unsigned* o4 = (GAS unsigned*)(out8 + (size_t)m * DM) + F.lane;
#pragma unroll
        for (int j = 0; j < 4; ++j) { unsigned w8 = pg8::pk_fp8(v[j].x, v[j].y, 0u, false); w8 = pg8::pk_fp8(v[j].z, v[j].w, w8, true); o4[64 * j] = w8; }
        float lg[8];
#pragma unroll
        for (int e = 0; e < 8; ++e) lg[e] = 0.f;
#pragma unroll
        for (int j = 0; j < 4; ++j)
#pragma unroll
            for (int cc = 0; cc < 4; ++cc) { const int sl = cc * 256 + F.lane + 64 * j; const f32x4 wa = *(const LAS f32x4*)(wr + sl * 4), wb = *(const LAS f32x4*)(wr + 4096 + sl * 4); const float xv = v[j][cc];
                lg[0] += xv * wa[0]; lg[1] += xv * wa[1]; lg[2] += xv * wa[2]; lg[3] += xv * wa[3]; lg[4] += xv * wb[0]; lg[5] += xv * wb[1]; lg[6] += xv * wb[2]; lg[7] += xv * wb[3]; }
#define XCH(v_, o_) __int_as_float(__builtin_amdgcn_ds_bpermute((F.lane ^ (o_)) << 2, __float_as_int(v_)))
        float ra[4], rb2[2], rc;
#pragma unroll
        for (int t = 0; t < 4; ++t) { const float send = b0 ? lg[t] : lg[t + 4], keep = b0 ? lg[t + 4] : lg[t]; ra[t] = keep + XCH(send, 1); }
#pragma unroll
        for (int t = 0; t < 2; ++t) { const float send = b1 ? ra[t] : ra[t + 2], keep = b1 ? ra[t + 2] : ra[t]; rb2[t] = keep + XCH(send, 2); }
        { const float send = b2 ? rb2[0] : rb2[1], keep = b2 ? rb2[1] : rb2[0]; rc = keep + XCH(send, 4); }
        rc += XCH(rc, 8); rc += XCH(rc, 16); rc += XCH(rc, 32);
#undef XCH
        lg[0] = __int_as_float(__builtin_amdgcn_readlane(__float_as_int(rc), 0)) + rb[0]; lg[1] = __int_as_float(__builtin_amdgcn_readlane(__float_as_int(rc), 4)) + rb[1];
        lg[2] = __int_as_float(__builtin_amdgcn_readlane(__float_as_int(rc), 2)) + rb[2]; lg[3] = __int_as_float(__builtin_amdgcn_readlane(__float_as_int(rc), 6)) + rb[3];
        lg[4] = __int_as_float(__builtin_amdgcn_readlane(__float_as_int(rc), 1)) + rb[4]; lg[5] = __int_as_float(__builtin_amdgcn_readlane(__float_as_int(rc), 5)) + rb[5];
        lg[6] = __int_as_float(__builtin_amdgcn_readlane(__float_as_int(rc), 3)) + rb[6]; lg[7] = __int_as_float(__builtin_amdgcn_readlane(__float_as_int(rc), 7)) + rb[7];
        int e0 = 0; float v0 = lg[0];
#pragma unroll
        for (int e = 1; e < 8; ++e) if (lg[e] > v0) { v0 = lg[e]; e0 = e; }
        int e1 = 0; float v1 = -__builtin_inff();
#pragma unroll
        for (int e = 0; e < 8; ++e) if (e != e0 && lg[e] > v1) { v1 = lg[e]; e1 = e; }
        const float w0 = 1.0f / (1.0f + expf(v1 - v0)), w1 = 1.0f - w0;
        if (F.lane == 0) { sel_l[tl] = e0 | (e1 << 8); WTS[2 * (size_t)m] = w0; WTS[2 * (size_t)m + 1] = w1; }
    }
    __syncthreads();
    if (F.tid < 128) { const int me = sel_l[F.tid], e0 = me & 255, e1 = me >> 8; int r0 = 0, r1 = 0;
        for (int t = 0; t < F.tid; ++t) { const int o = sel_l[t]; r0 += ((o & 255) == e0); r1 += ((o >> 8) == e1); }
        SEL[F.vcu * 128 + F.tid] = me | (r0 << 16) | (r1 << 24); }
    else if (F.tid < 144) { const int q = F.tid - 128, s = q >> 3, e = q & 7; int n = 0;
        for (int t = 0; t < 128; ++t) { const int o = sel_l[t]; n += ((s ? (o >> 8) : (o & 255)) == e); }
        CNT[F.vcu * 16 + q] = n; }
    __syncthreads();
}
__device__ __forceinline__ void route2_phase(Frame& F, const int* SEL, const float* WTS, const int* CNT, int* ROWTOK, float* ROWW, int* PLAN) {
    LAS int* call = (LAS int*)F.lds;
    LAS int* tot = call + 4096; LAS int* basew = tot + 16; LAS int* segst = basew + 16; LAS int* ntile = segst + 16;
    for (int i = F.tid; i < 4096; i += NWAVES * 64) call[i] = CNT[i];
    __syncthreads();
    if (F.tid < 16) { int t = 0, bsum = 0; for (int w = 0; w < 256; ++w) { const int c = call[w * 16 + F.tid]; t += c; bsum += (w < F.vcu) ? c : 0; } tot[F.tid] = t; basew[F.tid] = bsum; }
    __syncthreads();
    if (F.tid < 2) { int run = 0; for (int e = 0; e < 8; ++e) { segst[F.tid * 8 + e] = run; run += (tot[F.tid * 8 + e] + 255) & ~255; } ntile[F.tid] = run >> 8; }
    __syncthreads();
    if (F.tid < 128) { const int m = F.vcu * 128 + F.tid, sl = SEL[m], e0 = sl & 255, e1 = (sl >> 8) & 255, r0 = (sl >> 16) & 255, r1 = (sl >> 24) & 255;
        const int p0 = segst[e0] + basew[e0] + r0, p1 = segst[8 + e1] + basew[8 + e1] + r1;
        ROWTOK[p0] = m; ROWW[p0] = WTS[2 * (size_t)m]; ROWTOK[MOE_ROWS + p1] = m; ROWW[MOE_ROWS + p1] = WTS[2 * (size_t)m + 1]; }
    if (F.vcu < 8) {
        for (int s = 0; s < 2; ++s) { const int q = s * 8 + F.vcu, n = tot[q], np = (n + 255) & ~255;
            for (int p = n + F.tid; p < np; p += NWAVES * 64) { ROWTOK[s * MOE_ROWS + segst[q] + p] = -1; ROWW[s * MOE_ROWS + segst[q] + p] = 0.f; } } }
    if (F.vcu == 8) {
        if (F.tid < 2) PLAN[F.tid] = ntile[F.tid];
        if (F.tid < 2 * MOE_TILES) { const int s = F.tid / MOE_TILES, t = F.tid % MOE_TILES; int e = 0;
            for (int k = 1; k < 8; ++k) if ((segst[s * 8 + k] >> 8) <= t) e = k;
            PLAN[16 + MOE_TILES * s + t] = e; } }
    __syncthreads();
}
__device__ __forceinline__ void final_norm_phase(Frame& F, float* xio, const bf16* xb, const float* gain, const bf16* y) {
    const int gw = F.vcu * NWAVES + F.wave, NGW = F.G * NWAVES;
    f32x4 gn[4];
#pragma unroll
    for (int j = 0; j < 4; ++j) gn[j] = ((const GAS f32x4*)gain)[F.lane + 64 * j];
    for (int m = gw; m < MTOK; m += NGW) { f32x4 v[4]; float s = 0.f;
        const GAS unsigned long long* xr = (const GAS unsigned long long*)(xb + (size_t)m * XP) + F.lane;
        const GAS unsigned long long* y0 = (const GAS unsigned long long*)(y + (size_t)m * DM) + F.lane; const GAS unsigned long long* y1 = (const GAS unsigned long long*)(y + ((size_t)MTOK + m) * DM) + F.lane;
#pragma unroll
        for (int j = 0; j < 4; ++j) { const unsigned long long xw = xr[64 * j]; v[j].x = bflo((unsigned)xw); v[j].y = bfhi((unsigned)xw); v[j].z = bflo((unsigned)(xw >> 32)); v[j].w = bfhi((unsigned)(xw >> 32));
            const unsigned long long a0 = y0[64 * j], a1 = y1[64 * j];
            v[j].x += bflo((unsigned)a0) + bflo((unsigned)a1); v[j].y += bfhi((unsigned)a0) + bfhi((unsigned)a1);
            v[j].z += bflo((unsigned)(a0 >> 32)) + bflo((unsigned)(a1 >> 32)); v[j].w += bfhi((unsigned)(a0 >> 32)) + bfhi((unsigned)(a1 >> 32));
            s += (v[j].x * v[j].x + v[j].y * v[j].y) + (v[j].z * v[j].z + v[j].w * v[j].w); }
        const float rstd = 1.0f / sqrtf(wave_sum(s, F.lane) * (1.0f / DM) + RMS_EPS);
        GAS f32x4* o = (GAS f32x4*)(xio + (size_t)m * DM) + F.lane;
#pragma unroll
        for (int j = 0; j < 4; ++j) o[64 * j] = v[j] * rstd * gn[j]; }
}

struct MoeOrder { int nT0, nM, nN, nwg, G, c; unsigned lda, ldb; const int* tile_e; size_t estride; bool gather;
    __device__ bool next(int i, pg8::Unit& u) const {
        const long L = (long)i * G + c; if (L >= nwg) return false;
        int wgid = (int)L; { const int q = nwg / pg8::NXCD, r = nwg % pg8::NXCD, xcd = wgid % pg8::NXCD, off = wgid / pg8::NXCD; wgid = (xcd < r ? xcd * (q + 1) : r * (q + 1) + (xcd - r) * q) + off; }
        const int nig = pg8::WGM * nN, gid = wgid / nig, fm = gid * pg8::WGM, gsz = (nM - fm) < pg8::WGM ? (nM - fm) : pg8::WGM;
        const int lin = fm + ((wgid % nig) % gsz); u.pm = lin < nT0 ? lin : MOE_TILES + (lin - nT0); u.pn = (wgid % nig) / gsz; u.z = __builtin_amdgcn_readfirstlane(tile_e[u.pm]);
        u.aoff = gather ? (size_t)0 : (size_t)u.pm * 256 * lda; u.boff = (size_t)u.z * estride + (size_t)u.pn * 256 * ldb; return true; } };

template <class Epi, int BMAP = 0, int ALAY = 0> __device__ __forceinline__ void run_gemm(Frame& F, const void* A, unsigned lda, const void* B, unsigned ldb, int Mrows, int Ncols, int K, const Epi& E, int geff = 0) {
    int G_ = geff ? geff : F.G, c_ = (int)blockIdx.x; asm volatile("" : "+s"(G_), "+s"(c_));
    pg8::Gemm g{(const char*)A, (const char*)B, lda, ldb, K, nullptr}; pg8::PlainOrder S; S.init(Mrows, Ncols, G_, c_, lda, ldb, BMAP, ALAY);
    pg8::gemm_phase<Epi, pg8::PlainOrder, false, BMAP, ALAY>(F.lds, g, S, E);
}

__device__ __forceinline__ Args load_args() {
    Args r{};
#if defined(__HIP_DEVICE_COMPILE__)
    typedef const __attribute__((address_space(4))) Args CArgs;
    auto p = __builtin_amdgcn_kernarg_segment_ptr(); asm volatile("" : "+s"(p)); CArgs* q = (CArgs*)p;
#pragma unroll
    for (int i = 0; i < 16; ++i) r.in[i] = q->in[i];
    r.out = q->out; r.ws = q->ws; r.G = q->G;
#endif
    return r;
}
__device__ __forceinline__ Frame make_frame(LAS unsigned char* lds, unsigned char* ws, int G) {
    Frame F; int t = threadIdx.x, g = G, bx = blockIdx.x; asm volatile("" : "+v"(t), "+s"(g), "+s"(bx));
    F.lds = lds; F.MISC = (volatile LAS unsigned*)(lds + MISC_OFF); F.ctl = (gu32*)(ws + WS_CTL);
    F.tid = t; F.lane = t & 63; F.wave = __builtin_amdgcn_readfirstlane(t >> 6); F.G = g; F.vcu = (g % 8 == 0) ? (bx % 8) * (g / 8) + bx / 8 : bx; return F; }
#define PH_BEGIN const Args a = load_args(); unsigned char* const ws = a.ws; float* const xout = a.out; bf16* const xsA = (bf16*)a.out; bf16* const xsB = xsA + DM; Frame F = make_frame((LAS unsigned char*)lds, ws, a.G); (void)xout; (void)xsA; (void)xsB
__global__ void __launch_bounds__(NWAVES * 64, 2) fwd_kernel(Args args) {
    extern __shared__ __attribute__((aligned(16))) unsigned char lds[];
    for (int u = threadIdx.x; u < (LDS_BYTES - LDSCTL_OFF) / 4; u += NWAVES * 64) ((LAS unsigned*)((LAS unsigned char*)lds + LDSCTL_OFF))[u] = 0u;
    __syncthreads();
    XcdBarrier bar = xcd_barrier_post((unsigned*)(args.ws + WS_CTL) + CW_BAR, (volatile LAS unsigned*)((LAS unsigned char*)lds + MISC_OFF) + 8);
    bar.G = (unsigned)args.G;
#define GRID_BAR() do { XcdBarrier b2_ = bar; asm volatile("" : "+s"(b2_.bar), "+s"(b2_.x), "+s"(b2_.G)); xcd_barrier(b2_); } while (0)

    { PH_BEGIN; p0_weights(F, a); __syncthreads(); p0_tables(F, a); prep_x_phase(F, a.in[0], xsA, (float*)(ws + WS_SS), ws + WS_X8); }
    GRID_BAR();

    for (int layer = 0; layer < 2; ++layer) {
        asm volatile("" : "+s"(layer));
        { PH_BEGIN; int lyr = layer; asm volatile("" : "+s"(lyr)); const bf16* WinT = (const bf16*)(ws + WS_WIN + lyr * WIN_L);
          pg8::EpiInproj E{ws, WS_V, WS_Q, WS_K, WS_GF, WS_GA, WS_ROPE, QSCALE, (const float*)(ws + WS_SS) + (size_t)(2 * lyr) * SS_STRIDE, 1.0f / WG_SCALE};
          int G_ = F.G, c_ = (int)blockIdx.x; asm volatile("" : "+s"(G_), "+s"(c_));
          pg8::Gemm g{(const char*)(ws + WS_X8), (const char*)(ws + WS_WQK8 + (size_t)lyr * 1536 * DM), DM, DM, DM / 2, nullptr}; pg8::PlainOrder S; S.init(MTOK, 1536, G_, c_, DM, DM, 0, 0);
          pg8::gemm_phase<pg8::EpiInproj, pg8::PlainOrder, false, 0, 0, true>(F.lds, g, S, E); }
        { PH_BEGIN; int lyr = layer; asm volatile("" : "+s"(lyr)); const bf16* WinT = (const bf16*)(ws + WS_WIN + lyr * WIN_L);
          int bx_ = (int)blockIdx.x; asm volatile("" : "+s"(bx_));
          if (bx_ < 128) { pg8::EpiBf16 E{(bf16*)(ws + WS_UT), MTOK, (bf16*)(ws + WS_V), 2, (const float*)(ws + WS_SS) + (size_t)(2 * lyr) * SS_STRIDE, 1.0f};
            run_gemm<pg8::EpiBf16, 2, 0>(F, WinT, DM * 2, xsA, XP * 2, 512, MTOK, DM, E, 128); }
          else { pg8::EpiBf16 E{(bf16*)(ws + WS_UT), MTOK, (bf16*)(ws + WS_V), 2, (const float*)(ws + WS_SS) + (size_t)(2 * lyr) * SS_STRIDE, 1.0f / WG_SCALE};
            int G_ = 128, c_ = bx_ - 128; asm volatile("" : "+s"(G_), "+s"(c_));
            pg8::Gemm g{(const char*)(ws + WS_WV8 + (size_t)lyr * 768 * DM), (const char*)(ws + WS_X8), DM, DM, DM / 2, nullptr}; pg8::PlainOrder S; S.init(768, MTOK, G_, c_, DM, DM, 2, 0); S.pmoff = 2;
            pg8::gemm_phase<pg8::EpiBf16, pg8::PlainOrder, false, 2, 0, true>(F.lds, g, S, E); } }
        GRID_BAR();
        { PH_BEGIN; fft_phase(F, (const bf16*)(ws + WS_UT), (bf16*)(ws + WS_Z)); }
        { PH_BEGIN; attn_mfma_phase(F, ws + WS_Q, ws + WS_K, ws + WS_V, (bf16*)(ws + WS_OATT)); }
        { PH_BEGIN; int lyr = layer; asm volatile("" : "+s"(lyr)); int G_ = F.G, c_ = (int)blockIdx.x; asm volatile("" : "+s"(G_), "+s"(c_));
          pg8::Gemm g{(const char*)(ws + WS_X8), (const char*)(ws + WS_WG8 + (size_t)lyr * 2048 * DM), DM, DM, DM / 2, nullptr}; pg8::PlainOrder S; S.init(MTOK, 2048, G_, c_, DM, DM, 0, 0);
          pg8::EpiGates8 E{ws, WS_GF, WS_GA, (const float*)(ws + WS_SS) + (size_t)(2 * lyr) * SS_STRIDE}; pg8::gemm_phase<pg8::EpiGates8, pg8::PlainOrder, false, 0, 0, true>(F.lds, g, S, E); }
        GRID_BAR();
        { PH_BEGIN; int lyr = layer; asm volatile("" : "+s"(lyr)); pg8::EpiMix E{ws + WS_GF, ws + WS_GA, (bf16*)(ws + WS_MIX)};
          run_gemm<pg8::EpiMix, 0, 1>(F, ws + WS_OATT, MTOK * 16, (const bf16*)(ws + WS_WM) + (size_t)lyr * DM * KMIX, KMIX * 2, MTOK, DM, KMIX, E); }
        GRID_BAR();
        if (layer == 0) { PH_BEGIN; pg8::EpiResid<true> E{xsA, xsB, XP, (float*)(ws + WS_SS) + SS_STRIDE, nullptr};
          run_gemm(F, ws + WS_MIX, DM * 2, ws + WS_WOUT, DM * 2, MTOK, DM, DM, E); }
        else { PH_BEGIN; pg8::EpiResid<false> E{xsA, xsB, XP, nullptr, nullptr};
          run_gemm(F, ws + WS_MIX, DM * 2, (const bf16*)(ws + WS_WOUT) + (size_t)DM * DM, DM * 2, MTOK, DM, DM, E); }
        GRID_BAR();
        if (layer == 0) {
            { PH_BEGIN; int lyr = layer; asm volatile("" : "+s"(lyr)); pg8::EpiSwiglu E{(bf16*)(ws + WS_TT), FF, (const float*)(ws + WS_SS) + SS_STRIDE}; run_gemm(F, xsB, XP * 2, ws + WS_W13, DM * 2, MTOK, 2 * FF, DM, E); }
            GRID_BAR();
            { PH_BEGIN; int lyr = layer; asm volatile("" : "+s"(lyr)); pg8::EpiResid<true> E{xsB, xsA, XP, (float*)(ws + WS_SS) + 2 * SS_STRIDE, ws + WS_X8}; run_gemm(F, ws + WS_TT, FF * 2, ws + WS_W2, FF * 2, MTOK, DM, FF, E); }
            GRID_BAR();
        } else {
            { PH_BEGIN; int lyr = layer; asm volatile("" : "+s"(lyr)); p0_moe_weights(F, a, 2 * CONV_PHASE_ITEMS, MOE_NITEMS, F.vcu * NWAVES + F.wave, F.G * NWAVES); __syncthreads();
              norm_router_phase(F, xsB, a.in[6] + DM, ws + WS_H2B, a.in[10], a.in[11], (int*)(ws + WS_SEL), (float*)(ws + WS_WTS), (int*)(ws + WS_CNT)); }
            GRID_BAR();
            { PH_BEGIN; int lyr = layer; asm volatile("" : "+s"(lyr)); route2_phase(F, (const int*)(ws + WS_SEL), (const float*)(ws + WS_WTS), (const int*)(ws + WS_CNT), (int*)(ws + WS_ROWTOK), (float*)(ws + WS_ROWW), (int*)(ws + WS_PLAN)); }
            GRID_BAR();
            { PH_BEGIN; int G_ = F.G, c_ = (int)blockIdx.x; asm volatile("" : "+s"(G_), "+s"(c_));
              const int* plan = (const int*)(ws + WS_PLAN); const int nT0 = __builtin_amdgcn_readfirstlane(plan[0]), nT1 = __builtin_amdgcn_readfirstlane(plan[1]);
              pg8::Gemm g{(const char*)(ws + WS_H2B), (const char*)(ws + WS_M13), DM, DM, DM / 2, (const int*)(ws + WS_ROWTOK)};
              MoeOrder S{nT0, nT0 + nT1, 2 * FF / 256, (nT0 + nT1) * (2 * FF / 256), G_, c_, DM, DM, plan + 16, (size_t)2 * FF * DM, true};
              pg8::EpiSwigluF8 E{ws + WS_TTB, FF, 1.0f / W13_SCALE}; pg8::gemm_phase<pg8::EpiSwigluF8, MoeOrder, true, 0, 0, true>(F.lds, g, S, E); }
            GRID_BAR();
            { PH_BEGIN; int G_ = F.G, c_ = (int)blockIdx.x; asm volatile("" : "+s"(G_), "+s"(c_));
              const int* plan = (const int*)(ws + WS_PLAN); const int nT0 = __builtin_amdgcn_readfirstlane(plan[0]), nT1 = __builtin_amdgcn_readfirstlane(plan[1]);
              pg8::Gemm g{(const char*)(ws + WS_TTB), (const char*)(ws + WS_M2), FF, FF, FF / 2, nullptr};
              MoeOrder S{nT0, nT0 + nT1, DM / 256, (nT0 + nT1) * (DM / 256), G_, c_, FF, FF, plan + 16, (size_t)DM * FF, false};
              pg8::EpiScatterY E{(bf16*)(ws + WS_Y), (const int*)(ws + WS_ROWTOK), (const float*)(ws + WS_ROWW), 1.0f / W2_SCALE, MOE_ROWS, (size_t)MTOK * DM};
              pg8::gemm_phase<pg8::EpiScatterY, MoeOrder, false, 0, 0, true>(F.lds, g, S, E); }
            GRID_BAR();
        }
    }
    { PH_BEGIN; final_norm_phase(F, xout, xsB, a.in[15], (const bf16*)(ws + WS_Y)); }
#undef GRID_BAR
}

extern "C" void kernel_launch(void* const* d_in, const int* in_sizes, int n_in, void* d_out, int out_size, void* d_ws, size_t ws_size, hipStream_t stream) {
    static int grid = 0;
    if (grid == 0) {
        if (n_in != 16 || out_size != MTOK * DM || ws_size < WS_END) { fprintf(stderr, "kernel_launch: unexpected problem (n_in %d, out %d, ws %zu); nothing launched\n", n_in, out_size, ws_size); grid = -1; return; }
        int dev = 0, cus = 0;
        if (hipGetDevice(&dev) != hipSuccess || hipDeviceGetAttribute(&cus, hipDeviceAttributeMultiprocessorCount, dev) != hipSuccess) { grid = -1; return; }
        if (hipFuncSetAttribute((const void*)fwd_kernel, hipFuncAttributeMaxDynamicSharedMemorySize, LDS_BYTES) != hipSuccess) { fprintf(stderr, "kernel_launch: hipFuncSetAttribute failed\n"); grid = -1; return; }
        int per_cu = 0;
        if (hipOccupancyMaxActiveBlocksPerMultiprocessor(&per_cu, (const void*)fwd_kernel, NWAVES * 64, LDS_BYTES) != hipSuccess || per_cu < 1) fprintf(stderr, "kernel_launch: occupancy query reports %d\n", per_cu);
        (void)hipGetLastError();
        if (cus != 256) { fprintf(stderr, "kernel_launch: %d CUs; the router / attention unit maps assume a grid of 256\n", cus); grid = -1; return; }
        grid = cus;
    }
    if (grid < 0) return;
    (void)hipMemsetAsync((char*)d_ws + WS_CTL, 0, CTL_ZERO_BYTES, stream);
    Args a{};
    for (int i = 0; i < 16; ++i) a.in[i] = (const float*)d_in[i];
    a.out = (float*)d_out; a.ws = (unsigned char*)d_ws; a.G = grid; a.pad = 0;
    hipLaunchKernelGGL(fwd_kernel, dim3(grid), dim3(NWAVES * 64), LDS_BYTES, stream, a);
}
```

```cpp
#include <hip/hip_runtime.h>
#include <cstdio>
#include <cstdint>

namespace pg8 {
#define PG8_LAS __attribute__((address_space(3)))
typedef unsigned short bf16_t;
typedef short bf16x8 __attribute__((ext_vector_type(8)));
typedef float f32x4 __attribute__((ext_vector_type(4)));
typedef unsigned u32x4 __attribute__((ext_vector_type(4)));
typedef unsigned u32x2 __attribute__((ext_vector_type(2)));
typedef int v4i_t __attribute__((ext_vector_type(4)));
typedef int v8i_t __attribute__((ext_vector_type(8)));
constexpr int BM = 256, BK = 64, HALF = 128, HTB = HALF * BK * 2  , STAGE_BYTES = 8 * HTB, NXCD = 8, WGM = 4;

__host__ __device__ __forceinline__ int lds_byte(int r, int c) { const int st = (r >> 4) * 2 + (c >> 5), rr = r & 15, cc = c & 31, ob = rr * 64 + cc * 2; return st * 1024 + (ob ^ (((ob >> 9) & 1) << 5)); }
__host__ __device__ __forceinline__ void stage_rc(int b, int& R, int& C) { const int st = b / 1024, sb = b % 1024, swz = sb ^ (((sb >> 9) & 1) << 5); R = (st >> 1) * 16 + swz / 64; C = (st & 1) * 32 + (swz % 64) / 2; }
__host__ __device__ __forceinline__ int perm32(int rho) { const int n = rho >> 4, i = rho & 15; return 8 * (i >> 2) + 4 * n + (i & 3); }

struct Unit { int pm, pn, z; size_t aoff, boff; };
struct Gemm { const char* A; const char* B; unsigned lda, ldb; int K; const int* rows; };

struct PlainOrder {
    int nM, nN, nwg, G, c; unsigned lda, ldb; int bmap, alay, pmoff = 0;
    __device__ void init(int M, int N, int G_, int c_, unsigned lda_, unsigned ldb_, int bmap_ = 0, int alay_ = 0) { nM = M / BM; nN = N / BM; nwg = nM * nN; G = G_; c = c_; lda = lda_; ldb = ldb_; bmap = bmap_; alay = alay_; }
    __device__ bool next(int i, Unit& u) const {
        const long L = (long)i * G + c; if (L >= nwg) return false;
        int wgid = (int)L; { const int q = nwg / NXCD, r = nwg % NXCD, xcd = wgid % NXCD, off = wgid / NXCD; wgid = (xcd < r ? xcd * (q + 1) : r * (q + 1) + (xcd - r) * q) + off; }
        const int nig = WGM * nN, gid = wgid / nig, fm = gid * WGM, gsz = (nM - fm) < WGM ? (nM - fm) : WGM;
        u.pm = fm + ((wgid % nig) % gsz); u.pn = (wgid % nig) / gsz; u.z = 0;
        u.aoff = alay ? (size_t)u.pm * BM * 16 : (size_t)u.pm * BM * lda; u.pm += pmoff;
        if (bmap == 0) u.boff = (size_t)u.pn * BM * ldb;
        else { const int kind = bmap == 1 ? 1 : (u.pm < 2 ? 1 : (u.pm == 2 ? 0 : u.pm - 1)), bb = u.pn >> 4, t = u.pn & 15; u.z = kind;
            const int base = kind == 0 ? 256 * t : (kind == 1 ? 4 * t : (kind == 2 ? 1024 * (t & 3) + (t >> 2) : t));
            u.boff = (size_t)(bb * 4096 + base) * ldb; }
        return true;
    }
};

typedef float f32x2v_t __attribute__((ext_vector_type(2))); typedef __bf16 bf16x2v_t __attribute__((ext_vector_type(2)));
__device__ __forceinline__ unsigned cvt_pk_bf16(float lo, float hi) { const f32x2v_t v = {lo, hi}; return __builtin_bit_cast(unsigned, __builtin_convertvector(v, bf16x2v_t)); }
__device__ __forceinline__ float bf_lo(unsigned w) { return __uint_as_float(w << 16); }
__device__ __forceinline__ float bf_hi(unsigned w) { return __uint_as_float(w & 0xffff0000u); }
__device__ __forceinline__ f32x4 bf4_lo(const u32x4& w) { return (f32x4){bf_lo(w.x), bf_hi(w.x), bf_lo(w.y), bf_hi(w.y)}; }
__device__ __forceinline__ f32x4 bf4_hi(const u32x4& w) { return (f32x4){bf_lo(w.z), bf_hi(w.z), bf_lo(w.w), bf_hi(w.w)}; }
__device__ __forceinline__ unsigned pk_u8x4(const f32x4& g) { const f32x4 t = g * 255.0f; unsigned w = __builtin_amdgcn_cvt_pk_u8_f32(t[0], 0, 0u); w = __builtin_amdgcn_cvt_pk_u8_f32(t[1], 1, w); w = __builtin_amdgcn_cvt_pk_u8_f32(t[2], 2, w); return __builtin_amdgcn_cvt_pk_u8_f32(t[3], 3, w); }
__device__ __forceinline__ f32x4 u8x4_f(unsigned w) { return (f32x4){(float)(w & 0xffu), (float)((w >> 8) & 0xffu), (float)((w >> 16) & 0xffu), (float)(w >> 24)}; }
__device__ __forceinline__ float fast_sigmoid(float x) { return __builtin_amdgcn_rcpf(1.0f + __builtin_amdgcn_exp2f(-1.4426950408889634f * x)); }
__device__ __forceinline__ u32x4 pack8(const f32x4& v0, const f32x4& v1) { u32x4 w; w.x = cvt_pk_bf16(v0[0], v0[1]); w.y = cvt_pk_bf16(v0[2], v0[3]); w.z = cvt_pk_bf16(v1[0], v1[1]); w.w = cvt_pk_bf16(v1[2], v1[3]); return w; }

__device__ __forceinline__ float rstd_of(const float* ss, int row) { const f32x4 p = *(const f32x4*)(ss + (size_t)row * 4); return __builtin_amdgcn_rsqf(((p[0] + p[1]) + (p[2] + p[3])) * (1.0f / 1024.0f) + 1e-6f); }
__device__ __forceinline__ unsigned pk_fp8(float a, float b, unsigned old, bool hi) { a = __builtin_fminf(__builtin_fmaxf(a, -448.f), 448.f); b = __builtin_fminf(__builtin_fmaxf(b, -448.f), 448.f);
    return hi ? (unsigned)__builtin_amdgcn_cvt_pk_fp8_f32(a, b, (int)old, true) : (unsigned)__builtin_amdgcn_cvt_pk_fp8_f32(a, b, (int)old, false); }

struct EpiBf16 {
    static constexpr bool PERM = true;
    bf16_t* O; int ldc; bf16_t* O2; int split; const float* ss; float ascale;
    __device__ __forceinline__ void operator()(const f32x4 (&acc)[2][2][4][2], const Unit& u, int wr, int wc, int fr, int fq) const {
        bf16_t* const O = u.pm >= split ? O2 : this->O;
        const int row0 = (u.pm >= split ? u.pm - split : u.pm) * BM + wr * 64 + fr, col0 = u.pn * BM + wc * 32 + 8 * fq;
        f32x4 cs[2][2]; const int kind = u.z, bb = u.pn >> 4;
#pragma unroll
        for (int bj = 0; bj < 2; ++bj)
#pragma unroll
            for (int e = 0; e < 8; ++e) { const int v = (col0 & 4095) + bj * HALF + e;
                const int pos = kind == 0 ? v : (kind == 1 ? 64 * (v & 63) + (v >> 6) : (kind == 2 ? 4 * (v & 1023) + (v >> 10) : 16 * (v & 255) + (v >> 8)));
                cs[bj][e >> 2][e & 3] = rstd_of(ss, bb * 4096 + pos) * ascale; }
#pragma unroll
        for (int ai = 0; ai < 2; ++ai)
#pragma unroll
            for (int m = 0; m < 4; ++m) { const size_t eo = (size_t)(row0 + ai * HALF + m * 16) * ldc + col0;
#pragma unroll
                for (int bj = 0; bj < 2; ++bj) { const f32x4 v0 = acc[ai][bj][m][0] * cs[bj][0], v1 = acc[ai][bj][m][1] * cs[bj][1];
                    if (u.pm >= split) { u32x2 w8; w8.x = pk_fp8(v0[0], v0[1], 0u, false); w8.x = pk_fp8(v0[2], v0[3], w8.x, true); w8.y = pk_fp8(v1[0], v1[1], 0u, false); w8.y = pk_fp8(v1[2], v1[3], w8.y, true);
                        *(u32x2*)((unsigned char*)O + eo + bj * HALF) = w8; }
                    else *(u32x4*)(O + eo + bj * HALF) = pack8(v0, v1); } }
    }
};
struct EpiInproj {
    static constexpr bool PERM = true;
    unsigned char* ws; size_t oV, oQ, oK, oGF, oGA, oRope; float qscale; const float* ss; float ascale;
    __device__ __forceinline__ void operator()(const f32x4 (&acc)[2][2][4][2], const Unit& u, int wr, int wc, int fr, int fq) const {
        const int row0 = u.pm * BM + wr * 64 + fr, pn = u.pn;
        {
            const bool isq = pn < 3; bf16_t* base = (bf16_t*)(ws + (isq ? oQ : oK)); const float* rope = (const float*)(ws + oRope); const int colt = (isq ? pn : pn - 3) * 256; const float sc = isq ? qscale : 1.0f;
            const int col0 = colt + wc * 32 + 8 * fq, i0 = 16 * (wc & 1) + 4 * fq;
#pragma unroll
            for (int ai = 0; ai < 2; ++ai)
#pragma unroll
                for (int m = 0; m < 4; ++m) { const int row = row0 + ai * HALF + m * 16, pos = row & 4095;
                    const f32x4 cs0 = *(const f32x4*)(rope + (size_t)(pos * 32 + i0) * 2), cs1 = *(const f32x4*)(rope + (size_t)(pos * 32 + i0) * 2 + 4);
                    bf16_t* rowp = base + (size_t)row * 768 + col0; const float rs = rstd_of(ss, row) * ascale;
#pragma unroll
                    for (int bj = 0; bj < 2; ++bj) { const f32x4 v0 = acc[ai][bj][m][0] * rs, v1 = acc[ai][bj][m][1] * rs; f32x4 o0, o1;
                        o0[0] = (v0[0] * cs0[0] - v0[1] * cs0[1]) * sc; o0[1] = (v0[1] * cs0[0] + v0[0] * cs0[1]) * sc;
                        o0[2] = (v0[2] * cs0[2] - v0[3] * cs0[3]) * sc; o0[3] = (v0[3] * cs0[2] + v0[2] * cs0[3]) * sc;
                        o1[0] = (v1[0] * cs1[0] - v1[1] * cs1[1]) * sc; o1[1] = (v1[1] * cs1[0] + v1[0] * cs1[1]) * sc;
                        o1[2] = (v1[2] * cs1[2] - v1[3] * cs1[3]) * sc; o1[3] = (v1[3] * cs1[2] + v1[2] * cs1[3]) * sc;
                        { u32x2 w8; w8.x = pk_fp8(o0[0], o0[1], 0u, false); w8.x = pk_fp8(o0[2], o0[3], w8.x, true); w8.y = pk_fp8(o1[0], o1[1], 0u, false); w8.y = pk_fp8(o1[2], o1[3], w8.y, true);
                               *(u32x2*)((unsigned char*)base + (size_t)row * 768 + col0 + bj * HALF) = w8; } }
                    if (m == 3) asm volatile("" ::: "memory"); }
        }
    }
};
constexpr float WG8_SCALE = 32.0f;
struct EpiGates8 {
    static constexpr bool PERM = true;
    unsigned char* ws; size_t oGF, oGA; const float* ss;
    __device__ __forceinline__ void operator()(const f32x4 (&acc)[2][2][4][2], const Unit& u, int wr, int wc, int fr, int fq) const {
        const int row0 = u.pm * BM + wr * 64 + fr;
        {
            unsigned char* const gfp = ws + oGF; unsigned char* const gap = ws + oGA; const int col0 = u.pn * 128 + wc * 32 + 8 * fq;
#pragma unroll
            for (int ai = 0; ai < 2; ++ai)
#pragma unroll
                for (int m = 0; m < 4; ++m) { const size_t off = (size_t)(row0 + ai * HALF + m * 16) * 1024 + col0; const float rs = (-1.4426950408889634f / WG8_SCALE) * rstd_of(ss, row0 + ai * HALF + m * 16);
                    f32x4 g[2], ga[2];
#pragma unroll
                    for (int n = 0; n < 2; ++n) { const f32x4 xf = acc[ai][0][m][n] * rs, xa = acc[ai][1][m][n] * rs; f32x4 ef, ea, ia;
#pragma unroll
                        for (int j = 0; j < 4; ++j) { ef[j] = __builtin_fminf(__builtin_amdgcn_exp2f(xf[j]), 1.0e18f); ea[j] = __builtin_amdgcn_exp2f(xa[j]); }
                        ef = ef + 1.0f; ea = ea + 1.0f;
#pragma unroll
                        for (int j = 0; j < 4; ++j) { g[n][j] = __builtin_amdgcn_rcpf(ef[j]); ia[j] = __builtin_amdgcn_rcpf(ea[j]); }
                        ga[n] = ia; }
                    u32x2 wf, wa; wf.x = pk_u8x4(g[0]); wf.y = pk_u8x4(g[1]); wa.x = pk_u8x4(ga[0]); wa.y = pk_u8x4(ga[1]);
                    *(u32x2*)(gfp + off) = wf; *(u32x2*)(gap + off) = wa; }
        }
    }
};
struct EpiMix {
    static constexpr bool PERM = true; static constexpr int RESCALE_T = 4;
    const unsigned char* G; const unsigned char* R; bf16_t* O;
    __device__ __forceinline__ void rescale(f32x4 (&acc)[2][2][4][2], const Unit& u, int wr, int wc, int fr, int fq) const {
        asm volatile("" : "+v"(fr), "+v"(fq));
        const int row0 = u.pm * BM + wr * 64 + fr, col0 = u.pn * BM + wc * 32 + 8 * fq;
#pragma unroll
        for (int ai = 0; ai < 2; ++ai)
#pragma unroll
            for (int m = 0; m < 4; ++m) { const unsigned off = (unsigned)(row0 + ai * HALF + m * 16) * 1024u + (unsigned)col0;
#pragma unroll
                for (int bj = 0; bj < 2; ++bj) { const u32x2 ga = *(const u32x2*)(R + off + bj * HALF), gf = *(const u32x2*)(G + off + bj * HALF);
#pragma unroll
                    for (int n = 0; n < 2; ++n) { const f32x4 a4 = u8x4_f(n ? ga.y : ga.x); f32x4 f4 = u8x4_f(n ? gf.y : gf.x), q4;
#pragma unroll
                        for (int j = 0; j < 4; ++j) q4[j] = __builtin_amdgcn_rcpf(__builtin_fmaxf(f4[j], 0.25f));
                        acc[ai][bj][m][n] = acc[ai][bj][m][n] * (a4 * q4); } }
                if (m == 3) asm volatile("" ::: "memory"); }
    }
    __device__ __forceinline__ void operator()(const f32x4 (&acc)[2][2][4][2], const Unit& u, int wr, int wc, int fr, int fq) const {
        const int row0 = u.pm * BM + wr * 64 + fr, col0 = u.pn * BM + wc * 32 + 8 * fq;
#pragma unroll
        for (int ai = 0; ai < 2; ++ai) { u32x2 gq[4][2];
#pragma unroll
            for (int m = 0; m < 4; ++m)
#pragma unroll
                for (int bj = 0; bj < 2; ++bj) gq[m][bj] = *(const u32x2*)(G + (unsigned)(row0 + ai * HALF + m * 16) * 1024u + (unsigned)col0 + bj * HALF);
#pragma unroll
            for (int m = 0; m < 4; ++m) { const unsigned off = (unsigned)(row0 + ai * HALF + m * 16) * 1024u + (unsigned)col0;
#pragma unroll
                for (int bj = 0; bj < 2; ++bj) { f32x4 f0 = u8x4_f(gq[m][bj].x), f1 = u8x4_f(gq[m][bj].y);
#pragma unroll
                    for (int j = 0; j < 4; ++j) { f0[j] = __builtin_fmaxf(f0[j], 0.25f); f1[j] = __builtin_fmaxf(f1[j], 0.25f); }
                    const f32x4 v0 = acc[ai][bj][m][0] * (f0 * (1.0f / 255.0f)), v1 = acc[ai][bj][m][1] * (f1 * (1.0f / 255.0f));
                    *(u32x4*)(O + off + bj * HALF) = pack8(v0, v1); } }
            asm volatile("" ::: "memory"); }
    }
};
template <class E, class = void> struct rescale_at { static constexpr int t = -1; };
template <class E> struct rescale_at<E, decltype((void)E::RESCALE_T)> { static constexpr int t = E::RESCALE_T; };
template <bool SS> struct EpiResid {
    static constexpr bool PERM = true;
    const bf16_t* res; bf16_t* out; int ld; float* ssout; unsigned char* x8;
    __device__ __forceinline__ void operator()(const f32x4 (&acc)[2][2][4][2], const Unit& u, int wr, int wc, int fr, int fq) const {
        const int row0 = u.pm * BM + wr * 64 + fr, col0 = u.pn * BM + wc * 32 + 8 * fq, lane = fq * 16 + fr;
        PG8_LAS float* const part = (PG8_LAS float*)(unsigned)131072;
#pragma unroll
        for (int ai = 0; ai < 2; ++ai) { u32x4 rq[4][2];
#pragma unroll
            for (int m = 0; m < 4; ++m)
#pragma unroll
                for (int bj = 0; bj < 2; ++bj) rq[m][bj] = *(const u32x4*)(res + (size_t)(row0 + ai * HALF + m * 16) * ld + col0 + bj * HALF);
#pragma unroll
            for (int m = 0; m < 4; ++m) { const int row = row0 + ai * HALF + m * 16; const size_t off = (size_t)row * ld + col0; float sq = 0.f;
#pragma unroll
                for (int bj = 0; bj < 2; ++bj) { const u32x4 r = rq[m][bj]; const f32x4 v0 = acc[ai][bj][m][0] + bf4_lo(r), v1 = acc[ai][bj][m][1] + bf4_hi(r);
                    if (SS) { const f32x4 q = v0 * v0 + v1 * v1; sq += (q[0] + q[1]) + (q[2] + q[3]); }
                    *(u32x4*)(out + off + bj * HALF) = pack8(v0, v1);
                    if (x8) { u32x2 w8; w8.x = pk_fp8(v0[0], v0[1], 0u, false); w8.x = pk_fp8(v0[2], v0[3], w8.x, true); w8.y = pk_fp8(v1[0], v1[1], 0u, false); w8.y = pk_fp8(v1[2], v1[3], w8.y, true);
                        *(u32x2*)(x8 + (size_t)row * 1024 + col0 + bj * HALF) = w8; } }
                if (SS) { sq += __int_as_float(__builtin_amdgcn_ds_bpermute((lane ^ 16) << 2, __float_as_int(sq))); sq += __int_as_float(__builtin_amdgcn_ds_bpermute((lane ^ 32) << 2, __float_as_int(sq)));
                    if (fq == 0) part[wc * 256 + wr * 64 + fr + ai * HALF + m * 16] = sq; } }
            asm volatile("" ::: "memory"); }
        if (SS) {
            asm volatile("s_waitcnt lgkmcnt(0)" ::: "memory"); __builtin_amdgcn_s_barrier(); asm volatile("" ::: "memory");
            const int t = (wr * 4 + wc) * 64 + lane;
            if (t < 256) ssout[(size_t)(u.pm * BM + t) * 4 + u.pn] = (part[t] + part[256 + t]) + (part[512 + t] + part[768 + t]);
            asm volatile("s_waitcnt lgkmcnt(0)" ::: "memory"); __builtin_amdgcn_s_barrier(); asm volatile("" ::: "memory");
        }
    }
};
struct EpiSwiglu {
    static constexpr bool PERM = true;
    bf16_t* T; int ldc; const float* ss;
    __device__ __forceinline__ void operator()(const f32x4 (&acc)[2][2][4][2], const Unit& u, int wr, int wc, int fr, int fq) const {
        const int row0 = u.pm * BM + wr * 64 + fr, col0 = u.pn * 128 + wc * 32 + 8 * fq;
#pragma unroll
        for (int ai = 0; ai < 2; ++ai)
#pragma unroll
            for (int m = 0; m < 4; ++m) { const int r = row0 + ai * HALF + m * 16; const float rs = rstd_of(ss, r), rs2 = rs * rs, rse = -1.4426950408889634f * rs; f32x4 o[2];
#pragma unroll
                for (int n = 0; n < 2; ++n) { const f32x4 x = acc[ai][0][m][n] * rse; f32x4 e, q;
#pragma unroll
                    for (int j = 0; j < 4; ++j) e[j] = __builtin_amdgcn_exp2f(x[j]);
                    e = e + 1.0f;
#pragma unroll
                    for (int j = 0; j < 4; ++j) q[j] = __builtin_amdgcn_rcpf(e[j]);
                    o[n] = (acc[ai][0][m][n] * acc[ai][1][m][n]) * (q * rs2); }
                *(u32x4*)(T + (size_t)r * ldc + col0) = pack8(o[0], o[1]); }
    }
};
struct EpiSwigluF8 {
    static constexpr bool PERM = true;
    unsigned char* T; int ldc; float ascale;
    __device__ __forceinline__ void operator()(const f32x4 (&acc)[2][2][4][2], const Unit& u, int wr, int wc, int fr, int fq) const {
        const int row0 = u.pm * BM + wr * 64 + fr, col0 = u.pn * 128 + wc * 32 + 8 * fq;
#pragma unroll
        for (int ai = 0; ai < 2; ++ai)
#pragma unroll
            for (int m = 0; m < 4; ++m) { unsigned char* rowp = T + (size_t)(row0 + ai * HALF + m * 16) * ldc + col0; f32x4 o4[2];
#pragma unroll
                for (int n = 0; n < 2; ++n) { const f32x4 x = acc[ai][0][m][n] * (-1.4426950408889634f * ascale); f32x4 e;
#pragma unroll
                    for (int j = 0; j < 4; ++j) e[j] = __builtin_amdgcn_exp2f(x[j]);
                    e = e + 1.0f; f32x4 r;
#pragma unroll
                    for (int j = 0; j < 4; ++j) r[j] = __builtin_amdgcn_rcpf(e[j]);
                    o4[n] = (acc[ai][0][m][n] * acc[ai][1][m][n]) * (r * (ascale * ascale)); }
                const float* o = (const float*)o4;
                u32x2 w; w.x = pk_fp8(o4[0][0], o4[0][1], 0u, false); w.x = pk_fp8(o4[0][2], o4[0][3], w.x, true); w.y = pk_fp8(o4[1][0], o4[1][1], 0u, false); w.y = pk_fp8(o4[1][2], o4[1][3], w.y, true); (void)o;
                *(u32x2*)rowp = w; }
    }
};
struct EpiScatterY {
    static constexpr bool PERM = true;
    bf16_t* y; const int* rows; const float* w; float ascale; int slot_rows; size_t slot_stride;
    __device__ __forceinline__ void operator()(const f32x4 (&acc)[2][2][4][2], const Unit& u, int wr, int wc, int fr, int fq) const {
        const int row0 = u.pm * BM + wr * 64 + fr, col0 = u.pn * BM + wc * 32 + 8 * fq; bf16_t* const yb = y + (row0 >= slot_rows ? slot_stride : (size_t)0);
#pragma unroll
        for (int ai = 0; ai < 2; ++ai)
#pragma unroll
            for (int m = 0; m < 4; ++m) { const int r = row0 + ai * HALF + m * 16, tok = rows[r]; const float rs = w[r] * ascale;
                if (tok >= 0) { bf16_t* yp = yb + (size_t)tok * 1024 + col0;
#pragma unroll
                    for (int bj = 0; bj < 2; ++bj) *(u32x4*)(yp + bj * HALF) = pack8(acc[ai][bj][m][0] * rs, acc[ai][bj][m][1] * rs); } }
    }
};
template <class Epi, class Sched, bool GATHER = false, int BMAP = 0, int ALAY = 0, bool FP8 = false, bool ALIGN_EPI = true, bool SP2 = true>
__device__ __forceinline__ void gemm_phase(PG8_LAS unsigned char* lds, const Gemm g, const Sched& S, const Epi& E) {
    int tid_ = threadIdx.x; asm volatile("" : "+v"(tid_));
    const int tid = tid_, wid = __builtin_amdgcn_readfirstlane(tid >> 6), lane = tid & 63, wr = wid >> 2, wc = wid & 3, fr = lane & 15, fq = lane >> 4;
    const int K = g.K, nt = K / BK;
    unsigned voffA[2], voffA1[2], nvA0[2], nvA1[2], voffB[2], nvB[2]; int Rg[2], Cg[2], RbS[2];
#pragma unroll
    for (int i = 0; i < 2; ++i) { int R, C; stage_rc(tid * 16 + i * 8192, R, C); const int Rb = Epi::PERM ? ((R & ~31) + perm32(R & 31)) : R; Rg[i] = R; Cg[i] = C * 2;
        voffA[i] = ALAY == 1 ? (unsigned)(C >> 3) * g.lda + (unsigned)R * 16u : (unsigned)R * g.lda + (unsigned)C * 2u; voffA1[i] = voffA[i]; nvA0[i] = voffA[i]; nvA1[i] = voffA[i];
        voffB[i] = (BMAP == 1 ? (unsigned)(64 * (Rb & 63) + (Rb >> 6)) : (unsigned)Rb) * g.ldb + (unsigned)C * 2u; RbS[i] = Rb; }
#define PG8_BKIND(kind_, dv, dh) do { const int _k = (kind_); _Pragma("unroll") for (int _i = 0; _i < 2; ++_i) { const int _r = RbS[_i]; \
        dv[_i] = (unsigned)(_k == 0 ? _r : (_k == 1 ? 64 * (_r & 63) + (_r >> 6) : (_k == 2 ? 4 * _r : 16 * _r))) * g.ldb + (unsigned)Cg[_i]; } \
        dh = (size_t)(_k == 0 ? 128 : (_k == 1 ? 2 : (_k == 2 ? 512 : 2048))) * g.ldb; } while (0)
#define PG8_GROWS(pm_, d0, d1) do { _Pragma("unroll") for (int _i = 0; _i < 2; ++_i) { int _t0 = g.rows[(pm_) * BM + Rg[_i]], _t1 = g.rows[(pm_) * BM + HALF + Rg[_i]]; _t0 = _t0 < 0 ? 0 : _t0; _t1 = _t1 < 0 ? 0 : _t1; \
        d0[_i] = (unsigned)_t0 * g.lda + (unsigned)Cg[_i]; d1[_i] = (unsigned)_t1 * g.lda + (unsigned)Cg[_i]; } } while (0)
    const size_t kstepB = (size_t)(BK * 2), kstepA = ALAY == 1 ? (size_t)8 * g.lda : kstepB;
    const size_t hstepA = GATHER ? (size_t)0 : (ALAY == 1 ? (size_t)HALF * 16 : (size_t)HALF * g.lda); size_t hstepB = (BMAP == 1 ? (size_t)2 : (size_t)HALF) * g.ldb, nhB = hstepB;
    const unsigned ldsw = (unsigned)wid * 1024u;
    const int aoff = lds_byte(wr * 64 + fr, fq * 8), boff = lds_byte(wc * 32 + fr, fq * 8);
#define PG8_SA(b, h) (((b) * 2 + (h)) * HTB)
#define PG8_SB(b, h) ((4 + (b) * 2 + (h)) * HTB)
#define PG8_STAGE(bufoff, gbase, voff) do { _Pragma("unroll") for (int _i = 0; _i < 2; ++_i) \
        __builtin_amdgcn_global_load_lds((const unsigned*)((const char*)(gbase) + (voff)[_i]), (PG8_LAS unsigned*)(lds + (bufoff) + ldsw + _i * 8192), 16, 0, 0); } while (0)
#define PG8_LDA(dst, b, h) do { if constexpr (FP8) { _Pragma("unroll") for (int m = 0; m < 4; ++m) dst##8[m] = PG8_CAT8(*(const PG8_LAS bf16x8*)(lds + PG8_SA(b, h) + aoff + m * 2048), *(const PG8_LAS bf16x8*)(lds + PG8_SA(b, h) + aoff + m * 2048 + 1024)); } \
    else { _Pragma("unroll") for (int m = 0; m < 4; ++m) _Pragma("unroll") for (int k = 0; k < 2; ++k) dst[m][k] = *(const PG8_LAS bf16x8*)(lds + PG8_SA(b, h) + aoff + m * 2048 + k * 1024); } } while (0)
#define PG8_LDB(dst, b, h) do { if constexpr (FP8) { _Pragma("unroll") for (int n = 0; n < 2; ++n) dst##8[n] = PG8_CAT8(*(const PG8_LAS bf16x8*)(lds + PG8_SB(b, h) + boff + n * 2048), *(const PG8_LAS bf16x8*)(lds + PG8_SB(b, h) + boff + n * 2048 + 1024)); } \
    else { _Pragma("unroll") for (int n = 0; n < 2; ++n) _Pragma("unroll") for (int k = 0; k < 2; ++k) dst[n][k] = *(const PG8_LAS bf16x8*)(lds + PG8_SB(b, h) + boff + n * 2048 + k * 1024); } } while (0)
#define PG8_CAT8(lo, hi) __builtin_shufflevector(__builtin_bit_cast(v4i_t, lo), __builtin_bit_cast(v4i_t, hi), 0, 1, 2, 3, 4, 5, 6, 7)
#define PG8_MMA(ai, bj, At, Bt) do { __builtin_amdgcn_s_setprio(1); if constexpr (FP8) { _Pragma("unroll") for (int m = 0; m < 4; ++m) _Pragma("unroll") for (int n = 0; n < 2; ++n) \
        asm volatile("v_mfma_f32_16x16x128_f8f6f4 %0, %1, %2, %0" : "+v"(acc[ai][bj][m][n]) : "v"(Bt##8[n]), "v"(At##8[m])); } else { \
        _Pragma("unroll") for (int m = 0; m < 4; ++m) _Pragma("unroll") for (int n = 0; n < 2; ++n) _Pragma("unroll") for (int k = 0; k < 2; ++k) \
        acc[ai][bj][m][n] = __builtin_amdgcn_mfma_f32_16x16x32_bf16(Bt[n][k], At[m][k], acc[ai][bj][m][n], 0, 0, 0); } __builtin_amdgcn_s_setprio(0); } while (0)
#define PG8_WAIT_V(n) asm volatile("s_waitcnt vmcnt(" #n ")" ::: "memory")
#define PG8_WAIT_L(n) asm volatile("s_waitcnt lgkmcnt(" #n ")" ::: "memory")
#define PG8_BAR __builtin_amdgcn_s_barrier()
#define PG8_SCHED __builtin_amdgcn_sched_barrier(0)
    Unit cur, nxt; int ui = 0;
    if (!S.next(0, cur)) return;
    f32x4 acc[2][2][4][2];
#pragma unroll
    for (int a = 0; a < 2; ++a)
#pragma unroll
        for (int b = 0; b < 2; ++b)
#pragma unroll
            for (int m = 0; m < 4; ++m)
#pragma unroll
                for (int n = 0; n < 2; ++n) acc[a][b][m][n] = (f32x4){0.f, 0.f, 0.f, 0.f};
    bf16x8 At[4][2], B0[2][2], B1[2][2]; v8i_t At8[4], B08[2], B18[2];
    const char* cA = g.A + cur.aoff; const char* cB = g.B + cur.boff;
    if constexpr (GATHER) PG8_GROWS(cur.pm, voffA, voffA1);
    if constexpr (BMAP == 2) { PG8_BKIND(cur.z, voffB, hstepB); nvB[0] = voffB[0]; nvB[1] = voffB[1]; nhB = hstepB; }
    if constexpr (SP2) {
        PG8_STAGE(PG8_SB(0, 0), cB, voffB); PG8_STAGE(PG8_SB(0, 1), cB + hstepB, voffB); PG8_STAGE(PG8_SA(0, 0), cA, voffA); PG8_STAGE(PG8_SA(0, 1), cA + hstepA, voffA1);
        if (wr == 1) PG8_BAR;
        PG8_WAIT_V(2); PG8_BAR;
        PG8_STAGE(PG8_SB(1, 0), cB + kstepB, voffB); PG8_STAGE(PG8_SA(1, 0), cA + kstepA, voffA); PG8_STAGE(PG8_SB(1, 1), cB + hstepB + kstepB, voffB);
        PG8_WAIT_V(6); PG8_BAR;
    } else {
        PG8_STAGE(PG8_SB(0, 0), cB, voffB); PG8_STAGE(PG8_SA(0, 0), cA, voffA); PG8_STAGE(PG8_SB(0, 1), cB + hstepB, voffB); PG8_STAGE(PG8_SA(0, 1), cA + hstepA, voffA);
        if (wr == 1) PG8_BAR;
        PG8_WAIT_V(4); PG8_BAR;
        PG8_STAGE(PG8_SB(1, 0), cB + kstepB, voffB); PG8_STAGE(PG8_SA(1, 0), cA + kstepA, voffA); PG8_STAGE(PG8_SB(1, 1), cB + hstepB + kstepB, voffB);
        PG8_WAIT_V(6); PG8_BAR;
    }
    for (;;) {
        const bool has_next = S.next(ui + 1, nxt);
        const char* nA = has_next ? g.A + nxt.aoff : cA; const char* nB = has_next ? g.B + nxt.boff : cB;
        if constexpr (BMAP == 2) { if (has_next) PG8_BKIND(nxt.z, nvB, nhB); else { nvB[0] = voffB[0]; nvB[1] = voffB[1]; nhB = hstepB; } }
        if constexpr (GATHER) { if (has_next) PG8_GROWS(nxt.pm, nvA0, nvA1); else {
#pragma unroll
            for (int i = 0; i < 2; ++i) { nvA0[i] = voffA[i]; nvA1[i] = voffA1[i]; } } }
#pragma unroll 1
        for (int t = 0; t < nt; t += 2) {
            if constexpr (rescale_at<Epi>::t >= 0) { if (t == rescale_at<Epi>::t) E.rescale(acc, cur, wr, wc, fr, fq); }
            const bool last = (t == nt - 2);
            const char* a1 = cA + (size_t)(t + 1) * kstepA;
            const char* a2 = last ? nA : cA + (size_t)(t + 2) * kstepA; const char* b2 = last ? nB : cB + (size_t)(t + 2) * kstepB;
            const char* a3 = a2 + kstepA; const char* b3 = b2 + kstepB;
            unsigned w0[2], w1[2];
#pragma unroll
            for (int i = 0; i < 2; ++i) { w0[i] = voffA[i]; w1[i] = voffA1[i]; }
            unsigned wB[2] = {voffB[0], voffB[1]}; size_t hB = hstepB;
            if (BMAP == 2 && last) { asm volatile("; next unit's B row map" ::: ); wB[0] = nvB[0]; wB[1] = nvB[1]; hB = nhB; }
            if (GATHER && last) { asm volatile("; next unit's gathered rows" ::: );
#pragma unroll
                for (int i = 0; i < 2; ++i) { w0[i] = nvA0[i]; w1[i] = nvA1[i]; } }
            if constexpr (SP2) {
            PG8_LDB(B0, 0, 0); PG8_LDB(B1, 0, 1); PG8_SCHED; PG8_LDA(At, 0, 0); PG8_STAGE(PG8_SA(1, 1), a1 + hstepA, voffA1);
            PG8_WAIT_V(8); PG8_WAIT_L(0); PG8_BAR; PG8_MMA(0, 0, At, B0); PG8_MMA(0, 1, At, B1); PG8_BAR; PG8_SCHED;
            PG8_LDA(At, 0, 1); PG8_STAGE(PG8_SB(0, 0), b2, wB); PG8_STAGE(PG8_SB(0, 1), b2 + hB, wB); PG8_STAGE(PG8_SA(0, 0), a2, w0);
            PG8_WAIT_V(8); PG8_WAIT_L(0); PG8_BAR; PG8_MMA(1, 0, At, B0); PG8_MMA(1, 1, At, B1); PG8_BAR; PG8_SCHED;
            PG8_LDB(B0, 1, 0); PG8_LDB(B1, 1, 1); PG8_SCHED; PG8_LDA(At, 1, 0); PG8_STAGE(PG8_SA(0, 1), a2 + hstepA, w1);
            PG8_WAIT_V(8); PG8_WAIT_L(0); PG8_BAR; PG8_MMA(0, 0, At, B0); PG8_MMA(0, 1, At, B1); PG8_BAR; PG8_SCHED;
            PG8_LDA(At, 1, 1); PG8_STAGE(PG8_SB(1, 0), b3, wB); PG8_STAGE(PG8_SB(1, 1), b3 + hB, wB); PG8_STAGE(PG8_SA(1, 0), a3, w0);
            PG8_WAIT_V(8); PG8_WAIT_L(0); PG8_BAR; PG8_MMA(1, 0, At, B0); PG8_MMA(1, 1, At, B1); PG8_BAR; PG8_SCHED;
            } else { static_assert(SP2 || (!GATHER && BMAP != 2), "GATHER / BMAP 2 need the SP2 loop");
            PG8_LDB(B0, 0, 0); PG8_SCHED; PG8_LDA(At, 0, 0); PG8_STAGE(PG8_SA(1, 1), a1 + hstepA, voffA);
            PG8_WAIT_L(8); PG8_BAR; PG8_WAIT_L(0); PG8_MMA(0, 0, At, B0); PG8_BAR; PG8_SCHED;
            PG8_LDB(B1, 0, 1); PG8_STAGE(PG8_SB(0, 0), b2, voffB);
            PG8_BAR; PG8_WAIT_L(0); PG8_MMA(0, 1, At, B1); PG8_BAR;
            PG8_LDA(At, 0, 1); PG8_STAGE(PG8_SA(0, 0), a2, voffA);
            PG8_BAR; PG8_WAIT_L(0); PG8_MMA(1, 0, At, B0); PG8_BAR; PG8_SCHED;
            PG8_STAGE(PG8_SB(0, 1), b2 + hstepB, voffB);
            PG8_WAIT_V(6); PG8_BAR; PG8_MMA(1, 1, At, B1); PG8_BAR;
            PG8_LDB(B0, 1, 0); PG8_SCHED; PG8_LDA(At, 1, 0); PG8_STAGE(PG8_SA(0, 1), a2 + hstepA, voffA);
            PG8_WAIT_L(8); PG8_BAR; PG8_WAIT_L(0); PG8_MMA(0, 0, At, B0); PG8_BAR; PG8_SCHED;
            PG8_LDB(B1, 1, 1); PG8_STAGE(PG8_SB(1, 0), b3, voffB);
            PG8_BAR; PG8_WAIT_L(0); PG8_MMA(0, 1, At, B1); PG8_BAR;
            PG8_LDA(At, 1, 1); PG8_STAGE(PG8_SA(1, 0), a3, voffA);
            PG8_BAR; PG8_WAIT_L(0); PG8_MMA(1, 0, At, B0); PG8_BAR; PG8_SCHED;
            PG8_STAGE(PG8_SB(1, 1), b3 + hstepB, voffB);
            PG8_WAIT_V(6); PG8_BAR; PG8_MMA(1, 1, At, B1); PG8_BAR;
            }
        }
        if constexpr (ALIGN_EPI) { if (wr == 0) PG8_BAR; }
        if constexpr (FP8) {
            asm volatile("s_nop 15\n\ts_nop 15\n\ts_nop 15\n\ts_nop 15\n\ts_nop 15\n\ts_nop 15\n\ts_nop 15\n\ts_nop 15" ::: "memory");
#pragma unroll
            for (int a = 0; a < 2; ++a)
#pragma unroll
                for (int b = 0; b < 2; ++b)
#pragma unroll
                    for (int m = 0; m < 4; ++m) asm volatile("" : "+v"(acc[a][b][m][0]), "+v"(acc[a][b][m][1])); }
        E(acc, cur, wr, wc, fr, fq);
        if (!has_next) break;
#pragma unroll
        for (int a = 0; a < 2; ++a)
#pragma unroll
            for (int b = 0; b < 2; ++b)
#pragma unroll
                for (int m = 0; m < 4; ++m)
#pragma unroll
                    for (int n = 0; n < 2; ++n) acc[a][b][m][n] = (f32x4){0.f, 0.f, 0.f, 0.f};
        cur = nxt; cA = nA; cB = nB; ++ui;
        if constexpr (BMAP == 2) { voffB[0] = nvB[0]; voffB[1] = nvB[1]; hstepB = nhB; }
        if constexpr (GATHER) {
#pragma unroll
            for (int i = 0; i < 2; ++i) { voffA[i] = nvA0[i]; voffA1[i] = nvA1[i]; } }
        if constexpr (ALIGN_EPI) { if (wr == 1) PG8_BAR; }
    }
    PG8_WAIT_V(0);
    if constexpr (!ALIGN_EPI) { if (wr == 0) PG8_BAR; }
    PG8_BAR;
#undef PG8_GROWS
#undef PG8_BKIND
#undef PG8_SA
#undef PG8_SB
#undef PG8_STAGE
#undef PG8_LDA
#undef PG8_LDB
#undef PG8_MMA
#undef PG8_CAT8
#undef PG8_WAIT_V
#undef PG8_WAIT_L
#undef PG8_BAR
#undef PG8_SCHED
}
}
#define GAS __attribute__((address_space(1)))
#define LAS __attribute__((address_space(3)))
typedef unsigned short bf16;
typedef unsigned v4u __attribute__((ext_vector_type(4)));
typedef float f32x4 __attribute__((ext_vector_type(4)));
typedef short bf16x8 __attribute__((ext_vector_type(8)));
typedef GAS unsigned gu32;
typedef GAS unsigned long long gu64;
#define RLX_AGENT __ATOMIC_RELAXED, __HIP_MEMORY_SCOPE_AGENT
#define LDS_WAIT() asm volatile("s_waitcnt lgkmcnt(0)" ::: "memory")
#define VM_WAIT() asm volatile("s_waitcnt vmcnt(0)" ::: "memory")
__device__ __forceinline__ unsigned long long rt() { return __builtin_amdgcn_s_memrealtime(); }
__device__ __forceinline__ unsigned f2bf(float f) { unsigned u = __builtin_bit_cast(unsigned, f); return (u + 0x7fffu + ((u >> 16) & 1u)) >> 16; }
__device__ __forceinline__ unsigned pk2(float lo, float hi) { return f2bf(lo) | (f2bf(hi) << 16); }

#define XB_TMO      128
#define XB_XCNT(j)  (256  + 64 * (j))
#define XB_XSUB(j)  (1280 + 64 * (j))
#define XB_XGEN(j)  (2304 + 64 * (j))
#define XB_TOP      3328
#define XB_TOPGEN   3392
#define XCD_BAR_WORDS 3456
#define XB_SPIN_CAP (1u << 18)

__device__ __forceinline__ unsigned xb_ld(unsigned* p)              { return __hip_atomic_load(p, __ATOMIC_RELAXED, __HIP_MEMORY_SCOPE_AGENT); }
__device__ __forceinline__ unsigned xb_add(unsigned* p, unsigned v) { return __hip_atomic_fetch_add(p, v, __ATOMIC_RELAXED, __HIP_MEMORY_SCOPE_AGENT); }
__device__ __forceinline__ unsigned xb_xcc_id() { return (unsigned)__builtin_amdgcn_s_getreg((3 << 11) | 20) & 0xFu; }
#define XB_SPIN(cond, bar) do { unsigned _sp = 0; while (cond) { __builtin_amdgcn_s_sleep(1); \
    if ((++_sp & 255u) == 0u) { if (xb_ld(&(bar)[XB_TMO])) break; if (_sp > XB_SPIN_CAP) { atomicAdd(&(bar)[XB_TMO], 1u); break; } } } } while (0)

struct XcdBarrier {
    unsigned* bar; unsigned x; unsigned G;
    volatile LAS unsigned* st;
};

__device__ __forceinline__ XcdBarrier xcd_barrier_post(unsigned* bar, volatile LAS unsigned* st) {
    XcdBarrier b; b.bar = bar; b.x = xb_xcc_id(); b.st = st; b.G = 0u;
    if (threadIdx.x == 0) (void)xb_add(&bar[XB_XCNT(b.x)], 1u);
    return b;
}
__device__ __forceinline__ void xcd_barrier_complete(unsigned* bar, unsigned x, const unsigned G, unsigned& nloc, unsigned& nx) {
    unsigned sum, cnt, mine, sp = 0u;
    for (;;) {
        sum = 0u; cnt = 0u; mine = 0u;
#pragma nounroll
        for (unsigned j = 0; j < 16; ++j) { const unsigned c = xb_ld(&bar[XB_XCNT(j)]); sum += c; cnt += (c > 0u) ? 1u : 0u; mine = (j == x) ? c : mine; }
        if (sum == G) break;
        __builtin_amdgcn_s_sleep(1);
        if ((++sp & 255u) == 0u) { if (xb_ld(&bar[XB_TMO])) break; if (sp > XB_SPIN_CAP) { atomicAdd(&bar[XB_TMO], 1u); break; } }
    }
    nloc = mine > 0u ? mine : 1u; nx = cnt > 0u ? cnt : 1u;
}

__device__ __forceinline__ void xcd_barrier(const XcdBarrier& b) {
    asm volatile("s_waitcnt vmcnt(0)" ::: "memory");
    __syncthreads();
    if (threadIdx.x == 0) {
        unsigned* bar = b.bar;
        __builtin_amdgcn_s_waitcnt(0);
        unsigned nloc = b.st[0], nx = b.st[1];
        if (nloc == 0u) { xcd_barrier_complete(bar, b.x, b.G, nloc, nx); b.st[0] = nloc; b.st[1] = nx; }
        const unsigned old = xb_add(&bar[XB_XSUB(b.x)], 1u);
        const unsigned gen = old / nloc;
        if (old + 1u == (gen + 1u) * nloc) {
            __builtin_amdgcn_fence(__ATOMIC_RELEASE, "agent");
            asm volatile("s_waitcnt vmcnt(0)" ::: "memory");
            const unsigned og = xb_add(&bar[XB_TOP], 1u);
            const unsigned tg = og / nx;
            if (og + 1u == (tg + 1u) * nx) xb_add(&bar[XB_TOPGEN], 1u);
            else XB_SPIN(xb_ld(&bar[XB_TOPGEN]) == tg, bar);
            __builtin_amdgcn_fence(__ATOMIC_ACQUIRE, "agent");
            xb_add(&bar[XB_XGEN(b.x)], 1u);
            asm volatile("s_waitcnt vmcnt(0)" ::: "memory");
        } else {
            XB_SPIN(xb_ld(&bar[XB_XGEN(b.x)]) == gen, bar);
            __builtin_amdgcn_fence(__ATOMIC_ACQUIRE, "agent");
            asm volatile("s_waitcnt vmcnt(0)" ::: "memory");
        }
    }
    __syncthreads();
}

constexpr int NWAVES = 8;
constexpr int BATCH = 8, SEQ = 4096, DM = 1024, MTOK = BATCH * SEQ, INC = 4864, FF = 3584, NEXP = 8, AW = 768, AOW = 256;
constexpr float RMS_EPS = 1e-6f;
constexpr float QSCALE = 0.125f * 1.4426950408889634f;

constexpr size_t MiB = 1u << 20;
constexpr size_t WS_CTL = 0, CTL_ZERO_BYTES = 1 * MiB;
constexpr size_t WS_WIN = 1 * MiB;
constexpr size_t WIN_L = (size_t)INC * DM * 2;
constexpr size_t WS_WM = 20 * MiB; constexpr int KMIX = AOW + DM;
constexpr size_t WS_WOUT = 25 * MiB;
constexpr size_t WS_W13 = 29 * MiB;
constexpr size_t WS_W2 = 43 * MiB;
constexpr size_t WS_ROPE = 50 * MiB;
constexpr size_t WS_SS = 502 * MiB, SS_STRIDE = (size_t)MTOK * 4;
constexpr size_t WS_H = 118 * MiB;
constexpr size_t WS_Z = WS_H;
constexpr size_t WS_UT = 182 * MiB;
constexpr size_t WS_OATT = WS_Z - (size_t)(AOW / 8) * MTOK * 16;
constexpr size_t WS_Q = 214 * MiB, WS_K = 262 * MiB, WS_V = 310 * MiB;
constexpr size_t WS_GF = 358 * MiB, WS_GA = 422 * MiB;
constexpr size_t WS_MIX = 278 * MiB;
constexpr size_t WS_H2 = 118 * MiB, WS_TT = 182 * MiB;
constexpr size_t WS_M13 = 54 * MiB, WS_M2 = 110 * MiB;
constexpr size_t WS_H2B = 138 * MiB, WS_TTB = 170 * MiB;
constexpr float W13_SCALE = 32.0f, W2_SCALE = 64.0f;
constexpr int MOE_ROWS = MTOK + 2048;
constexpr int MOE_TILES = MOE_ROWS / 256;
constexpr size_t WS_ROWTOK = 52 * MiB, WS_ROWW = WS_ROWTOK + 512 * 1024;
constexpr size_t WS_SEL = 53 * MiB, WS_WTS = WS_SEL + 128 * 1024;
constexpr size_t WS_CNT = WS_WTS + 256 * 1024, WS_PLAN = WS_CNT + 64 * 1024;
constexpr size_t WS_WG8 = 96 * MiB;
constexpr size_t WS_WQK8 = 486 * MiB;
constexpr size_t WS_WV8 = 490 * MiB;
constexpr size_t WS_X8 = 504 * MiB;
constexpr float WG_SCALE = pg8::WG8_SCALE;
constexpr size_t WS_Y = 408 * MiB;
constexpr size_t WS_END = 536 * MiB;
static_assert(WS_TTB + (size_t)2 * MOE_ROWS * FF <= WS_Y && WS_Y + (size_t)2 * MTOK * DM * 2 <= WS_END && 2 * MOE_ROWS * 4 <= 512 * 1024 && WS_PLAN + 4096 <= 54 * MiB, "moe map");
static_assert(WS_M13 + (size_t)8 * 2 * FF * DM <= WS_M2 && WS_M2 + (size_t)8 * DM * FF <= WS_H2B && WS_H2B + (size_t)MTOK * DM <= WS_TTB && WS_MIX + (size_t)MTOK * DM * 2 <= WS_GF, "d_ws map");

constexpr int XP = 2 * DM;
constexpr int CW_BAR = 4096;
constexpr int RING_BYTES = 131072, LDS_BYTES = 147456, LDSCTL_OFF = LDS_BYTES - 1024, MISC_OFF = LDSCTL_OFF + 320;
static_assert(512 * 68 * 4 <= LDSCTL_OFF, "attention state fits under the control words");

struct Args { const float* in[16]; float* out; unsigned char* ws; int G, pad; };

struct Frame { LAS unsigned char* lds; volatile LAS unsigned* MISC; gu32* ctl; int tid, lane, wave, vcu, G; };

__device__ __forceinline__ float wave_sum(float v, int lane) {
#pragma unroll
    for (int o = 1; o < 64; o <<= 1) v += __int_as_float(__builtin_amdgcn_ds_bpermute((lane ^ o) << 2, __float_as_int(v)));
    return v;
}
__device__ __forceinline__ float bflo(unsigned w) { return __uint_as_float(w << 16); }
__device__ __forceinline__ float bfhi(unsigned w) { return __uint_as_float(w & 0xffff0000u); }

struct RowMap { int kind, base;
    __device__ __forceinline__ int operator()(int n) const {
        if (kind == 0) return n + base;
        if (kind == 2) return (n >> 2) * 8 + (n & 3) + base;
        if (kind == 5) { const int isk = n >= 768, c = n - (isk ? 768 : 0), hd = c >> 6, d = c & 63; return (isk ? 768 : 0) + hd * 64 + 2 * (d & 31) + (d >> 5); }
        if (kind == 4) { const int gch = n & 1023; return (gch >> 7) * 256 + (gch & 127) + (n >= 1024 ? 128 : 0); }
        if (kind == 3) return (n >> 7) * 256 + (n & 127) + base;
        if (n < 512) return n;
        if (n < 2048) { const int isk = n >= 1280, c = n - (isk ? 1280 : 512), hd = c >> 6, d = c & 63; return (isk ? 2048 : 1280) + hd * 64 + 2 * (d & 31) + (d >> 5); }
        if (n < 2816) return 512 + (n - 2048);
        { const int gch = (n - 2816) & 1023; return 2816 + (gch >> 7) * 256 + (gch & 127) + (n >= 3840 ? 128 : 0); }
    } };
struct TrJob { const float* W; int N; void* WT; int ldk; RowMap rm; const float* gain; float scale; int item; int ldw; int f8; };
__device__ __forceinline__ void tr_load(const TrJob& j, int lane, float (&r)[32]) {
    const int nblk = j.N / 32, kb = j.item / nblk, nb = j.item % nblk, k0 = 64 * kb, n0 = 32 * nb;
#pragma unroll
    for (int i = 0; i < 32; ++i) { const int kk = 2 * i + (lane >> 5); r[i] = j.W[(size_t)(k0 + kk) * (j.ldw ? j.ldw : j.N) + n0 + (lane & 31)]; }
}
template <bool F8> __device__ __forceinline__ void tr_store(const TrJob& j, int lane, const float (&r)[32], LAS float* scr) {
    const int nblk = j.N / 32, kb = j.item / nblk, nb = j.item % nblk, k0 = 64 * kb, n0 = 32 * nb;
#pragma unroll
    for (int i = 0; i < 32; ++i) { const int kk = 2 * i + (lane >> 5); scr[kk * 33 + (lane & 31)] = r[i] * (j.gain ? j.scale * j.gain[k0 + kk] : j.scale); }
    LDS_WAIT(); asm volatile("" ::: "memory");
    const int c = lane & 7;
#pragma unroll
    for (int q = 0; q < 4; ++q) { const int n = (lane >> 3) + 8 * q; const LAS float* sp = scr + (8 * c) * 33 + n; const size_t drow = (size_t)j.rm(n0 + n) * j.ldk + k0 + 8 * c;
        if (F8) { unsigned lo = pg8::pk_fp8(sp[0 * 33], sp[1 * 33], 0u, false); lo = pg8::pk_fp8(sp[2 * 33], sp[3 * 33], lo, true);
                  unsigned hi = pg8::pk_fp8(sp[4 * 33], sp[5 * 33], 0u, false); hi = pg8::pk_fp8(sp[6 * 33], sp[7 * 33], hi, true);
                  *(GAS unsigned long long*)((unsigned char*)j.WT + drow) = (unsigned long long)lo | ((unsigned long long)hi << 32); }
        else { v4u o; o.x = pk2(sp[0 * 33], sp[1 * 33]); o.y = pk2(sp[2 * 33], sp[3 * 33]); o.z = pk2(sp[4 * 33], sp[5 * 33]); o.w = pk2(sp[6 * 33], sp[7 * 33]);
               *(GAS v4u*)((bf16*)j.WT + drow) = o; } }
    LDS_WAIT(); asm volatile("" ::: "memory");
}
__device__ __forceinline__ void rms_row(const bf16* xrow, const f32x4 (&gn)[4], f32x4 (&v)[4], int lane) {
    const GAS unsigned long long* xr = (const GAS unsigned long long*)xrow + lane; float s = 0.f;
#pragma unroll
    for (int j = 0; j < 4; ++j) { const unsigned long long w = xr[64 * j]; v[j].x = bflo((unsigned)w); v[j].y = bfhi((unsigned)w); v[j].z = bflo((unsigned)(w >> 32)); v[j].w = bfhi((unsigned)(w >> 32)); s += (v[j].x * v[j].x + v[j].y * v[j].y) + (v[j].z * v[j].z + v[j].w * v[j].w); }
    const float rstd = 1.0f / sqrtf(wave_sum(s, lane) * (1.0f / DM) + RMS_EPS);
#pragma unroll
    for (int j = 0; j < 4; ++j) v[j] = v[j] * rstd * gn[j];
}
__device__ __forceinline__ void prep_x_phase(Frame& F, const float* x, bf16* xb, float* ss, unsigned char* x8) {
    const int gw = F.vcu * NWAVES + F.wave, NGW = F.G * NWAVES;
    for (int m = gw; m < MTOK; m += NGW) { const GAS f32x4* xr = (const GAS f32x4*)(x + (size_t)m * DM) + F.lane; f32x4 v[4]; float sq = 0.f;
#pragma unroll
        for (int j = 0; j < 4; ++j) { v[j] = xr[64 * j]; sq += (v[j].x * v[j].x + v[j].y * v[j].y) + (v[j].z * v[j].z + v[j].w * v[j].w); }
        sq = wave_sum(sq, F.lane); if (F.lane < 4) ss[(size_t)m * 4 + F.lane] = F.lane == 0 ? sq : 0.f;
        GAS unsigned long long* o8 = (GAS unsigned long long*)(xb + (size_t)m * XP) + F.lane;
#pragma unroll
        for (int j = 0; j < 4; ++j) o8[64 * j] = (unsigned long long)pk2(v[j].x, v[j].y) | ((unsigned long long)pk2(v[j].z, v[j].w) << 32);
        GAS unsigned* q8 = (GAS unsigned*)(x8 + (size_t)m * DM) + F.lane;
#pragma unroll
        for (int j = 0; j < 4; ++j) { unsigned w8 = pg8::pk_fp8(v[j].x, v[j].y, 0u, false); w8 = pg8::pk_fp8(v[j].z, v[j].w, w8, true); q8[64 * j] = w8; } }
}

__device__ __forceinline__ TrJob dense_job(const Args& a, int it) {
    unsigned char* ws = a.ws;
    constexpr int I_U = 16 * (512 / 32), I_V = 16 * (768 / 32), I_AT = 4 * 32, I_OUT = 16 * 32, I_W1 = 16 * (FF / 32), I_G = 16 * (2048 / 32), I_QK = 16 * (1536 / 32);
    constexpr int PER_L = I_U + I_V + I_AT + I_OUT;
    int r = it; TrJob j; j.gain = nullptr; j.scale = 1.0f; j.rm = RowMap{0, 0}; j.ldw = 0; j.f8 = 0;
    if (r < 2 * PER_L) { const int l = r / PER_L; r -= l * PER_L;
        if (r < I_U) { j.W = a.in[2] + (size_t)l * DM * INC; j.N = 512; j.ldw = INC; j.WT = ws + WS_WIN + l * WIN_L; j.ldk = DM; j.gain = a.in[1] + l * DM; }
        else if (r < I_U + I_V) { r -= I_U; j.W = a.in[2] + (size_t)l * DM * INC + 2048; j.N = 768; j.ldw = INC; j.WT = ws + WS_WV8 + (size_t)l * 768 * DM; j.ldk = DM; j.gain = a.in[1] + l * DM; j.scale = WG_SCALE; j.f8 = 1; }
        else if (r < I_U + I_V + I_AT) { r -= I_U + I_V; j.W = a.in[4] + (size_t)l * AOW * DM; j.N = DM; j.WT = (bf16*)(ws + WS_WM) + (size_t)l * DM * KMIX; j.ldk = KMIX; }
        else { r -= I_U + I_V + I_AT; j.W = a.in[5] + (size_t)l * DM * DM; j.N = DM; j.WT = (bf16*)(ws + WS_WOUT) + (size_t)l * DM * DM; j.ldk = DM; } }
    else { r -= 2 * PER_L;
        if (r < I_W1) { j.W = a.in[7]; j.N = FF; j.WT = ws + WS_W13; j.ldk = DM; j.rm = RowMap{3, 0}; j.gain = a.in[6]; }
        else if (r < 2 * I_W1) { r -= I_W1; j.W = a.in[8]; j.N = FF; j.WT = ws + WS_W13; j.ldk = DM; j.rm = RowMap{3, 128}; j.gain = a.in[6]; }
        else if (r < 3 * I_W1) { r -= 2 * I_W1; j.W = a.in[9]; j.N = DM; j.WT = ws + WS_W2; j.ldk = FF; }
        else if (r < 3 * I_W1 + 2 * I_G) { r -= 3 * I_W1; const int l = r / I_G; r -= l * I_G; j.W = a.in[2] + (size_t)l * DM * INC + 2816; j.N = 2048; j.ldw = INC; j.WT = ws + WS_WG8 + (size_t)l * 2048 * DM; j.ldk = DM; j.rm = RowMap{4, 0};
               j.gain = a.in[1] + l * DM; j.scale = WG_SCALE; j.f8 = 1; }
        else { r -= 3 * I_W1 + 2 * I_G; const int l = r / I_QK; r -= l * I_QK; j.W = a.in[2] + (size_t)l * DM * INC + 512; j.N = 1536; j.ldw = INC; j.WT = ws + WS_WQK8 + (size_t)l * 1536 * DM; j.ldk = DM; j.rm = RowMap{5, 0};
               j.gain = a.in[1] + l * DM; j.scale = WG_SCALE; j.f8 = 1; } }
    j.item = r; return j;
}
constexpr int MOE_I_W1 = 16 * (FF / 32), MOE_I_W2 = (FF / 64) * 32, MOE_NITEMS = NEXP * (2 * MOE_I_W1 + MOE_I_W2), MOE_EARLY_E = 6, MOE_EARLY = MOE_EARLY_E * 2 * MOE_I_W1;
constexpr int CONV_WGS = 40, GEMM_WGS = 256 - CONV_WGS, CONV_PER_WAVE = 0, CONV_PHASE_ITEMS = CONV_WGS * NWAVES * CONV_PER_WAVE;
static_assert(2 * CONV_PHASE_ITEMS <= MOE_EARLY && GEMM_WGS % 8 == 0 && (640 + GEMM_WGS - 1) / GEMM_WGS == 3, "early conversion");
__device__ __forceinline__ TrJob moe_job(const Args& a, int v) {
    unsigned char* ws = a.ws;
    constexpr int I_W1 = MOE_I_W1;
    int e, r;
    if (v < MOE_EARLY) { e = v / (2 * I_W1); r = v - e * (2 * I_W1); }
    else { v -= MOE_EARLY; if (v < (NEXP - MOE_EARLY_E) * 2 * I_W1) { const int q = v / (2 * I_W1); e = MOE_EARLY_E + q; r = v - q * (2 * I_W1); } else { v -= (NEXP - MOE_EARLY_E) * 2 * I_W1; e = v / MOE_I_W2; r = 2 * I_W1 + (v - e * MOE_I_W2); } }
    TrJob j; j.gain = nullptr; j.scale = W13_SCALE; j.rm = RowMap{3, 0}; j.ldw = 0; j.f8 = 1;
    if (r < I_W1) { j.W = a.in[12] + (size_t)e * DM * FF; j.N = FF; j.WT = ws + WS_M13 + (size_t)e * 2 * FF * DM; j.ldk = DM; }
    else if (r < 2 * I_W1) { r -= I_W1; j.W = a.in[13] + (size_t)e * DM * FF; j.N = FF; j.WT = ws + WS_M13 + (size_t)e * 2 * FF * DM; j.ldk = DM; j.rm = RowMap{3, 128}; }
    else { r -= 2 * I_W1; j.W = a.in[14] + (size_t)e * FF * DM; j.N = DM; j.WT = ws + WS_M2 + (size_t)e * DM * FF; j.ldk = FF; j.scale = W2_SCALE; j.rm = RowMap{0, 0}; }
    j.item = r; return j;
}
__device__ __forceinline__ void p0_weights(Frame& F, const Args& a) {
    LAS float* scr = (LAS float*)(F.lds + F.wave * 16384);
    const int gw = F.vcu * NWAVES + F.wave, NGW = F.G * NWAVES;
    constexpr int I_IN = 16 * (512 / 32) + 16 * (768 / 32), I_AT = 4 * 32, I_OUT = 16 * 32, I_W1 = 16 * (FF / 32), I_W2 = (FF / 64) * 32, I_G = 16 * (2048 / 32), I_QK = 16 * (1536 / 32), NITEMS = 2 * (I_IN + I_AT + I_OUT) + 2 * I_W1 + I_W2 + 2 * I_G + 2 * I_QK;
    static_assert(I_W2 == I_W1, "dense_job counts w2's items as I_W1");
    if (gw >= NITEMS) return;
    TrJob cur = dense_job(a, gw); float rc[32]; tr_load(cur, F.lane, rc);
#pragma unroll 1
    for (int it = gw; it < NITEMS; it += NGW) { const int nx = it + NGW; const bool more = nx < NITEMS; TrJob nj = cur; float rn[32];
        if (more) { nj = dense_job(a, nx); tr_load(nj, F.lane, rn); }
        if (cur.f8) tr_store<true>(cur, F.lane, rc, scr); else tr_store<false>(cur, F.lane, rc, scr);
        if (more) { cur = nj;
#pragma unroll
            for (int i = 0; i < 32; ++i) rc[i] = rn[i]; } }
}
__device__ __forceinline__ void p0_moe_weights(Frame& F, const Args& a, int first, int NITEMS, int gw, int NGW) {
    LAS float* scr = (LAS float*)(F.lds + F.wave * 16384);
    gw += first;
    if (gw >= NITEMS) return;
    TrJob cur = moe_job(a, gw), nx1 = cur; float rc[32], r1[32];
    tr_load(cur, F.lane, rc);
    if (gw + NGW < NITEMS) { nx1 = moe_job(a, gw + NGW); tr_load(nx1, F.lane, r1); }
#pragma unroll 1
    for (int it = gw; it < NITEMS; it += NGW) { const int n2 = it + 2 * NGW; const bool more2 = n2 < NITEMS, more1 = it + NGW < NITEMS; TrJob nx2 = cur; float r2[32];
        if (more2) { nx2 = moe_job(a, n2); tr_load(nx2, F.lane, r2); }
        tr_store<true>(cur, F.lane, rc, scr);
        if (more1) { cur = nx1;
#pragma unroll
            for (int i = 0; i < 32; ++i) rc[i] = r1[i]; }
        if (more2) { nx1 = nx2;
#pragma unroll
            for (int i = 0; i < 32; ++i) r1[i] = r2[i]; } }
}
__device__ __forceinline__ void p0_tables(Frame& F, const Args& a) {
    unsigned char* ws = a.ws;
    const int gt = F.vcu * (NWAVES * 64) + F.tid, NGT = F.G * NWAVES * 64;
    float* rope = (float*)(ws + WS_ROPE);
    for (int i = gt; i < SEQ * 32; i += NGT) { const int pos = i >> 5, f = i & 31; const float inv = powf(10000.0f, -(float)f * 2.0f / 64.0f); const float ang = (float)pos * inv;
        rope[2 * i] = cosf(ang); rope[2 * i + 1] = sinf(ang); }
    LAS float* tab = (LAS float*)F.lds;
    LAS float* wl = (LAS float*)(F.lds + 1024 + F.wave * 2048);
    if (F.tid < 128) tab[F.tid] = cospif((float)F.tid * (1.0f / 64.0f));
    __syncthreads();
    const int gw = F.vcu * NWAVES + F.wave, NGW = F.G * NWAVES;
    for (int it = gw; it < 2 * DM; it += NGW) { const int l = it >> 10, j = it & 1023; const float* wf = a.in[3] + (size_t)l * 512 * DM + j;
#pragma unroll
        for (int q = 0; q < 8; ++q) wl[F.lane + 64 * q] = wf[(size_t)(F.lane + 64 * q) * DM];
        LDS_WAIT(); asm volatile("" ::: "memory");
#pragma unroll 1
        for (int o = 0; o < 16; ++o) { const int kk = o * 64 + F.lane, part = kk & 1, cf = 4 * (kk >> 3) + ((kk >> 1) & 3), g = cf >> 7, c = cf & 127, sh = part ? 96 : 0;
            const float c1 = tab[c], tw = 2.0f * c1; float u0 = part ? 0.f : 1.f, u1 = part ? tab[(c + sh) & 127] : c1;
            float acc = 0.f, acc2 = 0.f; const LAS float* wg = wl + g * 128;
#pragma unroll 4
            for (int kc = 0; kc < 128; kc += 4) { const f32x4 w4 = *(const LAS f32x4*)(wg + kc);
                const float u2 = tw * u1 - u0, u3 = tw * u2 - u1; acc += u0 * w4[0]; acc2 += u1 * w4[1]; acc += u2 * w4[2]; acc2 += u3 * w4[3]; u0 = tw * u3 - u2; u1 = tw * u0 - u3; }
            acc += acc2;
            ((bf16*)(ws + WS_WM))[(size_t)l * DM * KMIX + (size_t)j * KMIX + AOW + kk] = (bf16)f2bf(acc * 0.08838834764831845f); }
        LDS_WAIT(); asm volatile("" ::: "memory");
    }
}

__device__ __forceinline__ void fft_phase(Frame& F, const bf16* UT, bf16* Zb) {
    const int lane = F.lane, w = F.wave & 3, cg = F.wave >> 2, lr = lane & 15, lg = lane >> 4;
    LAS unsigned char* f2 = F.lds; LAS unsigned char* f1 = F.lds + 16384; LAS float* tw = (LAS float*)(F.lds + 32768);
#pragma unroll 1
    for (int idx = F.tid; idx < 4096; idx += NWAVES * 64) {
        { const int f = idx >> 8, l = (idx >> 2) & 63, e2 = idx & 3, q = f >> 2, KK = (f >> 1) & 1, cs = f & 1, llr = l & 15, llg = l >> 4; float v[2];
#pragma unroll
          for (int h = 0; h < 2; ++h) { const int e = 2 * e2 + h, n2 = 32 * KK + (e < 4 ? 4 * llg + e : 16 + 4 * llg + e - 4), k2 = 16 * q + llr; const float x = (float)((n2 * k2) & 63) * (1.0f / 32.0f); v[h] = (cs ? sinpif(x) : cospif(x)) * 0.125f; }
          *(LAS unsigned*)(f2 + f * 1024 + l * 16 + e2 * 4) = pk2(v[0], v[1]); }
        { const int f = idx >> 8, l = (idx >> 2) & 63, e2 = idx & 3, ww = f >> 2, kk = (f >> 1) & 1, cs = f & 1, llr = l & 15, llg = l >> 4; float v[2];
#pragma unroll
          for (int h = 0; h < 2; ++h) { const int n1 = 32 * kk + 8 * llg + 2 * e2 + h, k1 = 16 * ww + llr; const float x = (float)((n1 * k1) & 63) * (1.0f / 32.0f); v[h] = (cs ? -sinpif(x) : cospif(x)) * 0.125f; }
          *(LAS unsigned*)(f1 + f * 1024 + l * 16 + e2 * 4) = pk2(v[0], v[1]); }
        { const int ww = idx >> 10, l = (idx >> 4) & 63, ir = idx & 15, n2 = 16 * (ir >> 2) + 4 * (l >> 4) + (ir & 3), k1 = 16 * ww + (l & 15); const float x = (float)(n2 * k1) * (1.0f / 2048.0f);
          tw[(ww * 64 + l) * 32 + ir] = cospif(x); tw[(ww * 64 + l) * 32 + 16 + ir] = sinpif(x); }
    }
    __syncthreads();
    bf16x8 F1c[2], F1s[2];
#pragma unroll
    for (int kk = 0; kk < 2; ++kk) { F1c[kk] = *(const LAS bf16x8*)(f1 + ((w * 2 + kk) * 2) * 1024 + lane * 16); F1s[kk] = *(const LAS bf16x8*)(f1 + ((w * 2 + kk) * 2 + 1) * 1024 + lane * 16); }
    float twc[4][4], tws[4][4];
#pragma unroll
    for (int I = 0; I < 4; ++I) { const f32x4 tc = *(const LAS f32x4*)(tw + (w * 64 + lane) * 32 + 4 * I), ts = *(const LAS f32x4*)(tw + (w * 64 + lane) * 32 + 16 + 4 * I);
#pragma unroll
        for (int r = 0; r < 4; ++r) { twc[I][r] = tc[r]; tws[I][r] = ts[r]; } }
    for (int it = F.vcu * 2 + cg; it < BATCH * 128; it += F.G * 2) {
        const int b = it >> 7, quad = it & 127;
        unsigned outp[4][4][4];
#pragma unroll
        for (int cc = 0; cc < 4; ++cc) {
            const bf16* xp = UT + (size_t)(quad * 4 + cc) * MTOK + b * SEQ + 64 * lr + 8 * lg;
            bf16x8 xa[4][2];
#pragma unroll
            for (int I = 0; I < 4; ++I)
#pragma unroll
                for (int kk = 0; kk < 2; ++kk) xa[I][kk] = *(const GAS bf16x8*)(xp + 1024 * I + 32 * kk);
            f32x4 d1r[4], d1i[4];
#pragma unroll
            for (int I = 0; I < 4; ++I) { d1r[I] = (f32x4){0.f, 0.f, 0.f, 0.f}; d1i[I] = (f32x4){0.f, 0.f, 0.f, 0.f};
#pragma unroll
                for (int kk = 0; kk < 2; ++kk) { d1r[I] = __builtin_amdgcn_mfma_f32_16x16x32_bf16(xa[I][kk], F1c[kk], d1r[I], 0, 0, 0); d1i[I] = __builtin_amdgcn_mfma_f32_16x16x32_bf16(xa[I][kk], F1s[kk], d1i[I], 0, 0, 0); } }
            bf16x8 yr[2], yi[2], yn[2];
#pragma unroll
            for (int KK = 0; KK < 2; ++KK) { float vr[8], vi[8];
#pragma unroll
                for (int e = 0; e < 8; ++e) { const int I = 2 * KK + (e >> 2), r = e & 3; const float a = d1r[I][r], bb = d1i[I][r]; vr[e] = a * twc[I][r] + bb * tws[I][r]; vi[e] = bb * twc[I][r] - a * tws[I][r]; }
                v4u pr, pi, pn; pr.x = pg8::cvt_pk_bf16(vr[0], vr[1]); pr.y = pg8::cvt_pk_bf16(vr[2], vr[3]); pr.z = pg8::cvt_pk_bf16(vr[4], vr[5]); pr.w = pg8::cvt_pk_bf16(vr[6], vr[7]);
                pi.x = pg8::cvt_pk_bf16(vi[0], vi[1]); pi.y = pg8::cvt_pk_bf16(vi[2], vi[3]); pi.z = pg8::cvt_pk_bf16(vi[4], vi[5]); pi.w = pg8::cvt_pk_bf16(vi[6], vi[7]);
                pn.x = pr.x ^ 0x80008000u; pn.y = pr.y ^ 0x80008000u; pn.z = pr.z ^ 0x80008000u; pn.w = pr.w ^ 0x80008000u;
                yr[KK] = __builtin_bit_cast(bf16x8, pr); yi[KK] = __builtin_bit_cast(bf16x8, pi); yn[KK] = __builtin_bit_cast(bf16x8, pn); }
#pragma unroll
            for (int q = 0; q < 4; ++q) { f32x4 zr = (f32x4){0.f, 0.f, 0.f, 0.f}, zi = (f32x4){0.f, 0.f, 0.f, 0.f};
#pragma unroll
                for (int KK = 0; KK < 2; ++KK) { const bf16x8 fc = *(const LAS bf16x8*)(f2 + ((q * 2 + KK) * 2) * 1024 + lane * 16), fs = *(const LAS bf16x8*)(f2 + ((q * 2 + KK) * 2 + 1) * 1024 + lane * 16);
                    zr = __builtin_amdgcn_mfma_f32_16x16x32_bf16(yr[KK], fc, zr, 0, 0, 0); zr = __builtin_amdgcn_mfma_f32_16x16x32_bf16(yi[KK], fs, zr, 0, 0, 0);
                    zi = __builtin_amdgcn_mfma_f32_16x16x32_bf16(yi[KK], fc, zi, 0, 0, 0); zi = __builtin_amdgcn_mfma_f32_16x16x32_bf16(yn[KK], fs, zi, 0, 0, 0); }
#pragma unroll
                for (int r = 0; r < 4; ++r) outp[q][r][cc] = pg8::cvt_pk_bf16(zr[r], zi[r]); }
        }
#pragma unroll
        for (int q = 0; q < 4; ++q)
#pragma unroll
            for (int r = 0; r < 4; ++r) { const int k = 16 * w + 4 * lg + r + 64 * (16 * q + lr); v4u o; o.x = outp[q][r][0]; o.y = outp[q][r][1]; o.z = outp[q][r][2]; o.w = outp[q][r][3];
                *(GAS v4u*)(Zb + ((size_t)quad * MTOK + (size_t)b * SEQ + k) * 8) = o; }
    }
    __syncthreads();
}

__device__ __forceinline__ bf16x8 f8x8_bf16(unsigned long long w) {
    typedef float f32x2_t __attribute__((ext_vector_type(2)));
    const f32x2_t a = __builtin_amdgcn_cvt_pk_f32_fp8((int)(unsigned)w, false), b = __builtin_amdgcn_cvt_pk_f32_fp8((int)(unsigned)w, true),
                  c = __builtin_amdgcn_cvt_pk_f32_fp8((int)(unsigned)(w >> 32), false), d = __builtin_amdgcn_cvt_pk_f32_fp8((int)(unsigned)(w >> 32), true);
    v4u o; o.x = pg8::cvt_pk_bf16(a.x, a.y); o.y = pg8::cvt_pk_bf16(b.x, b.y); o.z = pg8::cvt_pk_bf16(c.x, c.y); o.w = pg8::cvt_pk_bf16(d.x, d.y); return __builtin_bit_cast(bf16x8, o); }
__device__ __forceinline__ void attn_mfma_phase(Frame& F, const unsigned char* Q, const unsigned char* K, const unsigned char* VT, bf16* OA) {
    LAS float* st = (LAS float*)F.lds;
    const int lane = F.lane, lr = lane & 15, lg = lane >> 4, bp16 = (lane ^ 16) << 2, bp32 = (lane ^ 32) << 2;
    for (int unit = F.vcu; unit < 256; unit += F.G) {
        const int b = unit >> 5, pb = (unit >> 2) & 7, j = unit & 3, P0 = pb * 512;
#pragma unroll 1
        for (int pass = 0; pass < 3; ++pass) {
            const int g = 2 - pass, dsh = 2 * g, dl = 1 << dsh, L = SEQ >> dsh, head = g * 4 + j, lns = 4 - dsh;
#pragma unroll 1
            for (int tt = 0; tt < 2; ++tt) {
                const int tau = F.wave * 2 + tt, r = tau >> lns, sblk = tau & ((1 << lns) - 1), iq0 = (P0 >> dsh) + 32 * sblk;
                const unsigned char* Kh = K + (size_t)b * SEQ * AW + head * 64 + 8 * lg;
                const unsigned char* Vh = VT + (size_t)(head * 64 + lr) * MTOK + (size_t)b * SEQ + r * L;
                long qf[2][2]; int prow[2]; f32x4 o[4][2]; float m[2], l[2];
#pragma unroll
                for (int qb = 0; qb < 2; ++qb) { const int pl = dl * (32 * sblk + 16 * qb + lr) + r; prow[qb] = pl;
                    const unsigned char* qp = Q + (size_t)(b * SEQ + P0 + pl) * AW + head * 64 + 8 * lg;
                    qf[qb][0] = *(const GAS long*)qp; qf[qb][1] = *(const GAS long*)(qp + 32); }
                if (pass == 0) {
#pragma unroll
                    for (int qb = 0; qb < 2; ++qb) { m[qb] = -1e30f; l[qb] = 0.f;
#pragma unroll
                        for (int t = 0; t < 4; ++t) o[t][qb] = (f32x4){0.f, 0.f, 0.f, 0.f}; }
                } else {
#pragma unroll
                    for (int qb = 0; qb < 2; ++qb) { const LAS float* sp = st + prow[qb] * 68; m[qb] = sp[64]; l[qb] = lg == 0 ? sp[65] : 0.f;
#pragma unroll
                        for (int t = 0; t < 4; ++t) o[t][qb] = *(const LAS f32x4*)(sp + 16 * t + 4 * lg); }
                }
                typedef unsigned long long u64t; u64t kf[2][2], vf[4], kfn[2][2], vfn[4];
#define ATT_LOAD(c_, kd, vd) do { const int kb_ = iq0 - 64 + 32 * (c_); int ia_ = kb_ + 8 * (lr >> 2) + (lr & 3), ib_ = ia_ + 4; ia_ = ia_ < 0 ? 0 : (ia_ >= L ? L - 1 : ia_); ib_ = ib_ < 0 ? 0 : (ib_ >= L ? L - 1 : ib_); \
        const unsigned char* ka_ = Kh + (size_t)(dl * ia_ + r) * AW; const unsigned char* kb2_ = Kh + (size_t)(dl * ib_ + r) * AW; \
        kd[0][0] = *(const GAS u64t*)ka_; kd[0][1] = *(const GAS u64t*)(ka_ + 32); kd[1][0] = *(const GAS u64t*)kb2_; kd[1][1] = *(const GAS u64t*)(kb2_ + 32); \
        int vk_ = kb_ + 8 * lg; vk_ = vk_ < 0 ? 0 : (vk_ > L - 8 ? L - 8 : vk_); \
        _Pragma("unroll") for (int t_ = 0; t_ < 4; ++t_) vd[t_] = *(const GAS u64t*)(Vh + (size_t)(16 * t_) * MTOK + vk_); } while (0)
                ATT_LOAD(0, kf, vf);
#pragma unroll 1
                for (int c = 0; c < 5; ++c) {
                    if (c < 4) ATT_LOAD(c + 1, kfn, vfn);
                    const int kb = iq0 - 64 + 32 * c;
                    f32x4 s[2][2];
#pragma unroll
                    for (int tl = 0; tl < 2; ++tl) {
#pragma unroll
                        for (int qb = 0; qb < 2; ++qb) { s[tl][qb] = __builtin_amdgcn_mfma_f32_16x16x32_fp8_fp8((long)kf[tl][0], qf[qb][0], (f32x4){0.f, 0.f, 0.f, 0.f}, 0, 0, 0);
                            s[tl][qb] = __builtin_amdgcn_mfma_f32_16x16x32_fp8_fp8((long)kf[tl][1], qf[qb][1], s[tl][qb], 0, 0, 0); } }
                    long pf[2];
                    if (c == 0 || c == 4 || kb < 0 || kb + 32 > L) {
#pragma unroll
                        for (int qb = 0; qb < 2; ++qb) { const int iq = iq0 + 16 * qb + lr, lo = iq - 64 < 0 ? 0 : iq - 64, hi = iq + 64 > L - 1 ? L - 1 : iq + 64; const unsigned span = (unsigned)(hi - lo); const int k0 = kb + 8 * lg - lo;
#pragma unroll
                            for (int e = 0; e < 8; ++e) s[e >> 2][qb][e & 3] = (unsigned)(k0 + e) <= span ? s[e >> 2][qb][e & 3] : -__builtin_inff(); } }
#pragma unroll
                    for (int qb = 0; qb < 2; ++qb) { float sv[8]; float mx = -__builtin_inff();
#pragma unroll
                        for (int e = 0; e < 8; ++e) { sv[e] = s[e >> 2][qb][e & 3]; mx = fmaxf(mx, sv[e]); }
                        mx = fmaxf(mx, __int_as_float(__builtin_amdgcn_ds_bpermute(bp16, __float_as_int(mx)))); mx = fmaxf(mx, __int_as_float(__builtin_amdgcn_ds_bpermute(bp32, __float_as_int(mx))));
                        const float mn = fmaxf(m[qb], mx), al = __builtin_amdgcn_exp2f(m[qb] - mn); m[qb] = mn; float ps = 0.f; float p[8];
#pragma unroll
                        for (int e = 0; e < 8; ++e) { p[e] = __builtin_amdgcn_exp2f(sv[e] - mn); ps += p[e]; }
                        l[qb] = l[qb] * al + ps;
#pragma unroll
                        for (int t = 0; t < 4; ++t) o[t][qb] = o[t][qb] * al;
                        unsigned plo = (unsigned)__builtin_amdgcn_cvt_pk_fp8_f32(p[0], p[1], 0, false); plo = (unsigned)__builtin_amdgcn_cvt_pk_fp8_f32(p[2], p[3], (int)plo, true);
                        unsigned phi = (unsigned)__builtin_amdgcn_cvt_pk_fp8_f32(p[4], p[5], 0, false); phi = (unsigned)__builtin_amdgcn_cvt_pk_fp8_f32(p[6], p[7], (int)phi, true);
                        pf[qb] = (long)((unsigned long long)plo | ((unsigned long long)phi << 32)); }
#pragma unroll
                    for (int t = 0; t < 4; ++t) {
#pragma unroll
                        for (int qb = 0; qb < 2; ++qb) o[t][qb] = __builtin_amdgcn_mfma_f32_16x16x32_fp8_fp8((long)vf[t], pf[qb], o[t][qb], 0, 0, 0); }
#pragma unroll
                    for (int tl = 0; tl < 2; ++tl) { kf[tl][0] = kfn[tl][0]; kf[tl][1] = kfn[tl][1]; }
#pragma unroll
                    for (int t = 0; t < 4; ++t) vf[t] = vfn[t];
                }
#undef ATT_LOAD
#pragma unroll
                for (int qb = 0; qb < 2; ++qb) { float lt = l[qb]; lt += __int_as_float(__builtin_amdgcn_ds_bpermute(bp16, __float_as_int(lt))); lt += __int_as_float(__builtin_amdgcn_ds_bpermute(bp32, __float_as_int(lt)));
                    if (pass < 2) { LAS float* sp = st + prow[qb] * 68;
#pragma unroll
                        for (int t = 0; t < 4; ++t) *(LAS f32x4*)(sp + 16 * t + 4 * lg) = o[t][qb];
                        if (lg == 0) { sp[64] = m[qb]; sp[65] = lt; } }
                    else { const float il = 1.0f / lt; bf16* op = OA + ((size_t)(8 * j + (lg >> 1)) * MTOK + (size_t)(b * SEQ + P0 + prow[qb])) * 8 + 4 * (lg & 1);
#pragma unroll
                        for (int t = 0; t < 4; ++t) { const f32x4 x = o[t][qb] * il; *(GAS unsigned long long*)(op + (size_t)(2 * t) * MTOK * 8) = (unsigned long long)pg8::cvt_pk_bf16(x[0], x[1]) | ((unsigned long long)pg8::cvt_pk_bf16(x[2], x[3]) << 32); } } }
            }
            __syncthreads();
        }
    }
}

__device__ __forceinline__ void norm_router_phase(Frame& F, const bf16* x, const float* gain, unsigned char* out8, const float* rw, const float* rb, int* SEL, float* WTS, int* CNT) {
    LAS float* wr = (LAS float*)F.lds;
    LAS int* sel_l = (LAS int*)(F.lds + 32768);
    for (int i = F.tid; i < DM * NEXP; i += NWAVES * 64) { const int k = i >> 3, e = i & 7; wr[(((e >> 2) * 1024) + (k & 3) * 256 + (k >> 2)) * 4 + (e & 3)] = rw[i]; }
    __syncthreads();
    f32x4 gn[4];
#pragma unroll
    for (int j = 0; j < 4; ++j) gn[j] = ((const GAS f32x4*)gain)[F.lane + 64 * j];
    typedef unsigned long long u64r;
    u64r rw_[4];
    { const GAS u64r* xr = (const GAS u64r*)(x + (size_t)(F.vcu * 128 + F.wave * 16) * XP) + F.lane;
#pragma unroll
      for (int j = 0; j < 4; ++j) rw_[j] = xr[64 * j]; }
    const bool b0 = F.lane & 1, b1 = F.lane & 2, b2 = F.lane & 4;
#pragma unroll 1
    for (int i = 0; i < 16; ++i) { const int tl = F.wave * 16 + i, m = F.vcu * 128 + tl; f32x4 v[4]; float ssq = 0.f;
#pragma unroll
        for (int j = 0; j < 4; ++j) { const u64r w = rw_[j]; v[j].x = bflo((unsigned)w); v[j].y = bfhi((unsigned)w); v[j].z = bflo((unsigned)(w >> 32)); v[j].w = bfhi((unsigned)(w >> 32));
            ssq += (v[j].x * v[j].x + v[j].y * v[j].y) + (v[j].z * v[j].z + v[j].w * v[j].w); }
        if (i < 15) { const GAS u64r* xr = (const GAS u64r*)(x + (size_t)(m + 1) * XP) + F.lane;
#pragma unroll
            for (int j = 0; j < 4; ++j) rw_[j] = xr[64 * j]; }
        const float rstd = 1.0f / sqrtf(wave_sum(ssq, F.lane) * (1.0f / DM) + RMS_EPS);
#pragma unroll
        for (int j = 0; j < 4; ++j) v[j] = v[j] * rstd * gn[j];
        GAS unsigned* o4 = (GAS unsigned*)(out8 + (size_t)m * DM) + F.lane;
#pragma unroll
        for (int j = 0; j < 4; ++j) { unsigned w8 = pg8::pk_fp8(v[j].x, v[j].y, 0u, false); w8 = pg8::pk_fp8(v[j].z, v[j].w, w8, true); o4[64 * j] = w8; }
        float lg[8];
#pragma unroll
        for (int e = 0; e < 8; ++e) lg[e] = 0.f;
#pragma unroll
        for (int j = 0; j < 4; ++j)
#pragma unroll
            for (int cc = 0; cc < 4; ++cc) { const int sl = cc * 256 + F.lane + 64 * j; const f32x4 wa = *(const LAS f32x4*)(wr + sl * 4), wb = *(const LAS f32x4*)(wr + 4096 + sl * 4); const float xv = v[j][cc];
                lg[0] += xv * wa[0]; lg[1] += xv * wa[1]; lg[2] += xv * wa[2]; lg[3] += xv * wa[3]; lg[4] += xv * wb[0]; lg[5] += xv * wb[1]; lg[6] += xv * wb[2]; lg[7] += xv * wb[3]; }
#define XCH(v_, o_) __int_as_float(__builtin_amdgcn_ds_bpermute((F.lane ^ (o_)) << 2, __float_as_int(v_)))
        float ra[4], rb2[2], rc;
#pragma unroll
        for (int t = 0; t < 4; ++t) { const float send = b0 ? lg[t] : lg[t + 4], keep = b0 ? lg[t + 4] : lg[t]; ra[t] = keep + XCH(send, 1); }
#pragma unroll
        for (int t = 0; t < 2; ++t) { const float send = b1 ? ra[t] : ra[t + 2], keep = b1 ? ra[t + 2] : ra[t]; rb2[t] = keep + XCH(send, 2); }
        { const float send = b2 ? rb2[0] : rb2[1], keep = b2 ? rb2[1] : rb2[0]; rc = keep + XCH(send, 4); }
        rc += XCH(rc, 8); rc += XCH(rc, 16); rc += XCH(rc, 32);
#undef XCH
        lg[0] = __int_as_float(__builtin_amdgcn_readlane(__float_as_int(rc), 0)) + rb[0]; lg[1] = __int_as_float(__builtin_amdgcn_readlane(__float_as_int(rc), 4)) + rb[1];
        lg[2] = __int_as_float(__builtin_amdgcn_readlane(__float_as_int(rc), 2)) + rb[2]; lg[3] = __int_as_float(__builtin_amdgcn_readlane(__float_as_int(rc), 6)) + rb[3];
        lg[4] = __int_as_float(__builtin_amdgcn_readlane(__float_as_int(rc), 1)) + rb[4]; lg[5] = __int_as_float(__builtin_amdgcn_readlane(__float_as_int(rc), 5)) + rb[5];
        lg[6] = __int_as_float(__builtin_amdgcn_readlane(__float_as_int(rc), 3)) + rb[6]; lg[7] = __int_as_float(__builtin_amdgcn_readlane(__float_as_int(rc), 7)) + rb[7];
        int e0 = 0; float v0 = lg[0];
#pragma unroll
        for (int e = 1; e < 8; ++e) if (lg[e] > v0) { v0 = lg[e]; e0 = e; }
        int e1 = 0; float v1 = -__builtin_inff();
#pragma unroll
        for (int e = 0; e < 8; ++e) if (e != e0 && lg[e] > v1) { v1 = lg[e]; e1 = e; }
        const float w0 = 1.0f / (1.0f + expf(v1 - v0)), w1 = 1.0f - w0;
        if (F.lane == 0) { sel_l[tl] = e0 | (e1 << 8); WTS[2 * (size_t)m] = w0; WTS[2 * (size_t)m + 1] = w1; }
    }
    __syncthreads();
    if (F.tid < 128) { const int me = sel_l[F.tid], e0 = me & 255, e1 = me >> 8; int r0 = 0, r1 = 0;
        for (int t = 0; t < F.tid; ++t) { const int o = sel_l[t]; r0 += ((o & 255) == e0); r1 += ((o >> 8) == e1); }
        SEL[F.vcu * 128 + F.tid] = me | (r0 << 16) | (r1 << 24); }
    else if (F.tid < 144) { const int q = F.tid - 128, s = q >> 3, e = q & 7; int n = 0;
        for (int t = 0; t < 128; ++t) { const int o = sel_l[t]; n += ((s ? (o >> 8) : (o & 255)) == e); }
        CNT[F.vcu * 16 + q] = n; }
    __syncthreads();
}
__device__ __forceinline__ void route2_phase(Frame& F, const int* SEL, const float* WTS, const int* CNT, int* ROWTOK, float* ROWW, int* PLAN) {
    LAS int* call = (LAS int*)F.lds;
    LAS int* tot = call + 4096; LAS int* basew = tot + 16; LAS int* segst = basew + 16; LAS int* ntile = segst + 16;
    for (int i = F.tid; i < 4096; i += NWAVES * 64) call[i] = CNT[i];
    __syncthreads();
    if (F.tid < 16) { int t = 0, bsum = 0; for (int w = 0; w < 256; ++w) { const int c = call[w * 16 + F.tid]; t += c; bsum += (w < F.vcu) ? c : 0; } tot[F.tid] = t; basew[F.tid] = bsum; }
    __syncthreads();
    if (F.tid < 2) { int run = 0; for (int e = 0; e < 8; ++e) { segst[F.tid * 8 + e] = run; run += (tot[F.tid * 8 + e] + 255) & ~255; } ntile[F.tid] = run >> 8; }
    __syncthreads();
    if (F.tid < 128) { const int m = F.vcu * 128 + F.tid, sl = SEL[m], e0 = sl & 255, e1 = (sl >> 8) & 255, r0 = (sl >> 16) & 255, r1 = (sl >> 24) & 255;
        const int p0 = segst[e0] + basew[e0] + r0, p1 = segst[8 + e1] + basew[8 + e1] + r1;
        ROWTOK[p0] = m; ROWW[p0] = WTS[2 * (size_t)m]; ROWTOK[MOE_ROWS + p1] = m; ROWW[MOE_ROWS + p1] = WTS[2 * (size_t)m + 1]; }
    if (F.vcu < 8) {
        for (int s = 0; s < 2; ++s) { const int q = s * 8 + F.vcu, n = tot[q], np = (n + 255) & ~255;
            for (int p = n + F.tid; p < np; p += NWAVES * 64) { ROWTOK[s * MOE_ROWS + segst[q] + p] = -1; ROWW[s * MOE_ROWS + segst[q] + p] = 0.f; } } }
    if (F.vcu == 8) {
        if (F.tid < 2) PLAN[F.tid] = ntile[F.tid];
        if (F.tid < 2 * MOE_TILES) { const int s = F.tid / MOE_TILES, t = F.tid % MOE_TILES; int e = 0;
            for (int k = 1; k < 8; ++k) if ((segst[s * 8 + k] >> 8) <= t) e = k;
            PLAN[16 + MOE_TILES * s + t] = e; } }
    __syncthreads();
}
__device__ __forceinline__ void final_norm_phase(Frame& F, float* xio, const bf16* xb, const float* gain, const bf16* y) {
    const int gw = F.vcu * NWAVES + F.wave, NGW = F.G * NWAVES;
    f32x4 gn[4];
#pragma unroll
    for (int j = 0; j < 4; ++j) gn[j] = ((const GAS f32x4*)gain)[F.lane + 64 * j];
    for (int m = gw; m < MTOK; m += NGW) { f32x4 v[4]; float s = 0.f;
        const GAS unsigned long long* xr = (const GAS unsigned long long*)(xb + (size_t)m * XP) + F.lane;
        const GAS unsigned long long* y0 = (const GAS unsigned long long*)(y + (size_t)m * DM) + F.lane; const GAS unsigned long long* y1 = (const GAS unsigned long long*)(y + ((size_t)MTOK + m) * DM) + F.lane;
#pragma unroll
        for (int j = 0; j < 4; ++j) { const unsigned long long xw = xr[64 * j]; v[j].x = bflo((unsigned)xw); v[j].y = bfhi((unsigned)xw); v[j].z = bflo((unsigned)(xw >> 32)); v[j].w = bfhi((unsigned)(xw >> 32));
            const unsigned long long a0 = y0[64 * j], a1 = y1[64 * j];
            v[j].x += bflo((unsigned)a0) + bflo((unsigned)a1); v[j].y += bfhi((unsigned)a0) + bfhi((unsigned)a1);
            v[j].z += bflo((unsigned)(a0 >> 32)) + bflo((unsigned)(a1 >> 32)); v[j].w += bfhi((unsigned)(a0 >> 32)) + bfhi((unsigned)(a1 >> 32));
            s += (v[j].x * v[j].x + v[j].y * v[j].y) + (v[j].z * v[j].z + v[j].w * v[j].w); }
        const float rstd = 1.0f / sqrtf(wave_sum(s, F.lane) * (1.0f / DM) + RMS_EPS);
        GAS f32x4* o = (GAS f32x4*)(xio + (size_t)m * DM) + F.lane;
#pragma unroll
        for (int j = 0; j < 4; ++j) o[64 * j] = v[j] * rstd * gn[j]; }
}

struct MoeOrder { int nT0, nM, nN, nwg, G, c; unsigned lda, ldb; const int* tile_e; size_t estride; bool gather;
    __device__ bool next(int i, pg8::Unit& u) const {
        const long L = (long)i * G + c; if (L >= nwg) return false;
        int wgid = (int)L; { const int q = nwg / pg8::NXCD, r = nwg % pg8::NXCD, xcd = wgid % pg8::NXCD, off = wgid / pg8::NXCD; wgid = (xcd < r ? xcd * (q + 1) : r * (q + 1) + (xcd - r) * q) + off; }
        const int nig = pg8::WGM * nN, gid = wgid / nig, fm = gid * pg8::WGM, gsz = (nM - fm) < pg8::WGM ? (nM - fm) : pg8::WGM;
        const int lin = fm + ((wgid % nig) % gsz); u.pm = lin < nT0 ? lin : MOE_TILES + (lin - nT0); u.pn = (wgid % nig) / gsz; u.z = __builtin_amdgcn_readfirstlane(tile_e[u.pm]);
        u.aoff = gather ? (size_t)0 : (size_t)u.pm * 256 * lda; u.boff = (size_t)u.z * estride + (size_t)u.pn * 256 * ldb; return true; } };

template <class Epi, int BMAP = 0, int ALAY = 0> __device__ __forceinline__ void run_gemm(Frame& F, const void* A, unsigned lda, const void* B, unsigned ldb, int Mrows, int Ncols, int K, const Epi& E, int geff = 0) {
    int G_ = geff ? geff : F.G, c_ = (int)blockIdx.x; asm volatile("" : "+s"(G_), "+s"(c_));
    pg8::Gemm g{(const char*)A, (const char*)B, lda, ldb, K, nullptr}; pg8::PlainOrder S; S.init(Mrows, Ncols, G_, c_, lda, ldb, BMAP, ALAY);
    pg8::gemm_phase<Epi, pg8::PlainOrder, false, BMAP, ALAY>(F.lds, g, S, E);
}

__device__ __forceinline__ Args load_args() {
    Args r{};
#if defined(__HIP_DEVICE_COMPILE__)
    typedef const __attribute__((address_space(4))) Args CArgs;
    auto p = __builtin_amdgcn_kernarg_segment_ptr(); asm volatile("" : "+s"(p)); CArgs* q = (CArgs*)p;
#pragma unroll
    for (int i = 0; i < 16; ++i) r.in[i] = q->in[i];
    r.out = q->out; r.ws = q->ws; r.G = q->G;
#endif
    return r;
}
__device__ __forceinline__ Frame make_frame(LAS unsigned char* lds, unsigned char* ws, int G) {
    Frame F; int t = threadIdx.x, g = G, bx = blockIdx.x; asm volatile("" : "+v"(t), "+s"(g), "+s"(bx));
    F.lds = lds; F.MISC = (volatile LAS unsigned*)(lds + MISC_OFF); F.ctl = (gu32*)(ws + WS_CTL);
    F.tid = t; F.lane = t & 63; F.wave = __builtin_amdgcn_readfirstlane(t >> 6); F.G = g; F.vcu = (g % 8 == 0) ? (bx % 8) * (g / 8) + bx / 8 : bx; return F; }
#define PH_BEGIN const Args a = load_args(); unsigned char* const ws = a.ws; float* const xout = a.out; bf16* const xsA = (bf16*)a.out; bf16* const xsB = xsA + DM; Frame F = make_frame((LAS unsigned char*)lds, ws, a.G); (void)xout; (void)xsA; (void)xsB
__global__ void __launch_bounds__(NWAVES * 64, 2) fwd_kernel(Args args) {
    extern __shared__ __attribute__((aligned(16))) unsigned char lds[];
    for (int u = threadIdx.x; u < (LDS_BYTES - LDSCTL_OFF) / 4; u += NWAVES * 64) ((LAS unsigned*)((LAS unsigned char*)lds + LDSCTL_OFF))[u] = 0u;
    __syncthreads();
    XcdBarrier bar = xcd_barrier_post((unsigned*)(args.ws + WS_CTL) + CW_BAR, (volatile LAS unsigned*)((LAS unsigned char*)lds + MISC_OFF) + 8);
    bar.G = (unsigned)args.G;
#define GRID_BAR() do { XcdBarrier b2_ = bar; asm volatile("" : "+s"(b2_.bar), "+s"(b2_.x), "+s"(b2_.G)); xcd_barrier(b2_); } while (0)

    { PH_BEGIN; p0_weights(F, a); __syncthreads(); p0_tables(F, a); prep_x_phase(F, a.in[0], xsA, (float*)(ws + WS_SS), ws + WS_X8); }
    GRID_BAR();

    for (int layer = 0; layer < 2; ++layer) {
        asm volatile("" : "+s"(layer));
        { PH_BEGIN; int lyr = layer; asm volatile("" : "+s"(lyr)); const bf16* WinT = (const bf16*)(ws + WS_WIN + lyr * WIN_L);
          pg8::EpiInproj E{ws, WS_V, WS_Q, WS_K, WS_GF, WS_GA, WS_ROPE, QSCALE, (const float*)(ws + WS_SS) + (size_t)(2 * lyr) * SS_STRIDE, 1.0f / WG_SCALE};
          int G_ = F.G, c_ = (int)blockIdx.x; asm volatile("" : "+s"(G_), "+s"(c_));
          pg8::Gemm g{(const char*)(ws + WS_X8), (const char*)(ws + WS_WQK8 + (size_t)lyr * 1536 * DM), DM, DM, DM / 2, nullptr}; pg8::PlainOrder S; S.init(MTOK, 1536, G_, c_, DM, DM, 0, 0);
          pg8::gemm_phase<pg8::EpiInproj, pg8::PlainOrder, false, 0, 0, true>(F.lds, g, S, E); }
        { PH_BEGIN; int lyr = layer; asm volatile("" : "+s"(lyr)); const bf16* WinT = (const bf16*)(ws + WS_WIN + lyr * WIN_L);
          int bx_ = (int)blockIdx.x; asm volatile("" : "+s"(bx_));
          if (bx_ < 128) { pg8::EpiBf16 E{(bf16*)(ws + WS_UT), MTOK, (bf16*)(ws + WS_V), 2, (const float*)(ws + WS_SS) + (size_t)(2 * lyr) * SS_STRIDE, 1.0f};
            run_gemm<pg8::EpiBf16, 2, 0>(F, WinT, DM * 2, xsA, XP * 2, 512, MTOK, DM, E, 128); }
          else { pg8::EpiBf16 E{(bf16*)(ws + WS_UT), MTOK, (bf16*)(ws + WS_V), 2, (const float*)(ws + WS_SS) + (size_t)(2 * lyr) * SS_STRIDE, 1.0f / WG_SCALE};
            int G_ = 128, c_ = bx_ - 128; asm volatile("" : "+s"(G_), "+s"(c_));
            pg8::Gemm g{(const char*)(ws + WS_WV8 + (size_t)lyr * 768 * DM), (const char*)(ws + WS_X8), DM, DM, DM / 2, nullptr}; pg8::PlainOrder S; S.init(768, MTOK, G_, c_, DM, DM, 2, 0); S.pmoff = 2;
            pg8::gemm_phase<pg8::EpiBf16, pg8::PlainOrder, false, 2, 0, true>(F.lds, g, S, E); } }
        GRID_BAR();
        { PH_BEGIN; fft_phase(F, (const bf16*)(ws + WS_UT), (bf16*)(ws + WS_Z)); }
        { PH_BEGIN; attn_mfma_phase(F, ws + WS_Q, ws + WS_K, ws + WS_V, (bf16*)(ws + WS_OATT)); }
        { PH_BEGIN; int lyr = layer; asm volatile("" : "+s"(lyr)); int G_ = F.G, c_ = (int)blockIdx.x; asm volatile("" : "+s"(G_), "+s"(c_));
          pg8::Gemm g{(const char*)(ws + WS_X8), (const char*)(ws + WS_WG8 + (size_t)lyr * 2048 * DM), DM, DM, DM / 2, nullptr}; pg8::PlainOrder S; S.init(MTOK, 2048, G_, c_, DM, DM, 0, 0);
          pg8::EpiGates8 E{ws, WS_GF, WS_GA, (const float*)(ws + WS_SS) + (size_t)(2 * lyr) * SS_STRIDE}; pg8::gemm_phase<pg8::EpiGates8, pg8::PlainOrder, false, 0, 0, true>(F.lds, g, S, E); }
        GRID_BAR();
        { PH_BEGIN; int lyr = layer; asm volatile("" : "+s"(lyr)); pg8::EpiMix E{ws + WS_GF, ws + WS_GA, (bf16*)(ws + WS_MIX)};
          run_gemm<pg8::EpiMix, 0, 1>(F, ws + WS_OATT, MTOK * 16, (const bf16*)(ws + WS_WM) + (size_t)lyr * DM * KMIX, KMIX * 2, MTOK, DM, KMIX, E); }
        GRID_BAR();
        if (layer == 0) { PH_BEGIN; pg8::EpiResid<true> E{xsA, xsB, XP, (float*)(ws + WS_SS) + SS_STRIDE, nullptr};
          run_gemm(F, ws + WS_MIX, DM * 2, ws + WS_WOUT, DM * 2, MTOK, DM, DM, E); }
        else { PH_BEGIN; pg8::EpiResid<false> E{xsA, xsB, XP, nullptr, nullptr};
          run_gemm(F, ws + WS_MIX, DM * 2, (const bf16*)(ws + WS_WOUT) + (size_t)DM * DM, DM * 2, MTOK, DM, DM, E); }
        GRID_BAR();
        if (layer == 0) {
            { PH_BEGIN; int lyr = layer; asm volatile("" : "+s"(lyr)); pg8::EpiSwiglu E{(bf16*)(ws + WS_TT), FF, (const float*)(ws + WS_SS) + SS_STRIDE}; run_gemm(F, xsB, XP * 2, ws + WS_W13, DM * 2, MTOK, 2 * FF, DM, E); }
            GRID_BAR();
            { PH_BEGIN; int lyr = layer; asm volatile("" : "+s"(lyr)); pg8::EpiResid<true> E{xsB, xsA, XP, (float*)(ws + WS_SS) + 2 * SS_STRIDE, ws + WS_X8}; run_gemm(F, ws + WS_TT, FF * 2, ws + WS_W2, FF * 2, MTOK, DM, FF, E); }
            GRID_BAR();
        } else {
            { PH_BEGIN; int lyr = layer; asm volatile("" : "+s"(lyr)); p0_moe_weights(F, a, 2 * CONV_PHASE_ITEMS, MOE_NITEMS, F.vcu * NWAVES + F.wave, F.G * NWAVES); __syncthreads();
              norm_router_phase(F, xsB, a.in[6] + DM, ws + WS_H2B, a.in[10], a.in[11], (int*)(ws + WS_SEL), (float*)(ws + WS_WTS), (int*)(ws + WS_CNT)); }
            GRID_BAR();
            { PH_BEGIN; int lyr = layer; asm volatile("" : "+s"(lyr)); route2_phase(F, (const int*)(ws + WS_SEL), (const float*)(ws + WS_WTS), (const int*)(ws + WS_CNT), (int*)(ws + WS_ROWTOK), (float*)(ws + WS_ROWW), (int*)(ws + WS_PLAN)); }
            GRID_BAR();
            { PH_BEGIN; int G_ = F.G, c_ = (int)blockIdx.x; asm volatile("" : "+s"(G_), "+s"(c_));
              const int* plan = (const int*)(ws + WS_PLAN); const int nT0 = __builtin_amdgcn_readfirstlane(plan[0]), nT1 = __builtin_amdgcn_readfirstlane(plan[1]);
              pg8::Gemm g{(const char*)(ws + WS_H2B), (const char*)(ws + WS_M13), DM, DM, DM / 2, (const int*)(ws + WS_ROWTOK)};
              MoeOrder S{nT0, nT0 + nT1, 2 * FF / 256, (nT0 + nT1) * (2 * FF / 256), G_, c_, DM, DM, plan + 16, (size_t)2 * FF * DM, true};
              pg8::EpiSwigluF8 E{ws + WS_TTB, FF, 1.0f / W13_SCALE}; pg8::gemm_phase<pg8::EpiSwigluF8, MoeOrder, true, 0, 0, true>(F.lds, g, S, E); }
            GRID_BAR();
            { PH_BEGIN; int G_ = F.G, c_ = (int)blockIdx.x; asm volatile("" : "+s"(G_), "+s"(c_));
              const int* plan = (const int*)(ws + WS_PLAN); const int nT0 = __builtin_amdgcn_readfirstlane(plan[0]), nT1 = __builtin_amdgcn_readfirstlane(plan[1]);
              pg8::Gemm g{(const char*)(ws + WS_TTB), (const char*)(ws + WS_M2), FF, FF, FF / 2, nullptr};
              MoeOrder S{nT0, nT0 + nT1, DM / 256, (nT0 + nT1) * (DM / 256), G_, c_, FF, FF, plan + 16, (size_t)DM * FF, false};
              pg8::EpiScatterY E{(bf16*)(ws + WS_Y), (const int*)(ws + WS_ROWTOK), (const float*)(ws + WS_ROWW), 1.0f / W2_SCALE, MOE_ROWS, (size_t)MTOK * DM};
              pg8::gemm_phase<pg8::EpiScatterY, MoeOrder, false, 0, 0, true>(F.lds, g, S, E); }
            GRID_BAR();
        }
    }
    { PH_BEGIN; final_norm_phase(F, xout, xsB, a.in[15], (const bf16*)(ws + WS_Y)); }
#undef GRID_BAR
}

extern "C" void kernel_launch(void* const* d_in, const int* in_sizes, int n_in, void* d_out, int out_size, void* d_ws, size_t ws_size, hipStream_t stream) {
    static int grid = 0;
    if (grid == 0) {
        if (n_in != 16 || out_size != MTOK * DM || ws_size < WS_END) { fprintf(stderr, "kernel_launch: unexpected problem (n_in %d, out %d, ws %zu); nothing launched\n", n_in, out_size, ws_size); grid = -1; return; }
        int dev = 0, cus = 0;
        if (hipGetDevice(&dev) != hipSuccess || hipDeviceGetAttribute(&cus, hipDeviceAttributeMultiprocessorCount, dev) != hipSuccess) { grid = -1; return; }
        if (hipFuncSetAttribute((const void*)fwd_kernel, hipFuncAttributeMaxDynamicSharedMemorySize, LDS_BYTES) != hipSuccess) { fprintf(stderr, "kernel_launch: hipFuncSetAttribute failed\n"); grid = -1; return; }
        int per_cu = 0;
        if (hipOccupancyMaxActiveBlocksPerMultiprocessor(&per_cu, (const void*)fwd_kernel, NWAVES * 64, LDS_BYTES) != hipSuccess || per_cu < 1) fprintf(stderr, "kernel_launch: occupancy query reports %d\n", per_cu);
        (void)hipGetLastError();
        if (cus != 256) { fprintf(stderr, "kernel_launch: %d CUs; the router / attention unit maps assume a grid of 256\n", cus); grid = -1; return; }
        grid = cus;
    }
    if (grid < 0) return;
    (void)hipMemsetAsync((char*)d_ws + WS_CTL, 0, CTL_ZERO_BYTES, stream);
    Args a{};
    for (int i = 0; i < 16; ++i) a.in[i] = (const float*)d_in[i];
    a.out = (float*)d_out; a.ws = (unsigned char*)d_ws; a.G = grid; a.pad = 0;
    hipLaunchKernelGGL(fwd_kernel, dim3(grid), dim3(NWAVES * 64), LDS_BYTES, stream, a);
}
```

```cpp
#include <hip/hip_runtime.h>
#include <cstdio>
#include <cstdint>

namespace pg8 {
#define PG8_LAS __attribute__((address_space(3)))
typedef unsigned short bf16_t;
typedef short bf16x8 __attribute__((ext_vector_type(8)));
typedef float f32x4 __attribute__((ext_vector_type(4)));
typedef unsigned u32x4 __attribute__((ext_vector_type(4)));
typedef unsigned u32x2 __attribute__((ext_vector_type(2)));
typedef int v4i_t __attribute__((ext_vector_type(4)));
typedef int v8i_t __attribute__((ext_vector_type(8)));
constexpr int BM = 256, BK = 64, HALF = 128, HTB = HALF * BK * 2  , STAGE_BYTES = 8 * HTB, NXCD = 8, WGM = 4;

__host__ __device__ __forceinline__ int lds_byte(int r, int c) { const int st = (r >> 4) * 2 + (c >> 5), rr = r & 15, cc = c & 31, ob = rr * 64 + cc * 2; return st * 1024 + (ob ^ (((ob >> 9) & 1) << 5)); }
__host__ __device__ __forceinline__ void stage_rc(int b, int& R, int& C) { const int st = b / 1024, sb = b % 1024, swz = sb ^ (((sb >> 9) & 1) << 5); R = (st >> 1) * 16 + swz / 64; C = (st & 1) * 32 + (swz % 64) / 2; }
__host__ __device__ __forceinline__ int perm32(int rho) { const int n = rho >> 4, i = rho & 15; return 8 * (i >> 2) + 4 * n + (i & 3); }

struct Unit { int pm, pn, z; size_t aoff, boff; };
struct Gemm { const char* A; const char* B; unsigned lda, ldb; int K; const int* rows; };

struct PlainOrder {
    int nM, nN, nwg, G, c; unsigned lda, ldb; int bmap, alay, pmoff = 0;
    __device__ void init(int M, int N, int G_, int c_, unsigned lda_, unsigned ldb_, int bmap_ = 0, int alay_ = 0) { nM = M / BM; nN = N / BM; nwg = nM * nN; G = G_; c = c_; lda = lda_; ldb = ldb_; bmap = bmap_; alay = alay_; }
    __device__ bool next(int i, Unit& u) const {
        const long L = (long)i * G + c; if (L >= nwg) return false;
        int wgid = (int)L; { const int q = nwg / NXCD, r = nwg % NXCD, xcd = wgid % NXCD, off = wgid / NXCD; wgid = (xcd < r ? xcd * (q + 1) : r * (q + 1) + (xcd - r) * q) + off; }
        const int nig = WGM * nN, gid = wgid / nig, fm = gid * WGM, gsz = (nM - fm) < WGM ? (nM - fm) : WGM;
        u.pm = fm + ((wgid % nig) % gsz); u.pn = (wgid % nig) / gsz; u.z = 0;
        u.aoff = alay ? (size_t)u.pm * BM * 16 : (size_t)u.pm * BM * lda; u.pm += pmoff;
        if (bmap == 0) u.boff = (size_t)u.pn * BM * ldb;
        else { const int kind = bmap == 1 ? 1 : (u.pm < 2 ? 1 : (u.pm == 2 ? 0 : u.pm - 1)), bb = u.pn >> 4, t = u.pn & 15; u.z = kind;
            const int base = kind == 0 ? 256 * t : (kind == 1 ? 4 * t : (kind == 2 ? 1024 * (t & 3) + (t >> 2) : t));
            u.boff = (size_t)(bb * 4096 + base) * ldb; }
        return true;
    }
};

typedef float f32x2v_t __attribute__((ext_vector_type(2))); typedef __bf16 bf16x2v_t __attribute__((ext_vector_type(2)));
__device__ __forceinline__ unsigned cvt_pk_bf16(float lo, float hi) { const f32x2v_t v = {lo, hi}; return __builtin_bit_cast(unsigned, __builtin_convertvector(v, bf16x2v_t)); }
__device__ __forceinline__ float bf_lo(unsigned w) { return __uint_as_float(w << 16); }
__device__ __forceinline__ float bf_hi(unsigned w) { return __uint_as_float(w & 0xffff0000u); }
__device__ __forceinline__ f32x4 bf4_lo(const u32x4& w) { return (f32x4){bf_lo(w.x), bf_hi(w.x), bf_lo(w.y), bf_hi(w.y)}; }
__device__ __forceinline__ f32x4 bf4_hi(const u32x4& w) { return (f32x4){bf_lo(w.z), bf_hi(w.z), bf_lo(w.w), bf_hi(w.w)}; }
__device__ __forceinline__ unsigned pk_u8x4(const f32x4& g) { const f32x4 t = g * 255.0f; unsigned w = __builtin_amdgcn_cvt_pk_u8_f32(t[0], 0, 0u); w = __builtin_amdgcn_cvt_pk_u8_f32(t[1], 1, w); w = __builtin_amdgcn_cvt_pk_u8_f32(t[2], 2, w); return __builtin_amdgcn_cvt_pk_u8_f32(t[3], 3, w); }
__device__ __forceinline__ f32x4 u8x4_f(unsigned w) { return (f32x4){(float)(w & 0xffu), (float)((w >> 8) & 0xffu), (float)((w >> 16) & 0xffu), (float)(w >> 24)}; }
__device__ __forceinline__ float fast_sigmoid(float x) { return __builtin_amdgcn_rcpf(1.0f + __builtin_amdgcn_exp2f(-1.4426950408889634f * x)); }
__device__ __forceinline__ u32x4 pack8(const f32x4& v0, const f32x4& v1) { u32x4 w; w.x = cvt_pk_bf16(v0[0], v0[1]); w.y = cvt_pk_bf16(v0[2], v0[3]); w.z = cvt_pk_bf16(v1[0], v1[1]); w.w = cvt_pk_bf16(v1[2], v1[3]); return w; }

__device__ __forceinline__ float rstd_of(const float* ss, int row) { const f32x4 p = *(const f32x4*)(ss + (size_t)row * 4); return __builtin_amdgcn_rsqf(((p[0] + p[1]) + (p[2] + p[3])) * (1.0f / 1024.0f) + 1e-6f); }
__device__ __forceinline__ unsigned pk_fp8(float a, float b, unsigned old, bool hi) { a = __builtin_fminf(__builtin_fmaxf(a, -448.f), 448.f); b = __builtin_fminf(__builtin_fmaxf(b, -448.f), 448.f);
    return hi ? (unsigned)__builtin_amdgcn_cvt_pk_fp8_f32(a, b, (int)old, true) : (unsigned)__builtin_amdgcn_cvt_pk_fp8_f32(a, b, (int)old, false); }

struct EpiBf16 {
    static constexpr bool PERM = true;
    bf16_t* O; int ldc; bf16_t* O2; int split; const float* ss; float ascale;
    __device__ __forceinline__ void operator()(const f32x4 (&acc)[2][2][4][2], const Unit& u, int wr, int wc, int fr, int fq) const {
        bf16_t* const O = u.pm >= split ? O2 : this->O;
        const int row0 = (u.pm >= split ? u.pm - split : u.pm) * BM + wr * 64 + fr, col0 = u.pn * BM + wc * 32 + 8 * fq;
        f32x4 cs[2][2]; const int kind = u.z, bb = u.pn >> 4;
#pragma unroll
        for (int bj = 0; bj < 2; ++bj)
#pragma unroll
            for (int e = 0; e < 8; ++e) { const int v = (col0 & 4095) + bj * HALF + e;
                const int pos = kind == 0 ? v : (kind == 1 ? 64 * (v & 63) + (v >> 6) : (kind == 2 ? 4 * (v & 1023) + (v >> 10) : 16 * (v & 255) + (v >> 8)));
                cs[bj][e >> 2][e & 3] = rstd_of(ss, bb * 4096 + pos) * ascale; }
#pragma unroll
        for (int ai = 0; ai < 2; ++ai)
#pragma unroll
            for (int m = 0; m < 4; ++m) { const size_t eo = (size_t)(row0 + ai * HALF + m * 16) * ldc + col0;
#pragma unroll
                for (int bj = 0; bj < 2; ++bj) { const f32x4 v0 = acc[ai][bj][m][0] * cs[bj][0], v1 = acc[ai][bj][m][1] * cs[bj][1];
                    if (u.pm >= split) { u32x2 w8; w8.x = pk_fp8(v0[0], v0[1], 0u, false); w8.x = pk_fp8(v0[2], v0[3], w8.x, true); w8.y = pk_fp8(v1[0], v1[1], 0u, false); w8.y = pk_fp8(v1[2], v1[3], w8.y, true);
                        *(u32x2*)((unsigned char*)O + eo + bj * HALF) = w8; }
                    else *(u32x4*)(O + eo + bj * HALF) = pack8(v0, v1); } }
    }
};
struct EpiInproj {
    static constexpr bool PERM = true;
    unsigned char* ws; size_t oV, oQ, oK, oGF, oGA, oRope; float qscale; const float* ss; float ascale;
    __device__ __forceinline__ void operator()(const f32x4 (&acc)[2][2][4][2], const Unit& u, int wr, int wc, int fr, int fq) const {
        const int row0 = u.pm * BM + wr * 64 + fr, pn = u.pn;
        {
            const bool isq = pn < 3; bf16_t* base = (bf16_t*)(ws + (isq ? oQ : oK)); const float* rope = (const float*)(ws + oRope); const int colt = (isq ? pn : pn - 3) * 256; const float sc = isq ? qscale : 1.0f;
            const int col0 = colt + wc * 32 + 8 * fq, i0 = 16 * (wc & 1) + 4 * fq;
#pragma unroll
            for (int ai = 0; ai < 2; ++ai)
#pragma unroll
                for (int m = 0; m < 4; ++m) { const int row = row0 + ai * HALF + m * 16, pos = row & 4095;
                    const f32x4 cs0 = *(const f32x4*)(rope + (size_t)(pos * 32 + i0) * 2), cs1 = *(const f32x4*)(rope + (size_t)(pos * 32 + i0) * 2 + 4);
                    bf16_t* rowp = base + (size_t)row * 768 + col0; const float rs = rstd_of(ss, row) * ascale;
#pragma unroll
                    for (int bj = 0; bj < 2; ++bj) { const f32x4 v0 = acc[ai][bj][m][0] * rs, v1 = acc[ai][bj][m][1] * rs; f32x4 o0, o1;
                        o0[0] = (v0[0] * cs0[0] - v0[1] * cs0[1]) * sc; o0[1] = (v0[1] * cs0[0] + v0[0] * cs0[1]) * sc;
                        o0[2] = (v0[2] * cs0[2] - v0[3] * cs0[3]) * sc; o0[3] = (v0[3] * cs0[2] + v0[2] * cs0[3]) * sc;
                        o1[0] = (v1[0] * cs1[0] - v1[1] * cs1[1]) * sc; o1[1] = (v1[1] * cs1[0] + v1[0] * cs1[1]) * sc;
                        o1[2] = (v1[2] * cs1[2] - v1[3] * cs1[3]) * sc; o1[3] = (v1[3] * cs1[2] + v1[2] * cs1[3]) * sc;
                        { u32x2 w8; w8.x = pk_fp8(o0[0], o0[1], 0u, false); w8.x = pk_fp8(o0[2], o0[3], w8.x, true); w8.y = pk_fp8(o1[0], o1[1], 0u, false); w8.y = pk_fp8(o1[2], o1[3], w8.y, true);
                               *(u32x2*)((unsigned char*)base + (size_t)row * 768 + col0 + bj * HALF) = w8; } }
                    if (m == 3) asm volatile("" ::: "memory"); }
        }
    }
};
constexpr float WG8_SCALE = 32.0f;
struct EpiGates8 {
    static constexpr bool PERM = true;
    unsigned char* ws; size_t oGF, oGA; const float* ss;
    __device__ __forceinline__ void operator()(const f32x4 (&acc)[2][2][4][2], const Unit& u, int wr, int wc, int fr, int fq) const {
        const int row0 = u.pm * BM + wr * 64 + fr;
        {
            unsigned char* const gfp = ws + oGF; unsigned char* const gap = ws + oGA; const int col0 = u.pn * 128 + wc * 32 + 8 * fq;
#pragma unroll
            for (int ai = 0; ai < 2; ++ai)
#pragma unroll
                for (int m = 0; m < 4; ++m) { const size_t off = (size_t)(row0 + ai * HALF + m * 16) * 1024 + col0; const float rs = (-1.4426950408889634f / WG8_SCALE) * rstd_of(ss, row0 + ai * HALF + m * 16);
                    f32x4 g[2], ga[2];
#pragma unroll
                    for (int n = 0; n < 2; ++n) { const f32x4 xf = acc[ai][0][m][n] * rs, xa = acc[ai][1][m][n] * rs; f32x4 ef, ea, ia;
#pragma unroll
                        for (int j = 0; j < 4; ++j) { ef[j] = __builtin_fminf(__builtin_amdgcn_exp2f(xf[j]), 1.0e18f); ea[j] = __builtin_amdgcn_exp2f(xa[j]); }
                        ef = ef + 1.0f; ea = ea + 1.0f;
#pragma unroll
                        for (int j = 0; j < 4; ++j) { g[n][j] = __builtin_amdgcn_rcpf(ef[j]); ia[j] = __builtin_amdgcn_rcpf(ea[j]); }
                        ga[n] = ia; }
                    u32x2 wf, wa; wf.x = pk_u8x4(g[0]); wf.y = pk_u8x4(g[1]); wa.x = pk_u8x4(ga[0]); wa.y = pk_u8x4(ga[1]);
                    *(u32x2*)(gfp + off) = wf; *(u32x2*)(gap + off) = wa; }
        }
    }
};
struct EpiMix {
    static constexpr bool PERM = true; static constexpr int RESCALE_T = 4;
    const unsigned char* G; const unsigned char* R; bf16_t* O;
    __device__ __forceinline__ void rescale(f32x4 (&acc)[2][2][4][2], const Unit& u, int wr, int wc, int fr, int fq) const {
        asm volatile("" : "+v"(fr), "+v"(fq));
        const int row0 = u.pm * BM + wr * 64 + fr, col0 = u.pn * BM + wc * 32 + 8 * fq;
#pragma unroll
        for (int ai = 0; ai < 2; ++ai)
#pragma unroll
            for (int m = 0; m < 4; ++m) { const unsigned off = (unsigned)(row0 + ai * HALF + m * 16) * 1024u + (unsigned)col0;
#pragma unroll
                for (int bj = 0; bj < 2; ++bj) { const u32x2 ga = *(const u32x2*)(R + off + bj * HALF), gf = *(const u32x2*)(G + off + bj * HALF);
#pragma unroll
                    for (int n = 0; n < 2; ++n) { const f32x4 a4 = u8x4_f(n ? ga.y : ga.x); f32x4 f4 = u8x4_f(n ? gf.y : gf.x), q4;
#pragma unroll
                        for (int j = 0; j < 4; ++j) q4[j] = __builtin_amdgcn_rcpf(__builtin_fmaxf(f4[j], 0.25f));
                        acc[ai][bj][m][n] = acc[ai][bj][m][n] * (a4 * q4); } }
                if (m == 3) asm volatile("" ::: "memory"); }
    }
    __device__ __forceinline__ void operator()(const f32x4 (&acc)[2][2][4][2], const Unit& u, int wr, int wc, int fr, int fq) const {
        const int row0 = u.pm * BM + wr * 64 + fr, col0 = u.pn * BM + wc * 32 + 8 * fq;
#pragma unroll
        for (int ai = 0; ai < 2; ++ai) { u32x2 gq[4][2];
#pragma unroll
            for (int m = 0; m < 4; ++m)
#pragma unroll
                for (int bj = 0; bj < 2; ++bj) gq[m][bj] = *(const u32x2*)(G + (unsigned)(row0 + ai * HALF + m * 16) * 1024u + (unsigned)col0 + bj * HALF);
#pragma unroll
            for (int m = 0; m < 4; ++m) { const unsigned off = (unsigned)(row0 + ai * HALF + m * 16) * 1024u + (unsigned)col0;
#pragma unroll
                for (int bj = 0; bj < 2; ++bj) { f32x4 f0 = u8x4_f(gq[m][bj].x), f1 = u8x4_f(gq[m][bj].y);
#pragma unroll
                    for (int j = 0; j < 4; ++j) { f0[j] = __builtin_fmaxf(f0[j], 0.25f); f1[j] = __builtin_fmaxf(f1[j], 0.25f); }
                    const f32x4 v0 = acc[ai][bj][m][0] * (f0 * (1.0f / 255.0f)), v1 = acc[ai][bj][m][1] * (f1 * (1.0f / 255.0f));
                    *(u32x4*)(O + off + bj * HALF) = pack8(v0, v1); } }
            asm volatile("" ::: "memory"); }
    }
};
template <class E, class = void> struct rescale_at { static constexpr int t = -1; };
template <class E> struct rescale_at<E, decltype((void)E::RESCALE_T)> { static constexpr int t = E::RESCALE_T; };
template <bool SS> struct EpiResid {
    static constexpr bool PERM = true;
    const bf16_t* res; bf16_t* out; int ld; float* ssout; unsigned char* x8;
    __device__ __forceinline__ void operator()(const f32x4 (&acc)[2][2][4][2], const Unit& u, int wr, int wc, int fr, int fq) const {
        const int row0 = u.pm * BM + wr * 64 + fr, col0 = u.pn * BM + wc * 32 + 8 * fq, lane = fq * 16 + fr;
        PG8_LAS float* const part = (PG8_LAS float*)(unsigned)131072;
#pragma unroll
        for (int ai = 0; ai < 2; ++ai) { u32x4 rq[4][2];
#pragma unroll
            for (int m = 0; m < 4; ++m)
#pragma unroll
                for (int bj = 0; bj < 2; ++bj) rq[m][bj] = *(const u32x4*)(res + (size_t)(row0 + ai * HALF + m * 16) * ld + col0 + bj * HALF);
#pragma unroll
            for (int m = 0; m < 4; ++m) { const int row = row0 + ai * HALF + m * 16; const size_t off = (size_t)row * ld + col0; float sq = 0.f;
#pragma unroll
                for (int bj = 0; bj < 2; ++bj) { const u32x4 r = rq[m][bj]; const f32x4 v0 = acc[ai][bj][m][0] + bf4_lo(r), v1 = acc[ai][bj][m][1] + bf4_hi(r);
                    if (SS) { const f32x4 q = v0 * v0 + v1 * v1; sq += (q[0] + q[1]) + (q[2] + q[3]); }
                    *(u32x4*)(out + off + bj * HALF) = pack8(v0, v1);
                    if (x8) { u32x2 w8; w8.x = pk_fp8(v0[0], v0[1], 0u, false); w8.x = pk_fp8(v0[2], v0[3], w8.x, true); w8.y = pk_fp8(v1[0], v1[1], 0u, false); w8.y = pk_fp8(v1[2], v1[3], w8.y, true);
                        *(u32x2*)(x8 + (size_t)row * 1024 + col0 + bj * HALF) = w8; } }
                if (SS) { sq += __int_as_float(__builtin_amdgcn_ds_bpermute((lane ^ 16) << 2, __float_as_int(sq))); sq += __int_as_float(__builtin_amdgcn_ds_bpermute((lane ^ 32) << 2, __float_as_int(sq)));
                    if (fq == 0) part[wc * 256 + wr * 64 + fr + ai * HALF + m * 16] = sq; } }
            asm volatile("" ::: "memory"); }
        if (SS) {
            asm volatile("s_waitcnt lgkmcnt(0)" ::: "memory"); __builtin_amdgcn_s_barrier(); asm volatile("" ::: "memory");
            const int t = (wr * 4 + wc) * 64 + lane;
            if (t < 256) ssout[(size_t)(u.pm * BM + t) * 4 + u.pn] = (part[t] + part[256 + t]) + (part[512 + t] + part[768 + t]);
            asm volatile("s_waitcnt lgkmcnt(0)" ::: "memory"); __builtin_amdgcn_s_barrier(); asm volatile("" ::: "memory");
        }
    }
};
struct EpiSwiglu {
    static constexpr bool PERM = true;
    bf16_t* T; int ldc; const float* ss;
    __device__ __forceinline__ void operator()(const f32x4 (&acc)[2][2][4][2], const Unit& u, int wr, int wc, int fr, int fq) const {
        const int row0 = u.pm * BM + wr * 64 + fr, col0 = u.pn * 128 + wc * 32 + 8 * fq;
#pragma unroll
        for (int ai = 0; ai < 2; ++ai)
#pragma unroll
            for (int m = 0; m < 4; ++m) { const int r = row0 + ai * HALF + m * 16; const float rs = rstd_of(ss, r), rs2 = rs * rs, rse = -1.4426950408889634f * rs; f32x4 o[2];
#pragma unroll
                for (int n = 0; n < 2; ++n) { const f32x4 x = acc[ai][0][m][n] * rse; f32x4 e, q;
#pragma unroll
                    for (int j = 0; j < 4; ++j) e[j] = __builtin_amdgcn_exp2f(x[j]);
                    e = e + 1.0f;
#pragma unroll
                    for (int j = 0; j < 4; ++j) q[j] = __builtin_amdgcn_rcpf(e[j]);
                    o[n] = (acc[ai][0][m][n] * acc[ai][1][m][n]) * (q * rs2); }
                *(u32x4*)(T + (size_t)r * ldc + col0) = pack8(o[0], o[1]); }
    }
};
struct EpiSwigluF8 {
    static constexpr bool PERM = true;
    unsigned char* T; int ldc; float ascale;
    __device__ __forceinline__ void operator()(const f32x4 (&acc)[2][2][4][2], const Unit& u, int wr, int wc, int fr, int fq) const {
        const int row0 = u.pm * BM + wr * 64 + fr, col0 = u.pn * 128 + wc * 32 + 8 * fq;
#pragma unroll
        for (int ai = 0; ai < 2; ++ai)
#pragma unroll
            for (int m = 0; m < 4; ++m) { unsigned char* rowp = T + (size_t)(row0 + ai * HALF + m * 16) * ldc + col0; f32x4 o4[2];
#pragma unroll
                for (int n = 0; n < 2; ++n) { const f32x4 x = acc[ai][0][m][n] * (-1.4426950408889634f * ascale); f32x4 e;
#pragma unroll
                    for (int j = 0; j < 4; ++j) e[j] = __builtin_amdgcn_exp2f(x[j]);
                    e = e + 1.0f; f32x4 r;
#pragma unroll
                    for (int j = 0; j < 4; ++j) r[j] = __builtin_amdgcn_rcpf(e[j]);
                    o4[n] = (acc[ai][0][m][n] * acc[ai][1][m][n]) * (r * (ascale * ascale)); }
                const float* o = (const float*)o4;
                u32x2 w; w.x = pk_fp8(o4[0][0], o4[0][1], 0u, false); w.x = pk_fp8(o4[0][2], o4[0][3], w.x, true); w.y = pk_fp8(o4[1][0], o4[1][1], 0u, false); w.y = pk_fp8(o4[1][2], o4[1][3], w.y, true); (void)o;
                *(u32x2*)rowp = w; }
    }
};
struct EpiScatterY {
    static constexpr bool PERM = true;
    bf16_t* y; const int* rows; const float* w; float ascale; int slot_rows; size_t slot_stride;
    __device__ __forceinline__ void operator()(const f32x4 (&acc)[2][2][4][2], const Unit& u, int wr, int wc, int fr, int fq) const {
        const int row0 = u.pm * BM + wr * 64 + fr, col0 = u.pn * BM + wc * 32 + 8 * fq; bf16_t* const yb = y + (row0 >= slot_rows ? slot_stride : (size_t)0);
#pragma unroll
        for (int ai = 0; ai < 2; ++ai)
#pragma unroll
            for (int m = 0; m < 4; ++m) { const int r = row0 + ai * HALF + m * 16, tok = rows[r]; const float rs = w[r] * ascale;
                if (tok >= 0) { bf16_t* yp = yb + (size_t)tok * 1024 + col0;
#pragma unroll
                    for (int bj = 0; bj < 2; ++bj) *(u32x4*)(yp + bj * HALF) = pack8(acc[ai][bj][m][0] * rs, acc[ai][bj][m][1] * rs); } }
    }
};
template <class Epi, class Sched, bool GATHER = false, int BMAP = 0, int ALAY = 0, bool FP8 = false, bool ALIGN_EPI = true, bool SP2 = true>
__device__ __forceinline__ void gemm_phase(PG8_LAS unsigned char* lds, const Gemm g, const Sched& S, const Epi& E) {
    int tid_ = threadIdx.x; asm volatile("" : "+v"(tid_));
    const int tid = tid_, wid = __builtin_amdgcn_readfirstlane(tid >> 6), lane = tid & 63, wr = wid >> 2, wc = wid & 3, fr = lane & 15, fq = lane >> 4;
    const int K = g.K, nt = K / BK;
    unsigned voffA[2], voffA1[2], nvA0[2], nvA1[2], voffB[2], nvB[2]; int Rg[2], Cg[2], RbS[2];
#pragma unroll
    for (int i = 0; i < 2; ++i) { int R, C; stage_rc(tid * 16 + i * 8192, R, C); const int Rb = Epi::PERM ? ((R & ~31) + perm32(R & 31)) : R; Rg[i] = R; Cg[i] = C * 2;
        voffA[i] = ALAY == 1 ? (unsigned)(C >> 3) * g.lda + (unsigned)R * 16u : (unsigned)R * g.lda + (unsigned)C * 2u; voffA1[i] = voffA[i]; nvA0[i] = voffA[i]; nvA1[i] = voffA[i];
        voffB[i] = (BMAP == 1 ? (unsigned)(64 * (Rb & 63) + (Rb >> 6)) : (unsigned)Rb) * g.ldb + (unsigned)C * 2u; RbS[i] = Rb; }
#define PG8_BKIND(kind_, dv, dh) do { const int _k = (kind_); _Pragma("unroll") for (int _i = 0; _i < 2; ++_i) { const int _r = RbS[_i]; \
        dv[_i] = (unsigned)(_k == 0 ? _r : (_k == 1 ? 64 * (_r & 63) + (_r >> 6) : (_k == 2 ? 4 * _r : 16 * _r))) * g.ldb + (unsigned)Cg[_i]; } \
        dh = (size_t)(_k == 0 ? 128 : (_k == 1 ? 2 : (_k == 2 ? 512 : 2048))) * g.ldb; } while (0)
#define PG8_GROWS(pm_, d0, d1) do { _Pragma("unroll") for (int _i = 0; _i < 2; ++_i) { int _t0 = g.rows[(pm_) * BM + Rg[_i]], _t1 = g.rows[(pm_) * BM + HALF + Rg[_i]]; _t0 = _t0 < 0 ? 0 : _t0; _t1 = _t1 < 0 ? 0 : _t1; \
        d0[_i] = (unsigned)_t0 * g.lda + (unsigned)Cg[_i]; d1[_i] = (unsigned)_t1 * g.lda + (unsigned)Cg[_i]; } } while (0)
    const size_t kstepB = (size_t)(BK * 2), kstepA = ALAY == 1 ? (size_t)8 * g.lda : kstepB;
    const size_t hstepA = GATHER ? (size_t)0 : (ALAY == 1 ? (size_t)HALF * 16 : (size_t)HALF * g.lda); size_t hstepB = (BMAP == 1 ? (size_t)2 : (size_t)HALF) * g.ldb, nhB = hstepB;
    const unsigned ldsw = (unsigned)wid * 1024u;
    const int aoff = lds_byte(wr * 64 + fr, fq * 8), boff = lds_byte(wc * 32 + fr, fq * 8);
#define PG8_SA(b, h) (((b) * 2 + (h)) * HTB)
#define PG8_SB(b, h) ((4 + (b) * 2 + (h)) * HTB)
#define PG8_STAGE(bufoff, gbase, voff) do { _Pragma("unroll") for (int _i = 0; _i < 2; ++_i) \
        __builtin_amdgcn_global_load_lds((const unsigned*)((const char*)(gbase) + (voff)[_i]), (PG8_LAS unsigned*)(lds + (bufoff) + ldsw + _i * 8192), 16, 0, 0); } while (0)
#define PG8_LDA(dst, b, h) do { if constexpr (FP8) { _Pragma("unroll") for (int m = 0; m < 4; ++m) dst##8[m] = PG8_CAT8(*(const PG8_LAS bf16x8*)(lds + PG8_SA(b, h) + aoff + m * 2048), *(const PG8_LAS bf16x8*)(lds + PG8_SA(b, h) + aoff + m * 2048 + 1024)); } \
    else { _Pragma("unroll") for (int m = 0; m < 4; ++m) _Pragma("unroll") for (int k = 0; k < 2; ++k) dst[m][k] = *(const PG8_LAS bf16x8*)(lds + PG8_SA(b, h) + aoff + m * 2048 + k * 1024); } } while (0)
#define PG8_LDB(dst, b, h) do { if constexpr (FP8) { _Pragma("unroll") for (int n = 0; n < 2; ++n) dst##8[n] = PG8_CAT8(*(const PG8_LAS bf16x8*)(lds + PG8_SB(b, h) + boff + n * 2048), *(const PG8_LAS bf16x8*)(lds + PG8_SB(b, h) + boff + n * 2048 + 1024)); } \
    else { _Pragma("unroll") for (int n = 0; n < 2; ++n) _Pragma("unroll") for (int k = 0; k < 2; ++k) dst[n][k] = *(const PG8_LAS bf16x8*)(lds + PG8_SB(b, h) + boff + n * 2048 + k * 1024); } } while (0)
#define PG8_CAT8(lo, hi) __builtin_shufflevector(__builtin_bit_cast(v4i_t, lo), __builtin_bit_cast(v4i_t, hi), 0, 1, 2, 3, 4, 5, 6, 7)
#define PG8_MMA(ai, bj, At, Bt) do { __builtin_amdgcn_s_setprio(1); if constexpr (FP8) { _Pragma("unroll") for (int m = 0; m < 4; ++m) _Pragma("unroll") for (int n = 0; n < 2; ++n) \
        asm volatile("v_mfma_f32_16x16x128_f8f6f4 %0, %1, %2, %0" : "+v"(acc[ai][bj][m][n]) : "v"(Bt##8[n]), "v"(At##8[m])); } else { \
        _Pragma("unroll") for (int m = 0; m < 4; ++m) _Pragma("unroll") for (int n = 0; n < 2; ++n) _Pragma("unroll") for (int k = 0; k < 2; ++k) \
        acc[ai][bj][m][n] = __builtin_amdgcn_mfma_f32_16x16x32_bf16(Bt[n][k], At[m][k], acc[ai][bj][m][n], 0, 0, 0); } __builtin_amdgcn_s_setprio(0); } while (0)
#define PG8_WAIT_V(n) asm volatile("s_waitcnt vmcnt(" #n ")" ::: "memory")
#define PG8_WAIT_L(n) asm volatile("s_waitcnt lgkmcnt(" #n ")" ::: "memory")
#define PG8_BAR __builtin_amdgcn_s_barrier()
#define PG8_SCHED __builtin_amdgcn_sched_barrier(0)
    Unit cur, nxt; int ui = 0;
    if (!S.next(0, cur)) return;
    f32x4 acc[2][2][4][2];
#pragma unroll
    for (int a = 0; a < 2; ++a)
#pragma unroll
        for (int b = 0; b < 2; ++b)
#pragma unroll
            for (int m = 0; m < 4; ++m)
#pragma unroll
                for (int n = 0; n < 2; ++n) acc[a][b][m][n] = (f32x4){0.f, 0.f, 0.f, 0.f};
    bf16x8 At[4][2], B0[2][2], B1[2][2]; v8i_t At8[4], B08[2], B18[2];
    const char* cA = g.A + cur.aoff; const char* cB = g.B + cur.boff;
    if constexpr (GATHER) PG8_GROWS(cur.pm, voffA, voffA1);
    if constexpr (BMAP == 2) { PG8_BKIND(cur.z, voffB, hstepB); nvB[0] = voffB[0]; nvB[1] = voffB[1]; nhB = hstepB; }
    if constexpr (SP2) {
        PG8_STAGE(PG8_SB(0, 0), cB, voffB); PG8_STAGE(PG8_SB(0, 1), cB + hstepB, voffB); PG8_STAGE(PG8_SA(0, 0), cA, voffA); PG8_STAGE(PG8_SA(0, 1), cA + hstepA, voffA1);
        if (wr == 1) PG8_BAR;
        PG8_WAIT_V(2); PG8_BAR;
        PG8_STAGE(PG8_SB(1, 0), cB + kstepB, voffB); PG8_STAGE(PG8_SA(1, 0), cA + kstepA, voffA); PG8_STAGE(PG8_SB(1, 1), cB + hstepB + kstepB, voffB);
        PG8_WAIT_V(6); PG8_BAR;
    } else {
        PG8_STAGE(PG8_SB(0, 0), cB, voffB); PG8_STAGE(PG8_SA(0, 0), cA, voffA); PG8_STAGE(PG8_SB(0, 1), cB + hstepB, voffB); PG8_STAGE(PG8_SA(0, 1), cA + hstepA, voffA);
        if (wr == 1) PG8_BAR;
        PG8_WAIT_V(4); PG8_BAR;
        PG8_STAGE(PG8_SB(1, 0), cB + kstepB, voffB); PG8_STAGE(PG8_SA(1, 0), cA + kstepA, voffA); PG8_STAGE(PG8_SB(1, 1), cB + hstepB + kstepB, voffB);
        PG8_WAIT_V(6); PG8_BAR;
    }
    for (;;) {
        const bool has_next = S.next(ui + 1, nxt);
        const char* nA = has_next ? g.A + nxt.aoff : cA; const char* nB = has_next ? g.B + nxt.boff : cB;
        if constexpr (BMAP == 2) { if (has_next) PG8_BKIND(nxt.z, nvB, nhB); else { nvB[0] = voffB[0]; nvB[1] = voffB[1]; nhB = hstepB; } }
        if constexpr (GATHER) { if (has_next) PG8_GROWS(nxt.pm, nvA0, nvA1); else {
#pragma unroll
            for (int i = 0; i < 2; ++i) { nvA0[i] = voffA[i]; nvA1[i] = voffA1[i]; } } }
#pragma unroll 1
        for (int t = 0; t < nt; t += 2) {
            if constexpr (rescale_at<Epi>::t >= 0) { if (t == rescale_at<Epi>::t) E.rescale(acc, cur, wr, wc, fr, fq); }
            const bool last = (t == nt - 2);
            const char* a1 = cA + (size_t)(t + 1) * kstepA;
            const char* a2 = last ? nA : cA + (size_t)(t + 2) * kstepA; const char* b2 = last ? nB : cB + (size_t)(t + 2) * kstepB;
            const char* a3 = a2 + kstepA; const char* b3 = b2 + kstepB;
            unsigned w0[2], w1[2];
#pragma unroll
            for (int i = 0; i < 2; ++i) { w0[i] = voffA[i]; w1[i] = voffA1[i]; }
            unsigned wB[2] = {voffB[0], voffB[1]}; size_t hB = hstepB;
            if (BMAP == 2 && last) { asm volatile("; next unit's B row map" ::: ); wB[0] = nvB[0]; wB[1] = nvB[1]; hB = nhB; }
            if (GATHER && last) { asm volatile("; next unit's gathered rows" ::: );
#pragma unroll
                for (int i = 0; i < 2; ++i) { w0[i] = nvA0[i]; w1[i] = nvA1[i]; } }
            if constexpr (SP2) {
            PG8_LDB(B0, 0, 0); PG8_LDB(B1, 0, 1); PG8_SCHED; PG8_LDA(At, 0, 0); PG8_STAGE(PG8_SA(1, 1), a1 + hstepA, voffA1);
            PG8_WAIT_V(8); PG8_WAIT_L(0); PG8_BAR; PG8_MMA(0, 0, At, B0); PG8_MMA(0, 1, At, B1); PG8_BAR; PG8_SCHED;
            PG8_LDA(At, 0, 1); PG8_STAGE(PG8_SB(0, 0), b2, wB); PG8_STAGE(PG8_SB(0, 1), b2 + hB, wB); PG8_STAGE(PG8_SA(0, 0), a2, w0);
            PG8_WAIT_V(8); PG8_WAIT_L(0); PG8_BAR; PG8_MMA(1, 0, At, B0); PG8_MMA(1, 1, At, B1); PG8_BAR; PG8_SCHED;
            PG8_LDB(B0, 1, 0); PG8_LDB(B1, 1, 1); PG8_SCHED; PG8_LDA(At, 1, 0); PG8_STAGE(PG8_SA(0, 1), a2 + hstepA, w1);
            PG8_WAIT_V(8); PG8_WAIT_L(0); PG8_BAR; PG8_MMA(0, 0, At, B0); PG8_MMA(0, 1, At, B1); PG8_BAR; PG8_SCHED;
            PG8_LDA(At, 1, 1); PG8_STAGE(PG8_SB(1, 0), b3, wB); PG8_STAGE(PG8_SB(1, 1), b3 + hB, wB); PG8_STAGE(PG8_SA(1, 0), a3, w0);
            PG8_WAIT_V(8); PG8_WAIT_L(0); PG8_BAR; PG8_MMA(1, 0, At, B0); PG8_MMA(1, 1, At, B1); PG8_BAR; PG8_SCHED;
            } else { static_assert(SP2 || (!GATHER && BMAP != 2), "GATHER / BMAP 2 need the SP2 loop");
            PG8_LDB(B0, 0, 0); PG8_SCHED; PG8_LDA(At, 0, 0); PG8_STAGE(PG8_SA(1, 1), a1 + hstepA, voffA);
            PG8_WAIT_L(8); PG8_BAR; PG8_WAIT_L(0); PG8_MMA(0, 0, At, B0); PG8_BAR; PG8_SCHED;
            PG8_LDB(B1, 0, 1); PG8_STAGE(PG8_SB(0, 0), b2, voffB);
            PG8_BAR; PG8_WAIT_L(0); PG8_MMA(0, 1, At, B1); PG8_BAR;
            PG8_LDA(At, 0, 1); PG8_STAGE(PG8_SA(0, 0), a2, voffA);
            PG8_BAR; PG8_WAIT_L(0); PG8_MMA(1, 0, At, B0); PG8_BAR; PG8_SCHED;
            PG8_STAGE(PG8_SB(0, 1), b2 + hstepB, voffB);
            PG8_WAIT_V(6); PG8_BAR; PG8_MMA(1, 1, At, B1); PG8_BAR;
            PG8_LDB(B0, 1, 0); PG8_SCHED; PG8_LDA(At, 1, 0); PG8_STAGE(PG8_SA(0, 1), a2 + hstepA, voffA);
            PG8_WAIT_L(8); PG8_BAR; PG8_WAIT_L(0); PG8_MMA(0, 0, At, B0); PG8_BAR; PG8_SCHED;
            PG8_LDB(B1, 1, 1); PG8_STAGE(PG8_SB(1, 0), b3, voffB);
            PG8_BAR; PG8_WAIT_L(0); PG8_MMA(0, 1, At, B1); PG8_BAR;
            PG8_LDA(At, 1, 1); PG8_STAGE(PG8_SA(1, 0), a3, voffA);
            PG8_BAR; PG8_WAIT_L(0); PG8_MMA(1, 0, At, B0); PG8_BAR; PG8_SCHED;
            PG8_STAGE(PG8_SB(1, 1), b3 + hstepB, voffB);
            PG8_WAIT_V(6); PG8_BAR; PG8_MMA(1, 1, At, B1); PG8_BAR;
            }
        }
        if constexpr (ALIGN_EPI) { if (wr == 0) PG8_BAR; }
        if constexpr (FP8) {
            asm volatile("s_nop 15\n\ts_nop 15\n\ts_nop 15\n\ts_nop 15\n\ts_nop 15\n\ts_nop 15\n\ts_nop 15\n\ts_nop 15" ::: "memory");
#pragma unroll
            for (int a = 0; a < 2; ++a)
#pragma unroll
                for (int b = 0; b < 2; ++b)
#pragma unroll
                    for (int m = 0; m < 4; ++m) asm volatile("" : "+v"(acc[a][b][m][0]), "+v"(acc[a][b][m][1])); }
        E(acc, cur, wr, wc, fr, fq);
        if (!has_next) break;
#pragma unroll
        for (int a = 0; a < 2; ++a)
#pragma unroll
            for (int b = 0; b < 2; ++b)
#pragma unroll
                for (int m = 0; m < 4; ++m)
#pragma unroll
                    for (int n = 0; n < 2; ++n) acc[a][b][m][n] = (f32x4){0.f, 0.f, 0.f, 0.f};
        cur = nxt; cA = nA; cB = nB; ++ui;
        if constexpr (BMAP == 2) { voffB[0] = nvB[0]; voffB[1] = nvB[1]; hstepB = nhB; }
        if constexpr (GATHER) {
#pragma unroll
            for (int i = 0; i < 2; ++i) { voffA[i] = nvA0[i]; voffA1[i] = nvA1[i]; } }
        if constexpr (ALIGN_EPI) { if (wr == 1) PG8_BAR; }
    }
    PG8_WAIT_V(0);
    if constexpr (!ALIGN_EPI) { if (wr == 0) PG8_BAR; }
    PG8_BAR;
#undef PG8_GROWS
#undef PG8_BKIND
#undef PG8_SA
#undef PG8_SB
#undef PG8_STAGE
#undef PG8_LDA
#undef PG8_LDB
#undef PG8_MMA
#undef PG8_CAT8
#undef PG8_WAIT_V
#undef PG8_WAIT_L
#undef PG8_BAR
#undef PG8_SCHED
}
}
#define GAS __attribute__((address_space(1)))
#define LAS __attribute__((address_space(3)))
typedef unsigned short bf16;
typedef unsigned v4u __attribute__((ext_vector_type(4)));
typedef float f32x4 __attribute__((ext_vector_type(4)));
typedef short bf16x8 __attribute__((ext_vector_type(8)));
typedef GAS unsigned gu32;
typedef GAS unsigned long long gu64;
#define RLX_AGENT __ATOMIC_RELAXED, __HIP_MEMORY_SCOPE_AGENT
#define LDS_WAIT() asm volatile("s_waitcnt lgkmcnt(0)" ::: "memory")
#define VM_WAIT() asm volatile("s_waitcnt vmcnt(0)" ::: "memory")
__device__ __forceinline__ unsigned long long rt() { return __builtin_amdgcn_s_memrealtime(); }
__device__ __forceinline__ unsigned f2bf(float f) { unsigned u = __builtin_bit_cast(unsigned, f); return (u + 0x7fffu + ((u >> 16) & 1u)) >> 16; }
__device__ __forceinline__ unsigned pk2(float lo, float hi) { return f2bf(lo) | (f2bf(hi) << 16); }

#define XB_TMO      128
#define XB_XCNT(j)  (256  + 64 * (j))
#define XB_XSUB(j)  (1280 + 64 * (j))
#define XB_XGEN(j)  (2304 + 64 * (j))
#define XB_TOP      3328
#define XB_TOPGEN   3392
#define XCD_BAR_WORDS 3456
#define XB_SPIN_CAP (1u << 18)

__device__ __forceinline__ unsigned xb_ld(unsigned* p)              { return __hip_atomic_load(p, __ATOMIC_RELAXED, __HIP_MEMORY_SCOPE_AGENT); }
__device__ __forceinline__ unsigned xb_add(unsigned* p, unsigned v) { return __hip_atomic_fetch_add(p, v, __ATOMIC_RELAXED, __HIP_MEMORY_SCOPE_AGENT); }
__device__ __forceinline__ unsigned xb_xcc_id() { return (unsigned)__builtin_amdgcn_s_getreg((3 << 11) | 20) & 0xFu; }
#define XB_SPIN(cond, bar) do { unsigned _sp = 0; while (cond) { __builtin_amdgcn_s_sleep(1); \
    if ((++_sp & 255u) == 0u) { if (xb_ld(&(bar)[XB_TMO])) break; if (_sp > XB_SPIN_CAP) { atomicAdd(&(bar)[XB_TMO], 1u); break; } } } } while (0)

struct XcdBarrier {
    unsigned* bar; unsigned x; unsigned G;
    volatile LAS unsigned* st;
};

__device__ __forceinline__ XcdBarrier xcd_barrier_post(unsigned* bar, volatile LAS unsigned* st) {
    XcdBarrier b; b.bar = bar; b.x = xb_xcc_id(); b.st = st; b.G = 0u;
    if (threadIdx.x == 0) (void)xb_add(&bar[XB_XCNT(b.x)], 1u);
    return b;
}
__device__ __forceinline__ void xcd_barrier_complete(unsigned* bar, unsigned x, const unsigned G, unsigned& nloc, unsigned& nx) {
    unsigned sum, cnt, mine, sp = 0u;
    for (;;) {
        sum = 0u; cnt = 0u; mine = 0u;
#pragma nounroll
        for (unsigned j = 0; j < 16; ++j) { const unsigned c = xb_ld(&bar[XB_XCNT(j)]); sum += c; cnt += (c > 0u) ? 1u : 0u; mine = (j == x) ? c : mine; }
        if (sum == G) break;
        __builtin_amdgcn_s_sleep(1);
        if ((++sp & 255u) == 0u) { if (xb_ld(&bar[XB_TMO])) break; if (sp > XB_SPIN_CAP) { atomicAdd(&bar[XB_TMO], 1u); break; } }
    }
    nloc = mine > 0u ? mine : 1u; nx = cnt > 0u ? cnt : 1u;
}

__device__ __forceinline__ void xcd_barrier(const XcdBarrier& b) {
    asm volatile("s_waitcnt vmcnt(0)" ::: "memory");
    __syncthreads();
    if (threadIdx.x == 0) {
        unsigned* bar = b.bar;
        __builtin_amdgcn_s_waitcnt(0);
        unsigned nloc = b.st[0], nx = b.st[1];
        if (nloc == 0u) { xcd_barrier_complete(bar, b.x, b.G, nloc, nx); b.st[0] = nloc; b.st[1] = nx; }
        const unsigned old = xb_add(&bar[XB_XSUB(b.x)], 1u);
        const unsigned gen = old / nloc;
        if (old + 1u == (gen + 1u) * nloc) {
            __builtin_amdgcn_fence(__ATOMIC_RELEASE, "agent");
            asm volatile("s_waitcnt vmcnt(0)" ::: "memory");
            const unsigned og = xb_add(&bar[XB_TOP], 1u);
            const unsigned tg = og / nx;
            if (og + 1u == (tg + 1u) * nx) xb_add(&bar[XB_TOPGEN], 1u);
            else XB_SPIN(xb_ld(&bar[XB_TOPGEN]) == tg, bar);
            __builtin_amdgcn_fence(__ATOMIC_ACQUIRE, "agent");
            xb_add(&bar[XB_XGEN(b.x)], 1u);
            asm volatile("s_waitcnt vmcnt(0)" ::: "memory");
        } else {
            XB_SPIN(xb_ld(&bar[XB_XGEN(b.x)]) == gen, bar);
            __builtin_amdgcn_fence(__ATOMIC_ACQUIRE, "agent");
            asm volatile("s_waitcnt vmcnt(0)" ::: "memory");
        }
    }
    __syncthreads();
}

constexpr int NWAVES = 8;
constexpr int BATCH = 8, SEQ = 4096, DM = 1024, MTOK = BATCH * SEQ, INC = 4864, FF = 3584, NEXP = 8, AW = 768, AOW = 256;
constexpr float RMS_EPS = 1e-6f;
constexpr float QSCALE = 0.125f * 1.4426950408889634f;

constexpr size_t MiB = 1u << 20;
constexpr size_t WS_CTL = 0, CTL_ZERO_BYTES = 1 * MiB;
constexpr size_t WS_WIN = 1 * MiB;
constexpr size_t WIN_L = (size_t)INC * DM * 2;
constexpr size_t WS_WM = 20 * MiB; constexpr int KMIX = AOW + DM;
constexpr size_t WS_WOUT = 25 * MiB;
constexpr size_t WS_W13 = 29 * MiB;
constexpr size_t WS_W2 = 43 * MiB;
constexpr size_t WS_ROPE = 50 * MiB;
constexpr size_t WS_SS = 502 * MiB, SS_STRIDE = (size_t)MTOK * 4;
constexpr size_t WS_H = 118 * MiB;
constexpr size_t WS_Z = WS_H;
constexpr size_t WS_UT = 182 * MiB;
constexpr size_t WS_OATT = WS_Z - (size_t)(AOW / 8) * MTOK * 16;
constexpr size_t WS_Q = 214 * MiB, WS_K = 262 * MiB, WS_V = 310 * MiB;
constexpr size_t WS_GF = 358 * MiB, WS_GA = 422 * MiB;
constexpr size_t WS_MIX = 278 * MiB;
constexpr size_t WS_H2 = 118 * MiB, WS_TT = 182 * MiB;
constexpr size_t WS_M13 = 54 * MiB, WS_M2 = 110 * MiB;
constexpr size_t WS_H2B = 138 * MiB, WS_TTB = 170 * MiB;
constexpr float W13_SCALE = 32.0f, W2_SCALE = 64.0f;
constexpr int MOE_ROWS = MTOK + 2048;
constexpr int MOE_TILES = MOE_ROWS / 256;
constexpr size_t WS_ROWTOK = 52 * MiB, WS_ROWW = WS_ROWTOK + 512 * 1024;
constexpr size_t WS_SEL = 53 * MiB, WS_WTS = WS_SEL + 128 * 1024;
constexpr size_t WS_CNT = WS_WTS + 256 * 1024, WS_PLAN = WS_CNT + 64 * 1024;
constexpr size_t WS_WG8 = 96 * MiB;
constexpr size_t WS_WQK8 = 486 * MiB;
constexpr size_t WS_WV8 = 490 * MiB;
constexpr size_t WS_X8 = 504 * MiB;
constexpr float WG_SCALE = pg8::WG8_SCALE;
constexpr size_t WS_Y = 408 * MiB;
constexpr size_t WS_END = 536 * MiB;
static_assert(WS_TTB + (size_t)2 * MOE_ROWS * FF <= WS_Y && WS_Y + (size_t)2 * MTOK * DM * 2 <= WS_END && 2 * MOE_ROWS * 4 <= 512 * 1024 && WS_PLAN + 4096 <= 54 * MiB, "moe map");
static_assert(WS_M13 + (size_t)8 * 2 * FF * DM <= WS_M2 && WS_M2 + (size_t)8 * DM * FF <= WS_H2B && WS_H2B + (size_t)MTOK * DM <= WS_TTB && WS_MIX + (size_t)MTOK * DM * 2 <= WS_GF, "d_ws map");

constexpr int XP = 2 * DM;
constexpr int CW_BAR = 4096;
constexpr int RING_BYTES = 131072, LDS_BYTES = 147456, LDSCTL_OFF = LDS_BYTES - 1024, MISC_OFF = LDSCTL_OFF + 320;
static_assert(512 * 68 * 4 <= LDSCTL_OFF, "attention state fits under the control words");

struct Args { const float* in[16]; float* out; unsigned char* ws; int G, pad; };

struct Frame { LAS unsigned char* lds; volatile LAS unsigned* MISC; gu32* ctl; int tid, lane, wave, vcu, G; };

__device__ __forceinline__ float wave_sum(float v, int lane) {
#pragma unroll
    for (int o = 1; o < 64; o <<= 1) v += __int_as_float(__builtin_amdgcn_ds_bpermute((lane ^ o) << 2, __float_as_int(v)));
    return v;
}
__device__ __forceinline__ float bflo(unsigned w) { return __uint_as_float(w << 16); }
__device__ __forceinline__ float bfhi(unsigned w) { return __uint_as_float(w & 0xffff0000u); }

struct RowMap { int kind, base;
    __device__ __forceinline__ int operator()(int n) const {
        if (kind == 0) return n + base;
        if (kind == 2) return (n >> 2) * 8 + (n & 3) + base;
        if (kind == 5) { const int isk = n >= 768, c = n - (isk ? 768 : 0), hd = c >> 6, d = c & 63; return (isk ? 768 : 0) + hd * 64 + 2 * (d & 31) + (d >> 5); }
        if (kind == 4) { const int gch = n & 1023; return (gch >> 7) * 256 + (gch & 127) + (n >= 1024 ? 128 : 0); }
        if (kind == 3) return (n >> 7) * 256 + (n & 127) + base;
        if (n < 512) return n;
        if (n < 2048) { const int isk = n >= 1280, c = n - (isk ? 1280 : 512), hd = c >> 6, d = c & 63; return (isk ? 2048 : 1280) + hd * 64 + 2 * (d & 31) + (d >> 5); }
        if (n < 2816) return 512 + (n - 2048);
        { const int gch = (n - 2816) & 1023; return 2816 + (gch >> 7) * 256 + (gch & 127) + (n >= 3840 ? 128 : 0); }
    } };
struct TrJob { const float* W; int N; void* WT; int ldk; RowMap rm; const float* gain; float scale; int item; int ldw; int f8; };
__device__ __forceinline__ void tr_load(const TrJob& j, int lane, float (&r)[32]) {
    const int nblk = j.N / 32, kb = j.item / nblk, nb = j.item % nblk, k0 = 64 * kb, n0 = 32 * nb;
#pragma unroll
    for (int i = 0; i < 32; ++i) { const int kk = 2 * i + (lane >> 5); r[i] = j.W[(size_t)(k0 + kk) * (j.ldw ? j.ldw : j.N) + n0 + (lane & 31)]; }
}
template <bool F8> __device__ __forceinline__ void tr_store(const TrJob& j, int lane, const float (&r)[32], LAS float* scr) {
    const int nblk = j.N / 32, kb = j.item / nblk, nb = j.item % nblk, k0 = 64 * kb, n0 = 32 * nb;
#pragma unroll
    for (int i = 0; i < 32; ++i) { const int kk = 2 * i + (lane >> 5); scr[kk * 33 + (lane & 31)] = r[i] * (j.gain ? j.scale * j.gain[k0 + kk] : j.scale); }
    LDS_WAIT(); asm volatile("" ::: "memory");
    const int c = lane & 7;
#pragma unroll
    for (int q = 0; q < 4; ++q) { const int n = (lane >> 3) + 8 * q; const LAS float* sp = scr + (8 * c) * 33 + n; const size_t drow = (size_t)j.rm(n0 + n) * j.ldk + k0 + 8 * c;
        if (F8) { unsigned lo = pg8::pk_fp8(sp[0 * 33], sp[1 * 33], 0u, false); lo = pg8::pk_fp8(sp[2 * 33], sp[3 * 33], lo, true);
                  unsigned hi = pg8::pk_fp8(sp[4 * 33], sp[5 * 33], 0u, false); hi = pg8::pk_fp8(sp[6 * 33], sp[7 * 33], hi, true);
                  *(GAS unsigned long long*)((unsigned char*)j.WT + drow) = (unsigned long long)lo | ((unsigned long long)hi << 32); }
        else { v4u o; o.x = pk2(sp[0 * 33], sp[1 * 33]); o.y = pk2(sp[2 * 33], sp[3 * 33]); o.z = pk2(sp[4 * 33], sp[5 * 33]); o.w = pk2(sp[6 * 33], sp[7 * 33]);
               *(GAS v4u*)((bf16*)j.WT + drow) = o; } }
    LDS_WAIT(); asm volatile("" ::: "memory");
}
__device__ __forceinline__ void rms_row(const bf16* xrow, const f32x4 (&gn)[4], f32x4 (&v)[4], int lane) {
    const GAS unsigned long long* xr = (const GAS unsigned long long*)xrow + lane; float s = 0.f;
#pragma unroll
    for (int j = 0; j < 4; ++j) { const unsigned long long w = xr[64 * j]; v[j].x = bflo((unsigned)w); v[j].y = bfhi((unsigned)w); v[j].z = bflo((unsigned)(w >> 32)); v[j].w = bfhi((unsigned)(w >> 32)); s += (v[j].x * v[j].x + v[j].y * v[j].y) + (v[j].z * v[j].z + v[j].w * v[j].w); }
    const float rstd = 1.0f / sqrtf(wave_sum(s, lane) * (1.0f / DM) + RMS_EPS);
#pragma unroll
    for (int j = 0; j < 4; ++j) v[j] = v[j] * rstd * gn[j];
}
__device__ __forceinline__ void prep_x_phase(Frame& F, const float* x, bf16* xb, float* ss, unsigned char* x8) {
    const int gw = F.vcu * NWAVES + F.wave, NGW = F.G * NWAVES;
    for (int m = gw; m < MTOK; m += NGW) { const GAS f32x4* xr = (const GAS f32x4*)(x + (size_t)m * DM) + F.lane; f32x4 v[4]; float sq = 0.f;
#pragma unroll
        for (int j = 0; j < 4; ++j) { v[j] = xr[64 * j]; sq += (v[j].x * v[j].x + v[j].y * v[j].y) + (v[j].z * v[j].z + v[j].w * v[j].w); }
        sq = wave_sum(sq, F.lane); if (F.lane < 4) ss[(size_t)m * 4 + F.lane] = F.lane == 0 ? sq : 0.f;
        GAS unsigned long long* o8 = (GAS unsigned long long*)(xb + (size_t)m * XP) + F.lane;
#pragma unroll
        for (int j = 0; j < 4; ++j) o8[64 * j] = (unsigned long long)pk2(v[j].x, v[j].y) | ((unsigned long long)pk2(v[j].z, v[j].w) << 32);
        GAS unsigned* q8 = (GAS unsigned*)(x8 + (size_t)m * DM) + F.lane;
#pragma unroll
        for (int j = 0; j < 4; ++j) { unsigned w8 = pg8::pk_fp8(v[j].x, v[j].y, 0u, false); w8 = pg8::pk_fp8(v[j].z, v[j].w, w8, true); q8[64 * j] = w8; } }
}

__device__ __forceinline__ TrJob dense_job(const Args& a, int it) {
    unsigned char* ws = a.ws;
    constexpr int I_U = 16 * (512 / 32), I_V = 16 * (768 / 32), I_AT = 4 * 32, I_OUT = 16 * 32, I_W1 = 16 * (FF / 32), I_G = 16 * (2048 / 32), I_QK = 16 * (1536 / 32);
    constexpr int PER_L = I_U + I_V + I_AT + I_OUT;
    int r = it; TrJob j; j.gain = nullptr; j.scale = 1.0f; j.rm = RowMap{0, 0}; j.ldw = 0; j.f8 = 0;
    if (r < 2 * PER_L) { const int l = r / PER_L; r -= l * PER_L;
        if (r < I_U) { j.W = a.in[2] + (size_t)l * DM * INC; j.N = 512; j.ldw = INC; j.WT = ws + WS_WIN + l * WIN_L; j.ldk = DM; j.gain = a.in[1] + l * DM; }
        else if (r < I_U + I_V) { r -= I_U; j.W = a.in[2] + (size_t)l * DM * INC + 2048; j.N = 768; j.ldw = INC; j.WT = ws + WS_WV8 + (size_t)l * 768 * DM; j.ldk = DM; j.gain = a.in[1] + l * DM; j.scale = WG_SCALE; j.f8 = 1; }
        else if (r < I_U + I_V + I_AT) { r -= I_U + I_V; j.W = a.in[4] + (size_t)l * AOW * DM; j.N = DM; j.WT = (bf16*)(ws + WS_WM) + (size_t)l * DM * KMIX; j.ldk = KMIX; }
        else { r -= I_U + I_V + I_AT; j.W = a.in[5] + (size_t)l * DM * DM; j.N = DM; j.WT = (bf16*)(ws + WS_WOUT) + (size_t)l * DM * DM; j.ldk = DM; } }
    else { r -= 2 * PER_L;
        if (r < I_W1) { j.W = a.in[7]; j.N = FF; j.WT = ws + WS_W13; j.ldk = DM; j.rm = RowMap{3, 0}; j.gain = a.in[6]; }
        else if (r < 2 * I_W1) { r -= I_W1; j.W = a.in[8]; j.N = FF; j.WT = ws + WS_W13; j.ldk = DM; j.rm = RowMap{3, 128}; j.gain = a.in[6]; }
        else if (r < 3 * I_W1) { r -= 2 * I_W1; j.W = a.in[9]; j.N = DM; j.WT = ws + WS_W2; j.ldk = FF; }
        else if (r < 3 * I_W1 + 2 * I_G) { r -= 3 * I_W1; const int l = r / I_G; r -= l * I_G; j.W = a.in[2] + (size_t)l * DM * INC + 2816; j.N = 2048; j.ldw = INC; j.WT = ws + WS_WG8 + (size_t)l * 2048 * DM; j.ldk = DM; j.rm = RowMap{4, 0};
               j.gain = a.in[1] + l * DM; j.scale = WG_SCALE; j.f8 = 1; }
        else { r -= 3 * I_W1 + 2 * I_G; const int l = r / I_QK; r -= l * I_QK; j.W = a.in[2] + (size_t)l * DM * INC + 512; j.N = 1536; j.ldw = INC; j.WT = ws + WS_WQK8 + (size_t)l * 1536 * DM; j.ldk = DM; j.rm = RowMap{5, 0};
               j.gain = a.in[1] + l * DM; j.scale = WG_SCALE; j.f8 = 1; } }
    j.item = r; return j;
}
constexpr int MOE_I_W1 = 16 * (FF / 32), MOE_I_W2 = (FF / 64) * 32, MOE_NITEMS = NEXP * (2 * MOE_I_W1 + MOE_I_W2), MOE_EARLY_E = 6, MOE_EARLY = MOE_EARLY_E * 2 * MOE_I_W1;
constexpr int CONV_WGS = 40, GEMM_WGS = 256 - CONV_WGS, CONV_PER_WAVE = 0, CONV_PHASE_ITEMS = CONV_WGS * NWAVES * CONV_PER_WAVE;
static_assert(2 * CONV_PHASE_ITEMS <= MOE_EARLY && GEMM_WGS % 8 == 0 && (640 + GEMM_WGS - 1) / GEMM_WGS == 3, "early conversion");
__device__ __forceinline__ TrJob moe_job(const Args& a, int v) {
    unsigned char* ws = a.ws;
    constexpr int I_W1 = MOE_I_W1;
    int e, r;
    if (v < MOE_EARLY) { e = v / (2 * I_W1); r = v - e * (2 * I_W1); }
    else { v -= MOE_EARLY; if (v < (NEXP - MOE_EARLY_E) * 2 * I_W1) { const int q = v / (2 * I_W1); e = MOE_EARLY_E + q; r = v - q * (2 * I_W1); } else { v -= (NEXP - MOE_EARLY_E) * 2 * I_W1; e = v / MOE_I_W2; r = 2 * I_W1 + (v - e * MOE_I_W2); } }
    TrJob j; j.gain = nullptr; j.scale = W13_SCALE; j.rm = RowMap{3, 0}; j.ldw = 0; j.f8 = 1;
    if (r < I_W1) { j.W = a.in[12] + (size_t)e * DM * FF; j.N = FF; j.WT = ws + WS_M13 + (size_t)e * 2 * FF * DM; j.ldk = DM; }
    else if (r < 2 * I_W1) { r -= I_W1; j.W = a.in[13] + (size_t)e * DM * FF; j.N = FF; j.WT = ws + WS_M13 + (size_t)e * 2 * FF * DM; j.ldk = DM; j.rm = RowMap{3, 128}; }
    else { r -= 2 * I_W1; j.W = a.in[14] + (size_t)e * FF * DM; j.N = DM; j.WT = ws + WS_M2 + (size_t)e * DM * FF; j.ldk = FF; j.scale = W2_SCALE; j.rm = RowMap{0, 0}; }
    j.item = r; return j;
}
__device__ __forceinline__ void p0_weights(Frame& F, const Args& a) {
    LAS float* scr = (LAS float*)(F.lds + F.wave * 16384);
    const int gw = F.vcu * NWAVES + F.wave, NGW = F.G * NWAVES;
    constexpr int I_IN = 16 * (512 / 32) + 16 * (768 / 32), I_AT = 4 * 32, I_OUT = 16 * 32, I_W1 = 16 * (FF / 32), I_W2 = (FF / 64) * 32, I_G = 16 * (2048 / 32), I_QK = 16 * (1536 / 32), NITEMS = 2 * (I_IN + I_AT + I_OUT) + 2 * I_W1 + I_W2 + 2 * I_G + 2 * I_QK;
    static_assert(I_W2 == I_W1, "dense_job counts w2's items as I_W1");
    if (gw >= NITEMS) return;
    TrJob cur = dense_job(a, gw); float rc[32]; tr_load(cur, F.lane, rc);
#pragma unroll 1
    for (int it = gw; it < NITEMS; it += NGW) { const int nx = it + NGW; const bool more = nx < NITEMS; TrJob nj = cur; float rn[32];
        if (more) { nj = dense_job(a, nx); tr_load(nj, F.lane, rn); }
        if (cur.f8) tr_store<true>(cur, F.lane, rc, scr); else tr_store<false>(cur, F.lane, rc, scr);
        if (more) { cur = nj;
#pragma unroll
            for (int i = 0; i < 32; ++i) rc[i] = rn[i]; } }
}
__device__ __forceinline__ void p0_moe_weights(Frame& F, const Args& a, int first, int NITEMS, int gw, int NGW) {
    LAS float* scr = (LAS float*)(F.lds + F.wave * 16384);
    gw += first;
    if (gw >= NITEMS) return;
    TrJob cur = moe_job(a, gw), nx1 = cur; float rc[32], r1[32];
    tr_load(cur, F.lane, rc);
    if (gw + NGW < NITEMS) { nx1 = moe_job(a, gw + NGW); tr_load(nx1, F.lane, r1); }
#pragma unroll 1
    for (int it = gw; it < NITEMS; it += NGW) { const int n2 = it + 2 * NGW; const bool more2 = n2 < NITEMS, more1 = it + NGW < NITEMS; TrJob nx2 = cur; float r2[32];
        if (more2) { nx2 = moe_job(a, n2); tr_load(nx2, F.lane, r2); }
        tr_store<true>(cur, F.lane, rc, scr);
        if (more1) { cur = nx1;
#pragma unroll
            for (int i = 0; i < 32; ++i) rc[i] = r1[i]; }
        if (more2) { nx1 = nx2;
#pragma unroll
            for (int i = 0; i < 32; ++i) r1[i] = r2[i]; } }
}
__device__ __forceinline__ void p0_tables(Frame& F, const Args& a) {
    unsigned char* ws = a.ws;
    const int gt = F.vcu * (NWAVES * 64) + F.tid, NGT = F.G * NWAVES * 64;
    float* rope = (float*)(ws + WS_ROPE);
    for (int i = gt; i < SEQ * 32; i += NGT) { const int pos = i >> 5, f = i & 31; const float inv = powf(10000.0f, -(float)f * 2.0f / 64.0f); const float ang = (float)pos * inv;
        rope[2 * i] = cosf(ang); rope[2 * i + 1] = sinf(ang); }
    LAS float* tab = (LAS float*)F.lds;
    LAS float* wl = (LAS float*)(F.lds + 1024 + F.wave * 2048);
    if (F.tid < 128) tab[F.tid] = cospif((float)F.tid * (1.0f / 64.0f));
    __syncthreads();
    const int gw = F.vcu * NWAVES + F.wave, NGW = F.G * NWAVES;
    for (int it = gw; it < 2 * DM; it += NGW) { const int l = it >> 10, j = it & 1023; const float* wf = a.in[3] + (size_t)l * 512 * DM + j;
#pragma unroll
        for (int q = 0; q < 8; ++q) wl[F.lane + 64 * q] = wf[(size_t)(F.lane + 64 * q) * DM];
        LDS_WAIT(); asm volatile("" ::: "memory");
#pragma unroll 1
        for (int o = 0; o < 16; ++o) { const int kk = o * 64 + F.lane, part = kk & 1, cf = 4 * (kk >> 3) + ((kk >> 1) & 3), g = cf >> 7, c = cf & 127, sh = part ? 96 : 0;
            const float c1 = tab[c], tw = 2.0f * c1; float u0 = part ? 0.f : 1.f, u1 = part ? tab[(c + sh) & 127] : c1;
            float acc = 0.f, acc2 = 0.f; const LAS float* wg = wl + g * 128;
#pragma unroll 4
            for (int kc = 0; kc < 128; kc += 4) { const f32x4 w4 = *(const LAS f32x4*)(wg + kc);
                const float u2 = tw * u1 - u0, u3 = tw * u2 - u1; acc += u0 * w4[0]; acc2 += u1 * w4[1]; acc += u2 * w4[2]; acc2 += u3 * w4[3]; u0 = tw * u3 - u2; u1 = tw * u0 - u3; }
            acc += acc2;
            ((bf16*)(ws + WS_WM))[(size_t)l * DM * KMIX + (size_t)j * KMIX + AOW + kk] = (bf16)f2bf(acc * 0.08838834764831845f); }
        LDS_WAIT(); asm volatile("" ::: "memory");
    }
}

__device__ __forceinline__ void fft_phase(Frame& F, const bf16* UT, bf16* Zb) {
    const int lane = F.lane, w = F.wave & 3, cg = F.wave >> 2, lr = lane & 15, lg = lane >> 4;
    LAS unsigned char* f2 = F.lds; LAS unsigned char* f1 = F.lds + 16384; LAS float* tw = (LAS float*)(F.lds + 32768);
#pragma unroll 1
    for (int idx = F.tid; idx < 4096; idx += NWAVES * 64) {
        { const int f = idx >> 8, l = (idx >> 2) & 63, e2 = idx & 3, q = f >> 2, KK = (f >> 1) & 1, cs = f & 1, llr = l & 15, llg = l >> 4; float v[2];
#pragma unroll
          for (int h = 0; h < 2; ++h) { const int e = 2 * e2 + h, n2 = 32 * KK + (e < 4 ? 4 * llg + e : 16 + 4 * llg + e - 4), k2 = 16 * q + llr; const float x = (float)((n2 * k2) & 63) * (1.0f / 32.0f); v[h] = (cs ? sinpif(x) : cospif(x)) * 0.125f; }
          *(LAS unsigned*)(f2 + f * 1024 + l * 16 + e2 * 4) = pk2(v[0], v[1]); }
        { const int f = idx >> 8, l = (idx >> 2) & 63, e2 = idx & 3, ww = f >> 2, kk = (f >> 1) & 1, cs = f & 1, llr = l & 15, llg = l >> 4; float v[2];
#pragma unroll
          for (int h = 0; h < 2; ++h) { const int n1 = 32 * kk + 8 * llg + 2 * e2 + h, k1 = 16 * ww + llr; const float x = (float)((n1 * k1) & 63) * (1.0f / 32.0f); v[h] = (cs ? -sinpif(x) : cospif(x)) * 0.125f; }
          *(LAS unsigned*)(f1 + f * 1024 + l * 16 + e2 * 4) = pk2(v[0], v[1]); }
        { const int ww = idx >> 10, l = (idx >> 4) & 63, ir = idx & 15, n2 = 16 * (ir >> 2) + 4 * (l >> 4) + (ir & 3), k1 = 16 * ww + (l & 15); const float x = (float)(n2 * k1) * (1.0f / 2048.0f);
          tw[(ww * 64 + l) * 32 + ir] = cospif(x); tw[(ww * 64 + l) * 32 + 16 + ir] = sinpif(x); }
    }
    __syncthreads();
    bf16x8 F1c[2], F1s[2];
#pragma unroll
    for (int kk = 0; kk < 2; ++kk) { F1c[kk] = *(const LAS bf16x8*)(f1 + ((w * 2 + kk) * 2) * 1024 + lane * 16); F1s[kk] = *(const LAS bf16x8*)(f1 + ((w * 2 + kk) * 2 + 1) * 1024 + lane * 16); }
    float twc[4][4], tws[4][4];
#pragma unroll
    for (int I = 0; I < 4; ++I) { const f32x4 tc = *(const LAS f32x4*)(tw + (w * 64 + lane) * 32 + 4 * I), ts = *(const LAS f32x4*)(tw + (w * 64 + lane) * 32 + 16 + 4 * I);
#pragma unroll
        for (int r = 0; r < 4; ++r) { twc[I][r] = tc[r]; tws[I][r] = ts[r]; } }
    for (int it = F.vcu * 2 + cg; it < BATCH * 128; it += F.G * 2) {
        const int b = it >> 7, quad = it & 127;
        unsigned outp[4][4][4];
#pragma unroll
        for (int cc = 0; cc < 4; ++cc) {
            const bf16* xp = UT + (size_t)(quad * 4 + cc) * MTOK + b * SEQ + 64 * lr + 8 * lg;
            bf16x8 xa[4][2];
#pragma unroll
            for (int I = 0; I < 4; ++I)
#pragma unroll
                for (int kk = 0; kk < 2; ++kk) xa[I][kk] = *(const GAS bf16x8*)(xp + 1024 * I + 32 * kk);
            f32x4 d1r[4], d1i[4];
#pragma unroll
            for (int I = 0; I < 4; ++I) { d1r[I] = (f32x4){0.f, 0.f, 0.f, 0.f}; d1i[I] = (f32x4){0.f, 0.f, 0.f, 0.f};
#pragma unroll
                for (int kk = 0; kk < 2; ++kk) { d1r[I] = __builtin_amdgcn_mfma_f32_16x16x32_bf16(xa[I][kk], F1c[kk], d1r[I], 0, 0, 0); d1i[I] = __builtin_amdgcn_mfma_f32_16x16x32_bf16(xa[I][kk], F1s[kk], d1i[I], 0, 0, 0); } }
            bf16x8 yr[2], yi[2], yn[2];
#pragma unroll
            for (int KK = 0; KK < 2; ++KK) { float vr[8], vi[8];
#pragma unroll
                for (int e = 0; e < 8; ++e) { const int I = 2 * KK + (e >> 2), r = e & 3; const float a = d1r[I][r], bb = d1i[I][r]; vr[e] = a * twc[I][r] + bb * tws[I][r]; vi[e] = bb * twc[I][r] - a * tws[I][r]; }
                v4u pr, pi, pn; pr.x = pg8::cvt_pk_bf16(vr[0], vr[1]); pr.y = pg8::cvt_pk_bf16(vr[2], vr[3]); pr.z = pg8::cvt_pk_bf16(vr[4], vr[5]); pr.w = pg8::cvt_pk_bf16(vr[6], vr[7]);
                pi.x = pg8::cvt_pk_bf16(vi[0], vi[1]); pi.y = pg8::cvt_pk_bf16(vi[2], vi[3]); pi.z = pg8::cvt_pk_bf16(vi[4], vi[5]); pi.w = pg8::cvt_pk_bf16(vi[6], vi[7]);
                pn.x = pr.x ^ 0x80008000u; pn.y = pr.y ^ 0x80008000u; pn.z = pr.z ^ 0x80008000u; pn.w = pr.w ^ 0x80008000u;
                yr[KK] = __builtin_bit_cast(bf16x8, pr); yi[KK] = __builtin_bit_cast(bf16x8, pi); yn[KK] = __builtin_bit_cast(bf16x8, pn); }
#pragma unroll
            for (int q = 0; q < 4; ++q) { f32x4 zr = (f32x4){0.f, 0.f, 0.f, 0.f}, zi = (f32x4){0.f, 0.f, 0.f, 0.f};
#pragma unroll
                for (int KK = 0; KK < 2; ++KK) { const bf16x8 fc = *(const LAS bf16x8*)(f2 + ((q * 2 + KK) * 2) * 1024 + lane * 16), fs = *(const LAS bf16x8*)(f2 + ((q * 2 + KK) * 2 + 1) * 1024 + lane * 16);
                    zr = __builtin_amdgcn_mfma_f32_16x16x32_bf16(yr[KK], fc, zr, 0, 0, 0); zr = __builtin_amdgcn_mfma_f32_16x16x32_bf16(yi[KK], fs, zr, 0, 0, 0);
                    zi = __builtin_amdgcn_mfma_f32_16x16x32_bf16(yi[KK], fc, zi, 0, 0, 0); zi = __builtin_amdgcn_mfma_f32_16x16x32_bf16(yn[KK], fs, zi, 0, 0, 0); }
#pragma unroll
                for (int r = 0; r < 4; ++r) outp[q][r][cc] = pg8::cvt_pk_bf16(zr[r], zi[r]); }
        }
#pragma unroll
        for (int q = 0; q < 4; ++q)
#pragma unroll
            for (int r = 0; r < 4; ++r) { const int k = 16 * w + 4 * lg + r + 64 * (16 * q + lr); v4u o; o.x = outp[q][r][0]; o.y = outp[q][r][1]; o.z = outp[q][r][2]; o.w = outp[q][r][3];
                *(GAS v4u*)(Zb + ((size_t)quad * MTOK + (size_t)b * SEQ + k) * 8) = o; }
    }
    __syncthreads();
}

__device__ __forceinline__ bf16x8 f8x8_bf16(unsigned long long w) {
    typedef float f32x2_t __attribute__((ext_vector_type(2)));
    const f32x2_t a = __builtin_amdgcn_cvt_pk_f32_fp8((int)(unsigned)w, false), b = __builtin_amdgcn_cvt_pk_f32_fp8((int)(unsigned)w, true),
                  c = __builtin_amdgcn_cvt_pk_f32_fp8((int)(unsigned)(w >> 32), false), d = __builtin_amdgcn_cvt_pk_f32_fp8((int)(unsigned)(w >> 32), true);
    v4u o; o.x = pg8::cvt_pk_bf16(a.x, a.y); o.y = pg8::cvt_pk_bf16(b.x, b.y); o.z = pg8::cvt_pk_bf16(c.x, c.y); o.w = pg8::cvt_pk_bf16(d.x, d.y); return __builtin_bit_cast(bf16x8, o); }
__device__ __forceinline__ void attn_mfma_phase(Frame& F, const unsigned char* Q, const unsigned char* K, const unsigned char* VT, bf16* OA) {
    LAS float* st = (LAS float*)F.lds;
    const int lane = F.lane, lr = lane & 15, lg = lane >> 4, bp16 = (lane ^ 16) << 2, bp32 = (lane ^ 32) << 2;
    for (int unit = F.vcu; unit < 256; unit += F.G) {
        const int b = unit >> 5, pb = (unit >> 2) & 7, j = unit & 3, P0 = pb * 512;
#pragma unroll 1
        for (int pass = 0; pass < 3; ++pass) {
            const int g = 2 - pass, dsh = 2 * g, dl = 1 << dsh, L = SEQ >> dsh, head = g * 4 + j, lns = 4 - dsh;
#pragma unroll 1
            for (int tt = 0; tt < 2; ++tt) {
                const int tau = F.wave * 2 + tt, r = tau >> lns, sblk = tau & ((1 << lns) - 1), iq0 = (P0 >> dsh) + 32 * sblk;
                const unsigned char* Kh = K + (size_t)b * SEQ * AW + head * 64 + 8 * lg;
                const unsigned char* Vh = VT + (size_t)(head * 64 + lr) * MTOK + (size_t)b * SEQ + r * L;
                long qf[2][2]; int prow[2]; f32x4 o[4][2]; float m[2], l[2];
#pragma unroll
                for (int qb = 0; qb < 2; ++qb) { const int pl = dl * (32 * sblk + 16 * qb + lr) + r; prow[qb] = pl;
                    const unsigned char* qp = Q + (size_t)(b * SEQ + P0 + pl) * AW + head * 64 + 8 * lg;
                    qf[qb][0] = *(const GAS long*)qp; qf[qb][1] = *(const GAS long*)(qp + 32); }
                if (pass == 0) {
#pragma unroll
                    for (int qb = 0; qb < 2; ++qb) { m[qb] = -1e30f; l[qb] = 0.f;
#pragma unroll
                        for (int t = 0; t < 4; ++t) o[t][qb] = (f32x4){0.f, 0.f, 0.f, 0.f}; }
                } else {
#pragma unroll
                    for (int qb = 0; qb < 2; ++qb) { const LAS float* sp = st + prow[qb] * 68; m[qb] = sp[64]; l[qb] = lg == 0 ? sp[65] : 0.f;
#pragma unroll
                        for (int t = 0; t < 4; ++t) o[t][qb] = *(const LAS f32x4*)(sp + 16 * t + 4 * lg); }
                }
                typedef unsigned long long u64t; u64t kf[2][2], vf[4], kfn[2][2], vfn[4];
#define ATT_LOAD(c_, kd, vd) do { const int kb_ = iq0 - 64 + 32 * (c_); int ia_ = kb_ + 8 * (lr >> 2) + (lr & 3), ib_ = ia_ + 4; ia_ = ia_ < 0 ? 0 : (ia_ >= L ? L - 1 : ia_); ib_ = ib_ < 0 ? 0 : (ib_ >= L ? L - 1 : ib_); \
        const unsigned char* ka_ = Kh + (size_t)(dl * ia_ + r) * AW; const unsigned char* kb2_ = Kh + (size_t)(dl * ib_ + r) * AW; \
        kd[0][0] = *(const GAS u64t*)ka_; kd[0][1] = *(const GAS u64t*)(ka_ + 32); kd[1][0] = *(const GAS u64t*)kb2_; kd[1][1] = *(const GAS u64t*)(kb2_ + 32); \
        int vk_ = kb_ + 8 * lg; vk_ = vk_ < 0 ? 0 : (vk_ > L - 8 ? L - 8 : vk_); \
        _Pragma("unroll") for (int t_ = 0; t_ < 4; ++t_) vd[t_] = *(const GAS u64t*)(Vh + (size_t)(16 * t_) * MTOK + vk_); } while (0)
                ATT_LOAD(0, kf, vf);
#pragma unroll
                for (int c = 0; c < 5; ++c) {
                    if (c < 4) ATT_LOAD(c + 1, kfn, vfn);
                    const int kb = iq0 - 64 + 32 * c;
                    f32x4 s[2][2];
#pragma unroll
                    for (int tl = 0; tl < 2; ++tl) {
#pragma unroll
                        for (int qb = 0; qb < 2; ++qb) { s[tl][qb] = __builtin_amdgcn_mfma_f32_16x16x32_fp8_fp8((long)kf[tl][0], qf[qb][0], (f32x4){0.f, 0.f, 0.f, 0.f}, 0, 0, 0);
                            s[tl][qb] = __builtin_amdgcn_mfma_f32_16x16x32_fp8_fp8((long)kf[tl][1], qf[qb][1], s[tl][qb], 0, 0, 0); } }
                    long pf[2];
                    if (c == 0 || c == 4 || kb < 0 || kb + 32 > L) {
#pragma unroll
                        for (int qb = 0; qb < 2; ++qb) { const int iq = iq0 + 16 * qb + lr, lo = iq - 64 < 0 ? 0 : iq - 64, hi = iq + 64 > L - 1 ? L - 1 : iq + 64; const unsigned span = (unsigned)(hi - lo); const int k0 = kb + 8 * lg - lo;
#pragma unroll
                            for (int e = 0; e < 8; ++e) s[e >> 2][qb][e & 3] = (unsigned)(k0 + e) <= span ? s[e >> 2][qb][e & 3] : -__builtin_inff(); } }
#pragma unroll
                    for (int qb = 0; qb < 2; ++qb) { float sv[8]; float mx = -__builtin_inff();
#pragma unroll
                        for (int e = 0; e < 8; ++e) { sv[e] = s[e >> 2][qb][e & 3]; mx = fmaxf(mx, sv[e]); }
                        mx = fmaxf(mx, __int_as_float(__builtin_amdgcn_ds_bpermute(bp16, __float_as_int(mx)))); mx = fmaxf(mx, __int_as_float(__builtin_amdgcn_ds_bpermute(bp32, __float_as_int(mx))));
                        const float mn = fmaxf(m[qb], mx), al = __builtin_amdgcn_exp2f(m[qb] - mn); m[qb] = mn; float ps = 0.f; float p[8];
#pragma unroll
                        for (int e = 0; e < 8; ++e) { p[e] = __builtin_amdgcn_exp2f(sv[e] - mn); ps += p[e]; }
                        l[qb] = l[qb] * al + ps;
#pragma unroll
                        for (int t = 0; t < 4; ++t) o[t][qb] = o[t][qb] * al;
                        unsigned plo = (unsigned)__builtin_amdgcn_cvt_pk_fp8_f32(p[0], p[1], 0, false); plo = (unsigned)__builtin_amdgcn_cvt_pk_fp8_f32(p[2], p[3], (int)plo, true);
                        unsigned phi = (unsigned)__builtin_amdgcn_cvt_pk_fp8_f32(p[4], p[5], 0, false); phi = (unsigned)__builtin_amdgcn_cvt_pk_fp8_f32(p[6], p[7], (int)phi, true);
                        pf[qb] = (long)((unsigned long long)plo | ((unsigned long long)phi << 32)); }
#pragma unroll
                    for (int t = 0; t < 4; ++t) {
#pragma unroll
                        for (int qb = 0; qb < 2; ++qb) o[t][qb] = __builtin_amdgcn_mfma_f32_16x16x32_fp8_fp8((long)vf[t], pf[qb], o[t][qb], 0, 0, 0); }
#pragma unroll
                    for (int tl = 0; tl < 2; ++tl) { kf[tl][0] = kfn[tl][0]; kf[tl][1] = kfn[tl][1]; }
#pragma unroll
                    for (int t = 0; t < 4; ++t) vf[t] = vfn[t];
                }
#undef ATT_LOAD
#pragma unroll
                for (int qb = 0; qb < 2; ++qb) { float lt = l[qb]; lt += __int_as_float(__builtin_amdgcn_ds_bpermute(bp16, __float_as_int(lt))); lt += __int_as_float(__builtin_amdgcn_ds_bpermute(bp32, __float_as_int(lt)));
                    if (pass < 2) { LAS float* sp = st + prow[qb] * 68;
#pragma unroll
                        for (int t = 0; t < 4; ++t) *(LAS f32x4*)(sp + 16 * t + 4 * lg) = o[t][qb];
                        if (lg == 0) { sp[64] = m[qb]; sp[65] = lt; } }
                    else { const float il = 1.0f / lt; bf16* op = OA + ((size_t)(8 * j + (lg >> 1)) * MTOK + (size_t)(b * SEQ + P0 + prow[qb])) * 8 + 4 * (lg & 1);
#pragma unroll
                        for (int t = 0; t < 4; ++t) { const f32x4 x = o[t][qb] * il; *(GAS unsigned long long*)(op + (size_t)(2 * t) * MTOK * 8) = (unsigned long long)pg8::cvt_pk_bf16(x[0], x[1]) | ((unsigned long long)pg8::cvt_pk_bf16(x[2], x[3]) << 32); } } }
            }
            __syncthreads();
        }
    }
}

__device__ __forceinline__ void norm_router_phase(Frame& F, const bf16* x, const float* gain, unsigned char* out8, const float* rw, const float* rb, int* SEL, float* WTS, int* CNT) {
    LAS float* wr = (LAS float*)F.lds;
    LAS int* sel_l = (LAS int*)(F.lds + 32768);
    for (int i = F.tid; i < DM * NEXP; i += NWAVES * 64) { const int k = i >> 3, e = i & 7; wr[(((e >> 2) * 1024) + (k & 3) * 256 + (k >> 2)) * 4 + (e & 3)] = rw[i]; }
    __syncthreads();
    f32x4 gn[4];
#pragma unroll
    for (int j = 0; j < 4; ++j) gn[j] = ((const GAS f32x4*)gain)[F.lane + 64 * j];
    typedef unsigned long long u64r;
    u64r rw_[4];
    { const GAS u64r* xr = (const GAS u64r*)(x + (size_t)(F.vcu * 128 + F.wave * 16) * XP) + F.lane;
#pragma unroll
      for (int j = 0; j < 4; ++j) rw_[j] = xr[64 * j]; }
    const bool b0 = F.lane & 1, b1 = F.lane & 2, b2 = F.lane & 4;
#pragma unroll 1
    for (int i = 0; i < 16; ++i) { const int tl = F.wave * 16 + i, m = F.vcu * 128 + tl; f32x4 v[4]; float ssq = 0.f;
#pragma unroll
        for (int j = 0; j < 4; ++j) { const u64r w = rw_[j]; v[j].x = bflo((unsigned)w); v[j].y = bfhi((unsigned)w); v[j].z = bflo((unsigned)(w >> 32)); v[j].w = bfhi((unsigned)(w >> 32));
            ssq += (v[j].x * v[j].x + v[j].y * v[j].y) + (v[j].z * v[j].z + v[j].w * v[j].w); }
        if (i < 15) { const GAS u64r* xr = (const GAS u64r*)(x + (size_t)(m + 1) * XP) + F.lane;
#pragma unroll
            for (int j = 0; j < 4; ++j) rw_[j] = xr[64 * j]; }
        const float rstd = 1.0f / sqrtf(wave_sum(ssq, F.lane) * (1.0f / DM) + RMS_EPS);
#pragma unroll
        for (int j = 0; j < 4; ++j) v[j] = v[j] * rstd * gn[j];
        GAS unsigned* o4 = (GAS unsigned*)(out8 + (size_t)m * DM) + F.lane;
#pragma unroll
        for (int j = 0; j < 4; ++j) { unsigned w8 = pg8::pk_fp8(v[j].x, v[j].y, 0u, false); w8 = pg8::pk_fp8(v[j].z, v[j].w, w8, true); o4[64 * j] = w8; }
        float lg[8];
#pragma unroll
        for (int e = 0; e < 8; ++e) lg[e] = 0.f;
#pragma unroll
        for (int j = 0; j < 4; ++j)
#pragma unroll
            for (int cc = 0; cc < 4; ++cc) { const int sl = cc * 256 + F.lane + 64 * j; const f32x4 wa = *(const LAS f32x4*)(wr + sl * 4), wb = *(const LAS f32x4*)(wr + 4096 + sl * 4); const float xv = v[j][cc];
                lg[0] += xv * wa[0]; lg[1] += xv * wa[1]; lg[2] += xv * wa[2]; lg[3] += xv * wa[3]; lg[4] += xv * wb[0]; lg[5] += xv * wb[1]; lg[6] += xv * wb[2]; lg[7] += xv * wb[3]; }
#define XCH(v_, o_) __int_as_float(__builtin_amdgcn_ds_bpermute((F.lane ^ (o_)) << 2, __float_as_int(v_)))
        float ra[4], rb2[2], rc;
#pragma unroll
        for (int t = 0; t < 4; ++t) { const float send = b0 ? lg[t] : lg[t + 4], keep = b0 ? lg[t + 4] : lg[t]; ra[t] = keep + XCH(send, 1); }
#pragma unroll
        for (int t = 0; t < 2; ++t) { const float send = b1 ? ra[t] : ra[t + 2], keep = b1 ? ra[t + 2] : ra[t]; rb2[t] = keep + XCH(send, 2); }
        { const float send = b2 ? rb2[0] : rb2[1], keep = b2 ? rb2[1] : rb2[0]; rc = keep + XCH(send, 4); }
        rc += XCH(rc, 8); rc += XCH(rc, 16); rc += XCH(rc, 32);
#undef XCH
        lg[0] = __int_as_float(__builtin_amdgcn_readlane(__float_as_int(rc), 0)) + rb[0]; lg[1] = __int_as_float(__builtin_amdgcn_readlane(__float_as_int(rc), 4)) + rb[1];
        lg[2] = __int_as_float(__builtin_amdgcn_readlane(__float_as_int(rc), 2)) + rb[2]; lg[3] = __int_as_float(__builtin_amdgcn_readlane(__float_as_int(rc), 6)) + rb[3];
        lg[4] = __int_as_float(__builtin_amdgcn_readlane(__float_as_int(rc), 1)) + rb[4]; lg[5] = __int_as_float(__builtin_amdgcn_readlane(__float_as_int(rc), 5)) + rb[5];
        lg[6] = __int_as_float(__builtin_amdgcn_readlane(__float_as_int(rc), 3)) + rb[6]; lg[7] = __int_as_float(__builtin_amdgcn_readlane(__float_as_int(rc), 7)) + rb[7];
        int e0 = 0; float v0 = lg[0];
#pragma unroll
        for (int e = 1; e < 8; ++e) if (lg[e] > v0) { v0 = lg[e]; e0 = e; }
        int e1 = 0; float v1 = -__builtin_inff();
#pragma unroll
        for (int e = 0; e < 8; ++e) if (e != e0 && lg[e] > v1) { v1 = lg[e]; e1 = e; }
        const float w0 = 1.0f / (1.0f + expf(v1 - v0)), w1 = 1.0f - w0;
        if (F.lane == 0) { sel_l[tl] = e0 | (e1 << 8); WTS[2 * (size_t)m] = w0; WTS[2 * (size_t)m + 1] = w1; }
    }
    __syncthreads();
    if (F.tid < 128) { const int me = sel_l[F.tid], e0 = me & 255, e1 = me >> 8; int r0 = 0, r1 = 0;
        for (int t = 0; t < F.tid; ++t) { const int o = sel_l[t]; r0 += ((o & 255) == e0); r1 += ((o >> 8) == e1); }
        SEL[F.vcu * 128 + F.tid] = me | (r0 << 16) | (r1 << 24); }
    else if (F.tid < 144) { const int q = F.tid - 128, s = q >> 3, e = q & 7; int n = 0;
        for (int t = 0; t < 128; ++t) { const int o = sel_l[t]; n += ((s ? (o >> 8) : (o & 255)) == e); }
        CNT[F.vcu * 16 + q] = n; }
    __syncthreads();
}
__device__ __forceinline__ void route2_phase(Frame& F, const int* SEL, const float* WTS, const int* CNT, int* ROWTOK, float* ROWW, int* PLAN) {
    LAS int* call = (LAS int*)F.lds;
    LAS int* tot = call + 4096; LAS int* basew = tot + 16; LAS int* segst = basew + 16; LAS int* ntile = segst + 16;
    for (int i = F.tid; i < 4096; i += NWAVES * 64) call[i] = CNT[i];
    __syncthreads();
    if (F.tid < 16) { int t = 0, bsum = 0; for (int w = 0; w < 256; ++w) { const int c = call[w * 16 + F.tid]; t += c; bsum += (w < F.vcu) ? c : 0; } tot[F.tid] = t; basew[F.tid] = bsum; }
    __syncthreads();
    if (F.tid < 2) { int run = 0; for (int e = 0; e < 8; ++e) { segst[F.tid * 8 + e] = run; run += (tot[F.tid * 8 + e] + 255) & ~255; } ntile[F.tid] = run >> 8; }
    __syncthreads();
    if (F.tid < 128) { const int m = F.vcu * 128 + F.tid, sl = SEL[m], e0 = sl & 255, e1 = (sl >> 8) & 255, r0 = (sl >> 16) & 255, r1 = (sl >> 24) & 255;
        const int p0 = segst[e0] + basew[e0] + r0, p1 = segst[8 + e1] + basew[8 + e1] + r1;
        ROWTOK[p0] = m; ROWW[p0] = WTS[2 * (size_t)m]; ROWTOK[MOE_ROWS + p1] = m; ROWW[MOE_ROWS + p1] = WTS[2 * (size_t)m + 1]; }
    if (F.vcu < 8) {
        for (int s = 0; s < 2; ++s) { const int q = s * 8 + F.vcu, n = tot[q], np = (n + 255) & ~255;
            for (int p = n + F.tid; p < np; p += NWAVES * 64) { ROWTOK[s * MOE_ROWS + segst[q] + p] = -1; ROWW[s * MOE_ROWS + segst[q] + p] = 0.f; } } }
    if (F.vcu == 8) {
        if (F.tid < 2) PLAN[F.tid] = ntile[F.tid];
        if (F.tid < 2 * MOE_TILES) { const int s = F.tid / MOE_TILES, t = F.tid % MOE_TILES; int e = 0;
            for (int k = 1; k < 8; ++k) if ((segst[s * 8 + k] >> 8) <= t) e = k;
            PLAN[16 + MOE_TILES * s + t] = e; } }
    __syncthreads();
}
__device__ __forceinline__ void final_norm_phase(Frame& F, float* xio, const bf16* xb, const float* gain, const bf16* y) {
    const int gw = F.vcu * NWAVES + F.wave, NGW = F.G * NWAVES;
    f32x4 gn[4];
#pragma unroll
    for (int j = 0; j < 4; ++j) gn[j] = ((const GAS f32x4*)gain)[F.lane + 64 * j];
    for (int m = gw; m < MTOK; m += NGW) { f32x4 v[4]; float s = 0.f;
        const GAS unsigned long long* xr = (const GAS unsigned long long*)(xb + (size_t)m * XP) + F.lane;
        const GAS unsigned long long* y0 = (const GAS unsigned long long*)(y + (size_t)m * DM) + F.lane; const GAS unsigned long long* y1 = (const GAS unsigned long long*)(y + ((size_t)MTOK + m) * DM) + F.lane;
#pragma unroll
        for (int j = 0; j < 4; ++j) { const unsigned long long xw = xr[64 * j]; v[j].x = bflo((unsigned)xw); v[j].y = bfhi((unsigned)xw); v[j].z = bflo((unsigned)(xw >> 32)); v[j].w = bfhi((unsigned)(xw >> 32));
            const unsigned long long a0 = y0[64 * j], a1 = y1[64 * j];
            v[j].x += bflo((unsigned)a0) + bflo((unsigned)a1); v[j].y += bfhi((unsigned)a0) + bfhi((unsigned)a1);
            v[j].z += bflo((unsigned)(a0 >> 32)) + bflo((unsigned)(a1 >> 32)); v[j].w += bfhi((unsigned)(a0 >> 32)) + bfhi((unsigned)(a1 >> 32));
            s += (v[j].x * v[j].x + v[j].y * v[j].y) + (v[j].z * v[j].z + v[j].w * v[j].w); }
        const float rstd = 1.0f / sqrtf(wave_sum(s, F.lane) * (1.0f / DM) + RMS_EPS);
        GAS f32x4* o = (GAS f32x4*)(xio + (size_t)m * DM) + F.lane;
#pragma unroll
        for (int j = 0; j < 4; ++j) o[64 * j] = v[j] * rstd * gn[j]; }
}

struct MoeOrder { int nT0, nM, nN, nwg, G, c; unsigned lda, ldb; const int* tile_e; size_t estride; bool gather;
    __device__ bool next(int i, pg8::Unit& u) const {
        const long L = (long)i * G + c; if (L >= nwg) return false;
        int wgid = (int)L; { const int q = nwg / pg8::NXCD, r = nwg % pg8::NXCD, xcd = wgid % pg8::NXCD, off = wgid / pg8::NXCD; wgid = (xcd < r ? xcd * (q + 1) : r * (q + 1) + (xcd - r) * q) + off; }
        const int nig = pg8::WGM * nN, gid = wgid / nig, fm = gid * pg8::WGM, gsz = (nM - fm) < pg8::WGM ? (nM - fm) : pg8::WGM;
        const int lin = fm + ((wgid % nig) % gsz); u.pm = lin < nT0 ? lin : MOE_TILES + (lin - nT0); u.pn = (wgid % nig) / gsz; u.z = __builtin_amdgcn_readfirstlane(tile_e[u.pm]);
        u.aoff = gather ? (size_t)0 : (size_t)u.pm * 256 * lda; u.boff = (size_t)u.z * estride + (size_t)u.pn * 256 * ldb; return true; } };

template <class Epi, int BMAP = 0, int ALAY = 0> __device__ __forceinline__ void run_gemm(Frame& F, const void* A, unsigned lda, const void* B, unsigned ldb, int Mrows, int Ncols, int K, const Epi& E, int geff = 0) {
    int G_ = geff ? geff : F.G, c_ = (int)blockIdx.x; asm volatile("" : "+s"(G_), "+s"(c_));
    pg8::Gemm g{(const char*)A, (const char*)B, lda, ldb, K, nullptr}; pg8::PlainOrder S; S.init(Mrows, Ncols, G_, c_, lda, ldb, BMAP, ALAY);
    pg8::gemm_phase<Epi, pg8::PlainOrder, false, BMAP, ALAY>(F.lds, g, S, E);
}

__device__ __forceinline__ Args load_args() {
    Args r{};
#if defined(__HIP_DEVICE_COMPILE__)
    typedef const __attribute__((address_space(4))) Args CArgs;
    auto p = __builtin_amdgcn_kernarg_segment_ptr(); asm volatile("" : "+s"(p)); CArgs* q = (CArgs*)p;
#pragma unroll
    for (int i = 0; i < 16; ++i) r.in[i] = q->in[i];
    r.out = q->out; r.ws = q->ws; r.G = q->G;
#endif
    return r;
}
__device__ __forceinline__ Frame make_frame(LAS unsigned char* lds, unsigned char* ws, int G) {
    Frame F; int t = threadIdx.x, g = G, bx = blockIdx.x; asm volatile("" : "+v"(t), "+s"(g), "+s"(bx));
    F.lds = lds; F.MISC = (volatile LAS unsigned*)(lds + MISC_OFF); F.ctl = (gu32*)(ws + WS_CTL);
    F.tid = t; F.lane = t & 63; F.wave = __builtin_amdgcn_readfirstlane(t >> 6); F.G = g; F.vcu = (g % 8 == 0) ? (bx % 8) * (g / 8) + bx / 8 : bx; return F; }
#define PH_BEGIN const Args a = load_args(); unsigned char* const ws = a.ws; float* const xout = a.out; bf16* const xsA = (bf16*)a.out; bf16* const xsB = xsA + DM; Frame F = make_frame((LAS unsigned char*)lds, ws, a.G); (void)xout; (void)xsA; (void)xsB
__global__ void __launch_bounds__(NWAVES * 64, 2) fwd_kernel(Args args) {
    extern __shared__ __attribute__((aligned(16))) unsigned char lds[];
    for (int u = threadIdx.x; u < (LDS_BYTES - LDSCTL_OFF) / 4; u += NWAVES * 64) ((LAS unsigned*)((LAS unsigned char*)lds + LDSCTL_OFF))[u] = 0u;
    __syncthreads();
    XcdBarrier bar = xcd_barrier_post((unsigned*)(args.ws + WS_CTL) + CW_BAR, (volatile LAS unsigned*)((LAS unsigned char*)lds + MISC_OFF) + 8);
    bar.G = (unsigned)args.G;
#define GRID_BAR() do { XcdBarrier b2_ = bar; asm volatile("" : "+s"(b2_.bar), "+s"(b2_.x), "+s"(b2_.G)); xcd_barrier(b2_); } while (0)

    { PH_BEGIN; p0_weights(F, a); __syncthreads(); p0_tables(F, a); prep_x_phase(F, a.in[0], xsA, (float*)(ws + WS_SS), ws + WS_X8); }
    GRID_BAR();

    for (int layer = 0; layer < 2; ++layer) {
        asm volatile("" : "+s"(layer));
        { PH_BEGIN; int lyr = layer; asm volatile("" : "+s"(lyr)); const bf16* WinT = (const bf16*)(ws + WS_WIN + lyr * WIN_L);
          pg8::EpiInproj E{ws, WS_V, WS_Q, WS_K, WS_GF, WS_GA, WS_ROPE, QSCALE, (const float*)(ws + WS_SS) + (size_t)(2 * lyr) * SS_STRIDE, 1.0f / WG_SCALE};
          int G_ = F.G, c_ = (int)blockIdx.x; asm volatile("" : "+s"(G_), "+s"(c_));
          pg8::Gemm g{(const char*)(ws + WS_X8), (const char*)(ws + WS_WQK8 + (size_t)lyr * 1536 * DM), DM, DM, DM / 2, nullptr}; pg8::PlainOrder S; S.init(MTOK, 1536, G_, c_, DM, DM, 0, 0);
          pg8::gemm_phase<pg8::EpiInproj, pg8::PlainOrder, false, 0, 0, true>(F.lds, g, S, E); }
        { PH_BEGIN; int lyr = layer; asm volatile("" : "+s"(lyr)); const bf16* WinT = (const bf16*)(ws + WS_WIN + lyr * WIN_L);
          int bx_ = (int)blockIdx.x; asm volatile("" : "+s"(bx_));
          if (bx_ < 128) { pg8::EpiBf16 E{(bf16*)(ws + WS_UT), MTOK, (bf16*)(ws + WS_V), 2, (const float*)(ws + WS_SS) + (size_t)(2 * lyr) * SS_STRIDE, 1.0f};
            run_gemm<pg8::EpiBf16, 2, 0>(F, WinT, DM * 2, xsA, XP * 2, 512, MTOK, DM, E, 128); }
          else { pg8::EpiBf16 E{(bf16*)(ws + WS_UT), MTOK, (bf16*)(ws + WS_V), 2, (const float*)(ws + WS_SS) + (size_t)(2 * lyr) * SS_STRIDE, 1.0f / WG_SCALE};
            int G_ = 128, c_ = bx_ - 128; asm volatile("" : "+s"(G_), "+s"(c_));
            pg8::Gemm g{(const char*)(ws + WS_WV8 + (size_t)lyr * 768 * DM), (const char*)(ws + WS_X8), DM, DM, DM / 2, nullptr}; pg8::PlainOrder S; S.init(768, MTOK, G_, c_, DM, DM, 2, 0); S.pmoff = 2;
            pg8::gemm_phase<pg8::EpiBf16, pg8::PlainOrder, false, 2, 0, true>(F.lds, g, S, E); } }
        GRID_BAR();
        { PH_BEGIN; fft_phase(F, (const bf16*)(ws + WS_UT), (bf16*)(ws + WS_Z)); }
        { PH_BEGIN; attn_mfma_phase(F, ws + WS_Q, ws + WS_K, ws + WS_V, (bf16*)(ws + WS_OATT)); }
        { PH_BEGIN; int lyr = layer; asm volatile("" : "+s"(lyr)); int G_ = F.G, c_ = (int)blockIdx.x; asm volatile("" : "+s"(G_), "+s"(c_));
          pg8::Gemm g{(const char*)(ws + WS_X8), (const char*)(ws + WS_WG8 + (size_t)lyr * 2048 * DM), DM, DM, DM / 2, nullptr}; pg8::PlainOrder S; S.init(MTOK, 2048, G_, c_, DM, DM, 0, 0);
          pg8::EpiGates8 E{ws, WS_GF, WS_GA, (const float*)(ws + WS_SS) + (size_t)(2 * lyr) * SS_STRIDE}; pg8::gemm_phase<pg8::EpiGates8, pg8::PlainOrder, false, 0, 0, true>(F.lds, g, S, E); }
        GRID_BAR();
        { PH_BEGIN; int lyr = layer; asm volatile("" : "+s"(lyr)); pg8::EpiMix E{ws + WS_GF, ws + WS_GA, (bf16*)(ws + WS_MIX)};
          run_gemm<pg8::EpiMix, 0, 1>(F, ws + WS_OATT, MTOK * 16, (const bf16*)(ws + WS_WM) + (size_t)lyr * DM * KMIX, KMIX * 2, MTOK, DM, KMIX, E); }
        GRID_BAR();
        if (layer == 0) { PH_BEGIN; pg8::EpiResid<true> E{xsA, xsB, XP, (float*)(ws + WS_SS) + SS_STRIDE, nullptr};
          run_gemm(F, ws + WS_MIX, DM * 2, ws + WS_WOUT, DM * 2, MTOK, DM, DM, E); }
        else { PH_BEGIN; pg8::EpiResid<false> E{xsA, xsB, XP, nullptr, nullptr};
          run_gemm(F, ws + WS_MIX, DM * 2, (const bf16*)(ws + WS_WOUT) + (size_t)DM * DM, DM * 2, MTOK, DM, DM, E); }
        GRID_BAR();
        if (layer == 0) {
            { PH_BEGIN; int lyr = layer; asm volatile("" : "+s"(lyr)); pg8::EpiSwiglu E{(bf16*)(ws + WS_TT), FF, (const float*)(ws + WS_SS) + SS_STRIDE}; run_gemm(F, xsB, XP * 2, ws + WS_W13, DM * 2, MTOK, 2 * FF, DM, E); }
            GRID_BAR();
            { PH_BEGIN; int lyr = layer; asm volatile("" : "+s"(lyr)); pg8::EpiResid<true> E{xsB, xsA, XP, (float*)(ws + WS_SS) + 2 * SS_STRIDE, ws + WS_X8}; run_gemm(F, ws + WS_TT, FF * 2, ws + WS_W2, FF * 2, MTOK, DM, FF, E); }
            GRID_BAR();
        } else {
            { PH_BEGIN; int lyr = layer; asm volatile("" : "+s"(lyr)); p0_moe_weights(F, a, 2 * CONV_PHASE_ITEMS, MOE_NITEMS, F.vcu * NWAVES + F.wave, F.G * NWAVES); __syncthreads();
              norm_router_phase(F, xsB, a.in[6] + DM, ws + WS_H2B, a.in[10], a.in[11], (int*)(ws + WS_SEL), (float*)(ws + WS_WTS), (int*)(ws + WS_CNT)); }
            GRID_BAR();
            { PH_BEGIN; int lyr = layer; asm volatile("" : "+s"(lyr)); route2_phase(F, (const int*)(ws + WS_SEL), (const float*)(ws + WS_WTS), (const int*)(ws + WS_CNT), (int*)(ws + WS_ROWTOK), (float*)(ws + WS_ROWW), (int*)(ws + WS_PLAN)); }
            GRID_BAR();
            { PH_BEGIN; int G_ = F.G, c_ = (int)blockIdx.x; asm volatile("" : "+s"(G_), "+s"(c_));
              const int* plan = (const int*)(ws + WS_PLAN); const int nT0 = __builtin_amdgcn_readfirstlane(plan[0]), nT1 = __builtin_amdgcn_readfirstlane(plan[1]);
              pg8::Gemm g{(const char*)(ws + WS_H2B), (const char*)(ws + WS_M13), DM, DM, DM / 2, (const int*)(ws + WS_ROWTOK)};
              MoeOrder S{nT0, nT0 + nT1, 2 * FF / 256, (nT0 + nT1) * (2 * FF / 256), G_, c_, DM, DM, plan + 16, (size_t)2 * FF * DM, true};
              pg8::EpiSwigluF8 E{ws + WS_TTB, FF, 1.0f / W13_SCALE}; pg8::gemm_phase<pg8::EpiSwigluF8, MoeOrder, true, 0, 0, true>(F.lds, g, S, E); }
            GRID_BAR();
            { PH_BEGIN; int G_ = F.G, c_ = (int)blockIdx.x; asm volatile("" : "+s"(G_), "+s"(c_));
              const int* plan = (const int*)(ws + WS_PLAN); const int nT0 = __builtin_amdgcn_readfirstlane(plan[0]), nT1 = __builtin_amdgcn_readfirstlane(plan[1]);
              pg8::Gemm g{(const char*)(ws + WS_TTB), (const char*)(ws + WS_M2), FF, FF, FF / 2, nullptr};
              MoeOrder S{nT0, nT0 + nT1, DM / 256, (nT0 + nT1) * (DM / 256), G_, c_, FF, FF, plan + 16, (size_t)DM * FF, false};
              pg8::EpiScatterY E{(bf16*)(ws + WS_Y), (const int*)(ws + WS_ROWTOK), (const float*)(ws + WS_ROWW), 1.0f / W2_SCALE, MOE_ROWS, (size_t)MTOK * DM};
              pg8::gemm_phase<pg8::EpiScatterY, MoeOrder, false, 0, 0, true>(F.lds, g, S, E); }
            GRID_BAR();
        }
    }
    { PH_BEGIN; final_norm_phase(F, xout, xsB, a.in[15], (const bf16*)(ws + WS_Y)); }
#undef GRID_BAR
}

extern "C" void kernel_launch(void* const* d_in, const int* in_sizes, int n_in, void* d_out, int out_size, void* d_ws, size_t ws_size, hipStream_t stream) {
    static int grid = 0;
    if (grid == 0) {
        if (n_in != 16 || out_size != MTOK * DM || ws_size < WS_END) { fprintf(stderr, "kernel_launch: unexpected problem (n_in %d, out %d, ws %zu); nothing launched\n", n_in, out_size, ws_size); grid = -1; return; }
        int dev = 0, cus = 0;
        if (hipGetDevice(&dev) != hipSuccess || hipDeviceGetAttribute(&cus, hipDeviceAttributeMultiprocessorCount, dev) != hipSuccess) { grid = -1; return; }
        if (hipFuncSetAttribute((const void*)fwd_kernel, hipFuncAttributeMaxDynamicSharedMemorySize, LDS_BYTES) != hipSuccess) { fprintf(stderr, "kernel_launch: hipFuncSetAttribute failed\n"); grid = -1; return; }
        int per_cu = 0;
        if (hipOccupancyMaxActiveBlocksPerMultiprocessor(&per_cu, (const void*)fwd_kernel, NWAVES * 64, LDS_BYTES) != hipSuccess || per_cu < 1) fprintf(stderr, "kernel_launch: occupancy query reports %d\n", per_cu);
        (void)hipGetLastError();
        if (cus != 256) { fprintf(stderr, "kernel_launch: %d CUs; the router / attention unit maps assume a grid of 256\n", cus); grid = -1; return; }
        grid = cus;
    }
    if (grid < 0) return;
    (void)hipMemsetAsync((char*)d_ws + WS_CTL, 0, CTL_ZERO_BYTES, stream);
    Args a{};
    for (int i = 0; i < 16; ++i) a.in[i] = (const float*)d_in[i];
    a.out = (float*)d_out; a.ws = (unsigned char*)d_ws; a.G = grid; a.pad = 0;
    hipLaunchKernelGGL(fwd_kernel, dim3(grid), dim3(NWAVES * 64), LDS_BYTES, stream, a);
}
```

```cpp
#include <hip/hip_runtime.h>
#include <cstdio>
#include <cstdint>

namespace pg8 {
#define PG8_LAS __attribute__((address_space(3)))
typedef unsigned short bf16_t;
typedef short bf16x8 __attribute__((ext_vector_type(8)));
typedef float f32x4 __attribute__((ext_vector_type(4)));
typedef unsigned u32x4 __attribute__((ext_vector_type(4)));
typedef unsigned u32x2 __attribute__((ext_vector_type(2)));
typedef int v4i_t __attribute__((ext_vector_type(4)));
typedef int v8i_t __attribute__((ext_vector_type(8)));
constexpr int BM = 256, BK = 64, HALF = 128, HTB = HALF * BK * 2  , STAGE_BYTES = 8 * HTB, NXCD = 8, WGM = 4;

__host__ __device__ __forceinline__ int lds_byte(int r, int c) { const int st = (r >> 4) * 2 + (c >> 5), rr = r & 15, cc = c & 31, ob = rr * 64 + cc * 2; return st * 1024 + (ob ^ (((ob >> 9) & 1) << 5)); }
__host__ __device__ __forceinline__ void stage_rc(int b, int& R, int& C) { const int st = b / 1024, sb = b % 1024, swz = sb ^ (((sb >> 9) & 1) << 5); R = (st >> 1) * 16 + swz / 64; C = (st & 1) * 32 + (swz % 64) / 2; }
__host__ __device__ __forceinline__ int perm32(int rho) { const int n = rho >> 4, i = rho & 15; return 8 * (i >> 2) + 4 * n + (i & 3); }

struct Unit { int pm, pn, z; size_t aoff, boff; };
struct Gemm { const char* A; const char* B; unsigned lda, ldb; int K; const int* rows; };

struct PlainOrder {
    int nM, nN, nwg, G, c; unsigned lda, ldb; int bmap, alay, pmoff = 0;
    __device__ void init(int M, int N, int G_, int c_, unsigned lda_, unsigned ldb_, int bmap_ = 0, int alay_ = 0) { nM = M / BM; nN = N / BM; nwg = nM * nN; G = G_; c = c_; lda = lda_; ldb = ldb_; bmap = bmap_; alay = alay_; }
    __device__ bool next(int i, Unit& u) const {
        const long L = (long)i * G + c; if (L >= nwg) return false;
        int wgid = (int)L; { const int q = nwg / NXCD, r = nwg % NXCD, xcd = wgid % NXCD, off = wgid / NXCD; wgid = (xcd < r ? xcd * (q + 1) : r * (q + 1) + (xcd - r) * q) + off; }
        const int nig = WGM * nN, gid = wgid / nig, fm = gid * WGM, gsz = (nM - fm) < WGM ? (nM - fm) : WGM;
        u.pm = fm + ((wgid % nig) % gsz); u.pn = (wgid % nig) / gsz; u.z = 0;
        u.aoff = alay ? (size_t)u.pm * BM * 16 : (size_t)u.pm * BM * lda; u.pm += pmoff;
        if (bmap == 0) u.boff = (size_t)u.pn * BM * ldb;
        else { const int kind = bmap == 1 ? 1 : (u.pm < 2 ? 1 : (u.pm == 2 ? 0 : u.pm - 1)), bb = u.pn >> 4, t = u.pn & 15; u.z = kind;
            const int base = kind == 0 ? 256 * t : (kind == 1 ? 4 * t : (kind == 2 ? 1024 * (t & 3) + (t >> 2) : t));
            u.boff = (size_t)(bb * 4096 + base) * ldb; }
        return true;
    }
};

typedef float f32x2v_t __attribute__((ext_vector_type(2))); typedef __bf16 bf16x2v_t __attribute__((ext_vector_type(2)));
__device__ __forceinline__ unsigned cvt_pk_bf16(float lo, float hi) { const f32x2v_t v = {lo, hi}; return __builtin_bit_cast(unsigned, __builtin_convertvector(v, bf16x2v_t)); }
__device__ __forceinline__ float bf_lo(unsigned w) { return __uint_as_float(w << 16); }
__device__ __forceinline__ float bf_hi(unsigned w) { return __uint_as_float(w & 0xffff0000u); }
__device__ __forceinline__ f32x4 bf4_lo(const u32x4& w) { return (f32x4){bf_lo(w.x), bf_hi(w.x), bf_lo(w.y), bf_hi(w.y)}; }
__device__ __forceinline__ f32x4 bf4_hi(const u32x4& w) { return (f32x4){bf_lo(w.z), bf_hi(w.z), bf_lo(w.w), bf_hi(w.w)}; }
__device__ __forceinline__ unsigned pk_u8x4(const f32x4& g) { const f32x4 t = g * 255.0f; unsigned w = __builtin_amdgcn_cvt_pk_u8_f32(t[0], 0, 0u); w = __builtin_amdgcn_cvt_pk_u8_f32(t[1], 1, w); w = __builtin_amdgcn_cvt_pk_u8_f32(t[2], 2, w); return __builtin_amdgcn_cvt_pk_u8_f32(t[3], 3, w); }
__device__ __forceinline__ f32x4 u8x4_f(unsigned w) { return (f32x4){(float)(w & 0xffu), (float)((w >> 8) & 0xffu), (float)((w >> 16) & 0xffu), (float)(w >> 24)}; }
__device__ __forceinline__ float fast_sigmoid(float x) { return __builtin_amdgcn_rcpf(1.0f + __builtin_amdgcn_exp2f(-1.4426950408889634f * x)); }
__device__ __forceinline__ u32x4 pack8(const f32x4& v0, const f32x4& v1) { u32x4 w; w.x = cvt_pk_bf16(v0[0], v0[1]); w.y = cvt_pk_bf16(v0[2], v0[3]); w.z = cvt_pk_bf16(v1[0], v1[1]); w.w = cvt_pk_bf16(v1[2], v1[3]); return w; }

__device__ __forceinline__ float rstd_of(const float* ss, int row) { const f32x4 p = *(const f32x4*)(ss + (size_t)row * 4); return __builtin_amdgcn_rsqf(((p[0] + p[1]) + (p[2] + p[3])) * (1.0f / 1024.0f) + 1e-6f); }
__device__ __forceinline__ unsigned pk_fp8(float a, float b, unsigned old, bool hi) { a = __builtin_fminf(__builtin_fmaxf(a, -448.f), 448.f); b = __builtin_fminf(__builtin_fmaxf(b, -448.f), 448.f);
    return hi ? (unsigned)__builtin_amdgcn_cvt_pk_fp8_f32(a, b, (int)old, true) : (unsigned)__builtin_amdgcn_cvt_pk_fp8_f32(a, b, (int)old, false); }

struct EpiBf16 {
    static constexpr bool PERM = true;
    bf16_t* O; int ldc; bf16_t* O2; int split; const float* ss; float ascale;
    __device__ __forceinline__ void operator()(const f32x4 (&acc)[2][2][4][2], const Unit& u, int wr, int wc, int fr, int fq) const {
        bf16_t* const O = u.pm >= split ? O2 : this->O;
        const int row0 = (u.pm >= split ? u.pm - split : u.pm) * BM + wr * 64 + fr, col0 = u.pn * BM + wc * 32 + 8 * fq;
        f32x4 cs[2][2]; const int kind = u.z, bb = u.pn >> 4;
#pragma unroll
        for (int bj = 0; bj < 2; ++bj)
#pragma unroll
            for (int e = 0; e < 8; ++e) { const int v = (col0 & 4095) + bj * HALF + e;
                const int pos = kind == 0 ? v : (kind == 1 ? 64 * (v & 63) + (v >> 6) : (kind == 2 ? 4 * (v & 1023) + (v >> 10) : 16 * (v & 255) + (v >> 8)));
                cs[bj][e >> 2][e & 3] = rstd_of(ss, bb * 4096 + pos) * ascale; }
#pragma unroll
        for (int ai = 0; ai < 2; ++ai)
#pragma unroll
            for (int m = 0; m < 4; ++m) { const size_t eo = (size_t)(row0 + ai * HALF + m * 16) * ldc + col0;
#pragma unroll
                for (int bj = 0; bj < 2; ++bj) { const f32x4 v0 = acc[ai][bj][m][0] * cs[bj][0], v1 = acc[ai][bj][m][1] * cs[bj][1];
                    if (u.pm >= split) { u32x2 w8; w8.x = pk_fp8(v0[0], v0[1], 0u, false); w8.x = pk_fp8(v0[2], v0[3], w8.x, true); w8.y = pk_fp8(v1[0], v1[1], 0u, false); w8.y = pk_fp8(v1[2], v1[3], w8.y, true);
                        *(u32x2*)((unsigned char*)O + eo + bj * HALF) = w8; }
                    else *(u32x4*)(O + eo + bj * HALF) = pack8(v0, v1); } }
    }
};
struct EpiInproj {
    static constexpr bool PERM = true;
    unsigned char* ws; size_t oV, oQ, oK, oGF, oGA, oRope; float qscale; const float* ss; float ascale;
    __device__ __forceinline__ void operator()(const f32x4 (&acc)[2][2][4][2], const Unit& u, int wr, int wc, int fr, int fq) const {
        const int row0 = u.pm * BM + wr * 64 + fr, pn = u.pn;
        {
            const bool isq = pn < 3; bf16_t* base = (bf16_t*)(ws + (isq ? oQ : oK)); const float* rope = (const float*)(ws + oRope); const int colt = (isq ? pn : pn - 3) * 256; const float sc = isq ? qscale : 1.0f;
            const int col0 = colt + wc * 32 + 8 * fq, i0 = 16 * (wc & 1) + 4 * fq;
#pragma unroll
            for (int ai = 0; ai < 2; ++ai)
#pragma unroll
                for (int m = 0; m < 4; ++m) { const int row = row0 + ai * HALF + m * 16, pos = row & 4095;
                    const f32x4 cs0 = *(const f32x4*)(rope + (size_t)(pos * 32 + i0) * 2), cs1 = *(const f32x4*)(rope + (size_t)(pos * 32 + i0) * 2 + 4);
                    bf16_t* rowp = base + (size_t)row * 768 + col0; const float rs = rstd_of(ss, row) * ascale;
#pragma unroll
                    for (int bj = 0; bj < 2; ++bj) { const f32x4 v0 = acc[ai][bj][m][0] * rs, v1 = acc[ai][bj][m][1] * rs; f32x4 o0, o1;
                        o0[0] = (v0[0] * cs0[0] - v0[1] * cs0[1]) * sc; o0[1] = (v0[1] * cs0[0] + v0[0] * cs0[1]) * sc;
                        o0[2] = (v0[2] * cs0[2] - v0[3] * cs0[3]) * sc; o0[3] = (v0[3] * cs0[2] + v0[2] * cs0[3]) * sc;
                        o1[0] = (v1[0] * cs1[0] - v1[1] * cs1[1]) * sc; o1[1] = (v1[1] * cs1[0] + v1[0] * cs1[1]) * sc;
                        o1[2] = (v1[2] * cs1[2] - v1[3] * cs1[3]) * sc; o1[3] = (v1[3] * cs1[2] + v1[2] * cs1[3]) * sc;
                        { u32x2 w8; w8.x = pk_fp8(o0[0], o0[1], 0u, false); w8.x = pk_fp8(o0[2], o0[3], w8.x, true); w8.y = pk_fp8(o1[0], o1[1], 0u, false); w8.y = pk_fp8(o1[2], o1[3], w8.y, true);
                               *(u32x2*)((unsigned char*)base + (size_t)row * 768 + col0 + bj * HALF) = w8; } }
                    if (m == 3) asm volatile("" ::: "memory"); }
        }
    }
};
constexpr float WG8_SCALE = 32.0f;
struct EpiGates8 {
    static constexpr bool PERM = true;
    unsigned char* ws; size_t oGF, oGA; const float* ss;
    __device__ __forceinline__ void operator()(const f32x4 (&acc)[2][2][4][2], const Unit& u, int wr, int wc, int fr, int fq) const {
        const int row0 = u.pm * BM + wr * 64 + fr;
        {
            unsigned char* const gfp = ws + oGF; unsigned char* const gap = ws + oGA; const int col0 = u.pn * 128 + wc * 32 + 8 * fq;
#pragma unroll
            for (int ai = 0; ai < 2; ++ai)
#pragma unroll
                for (int m = 0; m < 4; ++m) { const size_t off = (size_t)(row0 + ai * HALF + m * 16) * 1024 + col0; const float rs = (-1.4426950408889634f / WG8_SCALE) * rstd_of(ss, row0 + ai * HALF + m * 16);
                    f32x4 g[2], ga[2];
#pragma unroll
                    for (int n = 0; n < 2; ++n) { const f32x4 xf = acc[ai][0][m][n] * rs, xa = acc[ai][1][m][n] * rs; f32x4 ef, ea, ia;
#pragma unroll
                        for (int j = 0; j < 4; ++j) { ef[j] = __builtin_fminf(__builtin_amdgcn_exp2f(xf[j]), 1.0e18f); ea[j] = __builtin_amdgcn_exp2f(xa[j]); }
                        ef = ef + 1.0f; ea = ea + 1.0f;
#pragma unroll
                        for (int j = 0; j < 4; ++j) { g[n][j] = __builtin_amdgcn_rcpf(ef[j]); ia[j] = __builtin_amdgcn_rcpf(ea[j]); }
                        ga[n] = ia; }
                    u32x2 wf, wa; wf.x = pk_u8x4(g[0]); wf.y = pk_u8x4(g[1]); wa.x = pk_u8x4(ga[0]); wa.y = pk_u8x4(ga[1]);
                    *(u32x2*)(gfp + off) = wf; *(u32x2*)(gap + off) = wa; }
        }
    }
};
struct EpiMix {
    static constexpr bool PERM = true; static constexpr int RESCALE_T = 4;
    const unsigned char* G; const unsigned char* R; bf16_t* O;
    __device__ __forceinline__ void rescale(f32x4 (&acc)[2][2][4][2], const Unit& u, int wr, int wc, int fr, int fq) const {
        asm volatile("" : "+v"(fr), "+v"(fq));
        const int row0 = u.pm * BM + wr * 64 + fr, col0 = u.pn * BM + wc * 32 + 8 * fq;
#pragma unroll
        for (int ai = 0; ai < 2; ++ai)
#pragma unroll
            for (int m = 0; m < 4; ++m) { const unsigned off = (unsigned)(row0 + ai * HALF + m * 16) * 1024u + (unsigned)col0;
#pragma unroll
                for (int bj = 0; bj < 2; ++bj) { const u32x2 ga = *(const u32x2*)(R + off + bj * HALF), gf = *(const u32x2*)(G + off + bj * HALF);
#pragma unroll
                    for (int n = 0; n < 2; ++n) { const f32x4 a4 = u8x4_f(n ? ga.y : ga.x); f32x4 f4 = u8x4_f(n ? gf.y : gf.x), q4;
#pragma unroll
                        for (int j = 0; j < 4; ++j) q4[j] = __builtin_amdgcn_rcpf(__builtin_fmaxf(f4[j], 0.25f));
                        acc[ai][bj][m][n] = acc[ai][bj][m][n] * (a4 * q4); } }
                if (m == 3) asm volatile("" ::: "memory"); }
    }
    __device__ __forceinline__ void operator()(const f32x4 (&acc)[2][2][4][2], const Unit& u, int wr, int wc, int fr, int fq) const {
        const int row0 = u.pm * BM + wr * 64 + fr, col0 = u.pn * BM + wc * 32 + 8 * fq;
#pragma unroll
        for (int ai = 0; ai < 2; ++ai) { u32x2 gq[4][2];
#pragma unroll
            for (int m = 0; m < 4; ++m)
#pragma unroll
                for (int bj = 0; bj < 2; ++bj) gq[m][bj] = *(const u32x2*)(G + (unsigned)(row0 + ai * HALF + m * 16) * 1024u + (unsigned)col0 + bj * HALF);
#pragma unroll
            for (int m = 0; m < 4; ++m) { const unsigned off = (unsigned)(row0 + ai * HALF + m * 16) * 1024u + (unsigned)col0;
#pragma unroll
                for (int bj = 0; bj < 2; ++bj) { f32x4 f0 = u8x4_f(gq[m][bj].x), f1 = u8x4_f(gq[m][bj].y);
#pragma unroll
                    for (int j = 0; j < 4; ++j) { f0[j] = __builtin_fmaxf(f0[j], 0.25f); f1[j] = __builtin_fmaxf(f1[j], 0.25f); }
                    const f32x4 v0 = acc[ai][bj][m][0] * (f0 * (1.0f / 255.0f)), v1 = acc[ai][bj][m][1] * (f1 * (1.0f / 255.0f));
                    *(u32x4*)(O + off + bj * HALF) = pack8(v0, v1); } }
            asm volatile("" ::: "memory"); }
    }
};
template <class E, class = void> struct rescale_at { static constexpr int t = -1; };
template <class E> struct rescale_at<E, decltype((void)E::RESCALE_T)> { static constexpr int t = E::RESCALE_T; };
template <bool SS> struct EpiResid {
    static constexpr bool PERM = true;
    const bf16_t* res; bf16_t* out; int ld; float* ssout; unsigned char* x8; float ascale;
    __device__ __forceinline__ void operator()(const f32x4 (&acc)[2][2][4][2], const Unit& u, int wr, int wc, int fr, int fq) const {
        const int row0 = u.pm * BM + wr * 64 + fr, col0 = u.pn * BM + wc * 32 + 8 * fq, lane = fq * 16 + fr;
        PG8_LAS float* const part = (PG8_LAS float*)(unsigned)131072;
#pragma unroll
        for (int ai = 0; ai < 2; ++ai) { u32x4 rq[4][2];
#pragma unroll
            for (int m = 0; m < 4; ++m)
#pragma unroll
                for (int bj = 0; bj < 2; ++bj) rq[m][bj] = *(const u32x4*)(res + (size_t)(row0 + ai * HALF + m * 16) * ld + col0 + bj * HALF);
#pragma unroll
            for (int m = 0; m < 4; ++m) { const int row = row0 + ai * HALF + m * 16; const size_t off = (size_t)row * ld + col0; float sq = 0.f;
#pragma unroll
                for (int bj = 0; bj < 2; ++bj) { const u32x4 r = rq[m][bj]; const f32x4 v0 = acc[ai][bj][m][0] * ascale + bf4_lo(r), v1 = acc[ai][bj][m][1] * ascale + bf4_hi(r);
                    if (SS) { const f32x4 q = v0 * v0 + v1 * v1; sq += (q[0] + q[1]) + (q[2] + q[3]); }
                    *(u32x4*)(out + off + bj * HALF) = pack8(v0, v1);
                    if (x8) { u32x2 w8; w8.x = pk_fp8(v0[0], v0[1], 0u, false); w8.x = pk_fp8(v0[2], v0[3], w8.x, true); w8.y = pk_fp8(v1[0], v1[1], 0u, false); w8.y = pk_fp8(v1[2], v1[3], w8.y, true);
                        *(u32x2*)(x8 + (size_t)row * 1024 + col0 + bj * HALF) = w8; } }
                if (SS) { sq += __int_as_float(__builtin_amdgcn_ds_bpermute((lane ^ 16) << 2, __float_as_int(sq))); sq += __int_as_float(__builtin_amdgcn_ds_bpermute((lane ^ 32) << 2, __float_as_int(sq)));
                    if (fq == 0) part[wc * 256 + wr * 64 + fr + ai * HALF + m * 16] = sq; } }
            asm volatile("" ::: "memory"); }
        if (SS) {
            asm volatile("s_waitcnt lgkmcnt(0)" ::: "memory"); __builtin_amdgcn_s_barrier(); asm volatile("" ::: "memory");
            const int t = (wr * 4 + wc) * 64 + lane;
            if (t < 256) ssout[(size_t)(u.pm * BM + t) * 4 + u.pn] = (part[t] + part[256 + t]) + (part[512 + t] + part[768 + t]);
            asm volatile("s_waitcnt lgkmcnt(0)" ::: "memory"); __builtin_amdgcn_s_barrier(); asm volatile("" ::: "memory");
        }
    }
};
struct EpiSwiglu {
    static constexpr bool PERM = true;
    unsigned char* T; int ldc; const float* ss;
    __device__ __forceinline__ void operator()(const f32x4 (&acc)[2][2][4][2], const Unit& u, int wr, int wc, int fr, int fq) const {
        const int row0 = u.pm * BM + wr * 64 + fr, col0 = u.pn * 128 + wc * 32 + 8 * fq;
#pragma unroll
        for (int ai = 0; ai < 2; ++ai)
#pragma unroll
            for (int m = 0; m < 4; ++m) { const int r = row0 + ai * HALF + m * 16; const float rs = rstd_of(ss, r), rs2 = rs * rs, rse = -1.4426950408889634f * rs; f32x4 o[2];
#pragma unroll
                for (int n = 0; n < 2; ++n) { const f32x4 x = acc[ai][0][m][n] * rse; f32x4 e, q;
#pragma unroll
                    for (int j = 0; j < 4; ++j) e[j] = __builtin_amdgcn_exp2f(x[j]);
                    e = e + 1.0f;
#pragma unroll
                    for (int j = 0; j < 4; ++j) q[j] = __builtin_amdgcn_rcpf(e[j]);
                    o[n] = (acc[ai][0][m][n] * acc[ai][1][m][n]) * (q * rs2); }
                u32x2 w; w.x = pk_fp8(o[0][0], o[0][1], 0u, false); w.x = pk_fp8(o[0][2], o[0][3], w.x, true); w.y = pk_fp8(o[1][0], o[1][1], 0u, false); w.y = pk_fp8(o[1][2], o[1][3], w.y, true);
                *(u32x2*)(T + (size_t)r * ldc + col0) = w; }
    }
};
struct EpiSwigluF8 {
    static constexpr bool PERM = true;
    unsigned char* T; int ldc; float ascale;
    __device__ __forceinline__ void operator()(const f32x4 (&acc)[2][2][4][2], const Unit& u, int wr, int wc, int fr, int fq) const {
        const int row0 = u.pm * BM + wr * 64 + fr, col0 = u.pn * 128 + wc * 32 + 8 * fq;
#pragma unroll
        for (int ai = 0; ai < 2; ++ai)
#pragma unroll
            for (int m = 0; m < 4; ++m) { unsigned char* rowp = T + (size_t)(row0 + ai * HALF + m * 16) * ldc + col0; f32x4 o4[2];
#pragma unroll
                for (int n = 0; n < 2; ++n) { const f32x4 x = acc[ai][0][m][n] * (-1.4426950408889634f * ascale); f32x4 e;
#pragma unroll
                    for (int j = 0; j < 4; ++j) e[j] = __builtin_amdgcn_exp2f(x[j]);
                    e = e + 1.0f; f32x4 r;
#pragma unroll
                    for (int j = 0; j < 4; ++j) r[j] = __builtin_amdgcn_rcpf(e[j]);
                    o4[n] = (acc[ai][0][m][n] * acc[ai][1][m][n]) * (r * (ascale * ascale)); }
                const float* o = (const float*)o4;
                u32x2 w; w.x = pk_fp8(o4[0][0], o4[0][1], 0u, false); w.x = pk_fp8(o4[0][2], o4[0][3], w.x, true); w.y = pk_fp8(o4[1][0], o4[1][1], 0u, false); w.y = pk_fp8(o4[1][2], o4[1][3], w.y, true); (void)o;
                *(u32x2*)rowp = w; }
    }
};
struct EpiScatterY {
    static constexpr bool PERM = true;
    bf16_t* y; const int* rows; const float* w; float ascale; int slot_rows; size_t slot_stride;
    __device__ __forceinline__ void operator()(const f32x4 (&acc)[2][2][4][2], const Unit& u, int wr, int wc, int fr, int fq) const {
        const int row0 = u.pm * BM + wr * 64 + fr, col0 = u.pn * BM + wc * 32 + 8 * fq; bf16_t* const yb = y + (row0 >= slot_rows ? slot_stride : (size_t)0);
#pragma unroll
        for (int ai = 0; ai < 2; ++ai)
#pragma unroll
            for (int m = 0; m < 4; ++m) { const int r = row0 + ai * HALF + m * 16, tok = rows[r]; const float rs = w[r] * ascale;
                if (tok >= 0) { bf16_t* yp = yb + (size_t)tok * 1024 + col0;
#pragma unroll
                    for (int bj = 0; bj < 2; ++bj) *(u32x4*)(yp + bj * HALF) = pack8(acc[ai][bj][m][0] * rs, acc[ai][bj][m][1] * rs); } }
    }
};
template <class Epi, class Sched, bool GATHER = false, int BMAP = 0, int ALAY = 0, bool FP8 = false, bool ALIGN_EPI = true, bool SP2 = true>
__device__ __forceinline__ void gemm_phase(PG8_LAS unsigned char* lds, const Gemm g, const Sched& S, const Epi& E) {
    int tid_ = threadIdx.x; asm volatile("" : "+v"(tid_));
    const int tid = tid_, wid = __builtin_amdgcn_readfirstlane(tid >> 6), lane = tid & 63, wr = wid >> 2, wc = wid & 3, fr = lane & 15, fq = lane >> 4;
    const int K = g.K, nt = K / BK;
    unsigned voffA[2], voffA1[2], nvA0[2], nvA1[2], voffB[2], nvB[2]; int Rg[2], Cg[2], RbS[2];
#pragma unroll
    for (int i = 0; i < 2; ++i) { int R, C; stage_rc(tid * 16 + i * 8192, R, C); const int Rb = Epi::PERM ? ((R & ~31) + perm32(R & 31)) : R; Rg[i] = R; Cg[i] = C * 2;
        voffA[i] = ALAY == 1 ? (unsigned)(C >> 3) * g.lda + (unsigned)R * 16u : (unsigned)R * g.lda + (unsigned)C * 2u; voffA1[i] = voffA[i]; nvA0[i] = voffA[i]; nvA1[i] = voffA[i];
        voffB[i] = (BMAP == 1 ? (unsigned)(64 * (Rb & 63) + (Rb >> 6)) : (unsigned)Rb) * g.ldb + (unsigned)C * 2u; RbS[i] = Rb; }
#define PG8_BKIND(kind_, dv, dh) do { const int _k = (kind_); _Pragma("unroll") for (int _i = 0; _i < 2; ++_i) { const int _r = RbS[_i]; \
        dv[_i] = (unsigned)(_k == 0 ? _r : (_k == 1 ? 64 * (_r & 63) + (_r >> 6) : (_k == 2 ? 4 * _r : 16 * _r))) * g.ldb + (unsigned)Cg[_i]; } \
        dh = (size_t)(_k == 0 ? 128 : (_k == 1 ? 2 : (_k == 2 ? 512 : 2048))) * g.ldb; } while (0)
#define PG8_GROWS(pm_, d0, d1) do { _Pragma("unroll") for (int _i = 0; _i < 2; ++_i) { int _t0 = g.rows[(pm_) * BM + Rg[_i]], _t1 = g.rows[(pm_) * BM + HALF + Rg[_i]]; _t0 = _t0 < 0 ? 0 : _t0; _t1 = _t1 < 0 ? 0 : _t1; \
        d0[_i] = (unsigned)_t0 * g.lda + (unsigned)Cg[_i]; d1[_i] = (unsigned)_t1 * g.lda + (unsigned)Cg[_i]; } } while (0)
    const size_t kstepB = (size_t)(BK * 2), kstepA = ALAY == 1 ? (size_t)8 * g.lda : kstepB;
    const size_t hstepA = GATHER ? (size_t)0 : (ALAY == 1 ? (size_t)HALF * 16 : (size_t)HALF * g.lda); size_t hstepB = (BMAP == 1 ? (size_t)2 : (size_t)HALF) * g.ldb, nhB = hstepB;
    const unsigned ldsw = (unsigned)wid * 1024u;
    const int aoff = lds_byte(wr * 64 + fr, fq * 8), boff = lds_byte(wc * 32 + fr, fq * 8);
#define PG8_SA(b, h) (((b) * 2 + (h)) * HTB)
#define PG8_SB(b, h) ((4 + (b) * 2 + (h)) * HTB)
#define PG8_STAGE(bufoff, gbase, voff) do { _Pragma("unroll") for (int _i = 0; _i < 2; ++_i) \
        __builtin_amdgcn_global_load_lds((const unsigned*)((const char*)(gbase) + (voff)[_i]), (PG8_LAS unsigned*)(lds + (bufoff) + ldsw + _i * 8192), 16, 0, 0); } while (0)
#define PG8_LDA(dst, b, h) do { if constexpr (FP8) { _Pragma("unroll") for (int m = 0; m < 4; ++m) dst##8[m] = PG8_CAT8(*(const PG8_LAS bf16x8*)(lds + PG8_SA(b, h) + aoff + m * 2048), *(const PG8_LAS bf16x8*)(lds + PG8_SA(b, h) + aoff + m * 2048 + 1024)); } \
    else { _Pragma("unroll") for (int m = 0; m < 4; ++m) _Pragma("unroll") for (int k = 0; k < 2; ++k) dst[m][k] = *(const PG8_LAS bf16x8*)(lds + PG8_SA(b, h) + aoff + m * 2048 + k * 1024); } } while (0)
#define PG8_LDB(dst, b, h) do { if constexpr (FP8) { _Pragma("unroll") for (int n = 0; n < 2; ++n) dst##8[n] = PG8_CAT8(*(const PG8_LAS bf16x8*)(lds + PG8_SB(b, h) + boff + n * 2048), *(const PG8_LAS bf16x8*)(lds + PG8_SB(b, h) + boff + n * 2048 + 1024)); } \
    else { _Pragma("unroll") for (int n = 0; n < 2; ++n) _Pragma("unroll") for (int k = 0; k < 2; ++k) dst[n][k] = *(const PG8_LAS bf16x8*)(lds + PG8_SB(b, h) + boff + n * 2048 + k * 1024); } } while (0)
#define PG8_CAT8(lo, hi) __builtin_shufflevector(__builtin_bit_cast(v4i_t, lo), __builtin_bit_cast(v4i_t, hi), 0, 1, 2, 3, 4, 5, 6, 7)
#define PG8_MMA(ai, bj, At, Bt) do { __builtin_amdgcn_s_setprio(1); if constexpr (FP8) { _Pragma("unroll") for (int m = 0; m < 4; ++m) _Pragma("unroll") for (int n = 0; n < 2; ++n) \
        asm volatile("v_mfma_f32_16x16x128_f8f6f4 %0, %1, %2, %0" : "+v"(acc[ai][bj][m][n]) : "v"(Bt##8[n]), "v"(At##8[m])); } else { \
        _Pragma("unroll") for (int m = 0; m < 4; ++m) _Pragma("unroll") for (int n = 0; n < 2; ++n) _Pragma("unroll") for (int k = 0; k < 2; ++k) \
        acc[ai][bj][m][n] = __builtin_amdgcn_mfma_f32_16x16x32_bf16(Bt[n][k], At[m][k], acc[ai][bj][m][n], 0, 0, 0); } __builtin_amdgcn_s_setprio(0); } while (0)
#define PG8_WAIT_V(n) asm volatile("s_waitcnt vmcnt(" #n ")" ::: "memory")
#define PG8_WAIT_L(n) asm volatile("s_waitcnt lgkmcnt(" #n ")" ::: "memory")
#define PG8_BAR __builtin_amdgcn_s_barrier()
#define PG8_SCHED __builtin_amdgcn_sched_barrier(0)
    Unit cur, nxt; int ui = 0;
    if (!S.next(0, cur)) return;
    f32x4 acc[2][2][4][2];
#pragma unroll
    for (int a = 0; a < 2; ++a)
#pragma unroll
        for (int b = 0; b < 2; ++b)
#pragma unroll
            for (int m = 0; m < 4; ++m)
#pragma unroll
                for (int n = 0; n < 2; ++n) acc[a][b][m][n] = (f32x4){0.f, 0.f, 0.f, 0.f};
    bf16x8 At[4][2], B0[2][2], B1[2][2]; v8i_t At8[4], B08[2], B18[2];
    const char* cA = g.A + cur.aoff; const char* cB = g.B + cur.boff;
    if constexpr (GATHER) PG8_GROWS(cur.pm, voffA, voffA1);
    if constexpr (BMAP == 2) { PG8_BKIND(cur.z, voffB, hstepB); nvB[0] = voffB[0]; nvB[1] = voffB[1]; nhB = hstepB; }
    if constexpr (SP2) {
        PG8_STAGE(PG8_SB(0, 0), cB, voffB); PG8_STAGE(PG8_SB(0, 1), cB + hstepB, voffB); PG8_STAGE(PG8_SA(0, 0), cA, voffA); PG8_STAGE(PG8_SA(0, 1), cA + hstepA, voffA1);
        if (wr == 1) PG8_BAR;
        PG8_WAIT_V(2); PG8_BAR;
        PG8_STAGE(PG8_SB(1, 0), cB + kstepB, voffB); PG8_STAGE(PG8_SA(1, 0), cA + kstepA, voffA); PG8_STAGE(PG8_SB(1, 1), cB + hstepB + kstepB, voffB);
        PG8_WAIT_V(6); PG8_BAR;
    } else {
        PG8_STAGE(PG8_SB(0, 0), cB, voffB); PG8_STAGE(PG8_SA(0, 0), cA, voffA); PG8_STAGE(PG8_SB(0, 1), cB + hstepB, voffB); PG8_STAGE(PG8_SA(0, 1), cA + hstepA, voffA);
        if (wr == 1) PG8_BAR;
        PG8_WAIT_V(4); PG8_BAR;
        PG8_STAGE(PG8_SB(1, 0), cB + kstepB, voffB); PG8_STAGE(PG8_SA(1, 0), cA + kstepA, voffA); PG8_STAGE(PG8_SB(1, 1), cB + hstepB + kstepB, voffB);
        PG8_WAIT_V(6); PG8_BAR;
    }
    for (;;) {
        const bool has_next = S.next(ui + 1, nxt);
        const char* nA = has_next ? g.A + nxt.aoff : cA; const char* nB = has_next ? g.B + nxt.boff : cB;
        if constexpr (BMAP == 2) { if (has_next) PG8_BKIND(nxt.z, nvB, nhB); else { nvB[0] = voffB[0]; nvB[1] = voffB[1]; nhB = hstepB; } }
        if constexpr (GATHER) { if (has_next) PG8_GROWS(nxt.pm, nvA0, nvA1); else {
#pragma unroll
            for (int i = 0; i < 2; ++i) { nvA0[i] = voffA[i]; nvA1[i] = voffA1[i]; } } }
#pragma unroll 1
        for (int t = 0; t < nt; t += 2) {
            if constexpr (rescale_at<Epi>::t >= 0) { if (t == rescale_at<Epi>::t) E.rescale(acc, cur, wr, wc, fr, fq); }
            const bool last = (t == nt - 2);
            const char* a1 = cA + (size_t)(t + 1) * kstepA;
            const char* a2 = last ? nA : cA + (size_t)(t + 2) * kstepA; const char* b2 = last ? nB : cB + (size_t)(t + 2) * kstepB;
            const char* a3 = a2 + kstepA; const char* b3 = b2 + kstepB;
            unsigned w0[2], w1[2];
#pragma unroll
            for (int i = 0; i < 2; ++i) { w0[i] = voffA[i]; w1[i] = voffA1[i]; }
            unsigned wB[2] = {voffB[0], voffB[1]}; size_t hB = hstepB;
            if (BMAP == 2 && last) { asm volatile("; next unit's B row map" ::: ); wB[0] = nvB[0]; wB[1] = nvB[1]; hB = nhB; }
            if (GATHER && last) { asm volatile("; next unit's gathered rows" ::: );
#pragma unroll
                for (int i = 0; i < 2; ++i) { w0[i] = nvA0[i]; w1[i] = nvA1[i]; } }
            if constexpr (SP2) {
            PG8_LDB(B0, 0, 0); PG8_LDB(B1, 0, 1); PG8_SCHED; PG8_LDA(At, 0, 0); PG8_STAGE(PG8_SA(1, 1), a1 + hstepA, voffA1);
            PG8_WAIT_V(8); PG8_WAIT_L(0); PG8_BAR; PG8_MMA(0, 0, At, B0); PG8_MMA(0, 1, At, B1); PG8_BAR; PG8_SCHED;
            PG8_LDA(At, 0, 1); PG8_STAGE(PG8_SB(0, 0), b2, wB); PG8_STAGE(PG8_SB(0, 1), b2 + hB, wB); PG8_STAGE(PG8_SA(0, 0), a2, w0);
            PG8_WAIT_V(8); PG8_WAIT_L(0); PG8_BAR; PG8_MMA(1, 0, At, B0); PG8_MMA(1, 1, At, B1); PG8_BAR; PG8_SCHED;
            PG8_LDB(B0, 1, 0); PG8_LDB(B1, 1, 1); PG8_SCHED; PG8_LDA(At, 1, 0); PG8_STAGE(PG8_SA(0, 1), a2 + hstepA, w1);
            PG8_WAIT_V(8); PG8_WAIT_L(0); PG8_BAR; PG8_MMA(0, 0, At, B0); PG8_MMA(0, 1, At, B1); PG8_BAR; PG8_SCHED;
            PG8_LDA(At, 1, 1); PG8_STAGE(PG8_SB(1, 0), b3, wB); PG8_STAGE(PG8_SB(1, 1), b3 + hB, wB); PG8_STAGE(PG8_SA(1, 0), a3, w0);
            PG8_WAIT_V(8); PG8_WAIT_L(0); PG8_BAR; PG8_MMA(1, 0, At, B0); PG8_MMA(1, 1, At, B1); PG8_BAR; PG8_SCHED;
            } else { static_assert(SP2 || (!GATHER && BMAP != 2), "GATHER / BMAP 2 need the SP2 loop");
            PG8_LDB(B0, 0, 0); PG8_SCHED; PG8_LDA(At, 0, 0); PG8_STAGE(PG8_SA(1, 1), a1 + hstepA, voffA);
            PG8_WAIT_L(8); PG8_BAR; PG8_WAIT_L(0); PG8_MMA(0, 0, At, B0); PG8_BAR; PG8_SCHED;
            PG8_LDB(B1, 0, 1); PG8_STAGE(PG8_SB(0, 0), b2, voffB);
            PG8_BAR; PG8_WAIT_L(0); PG8_MMA(0, 1, At, B1); PG8_BAR;
            PG8_LDA(At, 0, 1); PG8_STAGE(PG8_SA(0, 0), a2, voffA);
            PG8_BAR; PG8_WAIT_L(0); PG8_MMA(1, 0, At, B0); PG8_BAR; PG8_SCHED;
            PG8_STAGE(PG8_SB(0, 1), b2 + hstepB, voffB);
            PG8_WAIT_V(6); PG8_BAR; PG8_MMA(1, 1, At, B1); PG8_BAR;
            PG8_LDB(B0, 1, 0); PG8_SCHED; PG8_LDA(At, 1, 0); PG8_STAGE(PG8_SA(0, 1), a2 + hstepA, voffA);
            PG8_WAIT_L(8); PG8_BAR; PG8_WAIT_L(0); PG8_MMA(0, 0, At, B0); PG8_BAR; PG8_SCHED;
            PG8_LDB(B1, 1, 1); PG8_STAGE(PG8_SB(1, 0), b3, voffB);
            PG8_BAR; PG8_WAIT_L(0); PG8_MMA(0, 1, At, B1); PG8_BAR;
            PG8_LDA(At, 1, 1); PG8_STAGE(PG8_SA(1, 0), a3, voffA);
            PG8_BAR; PG8_WAIT_L(0); PG8_MMA(1, 0, At, B0); PG8_BAR; PG8_SCHED;
            PG8_STAGE(PG8_SB(1, 1), b3 + hstepB, voffB);
            PG8_WAIT_V(6); PG8_BAR; PG8_MMA(1, 1, At, B1); PG8_BAR;
            }
        }
        if constexpr (ALIGN_EPI) { if (wr == 0) PG8_BAR; }
        if constexpr (FP8) {
            asm volatile("s_nop 15\n\ts_nop 15\n\ts_nop 15\n\ts_nop 15\n\ts_nop 15\n\ts_nop 15\n\ts_nop 15\n\ts_nop 15" ::: "memory");
#pragma unroll
            for (int a = 0; a < 2; ++a)
#pragma unroll
                for (int b = 0; b < 2; ++b)
#pragma unroll
                    for (int m = 0; m < 4; ++m) asm volatile("" : "+v"(acc[a][b][m][0]), "+v"(acc[a][b][m][1])); }
        E(acc, cur, wr, wc, fr, fq);
        if (!has_next) break;
#pragma unroll
        for (int a = 0; a < 2; ++a)
#pragma unroll
            for (int b = 0; b < 2; ++b)
#pragma unroll
                for (int m = 0; m < 4; ++m)
#pragma unroll
                    for (int n = 0; n < 2; ++n) acc[a][b][m][n] = (f32x4){0.f, 0.f, 0.f, 0.f};
        cur = nxt; cA = nA; cB = nB; ++ui;
        if constexpr (BMAP == 2) { voffB[0] = nvB[0]; voffB[1] = nvB[1]; hstepB = nhB; }
        if constexpr (GATHER) {
#pragma unroll
            for (int i = 0; i < 2; ++i) { voffA[i] = nvA0[i]; voffA1[i] = nvA1[i]; } }
        if constexpr (ALIGN_EPI) { if (wr == 1) PG8_BAR; }
    }
    PG8_WAIT_V(0);
    if constexpr (!ALIGN_EPI) { if (wr == 0) PG8_BAR; }
    PG8_BAR;
#undef PG8_GROWS
#undef PG8_BKIND
#undef PG8_SA
#undef PG8_SB
#undef PG8_STAGE
#undef PG8_LDA
#undef PG8_LDB
#undef PG8_MMA
#undef PG8_CAT8
#undef PG8_WAIT_V
#undef PG8_WAIT_L
#undef PG8_BAR
#undef PG8_SCHED
}
}
#define GAS __attribute__((address_space(1)))
#define LAS __attribute__((address_space(3)))
typedef unsigned short bf16;
typedef unsigned v4u __attribute__((ext_vector_type(4)));
typedef float f32x4 __attribute__((ext_vector_type(4)));
typedef short bf16x8 __attribute__((ext_vector_type(8)));
typedef GAS unsigned gu32;
typedef GAS unsigned long long gu64;
#define RLX_AGENT __ATOMIC_RELAXED, __HIP_MEMORY_SCOPE_AGENT
#define LDS_WAIT() asm volatile("s_waitcnt lgkmcnt(0)" ::: "memory")
#define VM_WAIT() asm volatile("s_waitcnt vmcnt(0)" ::: "memory")
__device__ __forceinline__ unsigned long long rt() { return __builtin_amdgcn_s_memrealtime(); }
__device__ __forceinline__ unsigned f2bf(float f) { unsigned u = __builtin_bit_cast(unsigned, f); return (u + 0x7fffu + ((u >> 16) & 1u)) >> 16; }
__device__ __forceinline__ unsigned pk2(float lo, float hi) { return f2bf(lo) | (f2bf(hi) << 16); }

#define XB_TMO      128
#define XB_XCNT(j)  (256  + 64 * (j))
#define XB_XSUB(j)  (1280 + 64 * (j))
#define XB_XGEN(j)  (2304 + 64 * (j))
#define XB_TOP      3328
#define XB_TOPGEN   3392
#define XCD_BAR_WORDS 3456
#define XB_SPIN_CAP (1u << 18)

__device__ __forceinline__ unsigned xb_ld(unsigned* p)              { return __hip_atomic_load(p, __ATOMIC_RELAXED, __HIP_MEMORY_SCOPE_AGENT); }
__device__ __forceinline__ unsigned xb_add(unsigned* p, unsigned v) { return __hip_atomic_fetch_add(p, v, __ATOMIC_RELAXED, __HIP_MEMORY_SCOPE_AGENT); }
__device__ __forceinline__ unsigned xb_xcc_id() { return (unsigned)__builtin_amdgcn_s_getreg((3 << 11) | 20) & 0xFu; }
#define XB_SPIN(cond, bar) do { unsigned _sp = 0; while (cond) { __builtin_amdgcn_s_sleep(1); \
    if ((++_sp & 255u) == 0u) { if (xb_ld(&(bar)[XB_TMO])) break; if (_sp > XB_SPIN_CAP) { atomicAdd(&(bar)[XB_TMO], 1u); break; } } } } while (0)

struct XcdBarrier {
    unsigned* bar; unsigned x; unsigned G;
    volatile LAS unsigned* st;
};

__device__ __forceinline__ XcdBarrier xcd_barrier_post(unsigned* bar, volatile LAS unsigned* st) {
    XcdBarrier b; b.bar = bar; b.x = xb_xcc_id(); b.st = st; b.G = 0u;
    if (threadIdx.x == 0) (void)xb_add(&bar[XB_XCNT(b.x)], 1u);
    return b;
}
__device__ __forceinline__ void xcd_barrier_complete(unsigned* bar, unsigned x, const unsigned G, unsigned& nloc, unsigned& nx) {
    unsigned sum, cnt, mine, sp = 0u;
    for (;;) {
        sum = 0u; cnt = 0u; mine = 0u;
#pragma nounroll
        for (unsigned j = 0; j < 16; ++j) { const unsigned c = xb_ld(&bar[XB_XCNT(j)]); sum += c; cnt += (c > 0u) ? 1u : 0u; mine = (j == x) ? c : mine; }
        if (sum == G) break;
        __builtin_amdgcn_s_sleep(1);
        if ((++sp & 255u) == 0u) { if (xb_ld(&bar[XB_TMO])) break; if (sp > XB_SPIN_CAP) { atomicAdd(&bar[XB_TMO], 1u); break; } }
    }
    nloc = mine > 0u ? mine : 1u; nx = cnt > 0u ? cnt : 1u;
}

__device__ __forceinline__ void xcd_barrier(const XcdBarrier& b) {
    asm volatile("s_waitcnt vmcnt(0)" ::: "memory");
    __syncthreads();
    if (threadIdx.x == 0) {
        unsigned* bar = b.bar;
        __builtin_amdgcn_s_waitcnt(0);
        unsigned nloc = b.st[0], nx = b.st[1];
        if (nloc == 0u) { xcd_barrier_complete(bar, b.x, b.G, nloc, nx); b.st[0] = nloc; b.st[1] = nx; }
        const unsigned old = xb_add(&bar[XB_XSUB(b.x)], 1u);
        const unsigned gen = old / nloc;
        if (old + 1u == (gen + 1u) * nloc) {
            __builtin_amdgcn_fence(__ATOMIC_RELEASE, "agent");
            asm volatile("s_waitcnt vmcnt(0)" ::: "memory");
            const unsigned og = xb_add(&bar[XB_TOP], 1u);
            const unsigned tg = og / nx;
            if (og + 1u == (tg + 1u) * nx) xb_add(&bar[XB_TOPGEN], 1u);
            else XB_SPIN(xb_ld(&bar[XB_TOPGEN]) == tg, bar);
            __builtin_amdgcn_fence(__ATOMIC_ACQUIRE, "agent");
            xb_add(&bar[XB_XGEN(b.x)], 1u);
            asm volatile("s_waitcnt vmcnt(0)" ::: "memory");
        } else {
            XB_SPIN(xb_ld(&bar[XB_XGEN(b.x)]) == gen, bar);
            __builtin_amdgcn_fence(__ATOMIC_ACQUIRE, "agent");
            asm volatile("s_waitcnt vmcnt(0)" ::: "memory");
        }
    }
    __syncthreads();
}

constexpr int NWAVES = 8;
constexpr int BATCH = 8, SEQ = 4096, DM = 1024, MTOK = BATCH * SEQ, INC = 4864, FF = 3584, NEXP = 8, AW = 768, AOW = 256;
constexpr float RMS_EPS = 1e-6f;
constexpr float QSCALE = 0.125f * 1.4426950408889634f;

constexpr size_t MiB = 1u << 20;
constexpr size_t WS_CTL = 0, CTL_ZERO_BYTES = 1 * MiB;
constexpr size_t WS_WIN = 1 * MiB;
constexpr size_t WIN_L = (size_t)INC * DM * 2;
constexpr size_t WS_WM = 20 * MiB; constexpr int KMIX = AOW + DM;
constexpr size_t WS_WOUT = 25 * MiB;
constexpr size_t WS_W13 = 29 * MiB;
constexpr size_t WS_W2 = 43 * MiB;
constexpr size_t WS_ROPE = 50 * MiB;
constexpr size_t WS_SS = 502 * MiB, SS_STRIDE = (size_t)MTOK * 4;
constexpr size_t WS_H = 118 * MiB;
constexpr size_t WS_Z = WS_H;
constexpr size_t WS_UT = 182 * MiB;
constexpr size_t WS_OATT = WS_Z - (size_t)(AOW / 8) * MTOK * 16;
constexpr size_t WS_Q = 214 * MiB, WS_K = 262 * MiB, WS_V = 310 * MiB;
constexpr size_t WS_GF = 358 * MiB, WS_GA = 422 * MiB;
constexpr size_t WS_MIX = 278 * MiB;
constexpr size_t WS_H2 = 118 * MiB, WS_TT = 182 * MiB;
constexpr size_t WS_M13 = 54 * MiB, WS_M2 = 110 * MiB;
constexpr size_t WS_H2B = 138 * MiB, WS_TTB = 170 * MiB;
constexpr float W13_SCALE = 32.0f, W2_SCALE = 64.0f;
constexpr int MOE_ROWS = MTOK + 2048;
constexpr int MOE_TILES = MOE_ROWS / 256;
constexpr size_t WS_ROWTOK = 52 * MiB, WS_ROWW = WS_ROWTOK + 512 * 1024;
constexpr size_t WS_SEL = 53 * MiB, WS_WTS = WS_SEL + 128 * 1024;
constexpr size_t WS_CNT = WS_WTS + 256 * 1024, WS_PLAN = WS_CNT + 64 * 1024;
constexpr size_t WS_WG8 = 96 * MiB;
constexpr size_t WS_WQK8 = 486 * MiB;
constexpr size_t WS_WV8 = 490 * MiB;
constexpr size_t WS_X8 = 504 * MiB;
constexpr float WG_SCALE = pg8::WG8_SCALE;
constexpr size_t WS_Y = 408 * MiB;
constexpr size_t WS_END = 536 * MiB;
static_assert(WS_TTB + (size_t)2 * MOE_ROWS * FF <= WS_Y && WS_Y + (size_t)2 * MTOK * DM * 2 <= WS_END && 2 * MOE_ROWS * 4 <= 512 * 1024 && WS_PLAN + 4096 <= 54 * MiB, "moe map");
static_assert(WS_M13 + (size_t)8 * 2 * FF * DM <= WS_M2 && WS_M2 + (size_t)8 * DM * FF <= WS_H2B && WS_H2B + (size_t)MTOK * DM <= WS_TTB && WS_MIX + (size_t)MTOK * DM * 2 <= WS_GF, "d_ws map");

constexpr int XP = 2 * DM;
constexpr int CW_BAR = 4096;
constexpr int RING_BYTES = 131072, LDS_BYTES = 147456, LDSCTL_OFF = LDS_BYTES - 1024, MISC_OFF = LDSCTL_OFF + 320;
static_assert(512 * 68 * 4 <= LDSCTL_OFF, "attention state fits under the control words");

struct Args { const float* in[16]; float* out; unsigned char* ws; int G, pad; };

struct Frame { LAS unsigned char* lds; volatile LAS unsigned* MISC; gu32* ctl; int tid, lane, wave, vcu, G; };

__device__ __forceinline__ float wave_sum(float v, int lane) {
#pragma unroll
    for (int o = 1; o < 64; o <<= 1) v += __int_as_float(__builtin_amdgcn_ds_bpermute((lane ^ o) << 2, __float_as_int(v)));
    return v;
}
__device__ __forceinline__ float bflo(unsigned w) { return __uint_as_float(w << 16); }
__device__ __forceinline__ float bfhi(unsigned w) { return __uint_as_float(w & 0xffff0000u); }

struct RowMap { int kind, base;
    __device__ __forceinline__ int operator()(int n) const {
        if (kind == 0) return n + base;
        if (kind == 2) return (n >> 2) * 8 + (n & 3) + base;
        if (kind == 5) { const int isk = n >= 768, c = n - (isk ? 768 : 0), hd = c >> 6, d = c & 63; return (isk ? 768 : 0) + hd * 64 + 2 * (d & 31) + (d >> 5); }
        if (kind == 4) { const int gch = n & 1023; return (gch >> 7) * 256 + (gch & 127) + (n >= 1024 ? 128 : 0); }
        if (kind == 3) return (n >> 7) * 256 + (n & 127) + base;
        if (n < 512) return n;
        if (n < 2048) { const int isk = n >= 1280, c = n - (isk ? 1280 : 512), hd = c >> 6, d = c & 63; return (isk ? 2048 : 1280) + hd * 64 + 2 * (d & 31) + (d >> 5); }
        if (n < 2816) return 512 + (n - 2048);
        { const int gch = (n - 2816) & 1023; return 2816 + (gch >> 7) * 256 + (gch & 127) + (n >= 3840 ? 128 : 0); }
    } };
struct TrJob { const float* W; int N; void* WT; int ldk; RowMap rm; const float* gain; float scale; int item; int ldw; int f8; };
__device__ __forceinline__ void tr_load(const TrJob& j, int lane, float (&r)[32]) {
    const int nblk = j.N / 32, kb = j.item / nblk, nb = j.item % nblk, k0 = 64 * kb, n0 = 32 * nb;
#pragma unroll
    for (int i = 0; i < 32; ++i) { const int kk = 2 * i + (lane >> 5); r[i] = j.W[(size_t)(k0 + kk) * (j.ldw ? j.ldw : j.N) + n0 + (lane & 31)]; }
}
template <bool F8> __device__ __forceinline__ void tr_store(const TrJob& j, int lane, const float (&r)[32], LAS float* scr) {
    const int nblk = j.N / 32, kb = j.item / nblk, nb = j.item % nblk, k0 = 64 * kb, n0 = 32 * nb;
#pragma unroll
    for (int i = 0; i < 32; ++i) { const int kk = 2 * i + (lane >> 5); scr[kk * 33 + (lane & 31)] = r[i] * (j.gain ? j.scale * j.gain[k0 + kk] : j.scale); }
    LDS_WAIT(); asm volatile("" ::: "memory");
    const int c = lane & 7;
#pragma unroll
    for (int q = 0; q < 4; ++q) { const int n = (lane >> 3) + 8 * q; const LAS float* sp = scr + (8 * c) * 33 + n; const size_t drow = (size_t)j.rm(n0 + n) * j.ldk + k0 + 8 * c;
        if (F8) { unsigned lo = pg8::pk_fp8(sp[0 * 33], sp[1 * 33], 0u, false); lo = pg8::pk_fp8(sp[2 * 33], sp[3 * 33], lo, true);
                  unsigned hi = pg8::pk_fp8(sp[4 * 33], sp[5 * 33], 0u, false); hi = pg8::pk_fp8(sp[6 * 33], sp[7 * 33], hi, true);
                  *(GAS unsigned long long*)((unsigned char*)j.WT + drow) = (unsigned long long)lo | ((unsigned long long)hi << 32); }
        else { v4u o; o.x = pk2(sp[0 * 33], sp[1 * 33]); o.y = pk2(sp[2 * 33], sp[3 * 33]); o.z = pk2(sp[4 * 33], sp[5 * 33]); o.w = pk2(sp[6 * 33], sp[7 * 33]);
               *(GAS v4u*)((bf16*)j.WT + drow) = o; } }
    LDS_WAIT(); asm volatile("" ::: "memory");
}
__device__ __forceinline__ void rms_row(const bf16* xrow, const f32x4 (&gn)[4], f32x4 (&v)[4], int lane) {
    const GAS unsigned long long* xr = (const GAS unsigned long long*)xrow + lane; float s = 0.f;
#pragma unroll
    for (int j = 0; j < 4; ++j) { const unsigned long long w = xr[64 * j]; v[j].x = bflo((unsigned)w); v[j].y = bfhi((unsigned)w); v[j].z = bflo((unsigned)(w >> 32)); v[j].w = bfhi((unsigned)(w >> 32)); s += (v[j].x * v[j].x + v[j].y * v[j].y) + (v[j].z * v[j].z + v[j].w * v[j].w); }
    const float rstd = 1.0f / sqrtf(wave_sum(s, lane) * (1.0f / DM) + RMS_EPS);
#pragma unroll
    for (int j = 0; j < 4; ++j) v[j] = v[j] * rstd * gn[j];
}
__device__ __forceinline__ void prep_x_phase(Frame& F, const float* x, bf16* xb, float* ss, unsigned char* x8) {
    const int gw = F.vcu * NWAVES + F.wave, NGW = F.G * NWAVES;
    for (int m = gw; m < MTOK; m += NGW) { const GAS f32x4* xr = (const GAS f32x4*)(x + (size_t)m * DM) + F.lane; f32x4 v[4]; float sq = 0.f;
#pragma unroll
        for (int j = 0; j < 4; ++j) { v[j] = xr[64 * j]; sq += (v[j].x * v[j].x + v[j].y * v[j].y) + (v[j].z * v[j].z + v[j].w * v[j].w); }
        sq = wave_sum(sq, F.lane); if (F.lane < 4) ss[(size_t)m * 4 + F.lane] = F.lane == 0 ? sq : 0.f;
        GAS unsigned long long* o8 = (GAS unsigned long long*)(xb + (size_t)m * XP) + F.lane;
#pragma unroll
        for (int j = 0; j < 4; ++j) o8[64 * j] = (unsigned long long)pk2(v[j].x, v[j].y) | ((unsigned long long)pk2(v[j].z, v[j].w) << 32);
        GAS unsigned* q8 = (GAS unsigned*)(x8 + (size_t)m * DM) + F.lane;
#pragma unroll
        for (int j = 0; j < 4; ++j) { unsigned w8 = pg8::pk_fp8(v[j].x, v[j].y, 0u, false); w8 = pg8::pk_fp8(v[j].z, v[j].w, w8, true); q8[64 * j] = w8; } }
}

__device__ __forceinline__ TrJob dense_job(const Args& a, int it) {
    unsigned char* ws = a.ws;
    constexpr int I_U = 16 * (512 / 32), I_V = 16 * (768 / 32), I_AT = 4 * 32, I_OUT = 16 * 32, I_W1 = 16 * (FF / 32), I_G = 16 * (2048 / 32), I_QK = 16 * (1536 / 32);
    constexpr int PER_L = I_U + I_V + I_AT + I_OUT;
    int r = it; TrJob j; j.gain = nullptr; j.scale = 1.0f; j.rm = RowMap{0, 0}; j.ldw = 0; j.f8 = 0;
    if (r < 2 * PER_L) { const int l = r / PER_L; r -= l * PER_L;
        if (r < I_U) { j.W = a.in[2] + (size_t)l * DM * INC; j.N = 512; j.ldw = INC; j.WT = ws + WS_WIN + l * WIN_L; j.ldk = DM; j.gain = a.in[1] + l * DM; }
        else if (r < I_U + I_V) { r -= I_U; j.W = a.in[2] + (size_t)l * DM * INC + 2048; j.N = 768; j.ldw = INC; j.WT = ws + WS_WV8 + (size_t)l * 768 * DM; j.ldk = DM; j.gain = a.in[1] + l * DM; j.scale = WG_SCALE; j.f8 = 1; }
        else if (r < I_U + I_V + I_AT) { r -= I_U + I_V; j.W = a.in[4] + (size_t)l * AOW * DM; j.N = DM; j.WT = (bf16*)(ws + WS_WM) + (size_t)l * DM * KMIX; j.ldk = KMIX; }
        else { r -= I_U + I_V + I_AT; j.W = a.in[5] + (size_t)l * DM * DM; j.N = DM; j.WT = (bf16*)(ws + WS_WOUT) + (size_t)l * DM * DM; j.ldk = DM; } }
    else { r -= 2 * PER_L;
        if (r < I_W1) { j.W = a.in[7]; j.N = FF; j.WT = ws + WS_W13; j.ldk = DM; j.rm = RowMap{3, 0}; j.gain = a.in[6]; }
        else if (r < 2 * I_W1) { r -= I_W1; j.W = a.in[8]; j.N = FF; j.WT = ws + WS_W13; j.ldk = DM; j.rm = RowMap{3, 128}; j.gain = a.in[6]; }
        else if (r < 3 * I_W1) { r -= 2 * I_W1; j.W = a.in[9]; j.N = DM; j.WT = ws + WS_W2; j.ldk = FF; j.scale = W2_SCALE; j.f8 = 1; }
        else if (r < 3 * I_W1 + 2 * I_G) { r -= 3 * I_W1; const int l = r / I_G; r -= l * I_G; j.W = a.in[2] + (size_t)l * DM * INC + 2816; j.N = 2048; j.ldw = INC; j.WT = ws + WS_WG8 + (size_t)l * 2048 * DM; j.ldk = DM; j.rm = RowMap{4, 0};
               j.gain = a.in[1] + l * DM; j.scale = WG_SCALE; j.f8 = 1; }
        else { r -= 3 * I_W1 + 2 * I_G; const int l = r / I_QK; r -= l * I_QK; j.W = a.in[2] + (size_t)l * DM * INC + 512; j.N = 1536; j.ldw = INC; j.WT = ws + WS_WQK8 + (size_t)l * 1536 * DM; j.ldk = DM; j.rm = RowMap{5, 0};
               j.gain = a.in[1] + l * DM; j.scale = WG_SCALE; j.f8 = 1; } }
    j.item = r; return j;
}
constexpr int MOE_I_W1 = 16 * (FF / 32), MOE_I_W2 = (FF / 64) * 32, MOE_NITEMS = NEXP * (2 * MOE_I_W1 + MOE_I_W2), MOE_EARLY_E = 6, MOE_EARLY = MOE_EARLY_E * 2 * MOE_I_W1;
constexpr int CONV_WGS = 40, GEMM_WGS = 256 - CONV_WGS, CONV_PER_WAVE = 0, CONV_PHASE_ITEMS = CONV_WGS * NWAVES * CONV_PER_WAVE;
static_assert(2 * CONV_PHASE_ITEMS <= MOE_EARLY && GEMM_WGS % 8 == 0 && (640 + GEMM_WGS - 1) / GEMM_WGS == 3, "early conversion");
__device__ __forceinline__ TrJob moe_job(const Args& a, int v) {
    unsigned char* ws = a.ws;
    constexpr int I_W1 = MOE_I_W1;
    int e, r;
    if (v < MOE_EARLY) { e = v / (2 * I_W1); r = v - e * (2 * I_W1); }
    else { v -= MOE_EARLY; if (v < (NEXP - MOE_EARLY_E) * 2 * I_W1) { const int q = v / (2 * I_W1); e = MOE_EARLY_E + q; r = v - q * (2 * I_W1); } else { v -= (NEXP - MOE_EARLY_E) * 2 * I_W1; e = v / MOE_I_W2; r = 2 * I_W1 + (v - e * MOE_I_W2); } }
    TrJob j; j.gain = nullptr; j.scale = W13_SCALE; j.rm = RowMap{3, 0}; j.ldw = 0; j.f8 = 1;
    if (r < I_W1) { j.W = a.in[12] + (size_t)e * DM * FF; j.N = FF; j.WT = ws + WS_M13 + (size_t)e * 2 * FF * DM; j.ldk = DM; }
    else if (r < 2 * I_W1) { r -= I_W1; j.W = a.in[13] + (size_t)e * DM * FF; j.N = FF; j.WT = ws + WS_M13 + (size_t)e * 2 * FF * DM; j.ldk = DM; j.rm = RowMap{3, 128}; }
    else { r -= 2 * I_W1; j.W = a.in[14] + (size_t)e * FF * DM; j.N = DM; j.WT = ws + WS_M2 + (size_t)e * DM * FF; j.ldk = FF; j.scale = W2_SCALE; j.rm = RowMap{0, 0}; }
    j.item = r; return j;
}
__device__ __forceinline__ void p0_weights(Frame& F, const Args& a) {
    LAS float* scr = (LAS float*)(F.lds + F.wave * 16384);
    const int gw = F.vcu * NWAVES + F.wave, NGW = F.G * NWAVES;
    constexpr int I_IN = 16 * (512 / 32) + 16 * (768 / 32), I_AT = 4 * 32, I_OUT = 16 * 32, I_W1 = 16 * (FF / 32), I_W2 = (FF / 64) * 32, I_G = 16 * (2048 / 32), I_QK = 16 * (1536 / 32), NITEMS = 2 * (I_IN + I_AT + I_OUT) + 2 * I_W1 + I_W2 + 2 * I_G + 2 * I_QK;
    static_assert(I_W2 == I_W1, "dense_job counts w2's items as I_W1");
    if (gw >= NITEMS) return;
    TrJob cur = dense_job(a, gw); float rc[32]; tr_load(cur, F.lane, rc);
#pragma unroll 1
    for (int it = gw; it < NITEMS; it += NGW) { const int nx = it + NGW; const bool more = nx < NITEMS; TrJob nj = cur; float rn[32];
        if (more) { nj = dense_job(a, nx); tr_load(nj, F.lane, rn); }
        if (cur.f8) tr_store<true>(cur, F.lane, rc, scr); else tr_store<false>(cur, F.lane, rc, scr);
        if (more) { cur = nj;
#pragma unroll
            for (int i = 0; i < 32; ++i) rc[i] = rn[i]; } }
}
__device__ __forceinline__ void p0_moe_weights(Frame& F, const Args& a, int first, int NITEMS, int gw, int NGW) {
    LAS float* scr = (LAS float*)(F.lds + F.wave * 16384);
    gw += first;
    if (gw >= NITEMS) return;
    TrJob cur = moe_job(a, gw), nx1 = cur; float rc[32], r1[32];
    tr_load(cur, F.lane, rc);
    if (gw + NGW < NITEMS) { nx1 = moe_job(a, gw + NGW); tr_load(nx1, F.lane, r1); }
#pragma unroll 1
    for (int it = gw; it < NITEMS; it += NGW) { const int n2 = it + 2 * NGW; const bool more2 = n2 < NITEMS, more1 = it + NGW < NITEMS; TrJob nx2 = cur; float r2[32];
        if (more2) { nx2 = moe_job(a, n2); tr_load(nx2, F.lane, r2); }
        tr_store<true>(cur, F.lane, rc, scr);
        if (more1) { cur = nx1;
#pragma unroll
            for (int i = 0; i < 32; ++i) rc[i] = r1[i]; }
        if (more2) { nx1 = nx2;
#pragma unroll
            for (int i = 0; i < 32; ++i) r1[i] = r2[i]; } }
}
__device__ __forceinline__ void p0_tables(Frame& F, const Args& a) {
    unsigned char* ws = a.ws;
    const int gt = F.vcu * (NWAVES * 64) + F.tid, NGT = F.G * NWAVES * 64;
    float* rope = (float*)(ws + WS_ROPE);
    for (int i = gt; i < SEQ * 32; i += NGT) { const int pos = i >> 5, f = i & 31; const float inv = powf(10000.0f, -(float)f * 2.0f / 64.0f); const float ang = (float)pos * inv;
        rope[2 * i] = cosf(ang); rope[2 * i + 1] = sinf(ang); }
    LAS float* tab = (LAS float*)F.lds;
    LAS float* wl = (LAS float*)(F.lds + 1024 + F.wave * 2048);
    if (F.tid < 128) tab[F.tid] = cospif((float)F.tid * (1.0f / 64.0f));
    __syncthreads();
    const int gw = F.vcu * NWAVES + F.wave, NGW = F.G * NWAVES;
    for (int it = gw; it < 2 * DM; it += NGW) { const int l = it >> 10, j = it & 1023; const float* wf = a.in[3] + (size_t)l * 512 * DM + j;
#pragma unroll
        for (int q = 0; q < 8; ++q) wl[F.lane + 64 * q] = wf[(size_t)(F.lane + 64 * q) * DM];
        LDS_WAIT(); asm volatile("" ::: "memory");
#pragma unroll 1
        for (int o = 0; o < 16; ++o) { const int kk = o * 64 + F.lane, part = kk & 1, cf = 4 * (kk >> 3) + ((kk >> 1) & 3), g = cf >> 7, c = cf & 127, sh = part ? 96 : 0;
            const float c1 = tab[c], tw = 2.0f * c1; float u0 = part ? 0.f : 1.f, u1 = part ? tab[(c + sh) & 127] : c1;
            float acc = 0.f, acc2 = 0.f; const LAS float* wg = wl + g * 128;
#pragma unroll 4
            for (int kc = 0; kc < 128; kc += 4) { const f32x4 w4 = *(const LAS f32x4*)(wg + kc);
                const float u2 = tw * u1 - u0, u3 = tw * u2 - u1; acc += u0 * w4[0]; acc2 += u1 * w4[1]; acc += u2 * w4[2]; acc2 += u3 * w4[3]; u0 = tw * u3 - u2; u1 = tw * u0 - u3; }
            acc += acc2;
            ((bf16*)(ws + WS_WM))[(size_t)l * DM * KMIX + (size_t)j * KMIX + AOW + kk] = (bf16)f2bf(acc * 0.08838834764831845f); }
        LDS_WAIT(); asm volatile("" ::: "memory");
    }
}

__device__ __forceinline__ void fft_phase(Frame& F, const bf16* UT, bf16* Zb) {
    const int lane = F.lane, w = F.wave & 3, cg = F.wave >> 2, lr = lane & 15, lg = lane >> 4;
    LAS unsigned char* f2 = F.lds; LAS unsigned char* f1 = F.lds + 16384; LAS float* tw = (LAS float*)(F.lds + 32768);
#pragma unroll 1
    for (int idx = F.tid; idx < 4096; idx += NWAVES * 64) {
        { const int f = idx >> 8, l = (idx >> 2) & 63, e2 = idx & 3, q = f >> 2, KK = (f >> 1) & 1, cs = f & 1, llr = l & 15, llg = l >> 4; float v[2];
#pragma unroll
          for (int h = 0; h < 2; ++h) { const int e = 2 * e2 + h, n2 = 32 * KK + (e < 4 ? 4 * llg + e : 16 + 4 * llg + e - 4), k2 = 16 * q + llr; const float x = (float)((n2 * k2) & 63) * (1.0f / 32.0f); v[h] = (cs ? sinpif(x) : cospif(x)) * 0.125f; }
          *(LAS unsigned*)(f2 + f * 1024 + l * 16 + e2 * 4) = pk2(v[0], v[1]); }
        { const int f = idx >> 8, l = (idx >> 2) & 63, e2 = idx & 3, ww = f >> 2, kk = (f >> 1) & 1, cs = f & 1, llr = l & 15, llg = l >> 4; float v[2];
#pragma unroll
          for (int h = 0; h < 2; ++h) { const int n1 = 32 * kk + 8 * llg + 2 * e2 + h, k1 = 16 * ww + llr; const float x = (float)((n1 * k1) & 63) * (1.0f / 32.0f); v[h] = (cs ? -sinpif(x) : cospif(x)) * 0.125f; }
          *(LAS unsigned*)(f1 + f * 1024 + l * 16 + e2 * 4) = pk2(v[0], v[1]); }
        { const int ww = idx >> 10, l = (idx >> 4) & 63, ir = idx & 15, n2 = 16 * (ir >> 2) + 4 * (l >> 4) + (ir & 3), k1 = 16 * ww + (l & 15); const float x = (float)(n2 * k1) * (1.0f / 2048.0f);
          tw[(ww * 64 + l) * 32 + ir] = cospif(x); tw[(ww * 64 + l) * 32 + 16 + ir] = sinpif(x); }
    }
    __syncthreads();
    bf16x8 F1c[2], F1s[2];
#pragma unroll
    for (int kk = 0; kk < 2; ++kk) { F1c[kk] = *(const LAS bf16x8*)(f1 + ((w * 2 + kk) * 2) * 1024 + lane * 16); F1s[kk] = *(const LAS bf16x8*)(f1 + ((w * 2 + kk) * 2 + 1) * 1024 + lane * 16); }
    float twc[4][4], tws[4][4];
#pragma unroll
    for (int I = 0; I < 4; ++I) { const f32x4 tc = *(const LAS f32x4*)(tw + (w * 64 + lane) * 32 + 4 * I), ts = *(const LAS f32x4*)(tw + (w * 64 + lane) * 32 + 16 + 4 * I);
#pragma unroll
        for (int r = 0; r < 4; ++r) { twc[I][r] = tc[r]; tws[I][r] = ts[r]; } }
    for (int it = F.vcu * 2 + cg; it < BATCH * 128; it += F.G * 2) {
        const int b = it >> 7, quad = it & 127;
        unsigned outp[4][4][4];
#pragma unroll
        for (int cc = 0; cc < 4; ++cc) {
            const bf16* xp = UT + (size_t)(quad * 4 + cc) * MTOK + b * SEQ + 64 * lr + 8 * lg;
            bf16x8 xa[4][2];
#pragma unroll
            for (int I = 0; I < 4; ++I)
#pragma unroll
                for (int kk = 0; kk < 2; ++kk) xa[I][kk] = *(const GAS bf16x8*)(xp + 1024 * I + 32 * kk);
            f32x4 d1r[4], d1i[4];
#pragma unroll
            for (int I = 0; I < 4; ++I) { d1r[I] = (f32x4){0.f, 0.f, 0.f, 0.f}; d1i[I] = (f32x4){0.f, 0.f, 0.f, 0.f};
#pragma unroll
                for (int kk = 0; kk < 2; ++kk) { d1r[I] = __builtin_amdgcn_mfma_f32_16x16x32_bf16(xa[I][kk], F1c[kk], d1r[I], 0, 0, 0); d1i[I] = __builtin_amdgcn_mfma_f32_16x16x32_bf16(xa[I][kk], F1s[kk], d1i[I], 0, 0, 0); } }
            bf16x8 yr[2], yi[2], yn[2];
#pragma unroll
            for (int KK = 0; KK < 2; ++KK) { float vr[8], vi[8];
#pragma unroll
                for (int e = 0; e < 8; ++e) { const int I = 2 * KK + (e >> 2), r = e & 3; const float a = d1r[I][r], bb = d1i[I][r]; vr[e] = a * twc[I][r] + bb * tws[I][r]; vi[e] = bb * twc[I][r] - a * tws[I][r]; }
                v4u pr, pi, pn; pr.x = pg8::cvt_pk_bf16(vr[0], vr[1]); pr.y = pg8::cvt_pk_bf16(vr[2], vr[3]); pr.z = pg8::cvt_pk_bf16(vr[4], vr[5]); pr.w = pg8::cvt_pk_bf16(vr[6], vr[7]);
                pi.x = pg8::cvt_pk_bf16(vi[0], vi[1]); pi.y = pg8::cvt_pk_bf16(vi[2], vi[3]); pi.z = pg8::cvt_pk_bf16(vi[4], vi[5]); pi.w = pg8::cvt_pk_bf16(vi[6], vi[7]);
                pn.x = pr.x ^ 0x80008000u; pn.y = pr.y ^ 0x80008000u; pn.z = pr.z ^ 0x80008000u; pn.w = pr.w ^ 0x80008000u;
                yr[KK] = __builtin_bit_cast(bf16x8, pr); yi[KK] = __builtin_bit_cast(bf16x8, pi); yn[KK] = __builtin_bit_cast(bf16x8, pn); }
#pragma unroll
            for (int q = 0; q < 4; ++q) { f32x4 zr = (f32x4){0.f, 0.f, 0.f, 0.f}, zi = (f32x4){0.f, 0.f, 0.f, 0.f};
#pragma unroll
                for (int KK = 0; KK < 2; ++KK) { const bf16x8 fc = *(const LAS bf16x8*)(f2 + ((q * 2 + KK) * 2) * 1024 + lane * 16), fs = *(const LAS bf16x8*)(f2 + ((q * 2 + KK) * 2 + 1) * 1024 + lane * 16);
                    zr = __builtin_amdgcn_mfma_f32_16x16x32_bf16(yr[KK], fc, zr, 0, 0, 0); zr = __builtin_amdgcn_mfma_f32_16x16x32_bf16(yi[KK], fs, zr, 0, 0, 0);
                    zi = __builtin_amdgcn_mfma_f32_16x16x32_bf16(yi[KK], fc, zi, 0, 0, 0); zi = __builtin_amdgcn_mfma_f32_16x16x32_bf16(yn[KK], fs, zi, 0, 0, 0); }
#pragma unroll
                for (int r = 0; r < 4; ++r) outp[q][r][cc] = pg8::cvt_pk_bf16(zr[r], zi[r]); }
        }
#pragma unroll
        for (int q = 0; q < 4; ++q)
#pragma unroll
            for (int r = 0; r < 4; ++r) { const int k = 16 * w + 4 * lg + r + 64 * (16 * q + lr); v4u o; o.x = outp[q][r][0]; o.y = outp[q][r][1]; o.z = outp[q][r][2]; o.w = outp[q][r][3];
                *(GAS v4u*)(Zb + ((size_t)quad * MTOK + (size_t)b * SEQ + k) * 8) = o; }
    }
    __syncthreads();
}

__device__ __forceinline__ bf16x8 f8x8_bf16(unsigned long long w) {
    typedef float f32x2_t __attribute__((ext_vector_type(2)));
    const f32x2_t a = __builtin_amdgcn_cvt_pk_f32_fp8((int)(unsigned)w, false), b = __builtin_amdgcn_cvt_pk_f32_fp8((int)(unsigned)w, true),
                  c = __builtin_amdgcn_cvt_pk_f32_fp8((int)(unsigned)(w >> 32), false), d = __builtin_amdgcn_cvt_pk_f32_fp8((int)(unsigned)(w >> 32), true);
    v4u o; o.x = pg8::cvt_pk_bf16(a.x, a.y); o.y = pg8::cvt_pk_bf16(b.x, b.y); o.z = pg8::cvt_pk_bf16(c.x, c.y); o.w = pg8::cvt_pk_bf16(d.x, d.y); return __builtin_bit_cast(bf16x8, o); }
__device__ __forceinline__ void attn_mfma_phase(Frame& F, const unsigned char* Q, const unsigned char* K, const unsigned char* VT, bf16* OA) {
    LAS float* st = (LAS float*)F.lds;
    const int lane = F.lane, lr = lane & 15, lg = lane >> 4, bp16 = (lane ^ 16) << 2, bp32 = (lane ^ 32) << 2;
    for (int unit = F.vcu; unit < 256; unit += F.G) {
        const int b = unit >> 5, pb = (unit >> 2) & 7, j = unit & 3, P0 = pb * 512;
#pragma unroll 1
        for (int pass = 0; pass < 3; ++pass) {
            const int g = 2 - pass, dsh = 2 * g, dl = 1 << dsh, L = SEQ >> dsh, head = g * 4 + j, lns = 4 - dsh;
#pragma unroll 1
            for (int tt = 0; tt < 2; ++tt) {
                const int tau = F.wave * 2 + tt, r = tau >> lns, sblk = tau & ((1 << lns) - 1), iq0 = (P0 >> dsh) + 32 * sblk;
                const unsigned char* Kh = K + (size_t)b * SEQ * AW + head * 64 + 8 * lg;
                const unsigned char* Vh = VT + (size_t)(head * 64 + lr) * MTOK + (size_t)b * SEQ + r * L;
                long qf[2][2]; int prow[2]; f32x4 o[4][2]; float m[2], l[2];
#pragma unroll
                for (int qb = 0; qb < 2; ++qb) { const int pl = dl * (32 * sblk + 16 * qb + lr) + r; prow[qb] = pl;
                    const unsigned char* qp = Q + (size_t)(b * SEQ + P0 + pl) * AW + head * 64 + 8 * lg;
                    qf[qb][0] = *(const GAS long*)qp; qf[qb][1] = *(const GAS long*)(qp + 32); }
                if (pass == 0) {
#pragma unroll
                    for (int qb = 0; qb < 2; ++qb) { m[qb] = -1e30f; l[qb] = 0.f;
#pragma unroll
                        for (int t = 0; t < 4; ++t) o[t][qb] = (f32x4){0.f, 0.f, 0.f, 0.f}; }
                } else {
#pragma unroll
                    for (int qb = 0; qb < 2; ++qb) { const LAS float* sp = st + prow[qb] * 68; m[qb] = sp[64]; l[qb] = lg == 0 ? sp[65] : 0.f;
#pragma unroll
                        for (int t = 0; t < 4; ++t) o[t][qb] = *(const LAS f32x4*)(sp + 16 * t + 4 * lg); }
                }
                typedef unsigned long long u64t; u64t kf[2][2], vf[4], kfn[2][2], vfn[4];
#define ATT_LOAD(c_, kd, vd) do { const int kb_ = iq0 - 64 + 32 * (c_); int ia_ = kb_ + 8 * (lr >> 2) + (lr & 3), ib_ = ia_ + 4; ia_ = ia_ < 0 ? 0 : (ia_ >= L ? L - 1 : ia_); ib_ = ib_ < 0 ? 0 : (ib_ >= L ? L - 1 : ib_); \
        const unsigned char* ka_ = Kh + (size_t)(dl * ia_ + r) * AW; const unsigned char* kb2_ = Kh + (size_t)(dl * ib_ + r) * AW; \
        kd[0][0] = *(const GAS u64t*)ka_; kd[0][1] = *(const GAS u64t*)(ka_ + 32); kd[1][0] = *(const GAS u64t*)kb2_; kd[1][1] = *(const GAS u64t*)(kb2_ + 32); \
        int vk_ = kb_ + 8 * lg; vk_ = vk_ < 0 ? 0 : (vk_ > L - 8 ? L - 8 : vk_); \
        _Pragma("unroll") for (int t_ = 0; t_ < 4; ++t_) vd[t_] = *(const GAS u64t*)(Vh + (size_t)(16 * t_) * MTOK + vk_); } while (0)
                ATT_LOAD(0, kf, vf);
#pragma unroll
                for (int c = 0; c < 5; ++c) {
                    if (c < 4) ATT_LOAD(c + 1, kfn, vfn);
                    const int kb = iq0 - 64 + 32 * c;
                    f32x4 s[2][2];
#pragma unroll
                    for (int tl = 0; tl < 2; ++tl) {
#pragma unroll
                        for (int qb = 0; qb < 2; ++qb) { s[tl][qb] = __builtin_amdgcn_mfma_f32_16x16x32_fp8_fp8((long)kf[tl][0], qf[qb][0], (f32x4){0.f, 0.f, 0.f, 0.f}, 0, 0, 0);
                            s[tl][qb] = __builtin_amdgcn_mfma_f32_16x16x32_fp8_fp8((long)kf[tl][1], qf[qb][1], s[tl][qb], 0, 0, 0); } }
                    long pf[2];
                    if (c == 0 || c == 4 || kb < 0 || kb + 32 > L) {
#pragma unroll
                        for (int qb = 0; qb < 2; ++qb) { const int iq = iq0 + 16 * qb + lr, lo = iq - 64 < 0 ? 0 : iq - 64, hi = iq + 64 > L - 1 ? L - 1 : iq + 64; const unsigned span = (unsigned)(hi - lo); const int k0 = kb + 8 * lg - lo;
#pragma unroll
                            for (int e = 0; e < 8; ++e) s[e >> 2][qb][e & 3] = (unsigned)(k0 + e) <= span ? s[e >> 2][qb][e & 3] : -__builtin_inff(); } }
#pragma unroll
                    for (int qb = 0; qb < 2; ++qb) { float sv[8]; float mx = -__builtin_inff();
#pragma unroll
                        for (int e = 0; e < 8; ++e) { sv[e] = s[e >> 2][qb][e & 3]; mx = fmaxf(mx, sv[e]); }
                        mx = fmaxf(mx, __int_as_float(__builtin_amdgcn_ds_bpermute(bp16, __float_as_int(mx)))); mx = fmaxf(mx, __int_as_float(__builtin_amdgcn_ds_bpermute(bp32, __float_as_int(mx))));
                        const float mn = fmaxf(m[qb], mx), al = __builtin_amdgcn_exp2f(m[qb] - mn); m[qb] = mn; float ps = 0.f; float p[8];
#pragma unroll
                        for (int e = 0; e < 8; ++e) { p[e] = __builtin_amdgcn_exp2f(sv[e] - mn); ps += p[e]; }
                        l[qb] = l[qb] * al + ps;
#pragma unroll
                        for (int t = 0; t < 4; ++t) o[t][qb] = o[t][qb] * al;
                        unsigned plo = (unsigned)__builtin_amdgcn_cvt_pk_fp8_f32(p[0], p[1], 0, false); plo = (unsigned)__builtin_amdgcn_cvt_pk_fp8_f32(p[2], p[3], (int)plo, true);
                        unsigned phi = (unsigned)__builtin_amdgcn_cvt_pk_fp8_f32(p[4], p[5], 0, false); phi = (unsigned)__builtin_amdgcn_cvt_pk_fp8_f32(p[6], p[7], (int)phi, true);
                        pf[qb] = (long)((unsigned long long)plo | ((unsigned long long)phi << 32)); }
#pragma unroll
                    for (int t = 0; t < 4; ++t) {
#pragma unroll
                        for (int qb = 0; qb < 2; ++qb) o[t][qb] = __builtin_amdgcn_mfma_f32_16x16x32_fp8_fp8((long)vf[t], pf[qb], o[t][qb], 0, 0, 0); }
#pragma unroll
                    for (int tl = 0; tl < 2; ++tl) { kf[tl][0] = kfn[tl][0]; kf[tl][1] = kfn[tl][1]; }
#pragma unroll
                    for (int t = 0; t < 4; ++t) vf[t] = vfn[t];
                }
#undef ATT_LOAD
#pragma unroll
                for (int qb = 0; qb < 2; ++qb) { float lt = l[qb]; lt += __int_as_float(__builtin_amdgcn_ds_bpermute(bp16, __float_as_int(lt))); lt += __int_as_float(__builtin_amdgcn_ds_bpermute(bp32, __float_as_int(lt)));
                    if (pass < 2) { LAS float* sp = st + prow[qb] * 68;
#pragma unroll
                        for (int t = 0; t < 4; ++t) *(LAS f32x4*)(sp + 16 * t + 4 * lg) = o[t][qb];
                        if (lg == 0) { sp[64] = m[qb]; sp[65] = lt; } }
                    else { const float il = 1.0f / lt; bf16* op = OA + ((size_t)(8 * j + (lg >> 1)) * MTOK + (size_t)(b * SEQ + P0 + prow[qb])) * 8 + 4 * (lg & 1);
#pragma unroll
                        for (int t = 0; t < 4; ++t) { const f32x4 x = o[t][qb] * il; *(GAS unsigned long long*)(op + (size_t)(2 * t) * MTOK * 8) = (unsigned long long)pg8::cvt_pk_bf16(x[0], x[1]) | ((unsigned long long)pg8::cvt_pk_bf16(x[2], x[3]) << 32); } } }
            }
            __syncthreads();
        }
    }
}

__device__ __forceinline__ void norm_router_phase(Frame& F, const bf16* x, const float* gain, unsigned char* out8, const float* rw, const float* rb, int* SEL, float* WTS, int* CNT) {
    LAS float* wr = (LAS float*)F.lds;
    LAS int* sel_l = (LAS int*)(F.lds + 32768);
    for (int i = F.tid; i < DM * NEXP; i += NWAVES * 64) { const int k = i >> 3, e = i & 7; wr[(((e >> 2) * 1024) + (k & 3) * 256 + (k >> 2)) * 4 + (e & 3)] = rw[i]; }
    __syncthreads();
    f32x4 gn[4];
#pragma unroll
    for (int j = 0; j < 4; ++j) gn[j] = ((const GAS f32x4*)gain)[F.lane + 64 * j];
    typedef unsigned long long u64r;
    u64r rw_[4];
    { const GAS u64r* xr = (const GAS u64r*)(x + (size_t)(F.vcu * 128 + F.wave * 16) * XP) + F.lane;
#pragma unroll
      for (int j = 0; j < 4; ++j) rw_[j] = xr[64 * j]; }
    const bool b0 = F.lane & 1, b1 = F.lane & 2, b2 = F.lane & 4;
#pragma unroll 1
    for (int i = 0; i < 16; ++i) { const int tl = F.wave * 16 + i, m = F.vcu * 128 + tl; f32x4 v[4]; float ssq = 0.f;
#pragma unroll
        for (int j = 0; j < 4; ++j) { const u64r w = rw_[j]; v[j].x = bflo((unsigned)w); v[j].y = bfhi((unsigned)w); v[j].z = bflo((unsigned)(w >> 32)); v[j].w = bfhi((unsigned)(w >> 32));
            ssq += (v[j].x * v[j].x + v[j].y * v[j].y) + (v[j].z * v[j].z + v[j].w * v[j].w); }
        if (i < 15) { const GAS u64r* xr = (const GAS u64r*)(x + (size_t)(m + 1) * XP) + F.lane;
#pragma unroll
            for (int j = 0; j < 4; ++j) rw_[j] = xr[64 * j]; }
        const float rstd = 1.0f / sqrtf(wave_sum(ssq, F.lane) * (1.0f / DM) + RMS_EPS);
#pragma unroll
        for (int j = 0; j < 4; ++j) v[j] = v[j] * rstd * gn[j];
        GAS unsigned* o4 = (GAS unsigned*)(out8 + (size_t)m * DM) + F.lane;
#pragma unroll
        for (int j = 0; j < 4; ++j) { unsigned w8 = pg8::pk_fp8(v[j].x, v[j].y, 0u, false); w8 = pg8::pk_fp8(v[j].z, v[j].w, w8, true); o4[64 * j] = w8; }
        float lg[8];
#pragma unroll
        for (int e = 0; e < 8; ++e) lg[e] = 0.f;
#pragma unroll
        for (int j = 0; j < 4; ++j)
#pragma unroll
            for (int cc = 0; cc < 4; ++cc) { const int sl = cc * 256 + F.lane + 64 * j; const f32x4 wa = *(const LAS f32x4*)(wr + sl * 4), wb = *(const LAS f32x4*)(wr + 4096 + sl * 4); const float xv = v[j][cc];
                lg[0] += xv * wa[0]; lg[1] += xv * wa[1]; lg[2] += xv * wa[2]; lg[3] += xv * wa[3]; lg[4] += xv * wb[0]; lg[5] += xv * wb[1]; lg[6] += xv * wb[2]; lg[7] += xv * wb[3]; }
#define XCH(v_, o_) __int_as_float(__builtin_amdgcn_ds_bpermute((F.lane ^ (o_)) << 2, __float_as_int(v_)))
        float ra[4], rb2[2], rc;
#pragma unroll
        for (int t = 0; t < 4; ++t) { const float send = b0 ? lg[t] : lg[t + 4], keep = b0 ? lg[t + 4] : lg[t]; ra[t] = keep + XCH(send, 1); }
#pragma unroll
        for (int t = 0; t < 2; ++t) { const float send = b1 ? ra[t] : ra[t + 2], keep = b1 ? ra[t + 2] : ra[t]; rb2[t] = keep + XCH(send, 2); }
        { const float send = b2 ? rb2[0] : rb2[1], keep = b2 ? rb2[1] : rb2[0]; rc = keep + XCH(send, 4); }
        rc += XCH(rc, 8); rc += XCH(rc, 16); rc += XCH(rc, 32);
#undef XCH
        lg[0] = __int_as_float(__builtin_amdgcn_readlane(__float_as_int(rc), 0)) + rb[0]; lg[1] = __int_as_float(__builtin_amdgcn_readlane(__float_as_int(rc), 4)) + rb[1];
        lg[2] = __int_as_float(__builtin_amdgcn_readlane(__float_as_int(rc), 2)) + rb[2]; lg[3] = __int_as_float(__builtin_amdgcn_readlane(__float_as_int(rc), 6)) + rb[3];
        lg[4] = __int_as_float(__builtin_amdgcn_readlane(__float_as_int(rc), 1)) + rb[4]; lg[5] = __int_as_float(__builtin_amdgcn_readlane(__float_as_int(rc), 5)) + rb[5];
        lg[6] = __int_as_float(__builtin_amdgcn_readlane(__float_as_int(rc), 3)) + rb[6]; lg[7] = __int_as_float(__builtin_amdgcn_readlane(__float_as_int(rc), 7)) + rb[7];
        int e0 = 0; float v0 = lg[0];
#pragma unroll
        for (int e = 1; e < 8; ++e) if (lg[e] > v0) { v0 = lg[e]; e0 = e; }
        int e1 = 0; float v1 = -__builtin_inff();
#pragma unroll
        for (int e = 0; e < 8; ++e) if (e != e0 && lg[e] > v1) { v1 = lg[e]; e1 = e; }
        const float w0 = 1.0f / (1.0f + expf(v1 - v0)), w1 = 1.0f - w0;
        if (F.lane == 0) { sel_l[tl] = e0 | (e1 << 8); WTS[2 * (size_t)m] = w0; WTS[2 * (size_t)m + 1] = w1; }
    }
    __syncthreads();
    if (F.tid < 128) { const int me = sel_l[F.tid], e0 = me & 255, e1 = me >> 8; int r0 = 0, r1 = 0;
        for (int t = 0; t < F.tid; ++t) { const int o = sel_l[t]; r0 += ((o & 255) == e0); r1 += ((o >> 8) == e1); }
        SEL[F.vcu * 128 + F.tid] = me | (r0 << 16) | (r1 << 24); }
    else if (F.tid < 144) { const int q = F.tid - 128, s = q >> 3, e = q & 7; int n = 0;
        for (int t = 0; t < 128; ++t) { const int o = sel_l[t]; n += ((s ? (o >> 8) : (o & 255)) == e); }
        CNT[F.vcu * 16 + q] = n; }
    __syncthreads();
}
__device__ __forceinline__ void route2_phase(Frame& F, const int* SEL, const float* WTS, const int* CNT, int* ROWTOK, float* ROWW, int* PLAN) {
    LAS int* call = (LAS int*)F.lds;
    LAS int* tot = call + 4096; LAS int* basew = tot + 16; LAS int* segst = basew + 16; LAS int* ntile = segst + 16;
    for (int i = F.tid; i < 4096; i += NWAVES * 64) call[i] = CNT[i];
    __syncthreads();
    if (F.tid < 16) { int t = 0, bsum = 0; for (int w = 0; w < 256; ++w) { const int c = call[w * 16 + F.tid]; t += c; bsum += (w < F.vcu) ? c : 0; } tot[F.tid] = t; basew[F.tid] = bsum; }
    __syncthreads();
    if (F.tid < 2) { int run = 0; for (int e = 0; e < 8; ++e) { segst[F.tid * 8 + e] = run; run += (tot[F.tid * 8 + e] + 255) & ~255; } ntile[F.tid] = run >> 8; }
    __syncthreads();
    if (F.tid < 128) { const int m = F.vcu * 128 + F.tid, sl = SEL[m], e0 = sl & 255, e1 = (sl >> 8) & 255, r0 = (sl >> 16) & 255, r1 = (sl >> 24) & 255;
        const int p0 = segst[e0] + basew[e0] + r0, p1 = segst[8 + e1] + basew[8 + e1] + r1;
        ROWTOK[p0] = m; ROWW[p0] = WTS[2 * (size_t)m]; ROWTOK[MOE_ROWS + p1] = m; ROWW[MOE_ROWS + p1] = WTS[2 * (size_t)m + 1]; }
    if (F.vcu < 8) {
        for (int s = 0; s < 2; ++s) { const int q = s * 8 + F.vcu, n = tot[q], np = (n + 255) & ~255;
            for (int p = n + F.tid; p < np; p += NWAVES * 64) { ROWTOK[s * MOE_ROWS + segst[q] + p] = -1; ROWW[s * MOE_ROWS + segst[q] + p] = 0.f; } } }
    if (F.vcu == 8) {
        if (F.tid < 2) PLAN[F.tid] = ntile[F.tid];
        if (F.tid < 2 * MOE_TILES) { const int s = F.tid / MOE_TILES, t = F.tid % MOE_TILES; int e = 0;
            for (int k = 1; k < 8; ++k) if ((segst[s * 8 + k] >> 8) <= t) e = k;
            PLAN[16 + MOE_TILES * s + t] = e; } }
    __syncthreads();
}
__device__ __forceinline__ void final_norm_phase(Frame& F, float* xio, const bf16* xb, const float* gain, const bf16* y) {
    const int gw = F.vcu * NWAVES + F.wave, NGW = F.G * NWAVES;
    f32x4 gn[4];
#pragma unroll
    for (int j = 0; j < 4; ++j) gn[j] = ((const GAS f32x4*)gain)[F.lane + 64 * j];
    for (int m = gw; m < MTOK; m += NGW) { f32x4 v[4]; float s = 0.f;
        const GAS unsigned long long* xr = (const GAS unsigned long long*)(xb + (size_t)m * XP) + F.lane;
        const GAS unsigned long long* y0 = (const GAS unsigned long long*)(y + (size_t)m * DM) + F.lane; const GAS unsigned long long* y1 = (const GAS unsigned long long*)(y + ((size_t)MTOK + m) * DM) + F.lane;
#pragma unroll
        for (int j = 0; j < 4; ++j) { const unsigned long long xw = xr[64 * j]; v[j].x = bflo((unsigned)xw); v[j].y = bfhi((unsigned)xw); v[j].z = bflo((unsigned)(xw >> 32)); v[j].w = bfhi((unsigned)(xw >> 32));
            const unsigned long long a0 = y0[64 * j], a1 = y1[64 * j];
            v[j].x += bflo((unsigned)a0) + bflo((unsigned)a1); v[j].y += bfhi((unsigned)a0) + bfhi((unsigned)a1);
            v[j].z += bflo((unsigned)(a0 >> 32)) + bflo((unsigned)(a1 >> 32)); v[j].w += bfhi((unsigned)(a0 >> 32)) + bfhi((unsigned)(a1 >> 32));
            s += (v[j].x * v[j].x + v[j].y * v[j].y) + (v[j].z * v[j].z + v[j].w * v[j].w); }
        const float rstd = 1.0f / sqrtf(wave_sum(s, F.lane) * (1.0f / DM) + RMS_EPS);
        GAS f32x4* o = (GAS f32x4*)(xio + (size_t)m * DM) + F.lane;
#pragma unroll
        for (int j = 0; j < 4; ++j) o[64 * j] = v[j] * rstd * gn[j]; }
}

struct MoeOrder { int nT0, nM, nN, nwg, G, c; unsigned lda, ldb; const int* tile_e; size_t estride; bool gather;
    __device__ bool next(int i, pg8::Unit& u) const {
        const long L = (long)i * G + c; if (L >= nwg) return false;
        int wgid = (int)L; { const int q = nwg / pg8::NXCD, r = nwg % pg8::NXCD, xcd = wgid % pg8::NXCD, off = wgid / pg8::NXCD; wgid = (xcd < r ? xcd * (q + 1) : r * (q + 1) + (xcd - r) * q) + off; }
        const int nig = pg8::WGM * nN, gid = wgid / nig, fm = gid * pg8::WGM, gsz = (nM - fm) < pg8::WGM ? (nM - fm) : pg8::WGM;
        const int lin = fm + ((wgid % nig) % gsz); u.pm = lin < nT0 ? lin : MOE_TILES + (lin - nT0); u.pn = (wgid % nig) / gsz; u.z = __builtin_amdgcn_readfirstlane(tile_e[u.pm]);
        u.aoff = gather ? (size_t)0 : (size_t)u.pm * 256 * lda; u.boff = (size_t)u.z * estride + (size_t)u.pn * 256 * ldb; return true; } };

template <class Epi, int BMAP = 0, int ALAY = 0> __device__ __forceinline__ void run_gemm(Frame& F, const void* A, unsigned lda, const void* B, unsigned ldb, int Mrows, int Ncols, int K, const Epi& E, int geff = 0) {
    int G_ = geff ? geff : F.G, c_ = (int)blockIdx.x; asm volatile("" : "+s"(G_), "+s"(c_));
    pg8::Gemm g{(const char*)A, (const char*)B, lda, ldb, K, nullptr}; pg8::PlainOrder S; S.init(Mrows, Ncols, G_, c_, lda, ldb, BMAP, ALAY);
    pg8::gemm_phase<Epi, pg8::PlainOrder, false, BMAP, ALAY>(F.lds, g, S, E);
}

__device__ __forceinline__ Args load_args() {
    Args r{};
#if defined(__HIP_DEVICE_COMPILE__)
    typedef const __attribute__((address_space(4))) Args CArgs;
    auto p = __builtin_amdgcn_kernarg_segment_ptr(); asm volatile("" : "+s"(p)); CArgs* q = (CArgs*)p;
#pragma unroll
    for (int i = 0; i < 16; ++i) r.in[i] = q->in[i];
    r.out = q->out; r.ws = q->ws; r.G = q->G;
#endif
    return r;
}
__device__ __forceinline__ Frame make_frame(LAS unsigned char* lds, unsigned char* ws, int G) {
    Frame F; int t = threadIdx.x, g = G, bx = blockIdx.x; asm volatile("" : "+v"(t), "+s"(g), "+s"(bx));
    F.lds = lds; F.MISC = (volatile LAS unsigned*)(lds + MISC_OFF); F.ctl = (gu32*)(ws + WS_CTL);
    F.tid = t; F.lane = t & 63; F.wave = __builtin_amdgcn_readfirstlane(t >> 6); F.G = g; F.vcu = (g % 8 == 0) ? (bx % 8) * (g / 8) + bx / 8 : bx; return F; }
#define PH_BEGIN const Args a = load_args(); unsigned char* const ws = a.ws; float* const xout = a.out; bf16* const xsA = (bf16*)a.out; bf16* const xsB = xsA + DM; Frame F = make_frame((LAS unsigned char*)lds, ws, a.G); (void)xout; (void)xsA; (void)xsB
__global__ void __launch_bounds__(NWAVES * 64, 2) fwd_kernel(Args args) {
    extern __shared__ __attribute__((aligned(16))) unsigned char lds[];
    for (int u = threadIdx.x; u < (LDS_BYTES - LDSCTL_OFF) / 4; u += NWAVES * 64) ((LAS unsigned*)((LAS unsigned char*)lds + LDSCTL_OFF))[u] = 0u;
    __syncthreads();
    XcdBarrier bar = xcd_barrier_post((unsigned*)(args.ws + WS_CTL) + CW_BAR, (volatile LAS unsigned*)((LAS unsigned char*)lds + MISC_OFF) + 8);
    bar.G = (unsigned)args.G;
#define GRID_BAR() do { XcdBarrier b2_ = bar; asm volatile("" : "+s"(b2_.bar), "+s"(b2_.x), "+s"(b2_.G)); xcd_barrier(b2_); } while (0)

    { PH_BEGIN; p0_weights(F, a); __syncthreads(); p0_tables(F, a); prep_x_phase(F, a.in[0], xsA, (float*)(ws + WS_SS), ws + WS_X8); }
    GRID_BAR();

    for (int layer = 0; layer < 2; ++layer) {
        asm volatile("" : "+s"(layer));
        { PH_BEGIN; int lyr = layer; asm volatile("" : "+s"(lyr)); const bf16* WinT = (const bf16*)(ws + WS_WIN + lyr * WIN_L);
          pg8::EpiInproj E{ws, WS_V, WS_Q, WS_K, WS_GF, WS_GA, WS_ROPE, QSCALE, (const float*)(ws + WS_SS) + (size_t)(2 * lyr) * SS_STRIDE, 1.0f / WG_SCALE};
          int G_ = F.G, c_ = (int)blockIdx.x; asm volatile("" : "+s"(G_), "+s"(c_));
          pg8::Gemm g{(const char*)(ws + WS_X8), (const char*)(ws + WS_WQK8 + (size_t)lyr * 1536 * DM), DM, DM, DM / 2, nullptr}; pg8::PlainOrder S; S.init(MTOK, 1536, G_, c_, DM, DM, 0, 0);
          pg8::gemm_phase<pg8::EpiInproj, pg8::PlainOrder, false, 0, 0, true>(F.lds, g, S, E); }
        { PH_BEGIN; int lyr = layer; asm volatile("" : "+s"(lyr)); const bf16* WinT = (const bf16*)(ws + WS_WIN + lyr * WIN_L);
          int bx_ = (int)blockIdx.x; asm volatile("" : "+s"(bx_));
          if (bx_ < 128) { pg8::EpiBf16 E{(bf16*)(ws + WS_UT), MTOK, (bf16*)(ws + WS_V), 2, (const float*)(ws + WS_SS) + (size_t)(2 * lyr) * SS_STRIDE, 1.0f};
            run_gemm<pg8::EpiBf16, 2, 0>(F, WinT, DM * 2, xsA, XP * 2, 512, MTOK, DM, E, 128); }
          else { pg8::EpiBf16 E{(bf16*)(ws + WS_UT), MTOK, (bf16*)(ws + WS_V), 2, (const float*)(ws + WS_SS) + (size_t)(2 * lyr) * SS_STRIDE, 1.0f / WG_SCALE};
            int G_ = 128, c_ = bx_ - 128; asm volatile("" : "+s"(G_), "+s"(c_));
            pg8::Gemm g{(const char*)(ws + WS_WV8 + (size_t)lyr * 768 * DM), (const char*)(ws + WS_X8), DM, DM, DM / 2, nullptr}; pg8::PlainOrder S; S.init(768, MTOK, G_, c_, DM, DM, 2, 0); S.pmoff = 2;
            pg8::gemm_phase<pg8::EpiBf16, pg8::PlainOrder, false, 2, 0, true>(F.lds, g, S, E); } }
        GRID_BAR();
        { PH_BEGIN; fft_phase(F, (const bf16*)(ws + WS_UT), (bf16*)(ws + WS_Z)); }
        { PH_BEGIN; attn_mfma_phase(F, ws + WS_Q, ws + WS_K, ws + WS_V, (bf16*)(ws + WS_OATT)); }
        { PH_BEGIN; int lyr = layer; asm volatile("" : "+s"(lyr)); int G_ = F.G, c_ = (int)blockIdx.x; asm volatile("" : "+s"(G_), "+s"(c_));
          pg8::Gemm g{(const char*)(ws + WS_X8), (const char*)(ws + WS_WG8 + (size_t)lyr * 2048 * DM), DM, DM, DM / 2, nullptr}; pg8::PlainOrder S; S.init(MTOK, 2048, G_, c_, DM, DM, 0, 0);
          pg8::EpiGates8 E{ws, WS_GF, WS_GA, (const float*)(ws + WS_SS) + (size_t)(2 * lyr) * SS_STRIDE}; pg8::gemm_phase<pg8::EpiGates8, pg8::PlainOrder, false, 0, 0, true>(F.lds, g, S, E); }
        GRID_BAR();
        { PH_BEGIN; int lyr = layer; asm volatile("" : "+s"(lyr)); pg8::EpiMix E{ws + WS_GF, ws + WS_GA, (bf16*)(ws + WS_MIX)};
          run_gemm<pg8::EpiMix, 0, 1>(F, ws + WS_OATT, MTOK * 16, (const bf16*)(ws + WS_WM) + (size_t)lyr * DM * KMIX, KMIX * 2, MTOK, DM, KMIX, E); }
        GRID_BAR();
        if (layer == 0) { PH_BEGIN; pg8::EpiResid<true> E{xsA, xsB, XP, (float*)(ws + WS_SS) + SS_STRIDE, nullptr, 1.0f};
          run_gemm(F, ws + WS_MIX, DM * 2, ws + WS_WOUT, DM * 2, MTOK, DM, DM, E); }
        else { PH_BEGIN; pg8::EpiResid<false> E{xsA, xsB, XP, nullptr, nullptr, 1.0f};
          run_gemm(F, ws + WS_MIX, DM * 2, (const bf16*)(ws + WS_WOUT) + (size_t)DM * DM, DM * 2, MTOK, DM, DM, E); }
        GRID_BAR();
        if (layer == 0) {
            { PH_BEGIN; int lyr = layer; asm volatile("" : "+s"(lyr)); pg8::EpiSwiglu E{ws + WS_TT, FF, (const float*)(ws + WS_SS) + SS_STRIDE}; run_gemm(F, xsB, XP * 2, ws + WS_W13, DM * 2, MTOK, 2 * FF, DM, E); }
            GRID_BAR();
            { PH_BEGIN; int lyr = layer; asm volatile("" : "+s"(lyr)); pg8::EpiResid<true> E{xsB, xsA, XP, (float*)(ws + WS_SS) + 2 * SS_STRIDE, ws + WS_X8, 1.0f / W2_SCALE}; int G_ = F.G, c_ = (int)blockIdx.x; asm volatile("" : "+s"(G_), "+s"(c_));
              pg8::Gemm g{(const char*)(ws + WS_TT), (const char*)(ws + WS_W2), FF, FF, FF / 2, nullptr}; pg8::PlainOrder S; S.init(MTOK, DM, G_, c_, FF, FF, 0, 0); pg8::gemm_phase<pg8::EpiResid<true>, pg8::PlainOrder, false, 0, 0, true>(F.lds, g, S, E); }
            GRID_BAR();
        } else {
            { PH_BEGIN; int lyr = layer; asm volatile("" : "+s"(lyr)); p0_moe_weights(F, a, 2 * CONV_PHASE_ITEMS, MOE_NITEMS, F.vcu * NWAVES + F.wave, F.G * NWAVES); __syncthreads();
              norm_router_phase(F, xsB, a.in[6] + DM, ws + WS_H2B, a.in[10], a.in[11], (int*)(ws + WS_SEL), (float*)(ws + WS_WTS), (int*)(ws + WS_CNT)); }
            GRID_BAR();
            { PH_BEGIN; int lyr = layer; asm volatile("" : "+s"(lyr)); route2_phase(F, (const int*)(ws + WS_SEL), (const float*)(ws + WS_WTS), (const int*)(ws + WS_CNT), (int*)(ws + WS_ROWTOK), (float*)(ws + WS_ROWW), (int*)(ws + WS_PLAN)); }
            GRID_BAR();
            { PH_BEGIN; int G_ = F.G, c_ = (int)blockIdx.x; asm volatile("" : "+s"(G_), "+s"(c_));
              const int* plan = (const int*)(ws + WS_PLAN); const int nT0 = __builtin_amdgcn_readfirstlane(plan[0]), nT1 = __builtin_amdgcn_readfirstlane(plan[1]);
              pg8::Gemm g{(const char*)(ws + WS_H2B), (const char*)(ws + WS_M13), DM, DM, DM / 2, (const int*)(ws + WS_ROWTOK)};
              MoeOrder S{nT0, nT0 + nT1, 2 * FF / 256, (nT0 + nT1) * (2 * FF / 256), G_, c_, DM, DM, plan + 16, (size_t)2 * FF * DM, true};
              pg8::EpiSwigluF8 E{ws + WS_TTB, FF, 1.0f / W13_SCALE}; pg8::gemm_phase<pg8::EpiSwigluF8, MoeOrder, true, 0, 0, true>(F.lds, g, S, E); }
            GRID_BAR();
            { PH_BEGIN; int G_ = F.G, c_ = (int)blockIdx.x; asm volatile("" : "+s"(G_), "+s"(c_));
              const int* plan = (const int*)(ws + WS_PLAN); const int nT0 = __builtin_amdgcn_readfirstlane(plan[0]), nT1 = __builtin_amdgcn_readfirstlane(plan[1]);
              pg8::Gemm g{(const char*)(ws + WS_TTB), (const char*)(ws + WS_M2), FF, FF, FF / 2, nullptr};
              MoeOrder S{nT0, nT0 + nT1, DM / 256, (nT0 + nT1) * (DM / 256), G_, c_, FF, FF, plan + 16, (size_t)DM * FF, false};
              pg8::EpiScatterY E{(bf16*)(ws + WS_Y), (const int*)(ws + WS_ROWTOK), (const float*)(ws + WS_ROWW), 1.0f / W2_SCALE, MOE_ROWS, (size_t)MTOK * DM};
              pg8::gemm_phase<pg8::EpiScatterY, MoeOrder, false, 0, 0, true>(F.lds, g, S, E); }
            GRID_BAR();
        }
    }
    { PH_BEGIN; final_norm_phase(F, xout, xsB, a.in[15], (const bf16*)(ws + WS_Y)); }
#undef GRID_BAR
}

extern "C" void kernel_launch(void* const* d_in, const int* in_sizes, int n_in, void* d_out, int out_size, void* d_ws, size_t ws_size, hipStream_t stream) {
    static int grid = 0;
    if (grid == 0) {
        if (n_in != 16 || out_size != MTOK * DM || ws_size < WS_END) { fprintf(stderr, "kernel_launch: unexpected problem (n_in %d, out %d, ws %zu); nothing launched\n", n_in, out_size, ws_size); grid = -1; return; }
        int dev = 0, cus = 0;
        if (hipGetDevice(&dev) != hipSuccess || hipDeviceGetAttribute(&cus, hipDeviceAttributeMultiprocessorCount, dev) != hipSuccess) { grid = -1; return; }
        if (hipFuncSetAttribute((const void*)fwd_kernel, hipFuncAttributeMaxDynamicSharedMemorySize, LDS_BYTES) != hipSuccess) { fprintf(stderr, "kernel_launch: hipFuncSetAttribute failed\n"); grid = -1; return; }
        int per_cu = 0;
        if (hipOccupancyMaxActiveBlocksPerMultiprocessor(&per_cu, (const void*)fwd_kernel, NWAVES * 64, LDS_BYTES) != hipSuccess || per_cu < 1) fprintf(stderr, "kernel_launch: occupancy query reports %d\n", per_cu);
        (void)hipGetLastError();
        if (cus != 256) { fprintf(stderr, "kernel_launch: %d CUs; the router / attention unit maps assume a grid of 256\n", cus); grid = -1; return; }
        grid = cus;
    }
    if (grid < 0) return;
    (void)hipMemsetAsync((char*)d_ws + WS_CTL, 0, CTL_ZERO_BYTES, stream);
    Args a{};
    for (int i = 0; i < 16; ++i) a.in[i] = (const float*)d_in[i];
    a.out = (float*)d_out; a.ws = (unsigned char*)d_ws; a.G = grid; a.pad = 0;
    hipLaunchKernelGGL(fwd_kernel, dim3(grid), dim3(NWAVES * 64), LDS_BYTES, stream, a);
}
```
